# Optimizing an MI355X kernel written in HIP

```python
import math
import jax, jax.numpy as jnp
from jax import lax
import numpy as np

D_MODEL = 1024
BATCH = 4
SEQ = 4096
DEPTH = 1
DEC_BATCH = 4
DEC_SEQ = 8192
PAST_LEN = 128

HEAD_DIM = 64
N_Q_HEADS = 8
N_KV_HEADS = 2
GROUP = N_Q_HEADS // N_KV_HEADS
ATTN_W = N_Q_HEADS * HEAD_DIM
KV_W = N_KV_HEADS * HEAD_DIM
POOL_WINDOWS = (2, 4, 8, 16)
POOL_CH = 128
POOL_W = POOL_CH * len(POOL_WINDOWS)
MIX_W = ATTN_W + POOL_W
IN_W = ATTN_W + 2 * KV_W + POOL_W
D_FF = 4 * D_MODEL
PLE_DIM = 256
GRID_W = 64
ROPE_THETA = 10000.0
ROPE_PAIRS = HEAD_DIM // 4
Q_BLOCK = 128
EPS = 1e-6

kernel_name = "hybrid_gqa_pool_encoder"


def _rmsnorm(x, g):
    xf = x.astype(jnp.float32)
    y = xf * lax.rsqrt(jnp.mean(xf * xf, axis=-1, keepdims=True) + EPS)
    return (y * g.astype(jnp.float32)).astype(x.dtype)


def _grid_angles(T):
    rows = T // GRID_W
    row = jnp.repeat(jnp.arange(rows, dtype=jnp.float32), GRID_W)
    col = jnp.tile(jnp.arange(GRID_W, dtype=jnp.float32), rows)
    inv_freq = ROPE_THETA ** (-jnp.arange(ROPE_PAIRS, dtype=jnp.float32) / ROPE_PAIRS)
    return row[:, None] * inv_freq[None, :], col[:, None] * inv_freq[None, :]


def _rope_half(x, ang):
    x1, x2 = x[..., :ROPE_PAIRS], x[..., ROPE_PAIRS:]
    c = jnp.cos(ang)[None, :, None, :]
    s = jnp.sin(ang)[None, :, None, :]
    return jnp.concatenate([x1 * c - x2 * s, x2 * c + x1 * s], axis=-1)


def _axial_rope(x, ang_row, ang_col):
    xf = x.astype(jnp.float32)
    half = HEAD_DIM // 2
    y = jnp.concatenate([_rope_half(xf[..., :half], ang_row),
                         _rope_half(xf[..., half:], ang_col)], axis=-1)
    return y.astype(x.dtype)


def _attention(q, k, v, q_g, k_g):
    B, T = q.shape[0], q.shape[1]
    ang_row, ang_col = _grid_angles(T)
    q = _axial_rope(_rmsnorm(q, q_g), ang_row, ang_col)
    k = _axial_rope(_rmsnorm(k, k_g), ang_row, ang_col)
    scale = 1.0 / math.sqrt(HEAD_DIM)
    nb = T // Q_BLOCK
    qb = q.reshape(B, nb, Q_BLOCK, N_KV_HEADS, GROUP, HEAD_DIM).transpose(1, 0, 2, 3, 4, 5)

    def block(qi):
        s = jnp.einsum('bqkgd,bskd->bkgqs', qi, k).astype(jnp.float32) * scale
        p = jax.nn.softmax(s, axis=-1).astype(v.dtype)
        return jnp.einsum('bkgqs,bskd->bqkgd', p, v)

    o = lax.map(block, qb)
    return o.transpose(1, 0, 2, 3, 4, 5).reshape(B, T, ATTN_W)


def _pool_mixer(u, w_pool, pool_scale):
    B, T, C = u.shape
    uf = u.astype(jnp.float32)
    cs = jnp.concatenate([jnp.zeros((B, 1, C), jnp.float32), jnp.cumsum(uf, axis=1)], axis=1)
    t = jnp.arange(T)
    outs = []
    for g, w in enumerate(POOL_WINDOWS):
        half = w // 2
        lo = jnp.clip(t - half, 0, T)
        hi = jnp.clip(t + half, 0, T)
        csg = cs[:, :, g * POOL_CH:(g + 1) * POOL_CH]
        win_sum = jnp.take(csg, hi, axis=1) - jnp.take(csg, lo, axis=1)
        mean = win_sum / (hi - lo).astype(jnp.float32)[None, :, None]
        outs.append(mean - uf[:, :, g * POOL_CH:(g + 1) * POOL_CH])
    d = jnp.stack(outs, axis=2).astype(u.dtype)
    y = jnp.einsum('btgc,gcd->btgd', d, w_pool).reshape(B, T, C)
    return y * pool_scale


def _layer(h, p_i, norm_mix_g, w_in, q_norm_g, k_norm_g, w_pool, pool_scale, w_out,
           norm_mlp_g, w_up, w_down, norm_ple_g, w_ple_gate, w_ple_proj):
    B, T, _ = h.shape
    a = _rmsnorm(h, norm_mix_g)
    z = a @ w_in
    q = z[..., :ATTN_W].reshape(B, T, N_Q_HEADS, HEAD_DIM)
    k = z[..., ATTN_W:ATTN_W + KV_W].reshape(B, T, N_KV_HEADS, HEAD_DIM)
    v = z[..., ATTN_W + KV_W:ATTN_W + 2 * KV_W].reshape(B, T, N_KV_HEADS, HEAD_DIM)
    u = z[..., ATTN_W + 2 * KV_W:]
    o_attn = _attention(q, k, v, q_norm_g, k_norm_g)
    o_pool = _pool_mixer(u, w_pool, pool_scale)
    h = h + jnp.concatenate([o_attn, o_pool], axis=-1) @ w_out
    m = _rmsnorm(h, norm_mlp_g)
    h = h + jnp.square(jax.nn.relu(m @ w_up)) @ w_down
    gate = jax.nn.sigmoid((_rmsnorm(h, norm_ple_g) @ w_ple_gate).astype(jnp.float32)).astype(h.dtype)
    h = h + gate * (p_i @ w_ple_proj)
    return h


def _trunk(x, p, norm_mix_g, w_in, q_norm_g, k_norm_g, w_pool, pool_scale, w_out,
           norm_mlp_g, w_up, w_down, norm_ple_g, w_ple_gate, w_ple_proj, final_norm_g):
    h = x
    for i in range(DEPTH):
        h = _layer(h, p[i], norm_mix_g[i], w_in[i], q_norm_g[i], k_norm_g[i], w_pool[i],
                   pool_scale[i], w_out[i], norm_mlp_g[i], w_up[i], w_down[i],
                   norm_ple_g[i], w_ple_gate[i], w_ple_proj[i])
    return _rmsnorm(h, final_norm_g)


def setup_inputs(seed: int = 0) -> dict:
    key = jax.random.key(seed)
    ks = jax.random.split(key, 20)
    f32 = jnp.float32

    def nrm(k, shape, scale):
        return jax.random.normal(k, shape, f32) * scale

    def gain(k, shape):
        return 1.0 + 0.05 * jax.random.normal(k, shape, f32)

    return {
        "x_prompt": nrm(ks[0], (BATCH, SEQ, D_MODEL), 1.0),
        "x_sample": nrm(ks[1], (DEC_BATCH, DEC_SEQ, D_MODEL), 1.0),
        "p_prompt": nrm(ks[2], (DEPTH, BATCH, SEQ, PLE_DIM), 1.0),
        "p_sample": nrm(ks[3], (DEPTH, DEC_BATCH, DEC_SEQ, PLE_DIM), 1.0),
        "norm_mix_g": gain(ks[4], (DEPTH, D_MODEL)),
        "w_in": nrm(ks[5], (DEPTH, D_MODEL, IN_W), D_MODEL ** -0.5),
        "q_norm_g": gain(ks[6], (DEPTH, HEAD_DIM)),
        "k_norm_g": gain(ks[7], (DEPTH, HEAD_DIM)),
        "w_pool": nrm(ks[8], (DEPTH, len(POOL_WINDOWS), POOL_CH, POOL_CH), POOL_CH ** -0.5),
        "pool_scale": gain(ks[9], (DEPTH, POOL_W)),
        "w_out": nrm(ks[10], (DEPTH, MIX_W, D_MODEL), MIX_W ** -0.5),
        "norm_mlp_g": gain(ks[11], (DEPTH, D_MODEL)),
        "w_up": nrm(ks[12], (DEPTH, D_MODEL, D_FF), D_MODEL ** -0.5),
        "w_down": nrm(ks[13], (DEPTH, D_FF, D_MODEL), D_FF ** -0.5),
        "norm_ple_g": gain(ks[14], (DEPTH, D_MODEL)),
        "w_ple_gate": nrm(ks[15], (DEPTH, D_MODEL, D_MODEL), D_MODEL ** -0.5),
        "w_ple_proj": nrm(ks[16], (DEPTH, PLE_DIM, D_MODEL), PLE_DIM ** -0.5),
        "final_norm_g": gain(ks[17], (D_MODEL,)),
    }


def reference(x_prompt, x_sample, p_prompt, p_sample, norm_mix_g, w_in, q_norm_g, k_norm_g,
              w_pool, pool_scale, w_out, norm_mlp_g, w_up, w_down, norm_ple_g, w_ple_gate,
              w_ple_proj, final_norm_g):
    y_prompt = _trunk(x_prompt, p_prompt, norm_mix_g, w_in, q_norm_g, k_norm_g, w_pool, pool_scale,
                      w_out, norm_mlp_g, w_up, w_down, norm_ple_g, w_ple_gate, w_ple_proj, final_norm_g)
    y_sample = _trunk(x_sample, p_sample, norm_mix_g, w_in, q_norm_g, k_norm_g, w_pool, pool_scale,
                      w_out, norm_mlp_g, w_up, w_down, norm_ple_g, w_ple_gate, w_ple_proj, final_norm_g)
    return (y_prompt, y_sample)
```

```cpp
#include <hip/hip_runtime.h>
#include <cstdio>
#include <cstdint>

#ifndef MK_ONE_LAUNCH
#define MK_ONE_LAUNCH 0
#endif

constexpr int DM = 1024, TP = 4096, TS = 8192, MP = 4 * TP, MS = 4 * TS, M = MP + MS;
constexpr int INW = 1280, DFF = 4096, PLE = 256;
constexpr int CHUNK = 16384, NCHUNK = M / CHUNK;
constexpr float EPS = 1e-6f;
constexpr float C2 = 0.125f * 1.4426950408889634f;

typedef unsigned short bf16;
typedef short bf16x8 __attribute__((ext_vector_type(8)));
typedef float f32x4 __attribute__((ext_vector_type(4)));
typedef unsigned u32x4 __attribute__((ext_vector_type(4)));
typedef unsigned u32x2 __attribute__((ext_vector_type(2)));
#define LAS __attribute__((address_space(3)))
#define GAS __attribute__((address_space(1)))

constexpr size_t MiB = 1u << 20;
constexpr size_t WS_CTL = 0, CTL_ZERO_BYTES = 1 * MiB;
constexpr size_t WS_ROPE = 1 * MiB;
constexpr size_t WS_SS1 = 2 * MiB, WS_SS2 = 5 * MiB;
constexpr size_t WS_WIN = 8 * MiB, WS_WOUT = 11 * MiB, WS_WUP = 13 * MiB, WS_WDOWN = 21 * MiB, WS_WGATE = 29 * MiB, WS_WPROJ = 31 * MiB;
constexpr size_t WS_PP = 32 * MiB;
constexpr size_t WS_XN = 128 * MiB;
constexpr size_t WS_PB = 224 * MiB;
constexpr size_t WS_Q = 248 * MiB, WS_K = 296 * MiB, WS_V = 308 * MiB, WS_U = 320 * MiB;
constexpr size_t WS_MIX = 368 * MiB;
constexpr size_t WS_HM = 224 * MiB;
constexpr size_t WS_END = 464 * MiB;

constexpr int LDS_BYTES = 147456;
constexpr int NWAVES = 8;

__device__ __forceinline__ unsigned f2bf(float f) { unsigned u = __builtin_bit_cast(unsigned, f); return (u + 0x7fffu + ((u >> 16) & 1u)) >> 16; }
__device__ __forceinline__ unsigned pk2(float lo, float hi) { return f2bf(lo) | (f2bf(hi) << 16); }
__device__ __forceinline__ float bf2f(unsigned short b) { return __builtin_bit_cast(float, (unsigned)b << 16); }
__device__ __forceinline__ float bflo(unsigned w) { return __builtin_bit_cast(float, w << 16); }
__device__ __forceinline__ float bfhi(unsigned w) { return __builtin_bit_cast(float, w & 0xffff0000u); }
__device__ __forceinline__ float wave_sum(float v) {
#pragma unroll
    for (int o = 1; o < 64; o <<= 1) v += __shfl_xor(v, o);
    return v;
}
__host__ __device__ __forceinline__ int inv_head(int n) { const int pn = n >> 8, r = n & 255, wc = r >> 6, bj = (r >> 5) & 1, j = r & 31; return pn * 256 + bj * 128 + wc * 32 + j; }

struct Args { const float* in[18]; float* out; unsigned char* ws; int ph_lo, ph_hi; };

struct Frame {
    LAS unsigned char* lds;
    int tid, lane, wave, vcu, G;
    const float* in[18]; float* out; unsigned char* ws;
};
__device__ __forceinline__ const float* xrow(const Frame& F, int m) { return m < MP ? F.in[0] + (size_t)m * DM : F.in[1] + (size_t)(m - MP) * DM; }
__device__ __forceinline__ const float* prow(const Frame& F, int m) { return m < MP ? F.in[2] + (size_t)m * PLE : F.in[3] + (size_t)(m - MP) * PLE; }
__device__ __forceinline__ int tpos(int m) { return m < MP ? (m & (TP - 1)) : ((m - MP) & (TS - 1)); }

__device__ __forceinline__ void p0_transpose_item(const float* W, int ldw, int K, int ncols, bf16* WT, LAS float* scr, int item, int lane, const float* kscale, bool headmap) {
    const int nblk = ncols / 32, kb = item / nblk, nb = item % nblk, k0 = 64 * kb, n0 = 32 * nb;
#pragma unroll 8
    for (int i = 0; i < 32; ++i) { const int kk = 2 * i + (lane >> 5); float v = W[(size_t)(k0 + kk) * ldw + n0 + (lane & 31)]; if (kscale) v *= kscale[k0 + kk]; scr[kk * 33 + (lane & 31)] = v; }
    asm volatile("s_waitcnt lgkmcnt(0)" ::: "memory");
    const int c = lane & 7;
#pragma unroll
    for (int j = 0; j < 4; ++j) { const int n = (lane >> 3) + 8 * j; const LAS float* s = scr + (8 * c) * 33 + n;
        u32x4 o; o.x = pk2(s[0 * 33], s[1 * 33]); o.y = pk2(s[2 * 33], s[3 * 33]); o.z = pk2(s[4 * 33], s[5 * 33]); o.w = pk2(s[6 * 33], s[7 * 33]);
        const int dr = headmap ? inv_head(n0 + n) : (n0 + n);
        *(u32x4*)(WT + (size_t)dr * K + k0 + 8 * c) = o; }
    asm volatile("s_waitcnt lgkmcnt(0)" ::: "memory");
}
__device__ __forceinline__ void p0_fold_item(const float* Win, const float* Wp, const float* psc, bf16* WT, LAS float* scr, int item, int lane) {
    const int g = item & 3, k0 = (item >> 2) * 16;
#pragma unroll
    for (int i = 0; i < 32; ++i) { const int e = i * 64 + lane, kk = e >> 7, c = e & 127; scr[e] = Win[(size_t)(k0 + kk) * INW + 768 + 128 * g + c]; }
    asm volatile("s_waitcnt lgkmcnt(0)" ::: "memory");
    float a0[16], a1[16];
#pragma unroll
    for (int kk = 0; kk < 16; ++kk) { a0[kk] = 0.f; a1[kk] = 0.f; }
    const float* wp = Wp + (size_t)g * 128 * 128;
    for (int c = 0; c < 128; ++c) {
        const float w0 = wp[c * 128 + lane], w1 = wp[c * 128 + 64 + lane];
#pragma unroll
        for (int kk = 0; kk < 16; ++kk) { const float a = scr[kk * 128 + c]; a0[kk] += a * w0; a1[kk] += a * w1; }
    }
    const float s0 = psc[128 * g + lane], s1 = psc[128 * g + 64 + lane];
    { u32x4 o0, o1; o0.x = pk2(a0[0] * s0, a0[1] * s0); o0.y = pk2(a0[2] * s0, a0[3] * s0); o0.z = pk2(a0[4] * s0, a0[5] * s0); o0.w = pk2(a0[6] * s0, a0[7] * s0);
      o1.x = pk2(a0[8] * s0, a0[9] * s0); o1.y = pk2(a0[10] * s0, a0[11] * s0); o1.z = pk2(a0[12] * s0, a0[13] * s0); o1.w = pk2(a0[14] * s0, a0[15] * s0);
      bf16* d = WT + (size_t)inv_head(768 + 128 * g + lane) * DM + k0; *(u32x4*)d = o0; *(u32x4*)(d + 8) = o1; }
    { u32x4 o0, o1; o0.x = pk2(a1[0] * s1, a1[1] * s1); o0.y = pk2(a1[2] * s1, a1[3] * s1); o0.z = pk2(a1[4] * s1, a1[5] * s1); o0.w = pk2(a1[6] * s1, a1[7] * s1);
      o1.x = pk2(a1[8] * s1, a1[9] * s1); o1.y = pk2(a1[10] * s1, a1[11] * s1); o1.z = pk2(a1[12] * s1, a1[13] * s1); o1.w = pk2(a1[14] * s1, a1[15] * s1);
      bf16* d = WT + (size_t)inv_head(768 + 128 * g + 64 + lane) * DM + k0; *(u32x4*)d = o0; *(u32x4*)(d + 8) = o1; }
    asm volatile("s_waitcnt lgkmcnt(0)" ::: "memory");
}
__device__ __forceinline__ void rms_row_to_bf16(const float* xr_, const float* g, bf16* orow, int lane) {
    const f32x4* xr = (const f32x4*)xr_ + lane; const f32x4* gr = (const f32x4*)g + lane;
    f32x4 v[4]; float s = 0.f;
#pragma unroll
    for (int j = 0; j < 4; ++j) { v[j] = xr[64 * j]; s += (v[j].x * v[j].x + v[j].y * v[j].y) + (v[j].z * v[j].z + v[j].w * v[j].w); }
    const float rstd = 1.0f / sqrtf(wave_sum(s) * (1.f / DM) + EPS);
    unsigned long long* o8 = (unsigned long long*)orow + lane;
#pragma unroll
    for (int j = 0; j < 4; ++j) { const f32x4 gg = gr[64 * j];
        o8[64 * j] = (unsigned long long)pk2(v[j].x * rstd * gg.x, v[j].y * rstd * gg.y) | ((unsigned long long)pk2(v[j].z * rstd * gg.z, v[j].w * rstd * gg.w) << 32); }
}
__device__ __forceinline__ void p0_prologue(Frame& F) {
    LAS float* scr = (LAS float*)(F.lds + F.wave * 16384);
    const int gw = F.vcu * NWAVES + F.wave, NGW = F.G * NWAVES;
    bf16* Bin = (bf16*)(F.ws + WS_WIN); bf16* Bout = (bf16*)(F.ws + WS_WOUT); bf16* Bup = (bf16*)(F.ws + WS_WUP);
    bf16* Bdown = (bf16*)(F.ws + WS_WDOWN); bf16* Bgate = (bf16*)(F.ws + WS_WGATE); bf16* Bproj = (bf16*)(F.ws + WS_WPROJ);
    constexpr int I_FOLD = 64 * 4, I_IN = (DM / 64) * (768 / 32), I_OUT = (DM / 64) * (DM / 32), I_UP = (DM / 64) * (DFF / 32), I_DOWN = (DFF / 64) * (DM / 32), I_GATE = I_OUT, I_PROJ = (PLE / 64) * (DM / 32);
    constexpr int NITEMS = I_FOLD + I_IN + I_OUT + I_UP + I_DOWN + I_GATE + I_PROJ;
    for (int it = gw; it < NITEMS; it += NGW) {
        int r = it;
        if (r < I_FOLD) { p0_fold_item(F.in[5], F.in[8], F.in[9], Bin, scr, r, F.lane); continue; } r -= I_FOLD;
        if (r < I_IN) { p0_transpose_item(F.in[5], INW, DM, 768, Bin, scr, r, F.lane, nullptr, true); continue; } r -= I_IN;
        if (r < I_OUT) { p0_transpose_item(F.in[10], DM, DM, DM, Bout, scr, r, F.lane, nullptr, false); continue; } r -= I_OUT;
        if (r < I_UP) { p0_transpose_item(F.in[12], DFF, DM, DFF, Bup, scr, r, F.lane, F.in[11], false); continue; } r -= I_UP;
        if (r < I_DOWN) { p0_transpose_item(F.in[13], DM, DFF, DM, Bdown, scr, r, F.lane, nullptr, false); continue; } r -= I_DOWN;
        if (r < I_GATE) { p0_transpose_item(F.in[15], DM, DM, DM, Bgate, scr, r, F.lane, F.in[14], false); continue; } r -= I_GATE;
        p0_transpose_item(F.in[16], DM, PLE, DM, Bproj, scr, r, F.lane, nullptr, false);
    }
    bf16* XN = (bf16*)(F.ws + WS_XN); bf16* PB = (bf16*)(F.ws + WS_PB);
    for (int m = gw; m < M; m += NGW) {
        rms_row_to_bf16(xrow(F, m), F.in[4], XN + (size_t)m * DM, F.lane);
        const f32x4 pv = *((const f32x4*)prow(F, m) + F.lane);
        *((unsigned long long*)(PB + (size_t)m * PLE) + F.lane) = (unsigned long long)pk2(pv.x, pv.y) | ((unsigned long long)pk2(pv.z, pv.w) << 32);
    }
    { const int gt = F.vcu * 512 + F.tid;
      if (gt < 2048) { const int p = gt >> 4, i = gt & 15; const float inv = exp2f(-(float)i * (13.287712379549449f / 16.0f)); const float a = (float)p * inv;
          float2* R = (float2*)(F.ws + WS_ROPE); R[gt] = make_float2(cosf(a), sinf(a)); } }
}

template <class Epi>
__device__ __forceinline__ void sgemm(const bf16* A, int lda, int a_row_sub, const bf16* Bt, int K, int row0, int nrows, int N, bool headmap, const Epi& E, const Frame& F) {
    const int nN = N / 64, nU = (nrows / 256) * nN, fr = F.lane & 15, fq = F.lane >> 4;
    for (int u = F.vcu; u < nU; u += F.G) {
        const int pm = u / nN, pn = u % nN, r0 = row0 + pm * 256 + F.wave * 32, c0 = pn * 64;
        f32x4 acc[2][4];
#pragma unroll
        for (int a = 0; a < 2; ++a)
#pragma unroll
            for (int b = 0; b < 4; ++b) acc[a][b] = (f32x4){0.f, 0.f, 0.f, 0.f};
        const bf16* ap0 = A + (size_t)(r0 - a_row_sub + fr) * lda + 8 * fq; const bf16* ap1 = ap0 + (size_t)16 * lda;
        const bf16* bp[4];
#pragma unroll
        for (int nt = 0; nt < 4; ++nt) { const int n = c0 + 16 * nt + fr; bp[nt] = Bt + (size_t)(headmap ? inv_head(n) : n) * K + 8 * fq; }
        for (int k0 = 0; k0 < K; k0 += 32) {
            const bf16x8 a0 = *(const bf16x8*)(ap0 + k0), a1 = *(const bf16x8*)(ap1 + k0);
            bf16x8 b[4];
#pragma unroll
            for (int nt = 0; nt < 4; ++nt) b[nt] = *(const bf16x8*)(bp[nt] + k0);
#pragma unroll
            for (int nt = 0; nt < 4; ++nt) { acc[0][nt] = __builtin_amdgcn_mfma_f32_16x16x32_bf16(b[nt], a0, acc[0][nt], 0, 0, 0); acc[1][nt] = __builtin_amdgcn_mfma_f32_16x16x32_bf16(b[nt], a1, acc[1][nt], 0, 0, 0); }
        }
        E.seg64(r0 + fr, c0, acc[0], fq); E.seg64(r0 + 16 + fr, c0, acc[1], fq);
    }
}

__device__ __forceinline__ void st_bf16x4(bf16* p, f32x4 v) { u32x2 w; w.x = pk2(v[0], v[1]); w.y = pk2(v[2], v[3]); *(u32x2*)p = w; }
__device__ __forceinline__ float quad_sum(float s) { s += __shfl_xor(s, 16); s += __shfl_xor(s, 32); return s; }
__device__ __forceinline__ float rstd_from_ss(const float* ss16) {
    const f32x4* p = (const f32x4*)ss16; const f32x4 a = p[0], b = p[1], c = p[2], d = p[3];
    const float s = ((a.x + a.y) + (a.z + a.w)) + ((b.x + b.y) + (b.z + b.w)) + ((c.x + c.y) + (c.z + c.w)) + ((d.x + d.y) + (d.z + d.w));
    return 1.0f / sqrtf(s * (1.f / DM) + EPS);
}

struct EpiIn {
    bf16 *Q, *K, *V, *U; const float *qg, *kg; const float2* rope;
    __device__ __forceinline__ void seg64(int m, int c0, f32x4 (&v)[4], int fq) const {
        if (c0 < 640) {
            const bool isq = c0 < 512;
            float ss = 0.f;
#pragma unroll
            for (int nt = 0; nt < 4; ++nt) ss += (v[nt][0] * v[nt][0] + v[nt][1] * v[nt][1]) + (v[nt][2] * v[nt][2] + v[nt][3] * v[nt][3]);
            ss = quad_sum(ss);
            const float rstd = 1.0f / sqrtf(ss * (1.f / 64.f) + EPS);
            const float* g = isq ? qg : kg;
#pragma unroll
            for (int nt = 0; nt < 4; ++nt) { const f32x4 gg = *(const f32x4*)(g + 16 * nt + 4 * fq); v[nt] = v[nt] * rstd * gg; }
            const int t = tpos(m), pr = t >> 6, pc = t & 63;
            const float sc = isq ? C2 : 1.0f;
            f32x4 o[4];
#pragma unroll
            for (int j = 0; j < 4; ++j) {
                const float2 cr = rope[pr * 16 + 4 * fq + j], cc = rope[pc * 16 + 4 * fq + j];
                o[0][j] = (v[0][j] * cr.x - v[1][j] * cr.y) * sc; o[1][j] = (v[1][j] * cr.x + v[0][j] * cr.y) * sc;
                o[2][j] = (v[2][j] * cc.x - v[3][j] * cc.y) * sc; o[3][j] = (v[3][j] * cc.x + v[2][j] * cc.y) * sc;
            }
            bf16* dst = isq ? Q + (size_t)m * 512 + c0 : K + (size_t)m * 128 + (c0 - 512);
#pragma unroll
            for (int nt = 0; nt < 4; ++nt) st_bf16x4(dst + 16 * nt + 4 * fq, o[nt]);
        } else {
            bf16* dst = c0 < 768 ? V + (size_t)m * 128 + (c0 - 640) : U + (size_t)m * 512 + (c0 - 768);
#pragma unroll
            for (int nt = 0; nt < 4; ++nt) st_bf16x4(dst + 16 * nt + 4 * fq, v[nt]);
        }
    }
};
struct EpiBf {
    bf16* O; int ld;
    __device__ __forceinline__ void seg64(int m, int c0, f32x4 (&v)[4], int fq) const {
#pragma unroll
        for (int nt = 0; nt < 4; ++nt) st_bf16x4(O + (size_t)m * ld + c0 + 16 * nt + 4 * fq, v[nt]);
    }
};
struct EpiRes {
    const float* base0; const float* base1; float* out; bf16* HB; float* SS;
    __device__ __forceinline__ void seg64(int m, int c0, f32x4 (&v)[4], int fq) const {
        const float* b = (m < MP ? base0 + (size_t)m * DM : base1 + (size_t)(m - MP) * DM) + c0 + 4 * fq;
        float* o = out + (size_t)m * DM + c0 + 4 * fq; bf16* hb = HB + (size_t)m * DM + c0 + 4 * fq; float ss = 0.f;
#pragma unroll
        for (int nt = 0; nt < 4; ++nt) { const f32x4 h = *(const f32x4*)(b + 16 * nt) + v[nt]; *(f32x4*)(o + 16 * nt) = h; st_bf16x4(hb + 16 * nt, h);
            ss += (h[0] * h[0] + h[1] * h[1]) + (h[2] * h[2] + h[3] * h[3]); }
        ss = quad_sum(ss);
        if (fq == 0) SS[(size_t)m * 16 + (c0 >> 6)] = ss;
    }
};
struct EpiUp {
    bf16* HM; const float* SS; int row0;
    __device__ __forceinline__ void seg64(int m, int c0, f32x4 (&v)[4], int fq) const {
        const float rstd = rstd_from_ss(SS + (size_t)m * 16);
        bf16* d = HM + (size_t)(m - row0) * DFF + c0 + 4 * fq;
#pragma unroll
        for (int nt = 0; nt < 4; ++nt) { f32x4 a = v[nt] * rstd;
#pragma unroll
            for (int j = 0; j < 4; ++j) { const float r = fmaxf(a[j], 0.f); a[j] = r * r; }
            st_bf16x4(d + 16 * nt, a); }
    }
};
struct EpiGate {
    float* out; const bf16* PP; const float* SS;
    __device__ __forceinline__ void seg64(int m, int c0, f32x4 (&v)[4], int fq) const {
        const float rstd = rstd_from_ss(SS + (size_t)m * 16);
        float* o = out + (size_t)m * DM + c0 + 4 * fq; const bf16* pp = PP + (size_t)m * DM + c0 + 4 * fq;
#pragma unroll
        for (int nt = 0; nt < 4; ++nt) { const u32x2 w = *(const u32x2*)(pp + 16 * nt); f32x4 h = *(const f32x4*)(o + 16 * nt);
            const float p0 = bflo(w.x), p1 = bfhi(w.x), p2 = bflo(w.y), p3 = bfhi(w.y);
            h[0] += p0 / (1.0f + __expf(-v[nt][0] * rstd)); h[1] += p1 / (1.0f + __expf(-v[nt][1] * rstd));
            h[2] += p2 / (1.0f + __expf(-v[nt][2] * rstd)); h[3] += p3 / (1.0f + __expf(-v[nt][3] * rstd));
            *(f32x4*)(o + 16 * nt) = h; }
    }
};

__device__ __forceinline__ void sattn_unit(const Frame& F, int seq, int h, int qb) {
    const int T = seq < 4 ? TP : TS; const int rowbase = seq < 4 ? seq * TP : MP + (seq - 4) * TS;
    const bf16* Q = (const bf16*)(F.ws + WS_Q); const bf16* Kb = (const bf16*)(F.ws + WS_K); const bf16* Vb = (const bf16*)(F.ws + WS_V); bf16* MIX = (bf16*)(F.ws + WS_MIX);
    const int kvh = h >> 2, m = rowbase + qb * 512 + F.tid;
    LAS float* Ks = (LAS float*)F.lds; LAS float* Vs = Ks + 64 * 64;
    float q[64], o[64];
    { const u32x4* qp = (const u32x4*)(Q + (size_t)m * 512 + h * 64);
#pragma unroll
      for (int i = 0; i < 8; ++i) { const u32x4 w = qp[i]; q[8 * i] = bflo(w.x); q[8 * i + 1] = bfhi(w.x); q[8 * i + 2] = bflo(w.y); q[8 * i + 3] = bfhi(w.y); q[8 * i + 4] = bflo(w.z); q[8 * i + 5] = bfhi(w.z); q[8 * i + 6] = bflo(w.w); q[8 * i + 7] = bfhi(w.w); } }
#pragma unroll
    for (int d = 0; d < 64; ++d) o[d] = 0.f;
    float mx = -1e30f, l = 0.f;
    const int lr = F.tid >> 3, lc = (F.tid & 7) * 8;
    for (int kt = 0; kt < T / 64; ++kt) {
        __syncthreads();
        { const size_t grow = (size_t)(rowbase + kt * 64 + lr) * 128 + kvh * 64 + lc;
          const u32x4 kw = *(const u32x4*)(Kb + grow), vw = *(const u32x4*)(Vb + grow);
          LAS f32x4* kd = (LAS f32x4*)(Ks + lr * 64 + lc); LAS f32x4* vd = (LAS f32x4*)(Vs + lr * 64 + lc);
          kd[0] = (f32x4){bflo(kw.x), bfhi(kw.x), bflo(kw.y), bfhi(kw.y)}; kd[1] = (f32x4){bflo(kw.z), bfhi(kw.z), bflo(kw.w), bfhi(kw.w)};
          vd[0] = (f32x4){bflo(vw.x), bfhi(vw.x), bflo(vw.y), bfhi(vw.y)}; vd[1] = (f32x4){bflo(vw.z), bfhi(vw.z), bflo(vw.w), bfhi(vw.w)}; }
        __syncthreads();
#pragma unroll 1
        for (int j = 0; j < 64; ++j) {
            const LAS f32x4* Kc = (const LAS f32x4*)(Ks + j * 64); const LAS f32x4* Vc = (const LAS f32x4*)(Vs + j * 64);
            float a = 0.f;
#pragma unroll
            for (int d4 = 0; d4 < 16; ++d4) { const f32x4 kv = Kc[d4]; a += q[4 * d4] * kv.x + q[4 * d4 + 1] * kv.y + q[4 * d4 + 2] * kv.z + q[4 * d4 + 3] * kv.w; }
            const float mn = fmaxf(mx, a), alpha = exp2f(mx - mn), p = exp2f(a - mn); mx = mn; l = l * alpha + p;
#pragma unroll
            for (int d4 = 0; d4 < 16; ++d4) { const f32x4 vv = Vc[d4]; o[4 * d4] = o[4 * d4] * alpha + p * vv.x; o[4 * d4 + 1] = o[4 * d4 + 1] * alpha + p * vv.y; o[4 * d4 + 2] = o[4 * d4 + 2] * alpha + p * vv.z; o[4 * d4 + 3] = o[4 * d4 + 3] * alpha + p * vv.w; }
        }
    }
    const float il = 1.0f / l;
    u32x4* op = (u32x4*)(MIX + (size_t)m * DM + h * 64);
#pragma unroll
    for (int i = 0; i < 8; ++i) { u32x4 w; w.x = pk2(o[8 * i] * il, o[8 * i + 1] * il); w.y = pk2(o[8 * i + 2] * il, o[8 * i + 3] * il); w.z = pk2(o[8 * i + 4] * il, o[8 * i + 5] * il); w.w = pk2(o[8 * i + 6] * il, o[8 * i + 7] * il); op[i] = w; }
}
__device__ __forceinline__ void sattn_phase(const Frame& F) {
    for (int u = F.vcu; u < 768; u += F.G) {
        if (u < 512) { const int qb = u & 15, h = (u >> 4) & 7, s = u >> 7; sattn_unit(F, 4 + s, h, qb); }
        else { const int v = u - 512, qb = v & 7, h = (v >> 3) & 7, s = v >> 6; sattn_unit(F, s, h, qb); }
    }
}
__device__ __forceinline__ void pool_phase(const Frame& F) {
    const bf16* U = (const bf16*)(F.ws + WS_U); bf16* MIX = (bf16*)(F.ws + WS_MIX);
    const int total = M * 64;
    for (int e = F.vcu * 512 + F.tid; e < total; e += F.G * 512) {
        const int m = e >> 6, c8 = (e & 63) * 8, g = c8 >> 7, half = 1 << g;
        const int T = m < MP ? TP : TS, t = tpos(m), lo = max(t - half, 0), hi = min(t + half, T);
        float a[8];
#pragma unroll
        for (int i = 0; i < 8; ++i) a[i] = 0.f;
        for (int j = lo; j < hi; ++j) { const u32x4 w = *(const u32x4*)(U + (size_t)(m - t + j) * 512 + c8);
            a[0] += bflo(w.x); a[1] += bfhi(w.x); a[2] += bflo(w.y); a[3] += bfhi(w.y); a[4] += bflo(w.z); a[5] += bfhi(w.z); a[6] += bflo(w.w); a[7] += bfhi(w.w); }
        const float inv = 1.0f / (float)(hi - lo);
        const u32x4 w = *(const u32x4*)(U + (size_t)m * 512 + c8);
        u32x4 o; o.x = pk2(a[0] * inv - bflo(w.x), a[1] * inv - bfhi(w.x)); o.y = pk2(a[2] * inv - bflo(w.y), a[3] * inv - bfhi(w.y));
        o.z = pk2(a[4] * inv - bflo(w.z), a[5] * inv - bfhi(w.z)); o.w = pk2(a[6] * inv - bflo(w.w), a[7] * inv - bfhi(w.w));
        *(u32x4*)(MIX + (size_t)m * DM + 512 + c8) = o;
    }
}
__device__ __forceinline__ void final_phase(const Frame& F) {
    const int gw = F.vcu * NWAVES + F.wave, NGW = F.G * NWAVES; const f32x4* gr = (const f32x4*)F.in[17] + F.lane;
    for (int m = gw; m < M; m += NGW) {
        f32x4* xr = (f32x4*)(F.out + (size_t)m * DM) + F.lane; f32x4 v[4]; float s = 0.f;
#pragma unroll
        for (int j = 0; j < 4; ++j) { v[j] = xr[64 * j]; s += (v[j].x * v[j].x + v[j].y * v[j].y) + (v[j].z * v[j].z + v[j].w * v[j].w); }
        const float rstd = 1.0f / sqrtf(wave_sum(s) * (1.f / DM) + EPS);
#pragma unroll
        for (int j = 0; j < 4; ++j) xr[64 * j] = v[j] * rstd * gr[64 * j];
    }
}

constexpr int NPHASE = 12;
__global__ void __launch_bounds__(NWAVES * 64, 2) fwd_kernel(Args args) {
    extern __shared__ __attribute__((aligned(16))) unsigned char lds[];
    Frame F;
    F.lds = (LAS unsigned char*)lds; F.tid = threadIdx.x; F.lane = F.tid & 63; F.wave = __builtin_amdgcn_readfirstlane(F.tid >> 6);
    F.G = gridDim.x; { const int bx = blockIdx.x; F.vcu = (F.G % 8 == 0) ? (bx % 8) * (F.G / 8) + bx / 8 : bx; }
#pragma unroll
    for (int i = 0; i < 18; ++i) F.in[i] = args.in[i];
    F.out = args.out; F.ws = args.ws;
    unsigned char* ws = args.ws;
    bf16* XN = (bf16*)(ws + WS_XN); bf16* PP = (bf16*)(ws + WS_PP); bf16* MIX = (bf16*)(ws + WS_MIX); bf16* HM = (bf16*)(ws + WS_HM);
    float* SS1 = (float*)(ws + WS_SS1); float* SS2 = (float*)(ws + WS_SS2);
    for (int ph = args.ph_lo; ph < args.ph_hi; ++ph) {
        if (ph == 0) p0_prologue(F);
        else if (ph == 1) {
            EpiIn E{(bf16*)(ws + WS_Q), (bf16*)(ws + WS_K), (bf16*)(ws + WS_V), (bf16*)(ws + WS_U), F.in[6], F.in[7], (const float2*)(ws + WS_ROPE)};
            sgemm(XN, DM, 0, (const bf16*)(ws + WS_WIN), DM, 0, M, INW, true, E, F);
            EpiBf E2{PP, DM};
            sgemm((const bf16*)(ws + WS_PB), PLE, 0, (const bf16*)(ws + WS_WPROJ), PLE, 0, M, DM, false, E2, F);
        } else if (ph == 2) { sattn_phase(F); pool_phase(F); }
        else if (ph == 3) { EpiRes E{F.in[0], F.in[1], F.out, XN, SS1}; sgemm(MIX, DM, 0, (const bf16*)(ws + WS_WOUT), DM, 0, M, DM, false, E, F); }
        else if (ph >= 4 && ph <= 9) {
            const int c = (ph - 4) >> 1, row0 = c * CHUNK;
            if (((ph - 4) & 1) == 0) { EpiUp E{HM, SS1, row0}; sgemm(XN, DM, 0, (const bf16*)(ws + WS_WUP), DM, row0, CHUNK, DFF, false, E, F); }
            else { EpiRes E{F.out, F.out + (size_t)MP * DM, F.out, XN, SS2}; sgemm(HM, DFF, row0, (const bf16*)(ws + WS_WDOWN), DFF, row0, CHUNK, DM, false, E, F); }
        } else if (ph == 10) { EpiGate E{F.out, PP, SS2}; sgemm(XN, DM, 0, (const bf16*)(ws + WS_WGATE), DM, 0, M, DM, false, E, F); }
        else if (ph == 11) final_phase(F);
    }
}

extern "C" void kernel_launch(void* const* d_in, const int* in_sizes, int n_in, void* d_out, int out_size, void* d_ws, size_t ws_size, hipStream_t stream) {
    static int grid = 0;
    if (grid == 0) {
        if (n_in != 18 || out_size != M * DM || ws_size < WS_END) { fprintf(stderr, "kernel_launch: unexpected shapes (n_in %d out %d ws %zu)\n", n_in, out_size, ws_size); grid = -1; return; }
        if (hipFuncSetAttribute((const void*)fwd_kernel, hipFuncAttributeMaxDynamicSharedMemorySize, LDS_BYTES) != hipSuccess) { fprintf(stderr, "kernel_launch: hipFuncSetAttribute failed\n"); grid = -1; return; }
        int dev = 0, cus = 0; hipGetDevice(&dev); hipDeviceGetAttribute(&cus, hipDeviceAttributeMultiprocessorCount, dev);
        grid = cus > 0 ? cus : 256;
    }
    if (grid < 0) return;
    Args a{};
    for (int i = 0; i < 18; ++i) a.in[i] = (const float*)d_in[i];
    a.out = (float*)d_out; a.ws = (unsigned char*)d_ws;
    for (int ph = 0; ph < NPHASE; ++ph) { a.ph_lo = ph; a.ph_hi = ph + 1; hipLaunchKernelGGL(fwd_kernel, dim3(grid), dim3(NWAVES * 64), LDS_BYTES, stream, a); }
}
```

```cpp
#include <hip/hip_runtime.h>
#include <cstdio>
#include <cstdint>

#ifndef MK_ONE_LAUNCH
#define MK_ONE_LAUNCH 1
#endif

constexpr int DM = 1024, TP = 4096, TS = 8192, MP = 4 * TP, MS = 4 * TS, M = MP + MS;
constexpr int INW = 1280, DFF = 4096, PLE = 256;
constexpr int CHUNK = 16384, NCHUNK = M / CHUNK;
constexpr float EPS = 1e-6f;
constexpr float C2 = 0.125f * 1.4426950408889634f;

typedef unsigned short bf16;
typedef short bf16x8 __attribute__((ext_vector_type(8)));
typedef float f32x4 __attribute__((ext_vector_type(4)));
typedef unsigned u32x4 __attribute__((ext_vector_type(4)));
typedef unsigned u32x2 __attribute__((ext_vector_type(2)));
#define LAS __attribute__((address_space(3)))
#define GAS __attribute__((address_space(1)))

constexpr size_t MiB = 1u << 20;
constexpr size_t WS_CTL = 0, CTL_ZERO_BYTES = 1 * MiB;
constexpr size_t WS_ROPE = 1 * MiB;
constexpr size_t WS_SS1 = 2 * MiB, WS_SS2 = 5 * MiB;
constexpr size_t WS_WIN = 8 * MiB, WS_WOUT = 11 * MiB, WS_WUP = 13 * MiB, WS_WDOWN = 21 * MiB, WS_WGATE = 29 * MiB, WS_WPROJ = 31 * MiB;
constexpr size_t WS_PP = 32 * MiB;
constexpr size_t WS_XN = 128 * MiB;
constexpr size_t WS_PB = 224 * MiB;
constexpr size_t WS_Q = 248 * MiB, WS_K = 296 * MiB, WS_V = 308 * MiB, WS_U = 320 * MiB;
constexpr size_t WS_MIX = 368 * MiB;
constexpr size_t WS_HM = 224 * MiB;
constexpr size_t WS_END = 464 * MiB;

constexpr int LDS_BYTES = 147456;
constexpr int NWAVES = 8;

__device__ __forceinline__ unsigned f2bf(float f) { unsigned u = __builtin_bit_cast(unsigned, f); return (u + 0x7fffu + ((u >> 16) & 1u)) >> 16; }
__device__ __forceinline__ unsigned pk2(float lo, float hi) { return f2bf(lo) | (f2bf(hi) << 16); }
__device__ __forceinline__ float bf2f(unsigned short b) { return __builtin_bit_cast(float, (unsigned)b << 16); }
__device__ __forceinline__ float bflo(unsigned w) { return __builtin_bit_cast(float, w << 16); }
__device__ __forceinline__ float bfhi(unsigned w) { return __builtin_bit_cast(float, w & 0xffff0000u); }
__device__ __forceinline__ float wave_sum(float v) {
#pragma unroll
    for (int o = 1; o < 64; o <<= 1) v += __shfl_xor(v, o);
    return v;
}
__host__ __device__ __forceinline__ int inv_head(int n) { const int pn = n >> 8, r = n & 255, wc = r >> 6, bj = (r >> 5) & 1, j = r & 31; return pn * 256 + bj * 128 + wc * 32 + j; }

struct Args { const float* in[18]; float* out; unsigned char* ws; int ph_lo, ph_hi; };

struct Frame {
    LAS unsigned char* lds;
    int tid, lane, wave, vcu, G;
    unsigned char* ws;
};
__device__ __forceinline__ const float* xrow(const Args& A, int m) { return m < MP ? A.in[0] + (size_t)m * DM : A.in[1] + (size_t)(m - MP) * DM; }
__device__ __forceinline__ const float* prow(const Args& A, int m) { return m < MP ? A.in[2] + (size_t)m * PLE : A.in[3] + (size_t)(m - MP) * PLE; }
__device__ __forceinline__ int tpos(int m) { return m < MP ? (m & (TP - 1)) : ((m - MP) & (TS - 1)); }

__device__ __forceinline__ void p0_transpose_item(const float* W, int ldw, int K, int ncols, bf16* WT, LAS float* scr, int item, int lane, const float* kscale, bool headmap) {
    const int nblk = ncols / 32, kb = item / nblk, nb = item % nblk, k0 = 64 * kb, n0 = 32 * nb;
#pragma unroll 8
    for (int i = 0; i < 32; ++i) { const int kk = 2 * i + (lane >> 5); float v = W[(size_t)(k0 + kk) * ldw + n0 + (lane & 31)]; if (kscale) v *= kscale[k0 + kk]; scr[kk * 33 + (lane & 31)] = v; }
    asm volatile("s_waitcnt lgkmcnt(0)" ::: "memory");
    const int c = lane & 7;
#pragma unroll
    for (int j = 0; j < 4; ++j) { const int n = (lane >> 3) + 8 * j; const LAS float* s = scr + (8 * c) * 33 + n;
        u32x4 o; o.x = pk2(s[0 * 33], s[1 * 33]); o.y = pk2(s[2 * 33], s[3 * 33]); o.z = pk2(s[4 * 33], s[5 * 33]); o.w = pk2(s[6 * 33], s[7 * 33]);
        const int dr = headmap ? inv_head(n0 + n) : (n0 + n);
        *(u32x4*)(WT + (size_t)dr * K + k0 + 8 * c) = o; }
    asm volatile("s_waitcnt lgkmcnt(0)" ::: "memory");
}
__device__ __forceinline__ void p0_fold_item(const float* Win, const float* Wp, const float* psc, bf16* WT, LAS float* scr, int item, int lane) {
    const int g = item & 3, k0 = (item >> 2) * 16;
#pragma unroll
    for (int i = 0; i < 32; ++i) { const int e = i * 64 + lane, kk = e >> 7, c = e & 127; scr[e] = Win[(size_t)(k0 + kk) * INW + 768 + 128 * g + c]; }
    asm volatile("s_waitcnt lgkmcnt(0)" ::: "memory");
    float a0[16], a1[16];
#pragma unroll
    for (int kk = 0; kk < 16; ++kk) { a0[kk] = 0.f; a1[kk] = 0.f; }
    const float* wp = Wp + (size_t)g * 128 * 128;
    for (int c = 0; c < 128; ++c) {
        const float w0 = wp[c * 128 + lane], w1 = wp[c * 128 + 64 + lane];
#pragma unroll
        for (int kk = 0; kk < 16; ++kk) { const float a = scr[kk * 128 + c]; a0[kk] += a * w0; a1[kk] += a * w1; }
    }
    const float s0 = psc[128 * g + lane], s1 = psc[128 * g + 64 + lane];
    { u32x4 o0, o1; o0.x = pk2(a0[0] * s0, a0[1] * s0); o0.y = pk2(a0[2] * s0, a0[3] * s0); o0.z = pk2(a0[4] * s0, a0[5] * s0); o0.w = pk2(a0[6] * s0, a0[7] * s0);
      o1.x = pk2(a0[8] * s0, a0[9] * s0); o1.y = pk2(a0[10] * s0, a0[11] * s0); o1.z = pk2(a0[12] * s0, a0[13] * s0); o1.w = pk2(a0[14] * s0, a0[15] * s0);
      bf16* d = WT + (size_t)inv_head(768 + 128 * g + lane) * DM + k0; *(u32x4*)d = o0; *(u32x4*)(d + 8) = o1; }
    { u32x4 o0, o1; o0.x = pk2(a1[0] * s1, a1[1] * s1); o0.y = pk2(a1[2] * s1, a1[3] * s1); o0.z = pk2(a1[4] * s1, a1[5] * s1); o0.w = pk2(a1[6] * s1, a1[7] * s1);
      o1.x = pk2(a1[8] * s1, a1[9] * s1); o1.y = pk2(a1[10] * s1, a1[11] * s1); o1.z = pk2(a1[12] * s1, a1[13] * s1); o1.w = pk2(a1[14] * s1, a1[15] * s1);
      bf16* d = WT + (size_t)inv_head(768 + 128 * g + 64 + lane) * DM + k0; *(u32x4*)d = o0; *(u32x4*)(d + 8) = o1; }
    asm volatile("s_waitcnt lgkmcnt(0)" ::: "memory");
}
__device__ __forceinline__ void rms_row_to_bf16(const float* xr_, const float* g, bf16* orow, int lane) {
    const f32x4* xr = (const f32x4*)xr_ + lane; const f32x4* gr = (const f32x4*)g + lane;
    f32x4 v[4]; float s = 0.f;
#pragma unroll
    for (int j = 0; j < 4; ++j) { v[j] = xr[64 * j]; s += (v[j].x * v[j].x + v[j].y * v[j].y) + (v[j].z * v[j].z + v[j].w * v[j].w); }
    const float rstd = 1.0f / sqrtf(wave_sum(s) * (1.f / DM) + EPS);
    unsigned long long* o8 = (unsigned long long*)orow + lane;
#pragma unroll
    for (int j = 0; j < 4; ++j) { const f32x4 gg = gr[64 * j];
        o8[64 * j] = (unsigned long long)pk2(v[j].x * rstd * gg.x, v[j].y * rstd * gg.y) | ((unsigned long long)pk2(v[j].z * rstd * gg.z, v[j].w * rstd * gg.w) << 32); }
}
__device__ __forceinline__ void p0_prologue(const Frame& F, const Args& A) {
    LAS float* scr = (LAS float*)(F.lds + F.wave * 16384);
    const int gw = F.vcu * NWAVES + F.wave, NGW = F.G * NWAVES;
    bf16* Bin = (bf16*)(F.ws + WS_WIN); bf16* Bout = (bf16*)(F.ws + WS_WOUT); bf16* Bup = (bf16*)(F.ws + WS_WUP);
    bf16* Bdown = (bf16*)(F.ws + WS_WDOWN); bf16* Bgate = (bf16*)(F.ws + WS_WGATE); bf16* Bproj = (bf16*)(F.ws + WS_WPROJ);
    constexpr int I_FOLD = 64 * 4, I_IN = (DM / 64) * (768 / 32), I_OUT = (DM / 64) * (DM / 32), I_UP = (DM / 64) * (DFF / 32), I_DOWN = (DFF / 64) * (DM / 32), I_GATE = I_OUT, I_PROJ = (PLE / 64) * (DM / 32);
    constexpr int NITEMS = I_FOLD + I_IN + I_OUT + I_UP + I_DOWN + I_GATE + I_PROJ;
    for (int it = gw; it < NITEMS; it += NGW) {
        int r = it;
        if (r < I_FOLD) { p0_fold_item(A.in[5], A.in[8], A.in[9], Bin, scr, r, F.lane); continue; } r -= I_FOLD;
        if (r < I_IN) { p0_transpose_item(A.in[5], INW, DM, 768, Bin, scr, r, F.lane, nullptr, true); continue; } r -= I_IN;
        if (r < I_OUT) { p0_transpose_item(A.in[10], DM, DM, DM, Bout, scr, r, F.lane, nullptr, false); continue; } r -= I_OUT;
        if (r < I_UP) { p0_transpose_item(A.in[12], DFF, DM, DFF, Bup, scr, r, F.lane, A.in[11], false); continue; } r -= I_UP;
        if (r < I_DOWN) { p0_transpose_item(A.in[13], DM, DFF, DM, Bdown, scr, r, F.lane, nullptr, false); continue; } r -= I_DOWN;
        if (r < I_GATE) { p0_transpose_item(A.in[15], DM, DM, DM, Bgate, scr, r, F.lane, A.in[14], false); continue; } r -= I_GATE;
        p0_transpose_item(A.in[16], DM, PLE, DM, Bproj, scr, r, F.lane, nullptr, false);
    }
    bf16* XN = (bf16*)(F.ws + WS_XN); bf16* PB = (bf16*)(F.ws + WS_PB);
    for (int m = gw; m < M; m += NGW) {
        rms_row_to_bf16(xrow(A, m), A.in[4], XN + (size_t)m * DM, F.lane);
        const f32x4 pv = *((const f32x4*)prow(A, m) + F.lane);
        *((unsigned long long*)(PB + (size_t)m * PLE) + F.lane) = (unsigned long long)pk2(pv.x, pv.y) | ((unsigned long long)pk2(pv.z, pv.w) << 32);
    }
    { const int gt = F.vcu * 512 + F.tid;
      if (gt < 2048) { const int p = gt >> 4, i = gt & 15; const float inv = exp2f(-(float)i * (13.287712379549449f / 16.0f)); const float a = (float)p * inv;
          float2* R = (float2*)(F.ws + WS_ROPE); R[gt] = make_float2(cosf(a), sinf(a)); } }
}

template <class Epi>
__device__ __forceinline__ void sgemm(const bf16* A, int lda, int a_row_sub, const bf16* Bt, int K, int row0, int nrows, int N, bool headmap, const Epi& E, const Frame& F) {
    const int nN = N / 64, nU = (nrows / 256) * nN, fr = F.lane & 15, fq = F.lane >> 4;
    for (int u = F.vcu; u < nU; u += F.G) {
        const int pm = u / nN, pn = u % nN, r0 = row0 + pm * 256 + F.wave * 32, c0 = pn * 64;
        f32x4 acc[2][4];
#pragma unroll
        for (int a = 0; a < 2; ++a)
#pragma unroll
            for (int b = 0; b < 4; ++b) acc[a][b] = (f32x4){0.f, 0.f, 0.f, 0.f};
        const bf16* ap0 = A + (size_t)(r0 - a_row_sub + fr) * lda + 8 * fq; const bf16* ap1 = ap0 + (size_t)16 * lda;
        const bf16* bp[4];
#pragma unroll
        for (int nt = 0; nt < 4; ++nt) { const int n = c0 + 16 * nt + fr; bp[nt] = Bt + (size_t)(headmap ? inv_head(n) : n) * K + 8 * fq; }
        for (int k0 = 0; k0 < K; k0 += 32) {
            const bf16x8 a0 = *(const bf16x8*)(ap0 + k0), a1 = *(const bf16x8*)(ap1 + k0);
            bf16x8 b[4];
#pragma unroll
            for (int nt = 0; nt < 4; ++nt) b[nt] = *(const bf16x8*)(bp[nt] + k0);
#pragma unroll
            for (int nt = 0; nt < 4; ++nt) { acc[0][nt] = __builtin_amdgcn_mfma_f32_16x16x32_bf16(b[nt], a0, acc[0][nt], 0, 0, 0); acc[1][nt] = __builtin_amdgcn_mfma_f32_16x16x32_bf16(b[nt], a1, acc[1][nt], 0, 0, 0); }
        }
        E.seg64(r0 + fr, c0, acc[0], fq); E.seg64(r0 + 16 + fr, c0, acc[1], fq);
    }
}

__device__ __forceinline__ void st_bf16x4(bf16* p, f32x4 v) { u32x2 w; w.x = pk2(v[0], v[1]); w.y = pk2(v[2], v[3]); *(u32x2*)p = w; }
__device__ __forceinline__ float quad_sum(float s) { s += __shfl_xor(s, 16); s += __shfl_xor(s, 32); return s; }
__device__ __forceinline__ float rstd_from_ss(const float* ss16) {
    const f32x4* p = (const f32x4*)ss16; const f32x4 a = p[0], b = p[1], c = p[2], d = p[3];
    const float s = ((a.x + a.y) + (a.z + a.w)) + ((b.x + b.y) + (b.z + b.w)) + ((c.x + c.y) + (c.z + c.w)) + ((d.x + d.y) + (d.z + d.w));
    return 1.0f / sqrtf(s * (1.f / DM) + EPS);
}

struct EpiIn {
    bf16 *Q, *K, *V, *U; const float *qg, *kg; const float2* rope;
    __device__ __forceinline__ void seg64(int m, int c0, f32x4 (&v)[4], int fq) const {
        if (c0 < 640) {
            const bool isq = c0 < 512;
            float ss = 0.f;
#pragma unroll
            for (int nt = 0; nt < 4; ++nt) ss += (v[nt][0] * v[nt][0] + v[nt][1] * v[nt][1]) + (v[nt][2] * v[nt][2] + v[nt][3] * v[nt][3]);
            ss = quad_sum(ss);
            const float rstd = 1.0f / sqrtf(ss * (1.f / 64.f) + EPS);
            const float* g = isq ? qg : kg;
#pragma unroll
            for (int nt = 0; nt < 4; ++nt) { const f32x4 gg = *(const f32x4*)(g + 16 * nt + 4 * fq); v[nt] = v[nt] * rstd * gg; }
            const int t = tpos(m), pr = t >> 6, pc = t & 63;
            const float sc = isq ? C2 : 1.0f;
            f32x4 o[4];
#pragma unroll
            for (int j = 0; j < 4; ++j) {
                const float2 cr = rope[pr * 16 + 4 * fq + j], cc = rope[pc * 16 + 4 * fq + j];
                o[0][j] = (v[0][j] * cr.x - v[1][j] * cr.y) * sc; o[1][j] = (v[1][j] * cr.x + v[0][j] * cr.y) * sc;
                o[2][j] = (v[2][j] * cc.x - v[3][j] * cc.y) * sc; o[3][j] = (v[3][j] * cc.x + v[2][j] * cc.y) * sc;
            }
            bf16* dst = isq ? Q + (size_t)m * 512 + c0 : K + (size_t)m * 128 + (c0 - 512);
#pragma unroll
            for (int nt = 0; nt < 4; ++nt) st_bf16x4(dst + 16 * nt + 4 * fq, o[nt]);
        } else {
            bf16* dst = c0 < 768 ? V + (size_t)m * 128 + (c0 - 640) : U + (size_t)m * 512 + (c0 - 768);
#pragma unroll
            for (int nt = 0; nt < 4; ++nt) st_bf16x4(dst + 16 * nt + 4 * fq, v[nt]);
        }
    }
};
struct EpiBf {
    bf16* O; int ld;
    __device__ __forceinline__ void seg64(int m, int c0, f32x4 (&v)[4], int fq) const {
#pragma unroll
        for (int nt = 0; nt < 4; ++nt) st_bf16x4(O + (size_t)m * ld + c0 + 16 * nt + 4 * fq, v[nt]);
    }
};
struct EpiRes {
    const float* base0; const float* base1; float* out; bf16* HB; float* SS;
    __device__ __forceinline__ void seg64(int m, int c0, f32x4 (&v)[4], int fq) const {
        const float* b = (m < MP ? base0 + (size_t)m * DM : base1 + (size_t)(m - MP) * DM) + c0 + 4 * fq;
        float* o = out + (size_t)m * DM + c0 + 4 * fq; bf16* hb = HB + (size_t)m * DM + c0 + 4 * fq; float ss = 0.f;
#pragma unroll
        for (int nt = 0; nt < 4; ++nt) { const f32x4 h = *(const f32x4*)(b + 16 * nt) + v[nt]; *(f32x4*)(o + 16 * nt) = h; st_bf16x4(hb + 16 * nt, h);
            ss += (h[0] * h[0] + h[1] * h[1]) + (h[2] * h[2] + h[3] * h[3]); }
        ss = quad_sum(ss);
        if (fq == 0) SS[(size_t)m * 16 + (c0 >> 6)] = ss;
    }
};
struct EpiUp {
    bf16* HM; const float* SS; int row0;
    __device__ __forceinline__ void seg64(int m, int c0, f32x4 (&v)[4], int fq) const {
        const float rstd = rstd_from_ss(SS + (size_t)m * 16);
        bf16* d = HM + (size_t)(m - row0) * DFF + c0 + 4 * fq;
#pragma unroll
        for (int nt = 0; nt < 4; ++nt) { f32x4 a = v[nt] * rstd;
#pragma unroll
            for (int j = 0; j < 4; ++j) { const float r = fmaxf(a[j], 0.f); a[j] = r * r; }
            st_bf16x4(d + 16 * nt, a); }
    }
};
struct EpiGate {
    float* out; const bf16* PP; const float* SS;
    __device__ __forceinline__ void seg64(int m, int c0, f32x4 (&v)[4], int fq) const {
        const float rstd = rstd_from_ss(SS + (size_t)m * 16);
        float* o = out + (size_t)m * DM + c0 + 4 * fq; const bf16* pp = PP + (size_t)m * DM + c0 + 4 * fq;
#pragma unroll
        for (int nt = 0; nt < 4; ++nt) { const u32x2 w = *(const u32x2*)(pp + 16 * nt); f32x4 h = *(const f32x4*)(o + 16 * nt);
            const float p0 = bflo(w.x), p1 = bfhi(w.x), p2 = bflo(w.y), p3 = bfhi(w.y);
            h[0] += p0 / (1.0f + __expf(-v[nt][0] * rstd)); h[1] += p1 / (1.0f + __expf(-v[nt][1] * rstd));
            h[2] += p2 / (1.0f + __expf(-v[nt][2] * rstd)); h[3] += p3 / (1.0f + __expf(-v[nt][3] * rstd));
            *(f32x4*)(o + 16 * nt) = h; }
    }
};

__device__ __forceinline__ void sattn_unit(const Frame& F, int seq, int h, int qb) {
    const int T = seq < 4 ? TP : TS; const int rowbase = seq < 4 ? seq * TP : MP + (seq - 4) * TS;
    const bf16* Q = (const bf16*)(F.ws + WS_Q); const bf16* Kb = (const bf16*)(F.ws + WS_K); const bf16* Vb = (const bf16*)(F.ws + WS_V); bf16* MIX = (bf16*)(F.ws + WS_MIX);
    const int kvh = h >> 2, m = rowbase + qb * 512 + F.tid;
    LAS float* Ks = (LAS float*)F.lds; LAS float* Vs = Ks + 64 * 64;
    float q[64], o[64];
    { const u32x4* qp = (const u32x4*)(Q + (size_t)m * 512 + h * 64);
#pragma unroll
      for (int i = 0; i < 8; ++i) { const u32x4 w = qp[i]; q[8 * i] = bflo(w.x); q[8 * i + 1] = bfhi(w.x); q[8 * i + 2] = bflo(w.y); q[8 * i + 3] = bfhi(w.y); q[8 * i + 4] = bflo(w.z); q[8 * i + 5] = bfhi(w.z); q[8 * i + 6] = bflo(w.w); q[8 * i + 7] = bfhi(w.w); } }
#pragma unroll
    for (int d = 0; d < 64; ++d) o[d] = 0.f;
    float mx = -1e30f, l = 0.f;
    const int lr = F.tid >> 3, lc = (F.tid & 7) * 8;
    for (int kt = 0; kt < T / 64; ++kt) {
        __syncthreads();
        { const size_t grow = (size_t)(rowbase + kt * 64 + lr) * 128 + kvh * 64 + lc;
          const u32x4 kw = *(const u32x4*)(Kb + grow), vw = *(const u32x4*)(Vb + grow);
          LAS f32x4* kd = (LAS f32x4*)(Ks + lr * 64 + lc); LAS f32x4* vd = (LAS f32x4*)(Vs + lr * 64 + lc);
          kd[0] = (f32x4){bflo(kw.x), bfhi(kw.x), bflo(kw.y), bfhi(kw.y)}; kd[1] = (f32x4){bflo(kw.z), bfhi(kw.z), bflo(kw.w), bfhi(kw.w)};
          vd[0] = (f32x4){bflo(vw.x), bfhi(vw.x), bflo(vw.y), bfhi(vw.y)}; vd[1] = (f32x4){bflo(vw.z), bfhi(vw.z), bflo(vw.w), bfhi(vw.w)}; }
        __syncthreads();
#pragma unroll 1
        for (int j = 0; j < 64; ++j) {
            const LAS f32x4* Kc = (const LAS f32x4*)(Ks + j * 64); const LAS f32x4* Vc = (const LAS f32x4*)(Vs + j * 64);
            float a = 0.f;
#pragma unroll
            for (int d4 = 0; d4 < 16; ++d4) { const f32x4 kv = Kc[d4]; a += q[4 * d4] * kv.x + q[4 * d4 + 1] * kv.y + q[4 * d4 + 2] * kv.z + q[4 * d4 + 3] * kv.w; }
            const float mn = fmaxf(mx, a), alpha = exp2f(mx - mn), p = exp2f(a - mn); mx = mn; l = l * alpha + p;
#pragma unroll
            for (int d4 = 0; d4 < 16; ++d4) { const f32x4 vv = Vc[d4]; o[4 * d4] = o[4 * d4] * alpha + p * vv.x; o[4 * d4 + 1] = o[4 * d4 + 1] * alpha + p * vv.y; o[4 * d4 + 2] = o[4 * d4 + 2] * alpha + p * vv.z; o[4 * d4 + 3] = o[4 * d4 + 3] * alpha + p * vv.w; }
        }
    }
    const float il = 1.0f / l;
    u32x4* op = (u32x4*)(MIX + (size_t)m * DM + h * 64);
#pragma unroll
    for (int i = 0; i < 8; ++i) { u32x4 w; w.x = pk2(o[8 * i] * il, o[8 * i + 1] * il); w.y = pk2(o[8 * i + 2] * il, o[8 * i + 3] * il); w.z = pk2(o[8 * i + 4] * il, o[8 * i + 5] * il); w.w = pk2(o[8 * i + 6] * il, o[8 * i + 7] * il); op[i] = w; }
}
__device__ __forceinline__ void sattn_phase(const Frame& F) {
    for (int u = F.vcu; u < 768; u += F.G) {
        if (u < 512) { const int qb = u & 15, h = (u >> 4) & 7, s = u >> 7; sattn_unit(F, 4 + s, h, qb); }
        else { const int v = u - 512, qb = v & 7, h = (v >> 3) & 7, s = v >> 6; sattn_unit(F, s, h, qb); }
    }
}
__device__ __forceinline__ void pool_phase(const Frame& F) {
    const bf16* U = (const bf16*)(F.ws + WS_U); bf16* MIX = (bf16*)(F.ws + WS_MIX);
    const int total = M * 64;
    for (int e = F.vcu * 512 + F.tid; e < total; e += F.G * 512) {
        const int m = e >> 6, c8 = (e & 63) * 8, g = c8 >> 7, half = 1 << g;
        const int T = m < MP ? TP : TS, t = tpos(m), lo = max(t - half, 0), hi = min(t + half, T);
        float a[8];
#pragma unroll
        for (int i = 0; i < 8; ++i) a[i] = 0.f;
        for (int j = lo; j < hi; ++j) { const u32x4 w = *(const u32x4*)(U + (size_t)(m - t + j) * 512 + c8);
            a[0] += bflo(w.x); a[1] += bfhi(w.x); a[2] += bflo(w.y); a[3] += bfhi(w.y); a[4] += bflo(w.z); a[5] += bfhi(w.z); a[6] += bflo(w.w); a[7] += bfhi(w.w); }
        const float inv = 1.0f / (float)(hi - lo);
        const u32x4 w = *(const u32x4*)(U + (size_t)m * 512 + c8);
        u32x4 o; o.x = pk2(a[0] * inv - bflo(w.x), a[1] * inv - bfhi(w.x)); o.y = pk2(a[2] * inv - bflo(w.y), a[3] * inv - bfhi(w.y));
        o.z = pk2(a[4] * inv - bflo(w.z), a[5] * inv - bfhi(w.z)); o.w = pk2(a[6] * inv - bflo(w.w), a[7] * inv - bfhi(w.w));
        *(u32x4*)(MIX + (size_t)m * DM + 512 + c8) = o;
    }
}
__device__ __forceinline__ void final_phase(const Frame& F, float* out, const float* g) {
    const int gw = F.vcu * NWAVES + F.wave, NGW = F.G * NWAVES; const f32x4* gr = (const f32x4*)g + F.lane;
    for (int m = gw; m < M; m += NGW) {
        f32x4* xr = (f32x4*)(out + (size_t)m * DM) + F.lane; f32x4 v[4]; float s = 0.f;
#pragma unroll
        for (int j = 0; j < 4; ++j) { v[j] = xr[64 * j]; s += (v[j].x * v[j].x + v[j].y * v[j].y) + (v[j].z * v[j].z + v[j].w * v[j].w); }
        const float rstd = 1.0f / sqrtf(wave_sum(s) * (1.f / DM) + EPS);
#pragma unroll
        for (int j = 0; j < 4; ++j) xr[64 * j] = v[j] * rstd * gr[64 * j];
    }
}


constexpr int CW_BAR = 4096;
constexpr int LDSCTL_OFF = 131072, MISC_OFF = LDSCTL_OFF + 320;
#define XB_TMO      128
#define XB_XCNT(j)  (256  + 64 * (j))
#define XB_XSUB(j)  (1280 + 64 * (j))
#define XB_XGEN(j)  (2304 + 64 * (j))
#define XB_TOP      3328
#define XB_TOPGEN   3392
#define XCD_BAR_WORDS 3456
#define XB_SPIN_CAP (1u << 20)
__device__ __forceinline__ unsigned xb_ld(unsigned* p)              { return __hip_atomic_load(p, __ATOMIC_RELAXED, __HIP_MEMORY_SCOPE_AGENT); }
__device__ __forceinline__ unsigned xb_add(unsigned* p, unsigned v) { return __hip_atomic_fetch_add(p, v, __ATOMIC_RELAXED, __HIP_MEMORY_SCOPE_AGENT); }
__device__ __forceinline__ unsigned xb_xcc_id() { return (unsigned)__builtin_amdgcn_s_getreg((3 << 11) | 20) & 0xFu; }
#define XB_SPIN(cond, bar) do { unsigned _sp = 0; while (cond) { __builtin_amdgcn_s_sleep(1); \
    if ((++_sp & 255u) == 0u) { if (xb_ld(&(bar)[XB_TMO])) break; if (_sp > XB_SPIN_CAP) { atomicAdd(&(bar)[XB_TMO], 1u); break; } } } } while (0)
struct XcdBarrier { unsigned* bar; unsigned x; volatile LAS unsigned* st; };
__device__ __forceinline__ XcdBarrier xcd_barrier_post(unsigned* bar, volatile LAS unsigned* st) {
    XcdBarrier b; b.bar = bar; b.x = xb_xcc_id(); b.st = st;
    if (threadIdx.x == 0) (void)xb_add(&bar[XB_XCNT(b.x)], 1u);
    return b;
}
__device__ __forceinline__ void xcd_barrier_complete(unsigned* bar, unsigned x, unsigned& nloc, unsigned& nx) {
    const unsigned G = gridDim.x * gridDim.y * gridDim.z;
    unsigned sum, cnt, mine, sp = 0u;
    for (;;) {
        sum = 0u; cnt = 0u; mine = 0u;
#pragma unroll
        for (unsigned j = 0; j < 16; ++j) { const unsigned c = xb_ld(&bar[XB_XCNT(j)]); sum += c; cnt += (c > 0u) ? 1u : 0u; mine = (j == x) ? c : mine; }
        if (sum == G) break;
        __builtin_amdgcn_s_sleep(1);
        if ((++sp & 255u) == 0u) { if (xb_ld(&bar[XB_TMO])) break; if (sp > XB_SPIN_CAP) { atomicAdd(&bar[XB_TMO], 1u); break; } }
    }
    nloc = mine > 0u ? mine : 1u; nx = cnt > 0u ? cnt : 1u;
}
__device__ __forceinline__ void xcd_barrier(const XcdBarrier& b) {
    asm volatile("s_waitcnt vmcnt(0)" ::: "memory");
    __syncthreads();
    if (threadIdx.x == 0) {
        unsigned* bar = b.bar;
        __builtin_amdgcn_s_waitcnt(0);
        unsigned nloc = b.st[0], nx = b.st[1];
        if (nloc == 0u) { xcd_barrier_complete(bar, b.x, nloc, nx); b.st[0] = nloc; b.st[1] = nx; }
        const unsigned old = xb_add(&bar[XB_XSUB(b.x)], 1u);
        const unsigned gen = old / nloc;
        if (old + 1u == (gen + 1u) * nloc) {
            __builtin_amdgcn_fence(__ATOMIC_RELEASE, "agent");
            asm volatile("s_waitcnt vmcnt(0)" ::: "memory");
            const unsigned og = xb_add(&bar[XB_TOP], 1u);
            const unsigned tg = og / nx;
            if (og + 1u == (tg + 1u) * nx) xb_add(&bar[XB_TOPGEN], 1u);
            else XB_SPIN(xb_ld(&bar[XB_TOPGEN]) == tg, bar);
            __builtin_amdgcn_fence(__ATOMIC_ACQUIRE, "agent");
            xb_add(&bar[XB_XGEN(b.x)], 1u);
            asm volatile("s_waitcnt vmcnt(0)" ::: "memory");
        } else {
            XB_SPIN(xb_ld(&bar[XB_XGEN(b.x)]) == gen, bar);
            __builtin_amdgcn_fence(__ATOMIC_ACQUIRE, "agent");
            asm volatile("s_waitcnt vmcnt(0)" ::: "memory");
        }
    }
    __syncthreads();
}

constexpr int NPHASE = 12;
__global__ void __launch_bounds__(NWAVES * 64, 2) fwd_kernel(Args args) {
    extern __shared__ __attribute__((aligned(16))) unsigned char lds[];
    Frame F;
    F.lds = (LAS unsigned char*)lds; F.tid = threadIdx.x; F.lane = F.tid & 63; F.wave = __builtin_amdgcn_readfirstlane(F.tid >> 6);
    F.G = gridDim.x; { const int bx = blockIdx.x; F.vcu = (F.G % 8 == 0) ? (bx % 8) * (F.G / 8) + bx / 8 : bx; }
    F.ws = args.ws;
    unsigned char* ws = args.ws;
    for (int u = F.tid; u < (LDS_BYTES - LDSCTL_OFF) / 4; u += NWAVES * 64) ((LAS unsigned*)(F.lds + LDSCTL_OFF))[u] = 0u;
    __syncthreads();
    XcdBarrier bar; bar.bar = (unsigned*)(ws + WS_CTL) + CW_BAR; bar.x = 0; bar.st = nullptr;
    if (args.ph_hi - args.ph_lo > 1) bar = xcd_barrier_post((unsigned*)(ws + WS_CTL) + CW_BAR, (volatile LAS unsigned*)(F.lds + MISC_OFF) + 8);
    bf16* XN = (bf16*)(ws + WS_XN); bf16* PP = (bf16*)(ws + WS_PP); bf16* MIX = (bf16*)(ws + WS_MIX); bf16* HM = (bf16*)(ws + WS_HM);
    float* SS1 = (float*)(ws + WS_SS1); float* SS2 = (float*)(ws + WS_SS2);
    const int lo = args.ph_lo, hi = args.ph_hi;
#define IN(k) (lo <= (k) && (k) < hi)
#define SEAM(k) do { if (IN(k) && IN((k) + 1)) xcd_barrier(bar); } while (0)
    if (IN(0)) { p0_prologue(F, args); } SEAM(0);
    if (IN(1)) {
        EpiIn E{(bf16*)(ws + WS_Q), (bf16*)(ws + WS_K), (bf16*)(ws + WS_V), (bf16*)(ws + WS_U), args.in[6], args.in[7], (const float2*)(ws + WS_ROPE)};
        sgemm(XN, DM, 0, (const bf16*)(ws + WS_WIN), DM, 0, M, INW, true, E, F);
        EpiBf E2{PP, DM};
        sgemm((const bf16*)(ws + WS_PB), PLE, 0, (const bf16*)(ws + WS_WPROJ), PLE, 0, M, DM, false, E2, F);
    } SEAM(1);
    if (IN(2)) { sattn_phase(F); pool_phase(F); } SEAM(2);
    if (IN(3)) { EpiRes E{args.in[0], args.in[1], args.out, XN, SS1}; sgemm(MIX, DM, 0, (const bf16*)(ws + WS_WOUT), DM, 0, M, DM, false, E, F); } SEAM(3);
#pragma unroll 1
    for (int c = 0; c < NCHUNK; ++c) {
        const int row0 = c * CHUNK;
        if (IN(4 + 2 * c)) { EpiUp E{HM, SS1, row0}; sgemm(XN, DM, 0, (const bf16*)(ws + WS_WUP), DM, row0, CHUNK, DFF, false, E, F); } SEAM(4 + 2 * c);
        if (IN(5 + 2 * c)) { EpiRes E{args.out, args.out + (size_t)MP * DM, args.out, XN, SS2}; sgemm(HM, DFF, row0, (const bf16*)(ws + WS_WDOWN), DFF, row0, CHUNK, DM, false, E, F); } SEAM(5 + 2 * c);
    }
    if (IN(10)) { EpiGate E{args.out, PP, SS2}; sgemm(XN, DM, 0, (const bf16*)(ws + WS_WGATE), DM, 0, M, DM, false, E, F); } SEAM(10);
    if (IN(11)) final_phase(F, args.out, args.in[17]);
#undef IN
#undef SEAM
}

extern "C" void kernel_launch(void* const* d_in, const int* in_sizes, int n_in, void* d_out, int out_size, void* d_ws, size_t ws_size, hipStream_t stream) {
    static int grid = 0;
    if (grid == 0) {
        if (n_in != 18 || out_size != M * DM || ws_size < WS_END) { fprintf(stderr, "kernel_launch: unexpected shapes (n_in %d out %d ws %zu)\n", n_in, out_size, ws_size); grid = -1; return; }
        if (hipFuncSetAttribute((const void*)fwd_kernel, hipFuncAttributeMaxDynamicSharedMemorySize, LDS_BYTES) != hipSuccess) { fprintf(stderr, "kernel_launch: hipFuncSetAttribute failed\n"); grid = -1; return; }
        int dev = 0, cus = 0; (void)hipGetDevice(&dev); (void)hipDeviceGetAttribute(&cus, hipDeviceAttributeMultiprocessorCount, dev);
        grid = cus > 0 ? cus : 256;
    }
    if (grid < 0) return;
    Args a{};
    for (int i = 0; i < 18; ++i) a.in[i] = (const float*)d_in[i];
    a.out = (float*)d_out; a.ws = (unsigned char*)d_ws;
#if MK_ONE_LAUNCH
    if (hipMemsetAsync((char*)d_ws + WS_CTL, 0, 65536, stream) != hipSuccess) { fprintf(stderr, "kernel_launch: memset failed\n"); return; }
    a.ph_lo = 0; a.ph_hi = NPHASE; hipLaunchKernelGGL(fwd_kernel, dim3(grid), dim3(NWAVES * 64), LDS_BYTES, stream, a);
#else
    for (int ph = 0; ph < NPHASE; ++ph) { a.ph_lo = ph; a.ph_hi = ph + 1; hipLaunchKernelGGL(fwd_kernel, dim3(grid), dim3(NWAVES * 64), LDS_BYTES, stream, a); }
#endif
}
```

```cpp
#include <hip/hip_runtime.h>
#include <cstdio>
#include <cstdint>
#include <hip/hip_bf16.h>
#include <cmath>

#ifndef MK_ONE_LAUNCH
#define MK_ONE_LAUNCH 1
#endif

constexpr int DM = 1024, TP = 4096, TS = 8192, MP = 4 * TP, MS = 4 * TS, M = MP + MS;
constexpr int INW = 1280, DFF = 4096, PLE = 256;
constexpr int CHUNK = 16384, NCHUNK = M / CHUNK;
constexpr float EPS = 1e-6f;
constexpr float C2 = 0.125f * 1.4426950408889634f;

typedef unsigned short bf16;
typedef short bf16x8 __attribute__((ext_vector_type(8)));
typedef float f32x4 __attribute__((ext_vector_type(4)));
typedef unsigned u32x4 __attribute__((ext_vector_type(4)));
typedef unsigned u32x2 __attribute__((ext_vector_type(2)));
#define LAS __attribute__((address_space(3)))
#define GAS __attribute__((address_space(1)))

constexpr size_t MiB = 1u << 20;
constexpr size_t WS_CTL = 0, CTL_ZERO_BYTES = 1 * MiB;
constexpr size_t WS_ROPE = 1 * MiB;
constexpr size_t WS_SS1 = 2 * MiB, WS_SS2 = 5 * MiB;
constexpr size_t WS_WIN = 8 * MiB, WS_WOUT = 11 * MiB, WS_WUP = 13 * MiB, WS_WDOWN = 21 * MiB, WS_WGATE = 29 * MiB, WS_WPROJ = 31 * MiB;
constexpr size_t WS_PP = 32 * MiB;
constexpr size_t WS_XN = 128 * MiB;
constexpr size_t WS_PB = 224 * MiB;
constexpr size_t WS_Q = 248 * MiB, WS_K = 296 * MiB, WS_V = 308 * MiB, WS_U = 320 * MiB;
constexpr size_t WS_MIX = 368 * MiB;
constexpr size_t WS_HM = 224 * MiB;
constexpr size_t WS_END = 464 * MiB;

constexpr int LDS_BYTES = 147456;
constexpr int NWAVES = 8;

__device__ __forceinline__ unsigned f2bf(float f) { unsigned u = __builtin_bit_cast(unsigned, f); return (u + 0x7fffu + ((u >> 16) & 1u)) >> 16; }
__device__ __forceinline__ unsigned pk2(float lo, float hi) { return f2bf(lo) | (f2bf(hi) << 16); }
__device__ __forceinline__ float bf2f(unsigned short b) { return __builtin_bit_cast(float, (unsigned)b << 16); }
__device__ __forceinline__ float bflo(unsigned w) { return __builtin_bit_cast(float, w << 16); }
__device__ __forceinline__ float bfhi(unsigned w) { return __builtin_bit_cast(float, w & 0xffff0000u); }
__device__ __forceinline__ float wave_sum(float v) {
#pragma unroll
    for (int o = 1; o < 64; o <<= 1) v += __shfl_xor(v, o);
    return v;
}
__host__ __device__ __forceinline__ int inv_head(int n) { const int pn = n >> 8, r = n & 255, wc = r >> 6, bj = (r >> 5) & 1, j = r & 31; return pn * 256 + bj * 128 + wc * 32 + j; }

struct Args { const float* in[18]; float* out; unsigned char* ws; int ph_lo, ph_hi; };

struct Frame {
    LAS unsigned char* lds;
    int tid, lane, wave, vcu, G;
    unsigned char* ws;
};
__device__ __forceinline__ const float* xrow(const Args& A, int m) { return m < MP ? A.in[0] + (size_t)m * DM : A.in[1] + (size_t)(m - MP) * DM; }
__device__ __forceinline__ const float* prow(const Args& A, int m) { return m < MP ? A.in[2] + (size_t)m * PLE : A.in[3] + (size_t)(m - MP) * PLE; }
__device__ __forceinline__ int tpos(int m) { return m < MP ? (m & (TP - 1)) : ((m - MP) & (TS - 1)); }

__device__ __forceinline__ void p0_transpose_item(const float* W, int ldw, int K, int ncols, bf16* WT, LAS float* scr, int item, int lane, const float* kscale, bool headmap) {
    const int nblk = ncols / 32, kb = item / nblk, nb = item % nblk, k0 = 64 * kb, n0 = 32 * nb;
#pragma unroll 8
    for (int i = 0; i < 32; ++i) { const int kk = 2 * i + (lane >> 5); float v = W[(size_t)(k0 + kk) * ldw + n0 + (lane & 31)]; if (kscale) v *= kscale[k0 + kk]; scr[kk * 33 + (lane & 31)] = v; }
    asm volatile("s_waitcnt lgkmcnt(0)" ::: "memory");
    const int c = lane & 7;
#pragma unroll
    for (int j = 0; j < 4; ++j) { const int n = (lane >> 3) + 8 * j; const LAS float* s = scr + (8 * c) * 33 + n;
        u32x4 o; o.x = pk2(s[0 * 33], s[1 * 33]); o.y = pk2(s[2 * 33], s[3 * 33]); o.z = pk2(s[4 * 33], s[5 * 33]); o.w = pk2(s[6 * 33], s[7 * 33]);
        const int dr = headmap ? inv_head(n0 + n) : (n0 + n);
        *(u32x4*)(WT + (size_t)dr * K + k0 + 8 * c) = o; }
    asm volatile("s_waitcnt lgkmcnt(0)" ::: "memory");
}
__device__ __forceinline__ void p0_fold_item(const float* Win, const float* Wp, const float* psc, bf16* WT, LAS float* scr, int item, int lane) {
    const int g = item & 3, k0 = (item >> 2) * 16;
#pragma unroll
    for (int i = 0; i < 32; ++i) { const int e = i * 64 + lane, kk = e >> 7, c = e & 127; scr[e] = Win[(size_t)(k0 + kk) * INW + 768 + 128 * g + c]; }
    asm volatile("s_waitcnt lgkmcnt(0)" ::: "memory");
    float a0[16], a1[16];
#pragma unroll
    for (int kk = 0; kk < 16; ++kk) { a0[kk] = 0.f; a1[kk] = 0.f; }
    const float* wp = Wp + (size_t)g * 128 * 128;
    for (int c = 0; c < 128; ++c) {
        const float w0 = wp[c * 128 + lane], w1 = wp[c * 128 + 64 + lane];
#pragma unroll
        for (int kk = 0; kk < 16; ++kk) { const float a = scr[kk * 128 + c]; a0[kk] += a * w0; a1[kk] += a * w1; }
    }
    const float s0 = psc[128 * g + lane], s1 = psc[128 * g + 64 + lane];
    { u32x4 o0, o1; o0.x = pk2(a0[0] * s0, a0[1] * s0); o0.y = pk2(a0[2] * s0, a0[3] * s0); o0.z = pk2(a0[4] * s0, a0[5] * s0); o0.w = pk2(a0[6] * s0, a0[7] * s0);
      o1.x = pk2(a0[8] * s0, a0[9] * s0); o1.y = pk2(a0[10] * s0, a0[11] * s0); o1.z = pk2(a0[12] * s0, a0[13] * s0); o1.w = pk2(a0[14] * s0, a0[15] * s0);
      bf16* d = WT + (size_t)inv_head(768 + 128 * g + lane) * DM + k0; *(u32x4*)d = o0; *(u32x4*)(d + 8) = o1; }
    { u32x4 o0, o1; o0.x = pk2(a1[0] * s1, a1[1] * s1); o0.y = pk2(a1[2] * s1, a1[3] * s1); o0.z = pk2(a1[4] * s1, a1[5] * s1); o0.w = pk2(a1[6] * s1, a1[7] * s1);
      o1.x = pk2(a1[8] * s1, a1[9] * s1); o1.y = pk2(a1[10] * s1, a1[11] * s1); o1.z = pk2(a1[12] * s1, a1[13] * s1); o1.w = pk2(a1[14] * s1, a1[15] * s1);
      bf16* d = WT + (size_t)inv_head(768 + 128 * g + 64 + lane) * DM + k0; *(u32x4*)d = o0; *(u32x4*)(d + 8) = o1; }
    asm volatile("s_waitcnt lgkmcnt(0)" ::: "memory");
}
__device__ __forceinline__ void rms_row_to_bf16(const float* xr_, const float* g, bf16* orow, int lane) {
    const f32x4* xr = (const f32x4*)xr_ + lane; const f32x4* gr = (const f32x4*)g + lane;
    f32x4 v[4]; float s = 0.f;
#pragma unroll
    for (int j = 0; j < 4; ++j) { v[j] = xr[64 * j]; s += (v[j].x * v[j].x + v[j].y * v[j].y) + (v[j].z * v[j].z + v[j].w * v[j].w); }
    const float rstd = 1.0f / sqrtf(wave_sum(s) * (1.f / DM) + EPS);
    unsigned long long* o8 = (unsigned long long*)orow + lane;
#pragma unroll
    for (int j = 0; j < 4; ++j) { const f32x4 gg = gr[64 * j];
        o8[64 * j] = (unsigned long long)pk2(v[j].x * rstd * gg.x, v[j].y * rstd * gg.y) | ((unsigned long long)pk2(v[j].z * rstd * gg.z, v[j].w * rstd * gg.w) << 32); }
}
__device__ __forceinline__ void p0_prologue(const Frame& F, const Args& A) {
    LAS float* scr = (LAS float*)(F.lds + F.wave * 16384);
    const int gw = F.vcu * NWAVES + F.wave, NGW = F.G * NWAVES;
    bf16* Bin = (bf16*)(F.ws + WS_WIN); bf16* Bout = (bf16*)(F.ws + WS_WOUT); bf16* Bup = (bf16*)(F.ws + WS_WUP);
    bf16* Bdown = (bf16*)(F.ws + WS_WDOWN); bf16* Bgate = (bf16*)(F.ws + WS_WGATE); bf16* Bproj = (bf16*)(F.ws + WS_WPROJ);
    constexpr int I_FOLD = 64 * 4, I_IN = (DM / 64) * (768 / 32), I_OUT = (DM / 64) * (DM / 32), I_UP = (DM / 64) * (DFF / 32), I_DOWN = (DFF / 64) * (DM / 32), I_GATE = I_OUT, I_PROJ = (PLE / 64) * (DM / 32);
    constexpr int NITEMS = I_FOLD + I_IN + I_OUT + I_UP + I_DOWN + I_GATE + I_PROJ;
    for (int it = gw; it < NITEMS; it += NGW) {
        int r = it;
        if (r < I_FOLD) { p0_fold_item(A.in[5], A.in[8], A.in[9], Bin, scr, r, F.lane); continue; } r -= I_FOLD;
        if (r < I_IN) { p0_transpose_item(A.in[5], INW, DM, 768, Bin, scr, r, F.lane, nullptr, true); continue; } r -= I_IN;
        if (r < I_OUT) { p0_transpose_item(A.in[10], DM, DM, DM, Bout, scr, r, F.lane, nullptr, true); continue; } r -= I_OUT;
        if (r < I_UP) { p0_transpose_item(A.in[12], DFF, DM, DFF, Bup, scr, r, F.lane, A.in[11], true); continue; } r -= I_UP;
        if (r < I_DOWN) { p0_transpose_item(A.in[13], DM, DFF, DM, Bdown, scr, r, F.lane, nullptr, true); continue; } r -= I_DOWN;
        if (r < I_GATE) { p0_transpose_item(A.in[15], DM, DM, DM, Bgate, scr, r, F.lane, A.in[14], true); continue; } r -= I_GATE;
        p0_transpose_item(A.in[16], DM, PLE, DM, Bproj, scr, r, F.lane, nullptr, true);
    }
    bf16* XN = (bf16*)(F.ws + WS_XN); bf16* PB = (bf16*)(F.ws + WS_PB);
    for (int m = gw; m < M; m += NGW) {
        rms_row_to_bf16(xrow(A, m), A.in[4], XN + (size_t)m * DM, F.lane);
        const f32x4 pv = *((const f32x4*)prow(A, m) + F.lane);
        *((unsigned long long*)(PB + (size_t)m * PLE) + F.lane) = (unsigned long long)pk2(pv.x, pv.y) | ((unsigned long long)pk2(pv.z, pv.w) << 32);
    }
    { const int gt = F.vcu * 512 + F.tid;
      if (gt < 2048) { const int p = gt >> 4, i = gt & 15; const float inv = exp2f(-(float)i * (13.287712379549449f / 16.0f)); const float a = (float)p * inv;
          float2* R = (float2*)(F.ws + WS_ROPE); R[gt] = make_float2(cosf(a), sinf(a)); } }
}

namespace pg8 {
#define PG8_LAS __attribute__((address_space(3)))
typedef unsigned short bf16_t;
typedef short bf16x8 __attribute__((ext_vector_type(8)));
typedef float f32x4 __attribute__((ext_vector_type(4)));
typedef unsigned u32x4 __attribute__((ext_vector_type(4)));
constexpr int BM = 256, BK = 64, HALF = 128, HTB = HALF * BK * 2  , STAGE_BYTES = 8 * HTB, NXCD = 8, WGM = 8;

__host__ __device__ __forceinline__ int lds_byte(int r, int c) { const int st = (r >> 4) * 2 + (c >> 5), rr = r & 15, cc = c & 31, ob = rr * 64 + cc * 2; return st * 1024 + (ob ^ (((ob >> 9) & 1) << 5)); }
__host__ __device__ __forceinline__ void stage_rc(int b, int& R, int& C) { const int st = b / 1024, sb = b % 1024, swz = sb ^ (((sb >> 9) & 1) << 5); R = (st >> 1) * 16 + swz / 64; C = (st & 1) * 32 + (swz % 64) / 2; }
__host__ __device__ __forceinline__ int perm32(int rho) { const int n = rho >> 4, i = rho & 15; return 8 * (i >> 2) + 4 * n + (i & 3); }

struct Unit { int pm, pn; };
struct Gemm { const bf16_t* A; const bf16_t* Bt; int M, N, K; };

struct StaticOrder {
    int nM, nN, nwg, G, c;
    __host__ __device__ void init(int M, int N, int G_, int c_) { nM = M / BM; nN = N / BM; nwg = nM * nN; G = G_; c = c_; }
    __host__ __device__ bool next(int i, Unit& u) const {
        const long L = (long)i * G + c; if (L >= nwg) return false;
        int wgid = (int)L; { const int q = nwg / NXCD, r = nwg % NXCD, xcd = wgid % NXCD, off = wgid / NXCD; wgid = (xcd < r ? xcd * (q + 1) : r * (q + 1) + (xcd - r) * q) + off; }
        const int nig = WGM * nN, gid = wgid / nig, fm = gid * WGM, gsz = (nM - fm) < WGM ? (nM - fm) : WGM;
        u.pm = fm + ((wgid % nig) % gsz); u.pn = (wgid % nig) / gsz; return true;
    }
    __device__ __forceinline__ void a_ready(const Unit&) const {}
    __device__ __forceinline__ void done(const Unit&) const {}
};

template <class E> struct EpiAdapt {
    static constexpr bool PERM = false, AFTER_DRAIN = false;
    E e; int row0;
    __device__ __forceinline__ void operator()(f32x4 (&acc)[2][2][4][2], const Unit& u, int wr, int wc, int fr, int fq) const {
        const int c0 = u.pn * BM + wc * 64;
#pragma unroll
        for (int ai = 0; ai < 2; ++ai)
#pragma unroll
            for (int m = 0; m < 4; ++m) {
                ::f32x4 v[4] = {acc[ai][0][m][0], acc[ai][0][m][1], acc[ai][1][m][0], acc[ai][1][m][1]};
                e.seg64(row0 + u.pm * BM + ai * HALF + wr * 64 + m * 16 + fr, c0, v, fq);
                if (m & 1) asm volatile("" ::: "memory");
            }
    }
};
template <class Epi, class Sched, bool ALIGN_EPI = false, bool SP2 = false>
__device__ __forceinline__ void gemm_phase(PG8_LAS unsigned char* lds, const Gemm g, const Sched& S, const Epi& E) {
    const int tid = threadIdx.x, wid = __builtin_amdgcn_readfirstlane(tid >> 6), lane = tid & 63, wr = wid >> 2, wc = wid & 3, fr = lane & 15, fq = lane >> 4;
    const int K = g.K, nt = K / BK;
    unsigned voffA[2], voffB[2];
#pragma unroll
    for (int i = 0; i < 2; ++i) { int R, C; stage_rc(tid * 16 + i * 8192, R, C); const int Rb = Epi::PERM ? ((R & ~31) + perm32(R & 31)) : R;
        voffA[i] = (unsigned)(R * K + C) * 2u; voffB[i] = (unsigned)(Rb * K + C) * 2u; }
    const size_t kstep = (size_t)(BK * 2);
    const size_t hstep = (size_t)HALF * K * 2;
    const size_t tstep = 2 * hstep;
    const unsigned ldsw = (unsigned)wid * 1024u;
    const int aoff = lds_byte(wr * 64 + fr, fq * 8), boff = lds_byte(wc * 32 + fr, fq * 8);
#define PG8_SA(b, h) (((b) * 2 + (h)) * HTB)
#define PG8_SB(b, h) ((4 + (b) * 2 + (h)) * HTB)
#define PG8_STAGE(bufoff, gbase, voff) do { _Pragma("unroll") for (int _i = 0; _i < 2; ++_i) { unsigned _vo = (voff)[_i]; asm volatile("" : "+v"(_vo)); \
        __builtin_amdgcn_global_load_lds((const unsigned*)((const char*)(gbase) + _vo), (PG8_LAS unsigned*)(lds + (bufoff) + ldsw + _i * 8192), 16, 0, 0); } } while (0)
#define PG8_LDA(dst, b, h) do { _Pragma("unroll") for (int m = 0; m < 4; ++m) _Pragma("unroll") for (int k = 0; k < 2; ++k) dst[m][k] = *(const PG8_LAS bf16x8*)(lds + PG8_SA(b, h) + aoff + m * 2048 + k * 1024); } while (0)
#define PG8_LDB(dst, b, h) do { _Pragma("unroll") for (int n = 0; n < 2; ++n) _Pragma("unroll") for (int k = 0; k < 2; ++k) dst[n][k] = *(const PG8_LAS bf16x8*)(lds + PG8_SB(b, h) + boff + n * 2048 + k * 1024); } while (0)
#define PG8_MMA(ai, bj, At, Bt) do { __builtin_amdgcn_s_setprio(1); _Pragma("unroll") for (int m = 0; m < 4; ++m) _Pragma("unroll") for (int n = 0; n < 2; ++n) _Pragma("unroll") for (int k = 0; k < 2; ++k) \
        acc[ai][bj][m][n] = __builtin_amdgcn_mfma_f32_16x16x32_bf16(Bt[n][k], At[m][k], acc[ai][bj][m][n], 0, 0, 0); __builtin_amdgcn_s_setprio(0); } while (0)
#define PG8_WAIT_V(n) asm volatile("s_waitcnt vmcnt(" #n ")" ::: "memory")
#define PG8_WAIT_L(n) asm volatile("s_waitcnt lgkmcnt(" #n ")" ::: "memory")
#define PG8_BAR __builtin_amdgcn_s_barrier()
#define PG8_SCHED __builtin_amdgcn_sched_barrier(0)
    Unit cur, nxt; int ui = 0;
    if (!S.next(0, cur)) return;
    f32x4 acc[2][2][4][2];
#pragma unroll
    for (int a = 0; a < 2; ++a)
#pragma unroll
        for (int b = 0; b < 2; ++b)
#pragma unroll
            for (int m = 0; m < 4; ++m)
#pragma unroll
                for (int n = 0; n < 2; ++n) acc[a][b][m][n] = (f32x4){0.f, 0.f, 0.f, 0.f};
    bf16x8 At[4][2], B0[2][2], B1[2][2];
    const char* cA = (const char*)g.A + (size_t)cur.pm * tstep; const char* cB = (const char*)g.Bt + (size_t)cur.pn * tstep;
    S.a_ready(cur);
    if constexpr (SP2) {
        PG8_STAGE(PG8_SB(0, 0), cB, voffB); PG8_STAGE(PG8_SB(0, 1), cB + hstep, voffB); PG8_STAGE(PG8_SA(0, 0), cA, voffA); PG8_STAGE(PG8_SA(0, 1), cA + hstep, voffA);
        if (wr == 1) PG8_BAR;
        PG8_WAIT_V(2); PG8_BAR;
        PG8_STAGE(PG8_SB(1, 0), cB + kstep, voffB); PG8_STAGE(PG8_SA(1, 0), cA + kstep, voffA); PG8_STAGE(PG8_SB(1, 1), cB + hstep + kstep, voffB);
        PG8_WAIT_V(6); PG8_BAR;
    } else {
        PG8_STAGE(PG8_SB(0, 0), cB, voffB); PG8_STAGE(PG8_SA(0, 0), cA, voffA); PG8_STAGE(PG8_SB(0, 1), cB + hstep, voffB); PG8_STAGE(PG8_SA(0, 1), cA + hstep, voffA);
        if (wr == 1) PG8_BAR;
        PG8_WAIT_V(4); PG8_BAR;
        PG8_STAGE(PG8_SB(1, 0), cB + kstep, voffB); PG8_STAGE(PG8_SA(1, 0), cA + kstep, voffA); PG8_STAGE(PG8_SB(1, 1), cB + hstep + kstep, voffB);
        PG8_WAIT_V(6); PG8_BAR;
    }
    for (;;) {
        const bool has_next = S.next(ui + 1, nxt);
        const char* nA = has_next ? (const char*)g.A + (size_t)nxt.pm * tstep : cA; const char* nB = has_next ? (const char*)g.Bt + (size_t)nxt.pn * tstep : cB;
        for (int t = 0; t < nt; t += 2) {
            const bool last = (t == nt - 2);
            const char* a1 = cA + (size_t)(t + 1) * kstep;
            const char* a2 = last ? nA : cA + (size_t)(t + 2) * kstep; const char* b2 = last ? nB : cB + (size_t)(t + 2) * kstep;
            const char* a3 = a2 + kstep; const char* b3 = b2 + kstep;
            if (last && has_next) S.a_ready(nxt);
            if constexpr (SP2) {
            PG8_LDB(B0, 0, 0); PG8_LDB(B1, 0, 1); PG8_SCHED; PG8_LDA(At, 0, 0); PG8_STAGE(PG8_SA(1, 1), a1 + hstep, voffA);
            PG8_WAIT_V(8); PG8_WAIT_L(0); PG8_BAR; PG8_MMA(0, 0, At, B0); PG8_MMA(0, 1, At, B1); PG8_BAR; PG8_SCHED;
            PG8_LDA(At, 0, 1); PG8_STAGE(PG8_SB(0, 0), b2, voffB); PG8_STAGE(PG8_SB(0, 1), b2 + hstep, voffB); PG8_STAGE(PG8_SA(0, 0), a2, voffA);
            PG8_WAIT_V(8); PG8_WAIT_L(0); PG8_BAR; PG8_MMA(1, 0, At, B0); PG8_MMA(1, 1, At, B1); PG8_BAR; PG8_SCHED;
            PG8_LDB(B0, 1, 0); PG8_LDB(B1, 1, 1); PG8_SCHED; PG8_LDA(At, 1, 0); PG8_STAGE(PG8_SA(0, 1), a2 + hstep, voffA);
            PG8_WAIT_V(8); PG8_WAIT_L(0); PG8_BAR; PG8_MMA(0, 0, At, B0); PG8_MMA(0, 1, At, B1); PG8_BAR; PG8_SCHED;
            PG8_LDA(At, 1, 1); PG8_STAGE(PG8_SB(1, 0), b3, voffB); PG8_STAGE(PG8_SB(1, 1), b3 + hstep, voffB); PG8_STAGE(PG8_SA(1, 0), a3, voffA);
            PG8_WAIT_V(8); PG8_WAIT_L(0); PG8_BAR; PG8_MMA(1, 0, At, B0); PG8_MMA(1, 1, At, B1); PG8_BAR; PG8_SCHED;
            } else {
            PG8_LDB(B0, 0, 0); PG8_SCHED; PG8_LDA(At, 0, 0); PG8_STAGE(PG8_SA(1, 1), a1 + hstep, voffA);
            PG8_WAIT_L(8); PG8_BAR; PG8_WAIT_L(0); PG8_MMA(0, 0, At, B0); PG8_BAR; PG8_SCHED;
            PG8_LDB(B1, 0, 1); PG8_STAGE(PG8_SB(0, 0), b2, voffB);
            PG8_BAR; PG8_WAIT_L(0); PG8_MMA(0, 1, At, B1); PG8_BAR;
            PG8_LDA(At, 0, 1); PG8_STAGE(PG8_SA(0, 0), a2, voffA);
            PG8_BAR; PG8_WAIT_L(0); PG8_MMA(1, 0, At, B0); PG8_BAR; PG8_SCHED;
            PG8_STAGE(PG8_SB(0, 1), b2 + hstep, voffB);
            PG8_WAIT_V(6); PG8_BAR; PG8_MMA(1, 1, At, B1); PG8_BAR;
            PG8_LDB(B0, 1, 0); PG8_SCHED; PG8_LDA(At, 1, 0); PG8_STAGE(PG8_SA(0, 1), a2 + hstep, voffA);
            PG8_WAIT_L(8); PG8_BAR; PG8_WAIT_L(0); PG8_MMA(0, 0, At, B0); PG8_BAR; PG8_SCHED;
            PG8_LDB(B1, 1, 1); PG8_STAGE(PG8_SB(1, 0), b3, voffB);
            PG8_BAR; PG8_WAIT_L(0); PG8_MMA(0, 1, At, B1); PG8_BAR;
            PG8_LDA(At, 1, 1); PG8_STAGE(PG8_SA(1, 0), a3, voffA);
            PG8_BAR; PG8_WAIT_L(0); PG8_MMA(1, 0, At, B0); PG8_BAR; PG8_SCHED;
            PG8_STAGE(PG8_SB(1, 1), b3 + hstep, voffB);
            PG8_WAIT_V(6); PG8_BAR; PG8_MMA(1, 1, At, B1); PG8_BAR;
            }
        }
        if constexpr (ALIGN_EPI) { if (wr == 0) PG8_BAR; }
        if constexpr (!Epi::AFTER_DRAIN) { E(acc, cur, wr, wc, fr, fq); S.done(cur); }
        if (!has_next) break;
#pragma unroll
        for (int a = 0; a < 2; ++a)
#pragma unroll
            for (int b = 0; b < 2; ++b)
#pragma unroll
                for (int m = 0; m < 4; ++m)
#pragma unroll
                    for (int n = 0; n < 2; ++n) acc[a][b][m][n] = (f32x4){0.f, 0.f, 0.f, 0.f};
        cur = nxt; cA = nA; cB = nB; ++ui;
        if constexpr (ALIGN_EPI) { if (wr == 1) PG8_BAR; }
    }
    PG8_WAIT_V(0);
    if constexpr (!ALIGN_EPI) { if (wr == 0) PG8_BAR; }
    PG8_BAR;
    if constexpr (Epi::AFTER_DRAIN) { E.fused(acc, cur, wr, wc, fr, fq, lds, wid, lane); S.done(cur); }
#undef PG8_SA
#undef PG8_SB
#undef PG8_STAGE
#undef PG8_LDA
#undef PG8_LDB
#undef PG8_MMA
#undef PG8_WAIT_V
#undef PG8_WAIT_L
#undef PG8_BAR
#undef PG8_SCHED
}
}

template <class Epi>
__device__ __forceinline__ void sgemm(const bf16* A, int lda, int a_row_sub, const bf16* Bt, int K, int row0, int nrows, int N, bool headmap, const Epi& E, const Frame& F) {
    const int nN = N / 64, nU = (nrows / 256) * nN, fr = F.lane & 15, fq = F.lane >> 4;
    for (int u = F.vcu; u < nU; u += F.G) {
        const int pm = u / nN, pn = u % nN, r0 = row0 + pm * 256 + F.wave * 32, c0 = pn * 64;
        f32x4 acc[2][4];
#pragma unroll
        for (int a = 0; a < 2; ++a)
#pragma unroll
            for (int b = 0; b < 4; ++b) acc[a][b] = (f32x4){0.f, 0.f, 0.f, 0.f};
        const bf16* ap0 = A + (size_t)(r0 - a_row_sub + fr) * lda + 8 * fq; const bf16* ap1 = ap0 + (size_t)16 * lda;
        const bf16* bp[4];
#pragma unroll
        for (int nt = 0; nt < 4; ++nt) { const int n = c0 + 16 * nt + fr; bp[nt] = Bt + (size_t)(headmap ? inv_head(n) : n) * K + 8 * fq; }
        for (int k0 = 0; k0 < K; k0 += 32) {
            const bf16x8 a0 = *(const bf16x8*)(ap0 + k0), a1 = *(const bf16x8*)(ap1 + k0);
            bf16x8 b[4];
#pragma unroll
            for (int nt = 0; nt < 4; ++nt) b[nt] = *(const bf16x8*)(bp[nt] + k0);
#pragma unroll
            for (int nt = 0; nt < 4; ++nt) { acc[0][nt] = __builtin_amdgcn_mfma_f32_16x16x32_bf16(b[nt], a0, acc[0][nt], 0, 0, 0); acc[1][nt] = __builtin_amdgcn_mfma_f32_16x16x32_bf16(b[nt], a1, acc[1][nt], 0, 0, 0); }
        }
        E.seg64(r0 + fr, c0, acc[0], fq); E.seg64(r0 + 16 + fr, c0, acc[1], fq);
    }
}

__device__ __forceinline__ void st_bf16x4(bf16* p, f32x4 v) { u32x2 w; w.x = pk2(v[0], v[1]); w.y = pk2(v[2], v[3]); *(u32x2*)p = w; }
__device__ __forceinline__ float quad_sum(float s) { s += __shfl_xor(s, 16); s += __shfl_xor(s, 32); return s; }
__device__ __forceinline__ float rstd_from_ss(const float* ss16) {
    const f32x4* p = (const f32x4*)ss16; const f32x4 a = p[0], b = p[1], c = p[2], d = p[3];
    const float s = ((a.x + a.y) + (a.z + a.w)) + ((b.x + b.y) + (b.z + b.w)) + ((c.x + c.y) + (c.z + c.w)) + ((d.x + d.y) + (d.z + d.w));
    return 1.0f / sqrtf(s * (1.f / DM) + EPS);
}

struct EpiIn {
    bf16 *Q, *K, *V, *U; const float *qg, *kg; const float2* rope;
    __device__ __forceinline__ void seg64(int m, int c0, f32x4 (&v)[4], int fq) const {
        if (c0 < 640) {
            const bool isq = c0 < 512;
            float ss = 0.f;
#pragma unroll
            for (int nt = 0; nt < 4; ++nt) ss += (v[nt][0] * v[nt][0] + v[nt][1] * v[nt][1]) + (v[nt][2] * v[nt][2] + v[nt][3] * v[nt][3]);
            ss = quad_sum(ss);
            const float rstd = 1.0f / sqrtf(ss * (1.f / 64.f) + EPS);
            const float* g = isq ? qg : kg;
#pragma unroll
            for (int nt = 0; nt < 4; ++nt) { const f32x4 gg = *(const f32x4*)(g + 16 * nt + 4 * fq); v[nt] = v[nt] * rstd * gg; }
            const int t = tpos(m), pr = t >> 6, pc = t & 63;
            const float sc = isq ? C2 : 1.0f;
            f32x4 o[4];
#pragma unroll
            for (int j = 0; j < 4; ++j) {
                const float2 cr = rope[pr * 16 + 4 * fq + j], cc = rope[pc * 16 + 4 * fq + j];
                o[0][j] = (v[0][j] * cr.x - v[1][j] * cr.y) * sc; o[1][j] = (v[1][j] * cr.x + v[0][j] * cr.y) * sc;
                o[2][j] = (v[2][j] * cc.x - v[3][j] * cc.y) * sc; o[3][j] = (v[3][j] * cc.x + v[2][j] * cc.y) * sc;
            }
            bf16* dst = isq ? Q + (size_t)m * 512 + c0 : K + (size_t)m * 128 + (c0 - 512);
#pragma unroll
            for (int nt = 0; nt < 4; ++nt) st_bf16x4(dst + 16 * nt + 4 * fq, o[nt]);
        } else {
            bf16* dst = c0 < 768 ? V + (size_t)m * 128 + (c0 - 640) : U + (size_t)m * 512 + (c0 - 768);
#pragma unroll
            for (int nt = 0; nt < 4; ++nt) st_bf16x4(dst + 16 * nt + 4 * fq, v[nt]);
        }
    }
};
struct EpiBf {
    bf16* O; int ld;
    __device__ __forceinline__ void seg64(int m, int c0, f32x4 (&v)[4], int fq) const {
#pragma unroll
        for (int nt = 0; nt < 4; ++nt) st_bf16x4(O + (size_t)m * ld + c0 + 16 * nt + 4 * fq, v[nt]);
    }
};
struct EpiRes {
    const float* base0; const float* base1; float* out; bf16* HB; float* SS;
    __device__ __forceinline__ void seg64(int m, int c0, f32x4 (&v)[4], int fq) const {
        const float* b = (m < MP ? base0 + (size_t)m * DM : base1 + (size_t)(m - MP) * DM) + c0 + 4 * fq;
        float* o = out + (size_t)m * DM + c0 + 4 * fq; bf16* hb = HB + (size_t)m * DM + c0 + 4 * fq; float ss = 0.f;
#pragma unroll
        for (int nt = 0; nt < 4; ++nt) { const f32x4 h = *(const f32x4*)(b + 16 * nt) + v[nt]; *(f32x4*)(o + 16 * nt) = h; st_bf16x4(hb + 16 * nt, h);
            ss += (h[0] * h[0] + h[1] * h[1]) + (h[2] * h[2] + h[3] * h[3]); }
        ss = quad_sum(ss);
        if (fq == 0) SS[(size_t)m * 16 + (c0 >> 6)] = ss;
    }
};
struct EpiUp {
    bf16* HM; const float* SS; int row0;
    __device__ __forceinline__ void seg64(int m, int c0, f32x4 (&v)[4], int fq) const {
        const float rstd = rstd_from_ss(SS + (size_t)m * 16);
        bf16* d = HM + (size_t)(m - row0) * DFF + c0 + 4 * fq;
#pragma unroll
        for (int nt = 0; nt < 4; ++nt) { f32x4 a = v[nt] * rstd;
#pragma unroll
            for (int j = 0; j < 4; ++j) { const float r = fmaxf(a[j], 0.f); a[j] = r * r; }
            st_bf16x4(d + 16 * nt, a); }
    }
};
struct EpiGate {
    float* out; const bf16* PP; const float* SS;
    __device__ __forceinline__ void seg64(int m, int c0, f32x4 (&v)[4], int fq) const {
        const float rstd = rstd_from_ss(SS + (size_t)m * 16);
        float* o = out + (size_t)m * DM + c0 + 4 * fq; const bf16* pp = PP + (size_t)m * DM + c0 + 4 * fq;
#pragma unroll
        for (int nt = 0; nt < 4; ++nt) { const u32x2 w = *(const u32x2*)(pp + 16 * nt); f32x4 h = *(const f32x4*)(o + 16 * nt);
            const float p0 = bflo(w.x), p1 = bfhi(w.x), p2 = bflo(w.y), p3 = bfhi(w.y);
            h[0] += p0 / (1.0f + __expf(-v[nt][0] * rstd)); h[1] += p1 / (1.0f + __expf(-v[nt][1] * rstd));
            h[2] += p2 / (1.0f + __expf(-v[nt][2] * rstd)); h[3] += p3 / (1.0f + __expf(-v[nt][3] * rstd));
            *(f32x4*)(o + 16 * nt) = h; }
    }
};

namespace attn_body {
using bf16=__hip_bfloat16;
using bf16x8=__attribute__((ext_vector_type(8)))short;
using s16x4=__attribute__((ext_vector_type(4)))short;
using f32x16=__attribute__((ext_vector_type(16)))float;
using u32x4=__attribute__((ext_vector_type(4)))unsigned;
constexpr int D=64,QP=512,KP=128,OP=1024;
constexpr int NW=8,QBLK=32,QB=QBLK*NW,KVBLK=64;
constexpr int ATTN_UNIT_ROWS=QB;
__device__ __forceinline__ int crow(int r,int hi){return (r&3)+8*(r>>2)+4*hi;}
#define SBAR() __builtin_amdgcn_sched_barrier(0)

constexpr int NSLOT=3, SLOTB=8192;
constexpr int LDS_K=0, LDS_V=NSLOT*SLOTB, LDS_WS=2*NSLOT*SLOTB, LDS_OST=LDS_WS+NW*64*4, LDS_BYTES=LDS_OST+NW*4096;
constexpr float C2=0.125f*1.4426950408889634f;
__device__ __forceinline__ void glds16(const void*gsrc,unsigned lds_dst){unsigned keep;
  asm volatile("s_mov_b32 %0, m0\n\ts_mov_b32 m0, %2\n\ts_nop 0\n\tglobal_load_lds_dwordx4 %1, off\n\ts_mov_b32 m0, %0":"=&s"(keep):"v"(gsrc),"s"(lds_dst):"memory");}
__device__ __forceinline__ float max3f(float a,float b,float c){float r;asm("v_max3_f32 %0, %1, %2, %3":"=v"(r):"v"(a),"v"(b),"v"(c));return r;}
__device__ __forceinline__ float max2f(float a,float b){float r;asm("v_max_f32_e32 %0, %1, %2":"=v"(r):"v"(a),"v"(b));return r;}
__device__ __forceinline__ float fadd_s(float a,float b){float r;asm("v_add_f32_e32 %0, %1, %2":"=v"(r):"v"(a),"v"(b));return r;}
__device__ __forceinline__ float fsub_s(float a,float b){float r;asm("v_sub_f32_e32 %0, %1, %2":"=v"(r):"v"(a),"v"(b));return r;}
typedef float f32x2_t __attribute__((ext_vector_type(2))); typedef __bf16 bf16x2_t __attribute__((ext_vector_type(2)));
__device__ __forceinline__ unsigned cvtpk_s(float lo,float hi){f32x2_t v={lo,hi};bf16x2_t b=__builtin_convertvector(v,bf16x2_t);return __builtin_bit_cast(unsigned,b);}
#define WAIT_BAR(N) asm volatile("s_waitcnt vmcnt(" #N ") lgkmcnt(0)\n\ts_barrier":::"memory")

__device__ __forceinline__ void qkt(f32x16&p0,f32x16&p1,const char*Kslot,const bf16x8*qr,const f32x16&negm,int r32,int hi){
  const char*kb=Kslot+hi*1024+r32*16;
  #pragma unroll
  for(int d0=0;d0<4;++d0){
    const bf16x8 b0=*reinterpret_cast<const bf16x8*>(kb+d0*2048);
    const bf16x8 b1=*reinterpret_cast<const bf16x8*>(kb+d0*2048+512);
    if(d0==0){p0=__builtin_amdgcn_mfma_f32_32x32x16_bf16(b0,qr[0],negm,0,0,0);p1=__builtin_amdgcn_mfma_f32_32x32x16_bf16(b1,qr[0],negm,0,0,0);}
    else{p0=__builtin_amdgcn_mfma_f32_32x32x16_bf16(b0,qr[d0],p0,0,0,0);p1=__builtin_amdgcn_mfma_f32_32x32x16_bf16(b1,qr[d0],p1,0,0,0);}}
}
typedef __attribute__((address_space(3))) const char* lds_cptr;
typedef short v4i16_t __attribute__((ext_vector_type(4)));
__device__ __forceinline__ void kload8(bf16x8*kf,lds_cptr kp){
  kf[0]=*(const __attribute__((address_space(3))) bf16x8*)(kp);      kf[1]=*(const __attribute__((address_space(3))) bf16x8*)(kp+512);
  kf[2]=*(const __attribute__((address_space(3))) bf16x8*)(kp+2048); kf[3]=*(const __attribute__((address_space(3))) bf16x8*)(kp+2560);
  kf[4]=*(const __attribute__((address_space(3))) bf16x8*)(kp+4096); kf[5]=*(const __attribute__((address_space(3))) bf16x8*)(kp+4608);
  kf[6]=*(const __attribute__((address_space(3))) bf16x8*)(kp+6144); kf[7]=*(const __attribute__((address_space(3))) bf16x8*)(kp+6656);
}
__device__ __forceinline__ void kload2(bf16x8*kf,lds_cptr kp,int j){ kf[2*j]=*(const __attribute__((address_space(3))) bf16x8*)(kp+j*2048); kf[2*j+1]=*(const __attribute__((address_space(3))) bf16x8*)(kp+j*2048+512); }
__device__ __forceinline__ s16x4 vtr(lds_cptr p){ return __builtin_bit_cast(s16x4,__builtin_amdgcn_ds_read_tr16_b64_v4i16((__attribute__((address_space(3))) v4i16_t*)p)); }
__device__ __forceinline__ float rowmax(const f32x16&p0,const f32x16&p1){
  float a=max3f(p0[0],p0[1],p1[0]),b=max3f(p0[2],p0[3],p1[1]);a=max3f(a,p1[2],p1[3]);
  #pragma unroll
  for(int r=4;r<16;r+=4){a=max3f(a,p0[r],p0[r+1]);b=max3f(b,p0[r+2],p0[r+3]);a=max3f(a,p1[r],p1[r+1]);b=max3f(b,p1[r+2],p1[r+3]);}
  const float m=max2f(a,b);
  auto rr=__builtin_amdgcn_permlane32_swap(__float_as_uint(m),__float_as_uint(m),false,false);
  return max2f(__uint_as_float(rr[0]),__uint_as_float(rr[1]));
}
__device__ __forceinline__ void pv(f32x16*o,int vb,bf16x8 pa0,bf16x8 pa1,bf16x8 pa2,bf16x8 pa3){
  #pragma unroll
  for(int d0=0;d0<2;++d0){s16x4 lo[4],hi[4];
    #pragma unroll
    for(int ks=0;ks<4;++ks){
      asm volatile("ds_read_b64_tr_b16 %0,%1 offset:%c2":"=&v"(lo[ks]):"v"(vb),"i"(d0*4096+ks*1024):"memory");
      asm volatile("ds_read_b64_tr_b16 %0,%1 offset:%c2":"=&v"(hi[ks]):"v"(vb),"i"(d0*4096+ks*1024+512):"memory");}
    asm volatile("s_waitcnt lgkmcnt(0)":::"memory");SBAR();
    #define PK(k) (bf16x8){lo[k][0],lo[k][1],lo[k][2],lo[k][3],hi[k][0],hi[k][1],hi[k][2],hi[k][3]}
    o[d0]=__builtin_amdgcn_mfma_f32_32x32x16_bf16(pa0,PK(0),o[d0],0,0,0);
    o[d0]=__builtin_amdgcn_mfma_f32_32x32x16_bf16(pa1,PK(1),o[d0],0,0,0);
    o[d0]=__builtin_amdgcn_mfma_f32_32x32x16_bf16(pa2,PK(2),o[d0],0,0,0);
    o[d0]=__builtin_amdgcn_mfma_f32_32x32x16_bf16(pa3,PK(3),o[d0],0,0,0);
    #undef PK
  }
}

#ifndef ATTN_STORE16
#define ATTN_STORE16(p,v) (*(u32x4*)(p)=(v))
#endif
template<int THRL> __device__ __forceinline__ void attn_unit(int rowbase_,int T_,int h,int qb,const bf16*Q,const bf16*__restrict__ K,const bf16*__restrict__ V,bf16*O,char*shm){
  const int tid=threadIdx.x,lane=tid&63,r32=lane&31,hi=lane>>5; const int wid=__builtin_amdgcn_readfirstlane(tid>>6);
  const long rowbase=(long)rowbase_; const int q0=qb*QB; const int kvh=h>>2;
  const bf16*Qw=Q+(rowbase+q0+wid*QBLK)*QP+h*D;
  const bf16*Kh=K+rowbase*KP+kvh*D,*Vh=V+rowbase*KP+kvh*D;
  const unsigned lds0=(unsigned)(uintptr_t)shm;
  float*wsf=(float*)(shm+LDS_WS)+wid*64;
  const bf16*ksrc=Kh+(long)lane*KP+wid*8;
  const bf16*vsrc=Vh+(long)(16*(wid&3)+(lane>>2))*KP+(wid>>2)*32+(lane&3)*8;
  const unsigned kdst=lds0+LDS_K+wid*1024, vdst=lds0+LDS_V+wid*1024;
  #define DMA_K(t,slot) glds16(ksrc+(long)(t)*KVBLK*KP,(unsigned)__builtin_amdgcn_readfirstlane(kdst+(slot)))
  #define DMA_V(t,slot) glds16(vsrc+(long)(t)*KVBLK*KP,(unsigned)__builtin_amdgcn_readfirstlane(vdst+(slot)))
  const int vb0=(int)(lds0+LDS_V)+((lane>>4)&1)*32+(lane&3)*8+(4*hi+((lane&15)>>2))*64;
  const char*Kbase=shm+LDS_K; bf16x8 kf[8];
  const lds_cptr shm3=(lds_cptr)shm; const lds_cptr kp0=shm3+LDS_K+hi*1024+r32*16; const lds_cptr vp0=shm3+LDS_V+((lane>>4)&1)*32+(lane&3)*8+(4*hi+((lane&15)>>2))*64;
  const int NT=T_/KVBLK;
  DMA_K(0,0);DMA_V(0,0);DMA_K(1,SLOTB);
  bf16x8 qr[4];
  #pragma unroll
  for(int d0=0;d0<4;++d0)qr[d0]=*reinterpret_cast<const bf16x8*>(&Qw[(long)r32*QP+d0*16+hi*8]);
  float mhat=0.f,l_reg=0.f;f32x16 o[2];o[0]=f32x16{};o[1]=f32x16{};f32x16 negm=f32x16{};asm volatile("":"+v"(negm));
  const int qrel=wid*QBLK+r32;
  #define CMASK(P0,P1,t) do{}while(0)
  bool resc=false;
  #define START(P0,P1) do{ const float rm=rowmax(P0,P1); resc=false; \
    { const float dl=rm; mhat=fadd_s(mhat,dl); \
      _Pragma("unroll") for(int r=0;r<16;++r){P0[r]=fsub_s(P0[r],dl);P1[r]=fsub_s(P1[r],dl);} \
      _Pragma("unroll") for(int r=0;r<16;++r)negm[r]=-mhat; asm volatile("":"+v"(negm)); } \
    _Pragma("unroll") for(int r=0;r<16;++r)P0[r]=__builtin_amdgcn_exp2f(P0[r]); }while(0)
  #define RESC() do{ if(resc){ asm volatile("s_waitcnt lgkmcnt(0)":::"memory"); \
      _Pragma("unroll") for(int d_=0;d_<2;++d_) _Pragma("unroll") for(int r=0;r<16;++r)o[d_][r]*=wsf[crow(r,hi)]; } }while(0)
  f32x16 pA0,pA1,pB0,pB1;
  int sl_prev=0,sl_cur=0,sl_next=SLOTB;
  #define ROT() do{sl_prev=sl_cur;sl_cur=sl_next;sl_next=(sl_next==(NSLOT-1)*SLOTB)?0:sl_next+SLOTB;}while(0)
  DMA_K(2,2*SLOTB);
  WAIT_BAR(3);
  qkt(pA0,pA1,Kbase,qr,negm,r32,hi);asm volatile("s_nop 15\n\ts_nop 7":"+v"(pA0),"+v"(pA1));CMASK(pA0,pA1,0);
  START(pA0,pA1);
  _Pragma("unroll") for(int r=0;r<16;++r)pA1[r]=__builtin_amdgcn_exp2f(pA1[r]);
  WAIT_BAR(0);
  DMA_K(3,0);DMA_V(1,SLOTB);
  ROT();
  kload8(kf,kp0+sl_cur);
  WAIT_BAR(2);
  s16x4 vlo[8],vhi[8]; u32x4 pw0,pw1,pw2,pw3;
  #define PKW(P,B) cvtpk_s(P[B],P[B+1])
  #define PAF(k) __builtin_bit_cast(bf16x8,pw##k)
  #define VFR(i) (bf16x8){vlo[i][0],vlo[i][1],vlo[i][2],vlo[i][3],vhi[i][0],vhi[i][1],vhi[i][2],vhi[i][3]}
  #define PIN(x) asm volatile("":"+v"(x))
  #define MX3(a,b,c) __builtin_fmaxf(__builtin_fmaxf((a),(b)),(c))
  #define GAPA(MF,A0,A1,A2,A3,W0,W1,PW) do{ MF; sacc+=A0; sacc+=A1; sacc+=A2; sacc+=A3; PIN(sacc); W0; W1; PIN(PW); SBAR(); }while(0)
  #define EX(v) __builtin_amdgcn_exp2f(v)
  #define GAPB(MF,X,B) do{ MF; X[B]=EX(X[B]); X[B+1]=EX(X[B+1]); X[B+2]=EX(X[B+2]); X[B+3]=EX(X[B+3]); PIN(X); SBAR(); }while(0)
  #define VRD(i) do{ vlo[i]=vtr(vp_+(((i)>>2)*4096+((i)&3)*1024)); vhi[i]=vtr(vp_+(((i)>>2)*4096+((i)&3)*1024+512)); }while(0)
  #define KRD(G,j) do{ if(G){ kload2(kf,kp0+sl_next,j); SBAR(); } }while(0)
  #define STEP(C0,C1,P0,P1,t,GK,GV,GL) do{ SBAR(); \
    const lds_cptr vp_=vp0+sl_prev; \
    VRD(0); SBAR(); float sacc=(P0[0]+P0[1]); \
    GAPA(C0=__builtin_amdgcn_mfma_f32_32x32x16_bf16(kf[0],qr[0],negm,0,0,0), P0[2],P0[3],P0[4],P0[5],     pw0[0]=PKW(P0,0), pw0[1]=PKW(P0,2), pw0); \
    VRD(4); SBAR(); GAPA(C1=__builtin_amdgcn_mfma_f32_32x32x16_bf16(kf[1],qr[0],negm,0,0,0), P0[6],P0[7],P0[8],P0[9],     pw0[2]=PKW(P0,4), pw0[3]=PKW(P0,6), pw0); \
    VRD(1); SBAR(); GAPA(C0=__builtin_amdgcn_mfma_f32_32x32x16_bf16(kf[2],qr[1],C0,0,0,0),   P0[10],P0[11],P0[12],P0[13], pw1[0]=PKW(P0,8), pw1[1]=PKW(P0,10), pw1); \
    VRD(5); SBAR(); GAPA(C1=__builtin_amdgcn_mfma_f32_32x32x16_bf16(kf[3],qr[1],C1,0,0,0),   P0[14],P0[15],P1[0],P1[1],   pw1[2]=PKW(P0,12),pw1[3]=PKW(P0,14), pw1); \
    VRD(2); SBAR(); GAPA(C0=__builtin_amdgcn_mfma_f32_32x32x16_bf16(kf[4],qr[2],C0,0,0,0),   P1[2],P1[3],P1[4],P1[5],     pw2[0]=PKW(P1,0), pw2[1]=PKW(P1,2), pw2); \
    VRD(6); SBAR(); GAPA(C1=__builtin_amdgcn_mfma_f32_32x32x16_bf16(kf[5],qr[2],C1,0,0,0),   P1[6],P1[7],P1[8],P1[9],     pw2[2]=PKW(P1,4), pw2[3]=PKW(P1,6), pw2); \
    VRD(3); SBAR(); GAPA(C0=__builtin_amdgcn_mfma_f32_32x32x16_bf16(kf[6],qr[3],C0,0,0,0),   P1[10],P1[11],P1[12],P1[13], pw3[0]=PKW(P1,8), pw3[1]=PKW(P1,10), pw3); \
    VRD(7); SBAR(); GAPA(C1=__builtin_amdgcn_mfma_f32_32x32x16_bf16(kf[7],qr[3],C1,0,0,0),   P1[14],P1[15],0.f,0.f,       pw3[2]=PKW(P1,12),pw3[3]=PKW(P1,14), pw3); \
    l_reg+=sacc; \
    if(GK){DMA_K((t)+3,sl_cur);} if(GV){DMA_V((t)+1,sl_next);} \
    CMASK(C0,C1,t); \
    { float a=MX3(C0[0],C0[1],C1[0]),b=MX3(C0[2],C0[3],C1[1]); a=MX3(a,C1[2],C1[3]); \
      _Pragma("unroll") for(int r=4;r<16;r+=4){a=MX3(a,C0[r],C0[r+1]);b=MX3(b,C0[r+2],C0[r+3]);a=MX3(a,C1[r],C1[r+1]);b=MX3(b,C1[r+2],C1[r+3]);} \
      float rm=__builtin_fmaxf(a,b); { auto rr=__builtin_amdgcn_permlane32_swap(__float_as_uint(rm),__float_as_uint(rm),false,false); rm=__builtin_fmaxf(__uint_as_float(rr[0]),__uint_as_float(rr[1])); } \
      resc=false; \
      if(__builtin_expect(__any(rm>(float)THRL),0)){ const float dl=__builtin_fmaxf(rm,0.f); mhat+=dl; \
        _Pragma("unroll") for(int r=0;r<16;++r){C0[r]-=dl;C1[r]-=dl;} \
        _Pragma("unroll") for(int r=0;r<16;++r)negm[r]=-mhat; asm volatile("":"+v"(negm)); \
        const float f=__builtin_amdgcn_exp2f(-dl); l_reg*=f; if(hi==0)wsf[r32]=f; resc=true; } } \
    SBAR(); \
    GAPB(o[0]=__builtin_amdgcn_mfma_f32_32x32x16_bf16(PAF(0),VFR(0),o[0],0,0,0), C0,0); \
    GAPB(o[1]=__builtin_amdgcn_mfma_f32_32x32x16_bf16(PAF(0),VFR(4),o[1],0,0,0), C0,4); \
    KRD(GL,0); GAPB(o[0]=__builtin_amdgcn_mfma_f32_32x32x16_bf16(PAF(1),VFR(1),o[0],0,0,0), C0,8); \
    KRD(GL,1); GAPB(o[1]=__builtin_amdgcn_mfma_f32_32x32x16_bf16(PAF(1),VFR(5),o[1],0,0,0), C0,12); \
    KRD(GL,2); GAPB(o[0]=__builtin_amdgcn_mfma_f32_32x32x16_bf16(PAF(2),VFR(2),o[0],0,0,0), C1,0); \
    KRD(GL,3); GAPB(o[1]=__builtin_amdgcn_mfma_f32_32x32x16_bf16(PAF(2),VFR(6),o[1],0,0,0), C1,4); \
    GAPB(o[0]=__builtin_amdgcn_mfma_f32_32x32x16_bf16(PAF(3),VFR(3),o[0],0,0,0), C1,8); \
    GAPB(o[1]=__builtin_amdgcn_mfma_f32_32x32x16_bf16(PAF(3),VFR(7),o[1],0,0,0), C1,12); \
    }while(0)
  int t=1;
  #undef CMASK
  #define CMASK(P0,P1,t) do{}while(0)
  for(;t+5<NT;t+=2){
    STEP(pB0,pB1,pA0,pA1,t,true,true,true);     WAIT_BAR(2); RESC(); ROT();
    STEP(pA0,pA1,pB0,pB1,t+1,true,true,true);   WAIT_BAR(2); RESC(); ROT();
  }
  #undef CMASK
  #define CMASK(P0,P1,t) do{}while(0)
  #define ENDW(tt) do{ if((tt)+3<NT){WAIT_BAR(2);} else if((tt)+2<NT){WAIT_BAR(1);} else {WAIT_BAR(0);} }while(0)
  for(;t+1<NT;t+=2){
    STEP(pB0,pB1,pA0,pA1,t,(t+3<NT),(t+1<NT),(t+1<NT));       ENDW(t);   RESC(); ROT();
    STEP(pA0,pA1,pB0,pB1,t+1,(t+4<NT),(t+2<NT),(t+2<NT));     ENDW(t+1); RESC(); ROT();
  }
  STEP(pB0,pB1,pA0,pA1,NT-1,false,false,false); RESC();
  { float sacc=pB0[0]+pB0[1]; _Pragma("unroll") for(int r=2;r<16;++r)sacc+=pB0[r]; _Pragma("unroll") for(int r=0;r<16;++r)sacc+=pB1[r]; l_reg+=sacc;
    pw0=(u32x4){PKW(pB0,0),PKW(pB0,2),PKW(pB0,4),PKW(pB0,6)};pw1=(u32x4){PKW(pB0,8),PKW(pB0,10),PKW(pB0,12),PKW(pB0,14)};pw2=(u32x4){PKW(pB1,0),PKW(pB1,2),PKW(pB1,4),PKW(pB1,6)};pw3=(u32x4){PKW(pB1,8),PKW(pB1,10),PKW(pB1,12),PKW(pB1,14)};
    SBAR(); pv(o,vb0+sl_cur,PAF(0),PAF(1),PAF(2),PAF(3)); }
  #undef PKW
  #undef PAF
  #undef VFR
  #undef PIN
  #undef MX3
  #undef GAPA
  #undef GAPB
  #undef EX
  #undef VRD
  #undef KRD
  #undef STEP
  #undef ENDW
  {auto rr=__builtin_amdgcn_permlane32_swap(__float_as_uint(l_reg),__float_as_uint(l_reg),false,false);l_reg=__uint_as_float(rr[0])+__uint_as_float(rr[1]);}
  if(hi==0)wsf[32+r32]=l_reg;asm volatile("s_waitcnt lgkmcnt(0)":::"memory");
  float rli[16];
  #pragma unroll
  for(int r=0;r<16;++r)rli[r]=__builtin_amdgcn_rcpf(wsf[32+crow(r,hi)]);
  bf16*Ow=O+(rowbase+q0+wid*QBLK)*OP+h*D;
  { bf16*stg=(bf16*)(shm+LDS_OST)+wid*2048;
    #pragma unroll
    for(int r=0;r<16;++r){const int orow=crow(r,hi);
      #pragma unroll
      for(int d0=0;d0<2;++d0)stg[orow*64+d0*32+r32]=__float2bfloat16(o[d0][r]*rli[r]);}
    asm volatile("s_waitcnt lgkmcnt(0)":::"memory");
    #pragma unroll
    for(int i=0;i<4;++i){const int row=i*8+(lane>>3),ch=lane&7; const u32x4 v=*(const u32x4*)(stg+row*64+ch*8); ATTN_STORE16(Ow+(long)row*OP+ch*8,v);} }
  asm volatile("s_waitcnt lgkmcnt(0)\n\ts_barrier":::"memory");
  #undef DMA_K
  #undef DMA_V
  #undef CMASK
  #undef START
  #undef RESC
  #undef ROT
}
constexpr int ATTN_LDS_BYTES=LDS_BYTES;
struct AttnTensors { const bf16* Q; const bf16* K; const bf16* V; bf16* O; };
template<int THRL=8> __device__ __forceinline__ void attn_phase(char*lds,const AttnTensors&T,int vcu,int G){
  if(G==256){
    const int x=vcu>>5,j=vcu&31;
    for(int i=0;i<4;++i){ const int w=j*4+i,g=w>>5,qb=w&31; attn_unit<THRL>(16384+(x>>1)*8192,8192,(x&1)*4+g,qb,T.Q,T.K,T.V,T.O,lds); }
    for(int i=0;i<2;++i){ const int w=j*2+i,g=w>>4,qb=w&15; attn_unit<THRL>((x>>1)*4096,4096,(x&1)*4+g,qb,T.Q,T.K,T.V,T.O,lds); }
  } else {
    for(int u=vcu;u<1536;u+=G){
      if(u<1024){ const int qb=u&31,h=(u>>5)&7,s=u>>8; attn_unit<THRL>(16384+s*8192,8192,h,qb,T.Q,T.K,T.V,T.O,lds); }
      else { const int v=u-1024,qb=v&15,h=(v>>4)&7,s=v>>7; attn_unit<THRL>(s*4096,4096,h,qb,T.Q,T.K,T.V,T.O,lds); }
    }
  }
}
#undef SBAR
#undef WAIT_BAR
}

__device__ __forceinline__ void sattn_unit(const Frame& F, int seq, int h, int qb) {
    const int T = seq < 4 ? TP : TS; const int rowbase = seq < 4 ? seq * TP : MP + (seq - 4) * TS;
    const bf16* Q = (const bf16*)(F.ws + WS_Q); const bf16* Kb = (const bf16*)(F.ws + WS_K); const bf16* Vb = (const bf16*)(F.ws + WS_V); bf16* MIX = (bf16*)(F.ws + WS_MIX);
    const int kvh = h >> 2, m = rowbase + qb * 512 + F.tid;
    LAS float* Ks = (LAS float*)F.lds; LAS float* Vs = Ks + 64 * 64;
    float q[64], o[64];
    { const u32x4* qp = (const u32x4*)(Q + (size_t)m * 512 + h * 64);
#pragma unroll
      for (int i = 0; i < 8; ++i) { const u32x4 w = qp[i]; q[8 * i] = bflo(w.x); q[8 * i + 1] = bfhi(w.x); q[8 * i + 2] = bflo(w.y); q[8 * i + 3] = bfhi(w.y); q[8 * i + 4] = bflo(w.z); q[8 * i + 5] = bfhi(w.z); q[8 * i + 6] = bflo(w.w); q[8 * i + 7] = bfhi(w.w); } }
#pragma unroll
    for (int d = 0; d < 64; ++d) o[d] = 0.f;
    float mx = -1e30f, l = 0.f;
    const int lr = F.tid >> 3, lc = (F.tid & 7) * 8;
    for (int kt = 0; kt < T / 64; ++kt) {
        __syncthreads();
        { const size_t grow = (size_t)(rowbase + kt * 64 + lr) * 128 + kvh * 64 + lc;
          const u32x4 kw = *(const u32x4*)(Kb + grow), vw = *(const u32x4*)(Vb + grow);
          LAS f32x4* kd = (LAS f32x4*)(Ks + lr * 64 + lc); LAS f32x4* vd = (LAS f32x4*)(Vs + lr * 64 + lc);
          kd[0] = (f32x4){bflo(kw.x), bfhi(kw.x), bflo(kw.y), bfhi(kw.y)}; kd[1] = (f32x4){bflo(kw.z), bfhi(kw.z), bflo(kw.w), bfhi(kw.w)};
          vd[0] = (f32x4){bflo(vw.x), bfhi(vw.x), bflo(vw.y), bfhi(vw.y)}; vd[1] = (f32x4){bflo(vw.z), bfhi(vw.z), bflo(vw.w), bfhi(vw.w)}; }
        __syncthreads();
#pragma unroll 1
        for (int j = 0; j < 64; ++j) {
            const LAS f32x4* Kc = (const LAS f32x4*)(Ks + j * 64); const LAS f32x4* Vc = (const LAS f32x4*)(Vs + j * 64);
            float a = 0.f;
#pragma unroll
            for (int d4 = 0; d4 < 16; ++d4) { const f32x4 kv = Kc[d4]; a += q[4 * d4] * kv.x + q[4 * d4 + 1] * kv.y + q[4 * d4 + 2] * kv.z + q[4 * d4 + 3] * kv.w; }
            const float mn = fmaxf(mx, a), alpha = exp2f(mx - mn), p = exp2f(a - mn); mx = mn; l = l * alpha + p;
#pragma unroll
            for (int d4 = 0; d4 < 16; ++d4) { const f32x4 vv = Vc[d4]; o[4 * d4] = o[4 * d4] * alpha + p * vv.x; o[4 * d4 + 1] = o[4 * d4 + 1] * alpha + p * vv.y; o[4 * d4 + 2] = o[4 * d4 + 2] * alpha + p * vv.z; o[4 * d4 + 3] = o[4 * d4 + 3] * alpha + p * vv.w; }
        }
    }
    const float il = 1.0f / l;
    u32x4* op = (u32x4*)(MIX + (size_t)m * DM + h * 64);
#pragma unroll
    for (int i = 0; i < 8; ++i) { u32x4 w; w.x = pk2(o[8 * i] * il, o[8 * i + 1] * il); w.y = pk2(o[8 * i + 2] * il, o[8 * i + 3] * il); w.z = pk2(o[8 * i + 4] * il, o[8 * i + 5] * il); w.w = pk2(o[8 * i + 6] * il, o[8 * i + 7] * il); op[i] = w; }
}
__device__ __forceinline__ void sattn_phase(const Frame& F) {
    for (int u = F.vcu; u < 768; u += F.G) {
        if (u < 512) { const int qb = u & 15, h = (u >> 4) & 7, s = u >> 7; sattn_unit(F, 4 + s, h, qb); }
        else { const int v = u - 512, qb = v & 7, h = (v >> 3) & 7, s = v >> 6; sattn_unit(F, s, h, qb); }
    }
}
__device__ __forceinline__ void pool_phase(const Frame& F) {
    const bf16* U = (const bf16*)(F.ws + WS_U); bf16* MIX = (bf16*)(F.ws + WS_MIX);
    const int total = M * 64;
    for (int e = F.vcu * 512 + F.tid; e < total; e += F.G * 512) {
        const int m = e >> 6, c8 = (e & 63) * 8, g = c8 >> 7, half = 1 << g;
        const int T = m < MP ? TP : TS, t = tpos(m), lo = max(t - half, 0), hi = min(t + half, T);
        float a[8];
#pragma unroll
        for (int i = 0; i < 8; ++i) a[i] = 0.f;
        for (int j = lo; j < hi; ++j) { const u32x4 w = *(const u32x4*)(U + (size_t)(m - t + j) * 512 + c8);
            a[0] += bflo(w.x); a[1] += bfhi(w.x); a[2] += bflo(w.y); a[3] += bfhi(w.y); a[4] += bflo(w.z); a[5] += bfhi(w.z); a[6] += bflo(w.w); a[7] += bfhi(w.w); }
        const float inv = 1.0f / (float)(hi - lo);
        const u32x4 w = *(const u32x4*)(U + (size_t)m * 512 + c8);
        u32x4 o; o.x = pk2(a[0] * inv - bflo(w.x), a[1] * inv - bfhi(w.x)); o.y = pk2(a[2] * inv - bflo(w.y), a[3] * inv - bfhi(w.y));
        o.z = pk2(a[4] * inv - bflo(w.z), a[5] * inv - bfhi(w.z)); o.w = pk2(a[6] * inv - bflo(w.w), a[7] * inv - bfhi(w.w));
        *(u32x4*)(MIX + (size_t)m * DM + 512 + c8) = o;
    }
}
__device__ __forceinline__ void final_phase(const Frame& F, float* out, const float* g) {
    const int gw = F.vcu * NWAVES + F.wave, NGW = F.G * NWAVES; const f32x4* gr = (const f32x4*)g + F.lane;
    for (int m = gw; m < M; m += NGW) {
        f32x4* xr = (f32x4*)(out + (size_t)m * DM) + F.lane; f32x4 v[4]; float s = 0.f;
#pragma unroll
        for (int j = 0; j < 4; ++j) { v[j] = xr[64 * j]; s += (v[j].x * v[j].x + v[j].y * v[j].y) + (v[j].z * v[j].z + v[j].w * v[j].w); }
        const float rstd = 1.0f / sqrtf(wave_sum(s) * (1.f / DM) + EPS);
#pragma unroll
        for (int j = 0; j < 4; ++j) xr[64 * j] = v[j] * rstd * gr[64 * j];
    }
}


constexpr int CW_BAR = 4096;
constexpr int LDSCTL_OFF = 131072, MISC_OFF = LDSCTL_OFF + 320;
#define XB_TMO      128
#define XB_XCNT(j)  (256  + 64 * (j))
#define XB_XSUB(j)  (1280 + 64 * (j))
#define XB_XGEN(j)  (2304 + 64 * (j))
#define XB_TOP      3328
#define XB_TOPGEN   3392
#define XCD_BAR_WORDS 3456
#define XB_SPIN_CAP (1u << 20)
__device__ __forceinline__ unsigned xb_ld(unsigned* p)              { return __hip_atomic_load(p, __ATOMIC_RELAXED, __HIP_MEMORY_SCOPE_AGENT); }
__device__ __forceinline__ unsigned xb_add(unsigned* p, unsigned v) { return __hip_atomic_fetch_add(p, v, __ATOMIC_RELAXED, __HIP_MEMORY_SCOPE_AGENT); }
__device__ __forceinline__ unsigned xb_xcc_id() { return (unsigned)__builtin_amdgcn_s_getreg((3 << 11) | 20) & 0xFu; }
#define XB_SPIN(cond, bar) do { unsigned _sp = 0; while (cond) { __builtin_amdgcn_s_sleep(1); \
    if ((++_sp & 255u) == 0u) { if (xb_ld(&(bar)[XB_TMO])) break; if (_sp > XB_SPIN_CAP) { atomicAdd(&(bar)[XB_TMO], 1u); break; } } } } while (0)
struct XcdBarrier { unsigned* bar; unsigned x; volatile LAS unsigned* st; };
__device__ __forceinline__ XcdBarrier xcd_barrier_post(unsigned* bar, volatile LAS unsigned* st) {
    XcdBarrier b; b.bar = bar; b.x = xb_xcc_id(); b.st = st;
    if (threadIdx.x == 0) (void)xb_add(&bar[XB_XCNT(b.x)], 1u);
    return b;
}
__device__ __forceinline__ void xcd_barrier_complete(unsigned* bar, unsigned x, unsigned& nloc, unsigned& nx) {
    const unsigned G = gridDim.x * gridDim.y * gridDim.z;
    unsigned sum, cnt, mine, sp = 0u;
    for (;;) {
        sum = 0u; cnt = 0u; mine = 0u;
#pragma unroll
        for (unsigned j = 0; j < 16; ++j) { const unsigned c = xb_ld(&bar[XB_XCNT(j)]); sum += c; cnt += (c > 0u) ? 1u : 0u; mine = (j == x) ? c : mine; }
        if (sum == G) break;
        __builtin_amdgcn_s_sleep(1);
        if ((++sp & 255u) == 0u) { if (xb_ld(&bar[XB_TMO])) break; if (sp > XB_SPIN_CAP) { atomicAdd(&bar[XB_TMO], 1u); break; } }
    }
    nloc = mine > 0u ? mine : 1u; nx = cnt > 0u ? cnt : 1u;
}
__device__ __forceinline__ void xcd_barrier(const XcdBarrier& b) {
    asm volatile("s_waitcnt vmcnt(0)" ::: "memory");
    __syncthreads();
    if (threadIdx.x == 0) {
        unsigned* bar = b.bar;
        __builtin_amdgcn_s_waitcnt(0);
        unsigned nloc = b.st[0], nx = b.st[1];
        if (nloc == 0u) { xcd_barrier_complete(bar, b.x, nloc, nx); b.st[0] = nloc; b.st[1] = nx; }
        const unsigned old = xb_add(&bar[XB_XSUB(b.x)], 1u);
        const unsigned gen = old / nloc;
        if (old + 1u == (gen + 1u) * nloc) {
            __builtin_amdgcn_fence(__ATOMIC_RELEASE, "agent");
            asm volatile("s_waitcnt vmcnt(0)" ::: "memory");
            const unsigned og = xb_add(&bar[XB_TOP], 1u);
            const unsigned tg = og / nx;
            if (og + 1u == (tg + 1u) * nx) xb_add(&bar[XB_TOPGEN], 1u);
            else XB_SPIN(xb_ld(&bar[XB_TOPGEN]) == tg, bar);
            __builtin_amdgcn_fence(__ATOMIC_ACQUIRE, "agent");
            xb_add(&bar[XB_XGEN(b.x)], 1u);
            asm volatile("s_waitcnt vmcnt(0)" ::: "memory");
        } else {
            XB_SPIN(xb_ld(&bar[XB_XGEN(b.x)]) == gen, bar);
            __builtin_amdgcn_fence(__ATOMIC_ACQUIRE, "agent");
            asm volatile("s_waitcnt vmcnt(0)" ::: "memory");
        }
    }
    __syncthreads();
}


template <class E>
__device__ __forceinline__ void fgemm(const Frame& F, const bf16* A, const bf16* Bt, int Mrows, int N, int K, int row0, const E& e) {
    pg8::Gemm g{A, Bt, Mrows, N, K}; pg8::StaticOrder S; S.init(Mrows, N, F.G, (int)blockIdx.x);
    pg8::EpiAdapt<E> EA{e, row0};
    pg8::gemm_phase<pg8::EpiAdapt<E>, pg8::StaticOrder, true, true>(F.lds, g, S, EA);
}
constexpr int NPHASE = 12;
__global__ void __launch_bounds__(NWAVES * 64, 2) fwd_kernel(Args args) {
    extern __shared__ __attribute__((aligned(16))) unsigned char lds[];
    Frame F;
    F.lds = (LAS unsigned char*)lds; F.tid = threadIdx.x; F.lane = F.tid & 63; F.wave = __builtin_amdgcn_readfirstlane(F.tid >> 6);
    F.G = gridDim.x; { const int bx = blockIdx.x; F.vcu = (F.G % 8 == 0) ? (bx % 8) * (F.G / 8) + bx / 8 : bx; }
    F.ws = args.ws;
    unsigned char* ws = args.ws;
    for (int u = F.tid; u < (LDS_BYTES - LDSCTL_OFF) / 4; u += NWAVES * 64) ((LAS unsigned*)(F.lds + LDSCTL_OFF))[u] = 0u;
    __syncthreads();
    XcdBarrier bar; bar.bar = (unsigned*)(ws + WS_CTL) + CW_BAR; bar.x = 0; bar.st = nullptr;
    if (args.ph_hi - args.ph_lo > 1) bar = xcd_barrier_post((unsigned*)(ws + WS_CTL) + CW_BAR, (volatile LAS unsigned*)(F.lds + MISC_OFF) + 8);
    bf16* XN = (bf16*)(ws + WS_XN); bf16* PP = (bf16*)(ws + WS_PP); bf16* MIX = (bf16*)(ws + WS_MIX); bf16* HM = (bf16*)(ws + WS_HM);
    float* SS1 = (float*)(ws + WS_SS1); float* SS2 = (float*)(ws + WS_SS2);
    const int lo = args.ph_lo, hi = args.ph_hi;
#define IN(k) (lo <= (k) && (k) < hi)
#define SEAM(k) do { if (IN(k) && IN((k) + 1)) xcd_barrier(bar); } while (0)
    if (IN(0)) { p0_prologue(F, args); } SEAM(0);
    if (IN(1)) {
        EpiIn E{(bf16*)(ws + WS_Q), (bf16*)(ws + WS_K), (bf16*)(ws + WS_V), (bf16*)(ws + WS_U), args.in[6], args.in[7], (const float2*)(ws + WS_ROPE)};
        fgemm(F, XN, (const bf16*)(ws + WS_WIN), M, INW, DM, 0, E);
        EpiBf E2{PP, DM};
        fgemm(F, (const bf16*)(ws + WS_PB), (const bf16*)(ws + WS_WPROJ), M, DM, PLE, 0, E2);
    } SEAM(1);
    if (IN(2)) {
        const attn_body::AttnTensors AT{(const attn_body::bf16*)(ws + WS_Q), (const attn_body::bf16*)(ws + WS_K), (const attn_body::bf16*)(ws + WS_V), (attn_body::bf16*)MIX};
        attn_body::attn_phase<8>((char*)lds, AT, F.vcu, F.G);
        pool_phase(F);
    } SEAM(2);
    if (IN(3)) { EpiRes E{args.in[0], args.in[1], args.out, XN, SS1}; fgemm(F, MIX, (const bf16*)(ws + WS_WOUT), M, DM, DM, 0, E); } SEAM(3);
#pragma unroll 1
    for (int c = 0; c < NCHUNK; ++c) {
        const int row0 = c * CHUNK;
        if (IN(4 + 2 * c)) { EpiUp E{HM, SS1, row0}; fgemm(F, XN + (size_t)row0 * DM, (const bf16*)(ws + WS_WUP), CHUNK, DFF, DM, row0, E); } SEAM(4 + 2 * c);
        if (IN(5 + 2 * c)) { EpiRes E{args.out, args.out + (size_t)MP * DM, args.out, XN, SS2}; fgemm(F, HM, (const bf16*)(ws + WS_WDOWN), CHUNK, DM, DFF, row0, E); } SEAM(5 + 2 * c);
    }
    if (IN(10)) { EpiGate E{args.out, PP, SS2}; fgemm(F, XN, (const bf16*)(ws + WS_WGATE), M, DM, DM, 0, E); } SEAM(10);
    if (IN(11)) final_phase(F, args.out, args.in[17]);
#undef IN
#undef SEAM
}

extern "C" void kernel_launch(void* const* d_in, const int* in_sizes, int n_in, void* d_out, int out_size, void* d_ws, size_t ws_size, hipStream_t stream) {
    static int grid = 0;
    if (grid == 0) {
        if (n_in != 18 || out_size != M * DM || ws_size < WS_END) { fprintf(stderr, "kernel_launch: unexpected shapes (n_in %d out %d ws %zu)\n", n_in, out_size, ws_size); grid = -1; return; }
        if (hipFuncSetAttribute((const void*)fwd_kernel, hipFuncAttributeMaxDynamicSharedMemorySize, LDS_BYTES) != hipSuccess) { fprintf(stderr, "kernel_launch: hipFuncSetAttribute failed\n"); grid = -1; return; }
        int dev = 0, cus = 0; (void)hipGetDevice(&dev); (void)hipDeviceGetAttribute(&cus, hipDeviceAttributeMultiprocessorCount, dev);
        grid = cus > 0 ? cus : 256;
    }
    if (grid < 0) return;
    Args a{};
    for (int i = 0; i < 18; ++i) a.in[i] = (const float*)d_in[i];
    a.out = (float*)d_out; a.ws = (unsigned char*)d_ws;
#if MK_ONE_LAUNCH
    if (hipMemsetAsync((char*)d_ws + WS_CTL, 0, 65536, stream) != hipSuccess) { fprintf(stderr, "kernel_launch: memset failed\n"); return; }
    a.ph_lo = 0; a.ph_hi = NPHASE; hipLaunchKernelGGL(fwd_kernel, dim3(grid), dim3(NWAVES * 64), LDS_BYTES, stream, a);
#else
    for (int ph = 0; ph < NPHASE; ++ph) { a.ph_lo = ph; a.ph_hi = ph + 1; hipLaunchKernelGGL(fwd_kernel, dim3(grid), dim3(NWAVES * 64), LDS_BYTES, stream, a); }
#endif
}
```

```cpp
#include <hip/hip_runtime.h>
#include <cstdio>
#include <cstdint>
#include <hip/hip_bf16.h>
#include <cmath>

#ifndef PROBE_REPEAT
#define PROBE_REPEAT (-1)
#endif
#ifndef MK_ONE_LAUNCH
#define MK_ONE_LAUNCH 1
#endif

constexpr int DM = 1024, TP = 4096, TS = 8192, MP = 4 * TP, MS = 4 * TS, M = MP + MS;
constexpr int INW = 1280, DFF = 4096, PLE = 256;
constexpr int CHUNK = 16384, NCHUNK = M / CHUNK;
constexpr float EPS = 1e-6f;
constexpr float C2 = 0.125f * 1.4426950408889634f;

typedef unsigned short bf16;
typedef short bf16x8 __attribute__((ext_vector_type(8)));
typedef float f32x4 __attribute__((ext_vector_type(4)));
typedef unsigned u32x4 __attribute__((ext_vector_type(4)));
typedef unsigned u32x2 __attribute__((ext_vector_type(2)));
#define LAS __attribute__((address_space(3)))
#define GAS __attribute__((address_space(1)))

constexpr size_t MiB = 1u << 20;
constexpr size_t WS_CTL = 0, CTL_ZERO_BYTES = 1 * MiB;
constexpr size_t WS_ROPE = 1 * MiB;
constexpr size_t WS_SS1 = 2 * MiB, WS_SS2 = 5 * MiB;
constexpr size_t WS_WIN = 8 * MiB, WS_WOUT = 11 * MiB, WS_WUP = 13 * MiB, WS_WDOWN = 21 * MiB, WS_WGATE = 29 * MiB, WS_WPROJ = 31 * MiB;
constexpr size_t WS_PP = 32 * MiB;
constexpr size_t WS_XN = 128 * MiB;
constexpr size_t WS_PB = 224 * MiB;
constexpr size_t WS_Q = 248 * MiB, WS_K = 296 * MiB, WS_V = 308 * MiB, WS_U = 320 * MiB;
constexpr size_t WS_MIX = 368 * MiB;
constexpr size_t WS_HM = 224 * MiB;
constexpr size_t WS_END = 464 * MiB;

constexpr int LDS_BYTES = 147456;
constexpr int NWAVES = 8;

__device__ __forceinline__ unsigned f2bf(float f) { unsigned u = __builtin_bit_cast(unsigned, f); return (u + 0x7fffu + ((u >> 16) & 1u)) >> 16; }
__device__ __forceinline__ unsigned pk2(float lo, float hi) { return f2bf(lo) | (f2bf(hi) << 16); }
__device__ __forceinline__ float bf2f(unsigned short b) { return __builtin_bit_cast(float, (unsigned)b << 16); }
__device__ __forceinline__ float bflo(unsigned w) { return __builtin_bit_cast(float, w << 16); }
__device__ __forceinline__ float bfhi(unsigned w) { return __builtin_bit_cast(float, w & 0xffff0000u); }
__device__ __forceinline__ float wave_sum(float v) {
#pragma unroll
    for (int o = 1; o < 64; o <<= 1) v += __shfl_xor(v, o);
    return v;
}
__host__ __device__ __forceinline__ int inv_head(int n) { const int pn = n >> 8, r = n & 255, wc = r >> 6, bj = (r >> 5) & 1, j = r & 31; return pn * 256 + bj * 128 + wc * 32 + j; }

struct Args { const float* in[18]; float* out; unsigned char* ws; int ph_lo, ph_hi; };

struct Frame {
    LAS unsigned char* lds;
    int tid, lane, wave, vcu, G;
    unsigned char* ws;
};
__device__ __forceinline__ const float* xrow(const Args& A, int m) { return m < MP ? A.in[0] + (size_t)m * DM : A.in[1] + (size_t)(m - MP) * DM; }
__device__ __forceinline__ const float* prow(const Args& A, int m) { return m < MP ? A.in[2] + (size_t)m * PLE : A.in[3] + (size_t)(m - MP) * PLE; }
__device__ __forceinline__ int tpos(int m) { return m < MP ? (m & (TP - 1)) : ((m - MP) & (TS - 1)); }

__device__ __forceinline__ void p0_transpose_item(const float* W, int ldw, int K, int ncols, bf16* WT, LAS float* scr, int item, int lane, const float* kscale, bool headmap) {
    const int nblk = ncols / 32, kb = item / nblk, nb = item % nblk, k0 = 64 * kb, n0 = 32 * nb;
#pragma unroll 8
    for (int i = 0; i < 32; ++i) { const int kk = 2 * i + (lane >> 5); float v = W[(size_t)(k0 + kk) * ldw + n0 + (lane & 31)]; if (kscale) v *= kscale[k0 + kk]; scr[kk * 33 + (lane & 31)] = v; }
    asm volatile("s_waitcnt lgkmcnt(0)" ::: "memory");
    const int c = lane & 7;
#pragma unroll
    for (int j = 0; j < 4; ++j) { const int n = (lane >> 3) + 8 * j; const LAS float* s = scr + (8 * c) * 33 + n;
        u32x4 o; o.x = pk2(s[0 * 33], s[1 * 33]); o.y = pk2(s[2 * 33], s[3 * 33]); o.z = pk2(s[4 * 33], s[5 * 33]); o.w = pk2(s[6 * 33], s[7 * 33]);
        const int dr = headmap ? inv_head(n0 + n) : (n0 + n);
        *(u32x4*)(WT + (size_t)dr * K + k0 + 8 * c) = o; }
    asm volatile("s_waitcnt lgkmcnt(0)" ::: "memory");
}
__device__ __forceinline__ void p0_fold_item(const float* Win, const float* Wp, const float* psc, bf16* WT, LAS float* scr, int item, int lane) {
    const int g = item & 3, k0 = (item >> 2) * 16;
#pragma unroll
    for (int i = 0; i < 32; ++i) { const int e = i * 64 + lane, kk = e >> 7, c = e & 127; scr[e] = Win[(size_t)(k0 + kk) * INW + 768 + 128 * g + c]; }
    asm volatile("s_waitcnt lgkmcnt(0)" ::: "memory");
    float a0[16], a1[16];
#pragma unroll
    for (int kk = 0; kk < 16; ++kk) { a0[kk] = 0.f; a1[kk] = 0.f; }
    const float* wp = Wp + (size_t)g * 128 * 128;
    for (int c = 0; c < 128; ++c) {
        const float w0 = wp[c * 128 + lane], w1 = wp[c * 128 + 64 + lane];
#pragma unroll
        for (int kk = 0; kk < 16; ++kk) { const float a = scr[kk * 128 + c]; a0[kk] += a * w0; a1[kk] += a * w1; }
    }
    const float s0 = psc[128 * g + lane], s1 = psc[128 * g + 64 + lane];
    { u32x4 o0, o1; o0.x = pk2(a0[0] * s0, a0[1] * s0); o0.y = pk2(a0[2] * s0, a0[3] * s0); o0.z = pk2(a0[4] * s0, a0[5] * s0); o0.w = pk2(a0[6] * s0, a0[7] * s0);
      o1.x = pk2(a0[8] * s0, a0[9] * s0); o1.y = pk2(a0[10] * s0, a0[11] * s0); o1.z = pk2(a0[12] * s0, a0[13] * s0); o1.w = pk2(a0[14] * s0, a0[15] * s0);
      bf16* d = WT + (size_t)inv_head(768 + 128 * g + lane) * DM + k0; *(u32x4*)d = o0; *(u32x4*)(d + 8) = o1; }
    { u32x4 o0, o1; o0.x = pk2(a1[0] * s1, a1[1] * s1); o0.y = pk2(a1[2] * s1, a1[3] * s1); o0.z = pk2(a1[4] * s1, a1[5] * s1); o0.w = pk2(a1[6] * s1, a1[7] * s1);
      o1.x = pk2(a1[8] * s1, a1[9] * s1); o1.y = pk2(a1[10] * s1, a1[11] * s1); o1.z = pk2(a1[12] * s1, a1[13] * s1); o1.w = pk2(a1[14] * s1, a1[15] * s1);
      bf16* d = WT + (size_t)inv_head(768 + 128 * g + 64 + lane) * DM + k0; *(u32x4*)d = o0; *(u32x4*)(d + 8) = o1; }
    asm volatile("s_waitcnt lgkmcnt(0)" ::: "memory");
}
__device__ __forceinline__ void rms_row_to_bf16(const float* xr_, const float* g, bf16* orow, int lane) {
    const f32x4* xr = (const f32x4*)xr_ + lane; const f32x4* gr = (const f32x4*)g + lane;
    f32x4 v[4]; float s = 0.f;
#pragma unroll
    for (int j = 0; j < 4; ++j) { v[j] = xr[64 * j]; s += (v[j].x * v[j].x + v[j].y * v[j].y) + (v[j].z * v[j].z + v[j].w * v[j].w); }
    const float rstd = 1.0f / sqrtf(wave_sum(s) * (1.f / DM) + EPS);
    unsigned long long* o8 = (unsigned long long*)orow + lane;
#pragma unroll
    for (int j = 0; j < 4; ++j) { const f32x4 gg = gr[64 * j];
        o8[64 * j] = (unsigned long long)pk2(v[j].x * rstd * gg.x, v[j].y * rstd * gg.y) | ((unsigned long long)pk2(v[j].z * rstd * gg.z, v[j].w * rstd * gg.w) << 32); }
}
__device__ __forceinline__ void p0_prologue(const Frame& F, const Args& A) {
    LAS float* scr = (LAS float*)(F.lds + F.wave * 16384);
    const int gw = F.vcu * NWAVES + F.wave, NGW = F.G * NWAVES;
    bf16* Bin = (bf16*)(F.ws + WS_WIN); bf16* Bout = (bf16*)(F.ws + WS_WOUT); bf16* Bup = (bf16*)(F.ws + WS_WUP);
    bf16* Bdown = (bf16*)(F.ws + WS_WDOWN); bf16* Bgate = (bf16*)(F.ws + WS_WGATE); bf16* Bproj = (bf16*)(F.ws + WS_WPROJ);
    constexpr int I_FOLD = 64 * 4, I_IN = (DM / 64) * (768 / 32), I_OUT = (DM / 64) * (DM / 32), I_UP = (DM / 64) * (DFF / 32), I_DOWN = (DFF / 64) * (DM / 32), I_GATE = I_OUT, I_PROJ = (PLE / 64) * (DM / 32);
    constexpr int NITEMS = I_FOLD + I_IN + I_OUT + I_UP + I_DOWN + I_GATE + I_PROJ;
    for (int it = gw; it < NITEMS; it += NGW) {
        int r = it;
        if (r < I_FOLD) { p0_fold_item(A.in[5], A.in[8], A.in[9], Bin, scr, r, F.lane); continue; } r -= I_FOLD;
        if (r < I_IN) { p0_transpose_item(A.in[5], INW, DM, 768, Bin, scr, r, F.lane, nullptr, true); continue; } r -= I_IN;
        if (r < I_OUT) { p0_transpose_item(A.in[10], DM, DM, DM, Bout, scr, r, F.lane, nullptr, true); continue; } r -= I_OUT;
        if (r < I_UP) { p0_transpose_item(A.in[12], DFF, DM, DFF, Bup, scr, r, F.lane, A.in[11], true); continue; } r -= I_UP;
        if (r < I_DOWN) { p0_transpose_item(A.in[13], DM, DFF, DM, Bdown, scr, r, F.lane, nullptr, true); continue; } r -= I_DOWN;
        if (r < I_GATE) { p0_transpose_item(A.in[15], DM, DM, DM, Bgate, scr, r, F.lane, A.in[14], true); continue; } r -= I_GATE;
        p0_transpose_item(A.in[16], DM, PLE, DM, Bproj, scr, r, F.lane, nullptr, true);
    }
    bf16* XN = (bf16*)(F.ws + WS_XN); bf16* PB = (bf16*)(F.ws + WS_PB);
    for (int m = gw; m < M; m += 2 * NGW) {
        const int m1 = m + NGW;
        const f32x4* x0 = (const f32x4*)xrow(A, m) + F.lane; const f32x4* x1 = (const f32x4*)xrow(A, m1) + F.lane; const f32x4* gr = (const f32x4*)A.in[4] + F.lane;
        f32x4 v0[4], v1[4];
#pragma unroll
        for (int j = 0; j < 4; ++j) { v0[j] = x0[64 * j]; v1[j] = x1[64 * j]; }
        const f32x4 pv0 = *((const f32x4*)prow(A, m) + F.lane), pv1 = *((const f32x4*)prow(A, m1) + F.lane);
        float s0 = 0.f, s1 = 0.f;
#pragma unroll
        for (int j = 0; j < 4; ++j) { s0 += (v0[j].x * v0[j].x + v0[j].y * v0[j].y) + (v0[j].z * v0[j].z + v0[j].w * v0[j].w); s1 += (v1[j].x * v1[j].x + v1[j].y * v1[j].y) + (v1[j].z * v1[j].z + v1[j].w * v1[j].w); }
        const float r0 = 1.0f / sqrtf(wave_sum(s0) * (1.f / DM) + EPS), r1 = 1.0f / sqrtf(wave_sum(s1) * (1.f / DM) + EPS);
        unsigned long long* o0 = (unsigned long long*)(XN + (size_t)m * DM) + F.lane; unsigned long long* o1 = (unsigned long long*)(XN + (size_t)m1 * DM) + F.lane;
#pragma unroll
        for (int j = 0; j < 4; ++j) { const f32x4 gg = gr[64 * j];
            o0[64 * j] = (unsigned long long)pk2(v0[j].x * r0 * gg.x, v0[j].y * r0 * gg.y) | ((unsigned long long)pk2(v0[j].z * r0 * gg.z, v0[j].w * r0 * gg.w) << 32);
            o1[64 * j] = (unsigned long long)pk2(v1[j].x * r1 * gg.x, v1[j].y * r1 * gg.y) | ((unsigned long long)pk2(v1[j].z * r1 * gg.z, v1[j].w * r1 * gg.w) << 32); }
        *((unsigned long long*)(PB + (size_t)m * PLE) + F.lane) = (unsigned long long)pk2(pv0.x, pv0.y) | ((unsigned long long)pk2(pv0.z, pv0.w) << 32);
        *((unsigned long long*)(PB + (size_t)m1 * PLE) + F.lane) = (unsigned long long)pk2(pv1.x, pv1.y) | ((unsigned long long)pk2(pv1.z, pv1.w) << 32);
    }
    { const int gt = F.vcu * 512 + F.tid;
      if (gt < 2048) { const int p = gt >> 4, i = gt & 15; const float inv = exp2f(-(float)i * (13.287712379549449f / 16.0f)); const float a = (float)p * inv;
          float2* R = (float2*)(F.ws + WS_ROPE); R[gt] = make_float2(cosf(a), sinf(a)); } }
}

namespace pg8 {
#define PG8_LAS __attribute__((address_space(3)))
typedef unsigned short bf16_t;
typedef short bf16x8 __attribute__((ext_vector_type(8)));
typedef float f32x4 __attribute__((ext_vector_type(4)));
typedef unsigned u32x4 __attribute__((ext_vector_type(4)));
constexpr int BM = 256, BK = 64, HALF = 128, HTB = HALF * BK * 2  , STAGE_BYTES = 8 * HTB, NXCD = 8, WGM = 8;

__host__ __device__ __forceinline__ int lds_byte(int r, int c) { const int st = (r >> 4) * 2 + (c >> 5), rr = r & 15, cc = c & 31, ob = rr * 64 + cc * 2; return st * 1024 + (ob ^ (((ob >> 9) & 1) << 5)); }
__host__ __device__ __forceinline__ void stage_rc(int b, int& R, int& C) { const int st = b / 1024, sb = b % 1024, swz = sb ^ (((sb >> 9) & 1) << 5); R = (st >> 1) * 16 + swz / 64; C = (st & 1) * 32 + (swz % 64) / 2; }
__host__ __device__ __forceinline__ int perm32(int rho) { const int n = rho >> 4, i = rho & 15; return 8 * (i >> 2) + 4 * n + (i & 3); }

struct Unit { int pm, pn; };
struct Gemm { const bf16_t* A; const bf16_t* Bt; int M, N, K; };

struct StaticOrder {
    int nM, nN, nwg, G, c;
    __host__ __device__ void init(int M, int N, int G_, int c_) { nM = M / BM; nN = N / BM; nwg = nM * nN; G = G_; c = c_; }
    __host__ __device__ bool next(int i, Unit& u) const {
        const long L = (long)i * G + c; if (L >= nwg) return false;
        int wgid = (int)L; { const int q = nwg / NXCD, r = nwg % NXCD, xcd = wgid % NXCD, off = wgid / NXCD; wgid = (xcd < r ? xcd * (q + 1) : r * (q + 1) + (xcd - r) * q) + off; }
        const int nig = WGM * nN, gid = wgid / nig, fm = gid * WGM, gsz = (nM - fm) < WGM ? (nM - fm) : WGM;
        u.pm = fm + ((wgid % nig) % gsz); u.pn = (wgid % nig) / gsz; return true;
    }
    __device__ __forceinline__ void a_ready(const Unit&) const {}
    __device__ __forceinline__ void done(const Unit&) const {}
};

template <class E> struct EpiAdapt {
    static constexpr bool PERM = false, AFTER_DRAIN = false;
    E e; int row0;
    __device__ __forceinline__ void operator()(f32x4 (&acc)[2][2][4][2], const Unit& u, int wr, int wc, int fr, int fq) const {
        const int c0 = u.pn * BM + wc * 64;
#pragma unroll
        for (int ai = 0; ai < 2; ++ai)
#pragma unroll
            for (int m = 0; m < 4; ++m) {
                ::f32x4 v[4] = {acc[ai][0][m][0], acc[ai][0][m][1], acc[ai][1][m][0], acc[ai][1][m][1]};
                e.seg64(row0 + u.pm * BM + ai * HALF + wr * 64 + m * 16 + fr, c0, v, fq);
                if (m & 1) asm volatile("" ::: "memory");
            }
    }
};
template <class Epi, class Sched, bool ALIGN_EPI = false, bool SP2 = false>
__device__ __forceinline__ void gemm_phase(PG8_LAS unsigned char* lds, const Gemm g, const Sched& S, const Epi& E) {
    const int tid = threadIdx.x, wid = __builtin_amdgcn_readfirstlane(tid >> 6), lane = tid & 63, wr = wid >> 2, wc = wid & 3, fr = lane & 15, fq = lane >> 4;
    const int K = g.K, nt = K / BK;
    unsigned voffA[2], voffB[2];
#pragma unroll
    for (int i = 0; i < 2; ++i) { int R, C; stage_rc(tid * 16 + i * 8192, R, C); const int Rb = Epi::PERM ? ((R & ~31) + perm32(R & 31)) : R;
        voffA[i] = (unsigned)(R * K + C) * 2u; voffB[i] = (unsigned)(Rb * K + C) * 2u; }
    const size_t kstep = (size_t)(BK * 2);
    const size_t hstep = (size_t)HALF * K * 2;
    const size_t tstep = 2 * hstep;
    const unsigned ldsw = (unsigned)wid * 1024u;
    const int aoff = lds_byte(wr * 64 + fr, fq * 8), boff = lds_byte(wc * 32 + fr, fq * 8);
#define PG8_SA(b, h) (((b) * 2 + (h)) * HTB)
#define PG8_SB(b, h) ((4 + (b) * 2 + (h)) * HTB)
#define PG8_STAGE(bufoff, gbase, voff) do { _Pragma("unroll") for (int _i = 0; _i < 2; ++_i) { unsigned _vo = (voff)[_i]; asm volatile("" : "+v"(_vo)); \
        __builtin_amdgcn_global_load_lds((const unsigned*)((const char*)(gbase) + _vo), (PG8_LAS unsigned*)(lds + (bufoff) + ldsw + _i * 8192), 16, 0, 0); } } while (0)
#define PG8_LDA(dst, b, h) do { _Pragma("unroll") for (int m = 0; m < 4; ++m) _Pragma("unroll") for (int k = 0; k < 2; ++k) dst[m][k] = *(const PG8_LAS bf16x8*)(lds + PG8_SA(b, h) + aoff + m * 2048 + k * 1024); } while (0)
#define PG8_LDB(dst, b, h) do { _Pragma("unroll") for (int n = 0; n < 2; ++n) _Pragma("unroll") for (int k = 0; k < 2; ++k) dst[n][k] = *(const PG8_LAS bf16x8*)(lds + PG8_SB(b, h) + boff + n * 2048 + k * 1024); } while (0)
#define PG8_MMA(ai, bj, At, Bt) do { __builtin_amdgcn_s_setprio(1); _Pragma("unroll") for (int m = 0; m < 4; ++m) _Pragma("unroll") for (int n = 0; n < 2; ++n) _Pragma("unroll") for (int k = 0; k < 2; ++k) \
        acc[ai][bj][m][n] = __builtin_amdgcn_mfma_f32_16x16x32_bf16(Bt[n][k], At[m][k], acc[ai][bj][m][n], 0, 0, 0); __builtin_amdgcn_s_setprio(0); } while (0)
#define PG8_WAIT_V(n) asm volatile("s_waitcnt vmcnt(" #n ")" ::: "memory")
#define PG8_WAIT_L(n) asm volatile("s_waitcnt lgkmcnt(" #n ")" ::: "memory")
#define PG8_BAR __builtin_amdgcn_s_barrier()
#define PG8_SCHED __builtin_amdgcn_sched_barrier(0)
    Unit cur, nxt; int ui = 0;
    if (!S.next(0, cur)) return;
    f32x4 acc[2][2][4][2];
#pragma unroll
    for (int a = 0; a < 2; ++a)
#pragma unroll
        for (int b = 0; b < 2; ++b)
#pragma unroll
            for (int m = 0; m < 4; ++m)
#pragma unroll
                for (int n = 0; n < 2; ++n) acc[a][b][m][n] = (f32x4){0.f, 0.f, 0.f, 0.f};
    bf16x8 At[4][2], B0[2][2], B1[2][2];
    const char* cA = (const char*)g.A + (size_t)cur.pm * tstep; const char* cB = (const char*)g.Bt + (size_t)cur.pn * tstep;
    S.a_ready(cur);
    if constexpr (SP2) {
        PG8_STAGE(PG8_SB(0, 0), cB, voffB); PG8_STAGE(PG8_SB(0, 1), cB + hstep, voffB); PG8_STAGE(PG8_SA(0, 0), cA, voffA); PG8_STAGE(PG8_SA(0, 1), cA + hstep, voffA);
        if (wr == 1) PG8_BAR;
        PG8_WAIT_V(2); PG8_BAR;
        PG8_STAGE(PG8_SB(1, 0), cB + kstep, voffB); PG8_STAGE(PG8_SA(1, 0), cA + kstep, voffA); PG8_STAGE(PG8_SB(1, 1), cB + hstep + kstep, voffB);
        PG8_WAIT_V(6); PG8_BAR;
    } else {
        PG8_STAGE(PG8_SB(0, 0), cB, voffB); PG8_STAGE(PG8_SA(0, 0), cA, voffA); PG8_STAGE(PG8_SB(0, 1), cB + hstep, voffB); PG8_STAGE(PG8_SA(0, 1), cA + hstep, voffA);
        if (wr == 1) PG8_BAR;
        PG8_WAIT_V(4); PG8_BAR;
        PG8_STAGE(PG8_SB(1, 0), cB + kstep, voffB); PG8_STAGE(PG8_SA(1, 0), cA + kstep, voffA); PG8_STAGE(PG8_SB(1, 1), cB + hstep + kstep, voffB);
        PG8_WAIT_V(6); PG8_BAR;
    }
    for (;;) {
        const bool has_next = S.next(ui + 1, nxt);
        const char* nA = has_next ? (const char*)g.A + (size_t)nxt.pm * tstep : cA; const char* nB = has_next ? (const char*)g.Bt + (size_t)nxt.pn * tstep : cB;
        for (int t = 0; t < nt; t += 2) {
            const bool last = (t == nt - 2);
            const char* a1 = cA + (size_t)(t + 1) * kstep;
            const char* a2 = last ? nA : cA + (size_t)(t + 2) * kstep; const char* b2 = last ? nB : cB + (size_t)(t + 2) * kstep;
            const char* a3 = a2 + kstep; const char* b3 = b2 + kstep;
            if (last && has_next) S.a_ready(nxt);
            if constexpr (SP2) {
            PG8_LDB(B0, 0, 0); PG8_LDB(B1, 0, 1); PG8_SCHED; PG8_LDA(At, 0, 0); PG8_STAGE(PG8_SA(1, 1), a1 + hstep, voffA);
            PG8_WAIT_V(8); PG8_WAIT_L(0); PG8_BAR; PG8_MMA(0, 0, At, B0); PG8_MMA(0, 1, At, B1); PG8_BAR; PG8_SCHED;
            PG8_LDA(At, 0, 1); PG8_STAGE(PG8_SB(0, 0), b2, voffB); PG8_STAGE(PG8_SB(0, 1), b2 + hstep, voffB); PG8_STAGE(PG8_SA(0, 0), a2, voffA);
            PG8_WAIT_V(8); PG8_WAIT_L(0); PG8_BAR; PG8_MMA(1, 0, At, B0); PG8_MMA(1, 1, At, B1); PG8_BAR; PG8_SCHED;
            PG8_LDB(B0, 1, 0); PG8_LDB(B1, 1, 1); PG8_SCHED; PG8_LDA(At, 1, 0); PG8_STAGE(PG8_SA(0, 1), a2 + hstep, voffA);
            PG8_WAIT_V(8); PG8_WAIT_L(0); PG8_BAR; PG8_MMA(0, 0, At, B0); PG8_MMA(0, 1, At, B1); PG8_BAR; PG8_SCHED;
            PG8_LDA(At, 1, 1); PG8_STAGE(PG8_SB(1, 0), b3, voffB); PG8_STAGE(PG8_SB(1, 1), b3 + hstep, voffB); PG8_STAGE(PG8_SA(1, 0), a3, voffA);
            PG8_WAIT_V(8); PG8_WAIT_L(0); PG8_BAR; PG8_MMA(1, 0, At, B0); PG8_MMA(1, 1, At, B1); PG8_BAR; PG8_SCHED;
            } else {
            PG8_LDB(B0, 0, 0); PG8_SCHED; PG8_LDA(At, 0, 0); PG8_STAGE(PG8_SA(1, 1), a1 + hstep, voffA);
            PG8_WAIT_L(8); PG8_BAR; PG8_WAIT_L(0); PG8_MMA(0, 0, At, B0); PG8_BAR; PG8_SCHED;
            PG8_LDB(B1, 0, 1); PG8_STAGE(PG8_SB(0, 0), b2, voffB);
            PG8_BAR; PG8_WAIT_L(0); PG8_MMA(0, 1, At, B1); PG8_BAR;
            PG8_LDA(At, 0, 1); PG8_STAGE(PG8_SA(0, 0), a2, voffA);
            PG8_BAR; PG8_WAIT_L(0); PG8_MMA(1, 0, At, B0); PG8_BAR; PG8_SCHED;
            PG8_STAGE(PG8_SB(0, 1), b2 + hstep, voffB);
            PG8_WAIT_V(6); PG8_BAR; PG8_MMA(1, 1, At, B1); PG8_BAR;
            PG8_LDB(B0, 1, 0); PG8_SCHED; PG8_LDA(At, 1, 0); PG8_STAGE(PG8_SA(0, 1), a2 + hstep, voffA);
            PG8_WAIT_L(8); PG8_BAR; PG8_WAIT_L(0); PG8_MMA(0, 0, At, B0); PG8_BAR; PG8_SCHED;
            PG8_LDB(B1, 1, 1); PG8_STAGE(PG8_SB(1, 0), b3, voffB);
            PG8_BAR; PG8_WAIT_L(0); PG8_MMA(0, 1, At, B1); PG8_BAR;
            PG8_LDA(At, 1, 1); PG8_STAGE(PG8_SA(1, 0), a3, voffA);
            PG8_BAR; PG8_WAIT_L(0); PG8_MMA(1, 0, At, B0); PG8_BAR; PG8_SCHED;
            PG8_STAGE(PG8_SB(1, 1), b3 + hstep, voffB);
            PG8_WAIT_V(6); PG8_BAR; PG8_MMA(1, 1, At, B1); PG8_BAR;
            }
        }
        if constexpr (ALIGN_EPI) { if (wr == 0) PG8_BAR; }
        if constexpr (!Epi::AFTER_DRAIN) { E(acc, cur, wr, wc, fr, fq); S.done(cur); }
        if (!has_next) break;
#pragma unroll
        for (int a = 0; a < 2; ++a)
#pragma unroll
            for (int b = 0; b < 2; ++b)
#pragma unroll
                for (int m = 0; m < 4; ++m)
#pragma unroll
                    for (int n = 0; n < 2; ++n) acc[a][b][m][n] = (f32x4){0.f, 0.f, 0.f, 0.f};
        cur = nxt; cA = nA; cB = nB; ++ui;
        if constexpr (ALIGN_EPI) { if (wr == 1) PG8_BAR; }
    }
    PG8_WAIT_V(0);
    if constexpr (!ALIGN_EPI) { if (wr == 0) PG8_BAR; }
    PG8_BAR;
    if constexpr (Epi::AFTER_DRAIN) { E.fused(acc, cur, wr, wc, fr, fq, lds, wid, lane); S.done(cur); }
#undef PG8_SA
#undef PG8_SB
#undef PG8_STAGE
#undef PG8_LDA
#undef PG8_LDB
#undef PG8_MMA
#undef PG8_WAIT_V
#undef PG8_WAIT_L
#undef PG8_BAR
#undef PG8_SCHED
}
}

template <class Epi>
__device__ __forceinline__ void sgemm(const bf16* A, int lda, int a_row_sub, const bf16* Bt, int K, int row0, int nrows, int N, bool headmap, const Epi& E, const Frame& F) {
    const int nN = N / 64, nU = (nrows / 256) * nN, fr = F.lane & 15, fq = F.lane >> 4;
    for (int u = F.vcu; u < nU; u += F.G) {
        const int pm = u / nN, pn = u % nN, r0 = row0 + pm * 256 + F.wave * 32, c0 = pn * 64;
        f32x4 acc[2][4];
#pragma unroll
        for (int a = 0; a < 2; ++a)
#pragma unroll
            for (int b = 0; b < 4; ++b) acc[a][b] = (f32x4){0.f, 0.f, 0.f, 0.f};
        const bf16* ap0 = A + (size_t)(r0 - a_row_sub + fr) * lda + 8 * fq; const bf16* ap1 = ap0 + (size_t)16 * lda;
        const bf16* bp[4];
#pragma unroll
        for (int nt = 0; nt < 4; ++nt) { const int n = c0 + 16 * nt + fr; bp[nt] = Bt + (size_t)(headmap ? inv_head(n) : n) * K + 8 * fq; }
        for (int k0 = 0; k0 < K; k0 += 32) {
            const bf16x8 a0 = *(const bf16x8*)(ap0 + k0), a1 = *(const bf16x8*)(ap1 + k0);
            bf16x8 b[4];
#pragma unroll
            for (int nt = 0; nt < 4; ++nt) b[nt] = *(const bf16x8*)(bp[nt] + k0);
#pragma unroll
            for (int nt = 0; nt < 4; ++nt) { acc[0][nt] = __builtin_amdgcn_mfma_f32_16x16x32_bf16(b[nt], a0, acc[0][nt], 0, 0, 0); acc[1][nt] = __builtin_amdgcn_mfma_f32_16x16x32_bf16(b[nt], a1, acc[1][nt], 0, 0, 0); }
        }
        E.seg64(r0 + fr, c0, acc[0], fq); E.seg64(r0 + 16 + fr, c0, acc[1], fq);
    }
}

__device__ __forceinline__ void st_bf16x4(bf16* p, f32x4 v) { u32x2 w; w.x = pk2(v[0], v[1]); w.y = pk2(v[2], v[3]); *(u32x2*)p = w; }
__device__ __forceinline__ float quad_sum(float s) { s += __shfl_xor(s, 16); s += __shfl_xor(s, 32); return s; }
__device__ __forceinline__ float rstd_from_ss(const float* ss16) {
    const f32x4* p = (const f32x4*)ss16; const f32x4 a = p[0], b = p[1], c = p[2], d = p[3];
    const float s = ((a.x + a.y) + (a.z + a.w)) + ((b.x + b.y) + (b.z + b.w)) + ((c.x + c.y) + (c.z + c.w)) + ((d.x + d.y) + (d.z + d.w));
    return 1.0f / sqrtf(s * (1.f / DM) + EPS);
}

struct EpiIn {
    bf16 *Q, *K, *V, *U; const float *qg, *kg; const float2* rope;
    __device__ __forceinline__ void seg64(int m, int c0, f32x4 (&v)[4], int fq) const {
        if (c0 < 640) {
            const bool isq = c0 < 512;
            float ss = 0.f;
#pragma unroll
            for (int nt = 0; nt < 4; ++nt) ss += (v[nt][0] * v[nt][0] + v[nt][1] * v[nt][1]) + (v[nt][2] * v[nt][2] + v[nt][3] * v[nt][3]);
            ss = quad_sum(ss);
            const float rstd = 1.0f / sqrtf(ss * (1.f / 64.f) + EPS);
            const float* g = isq ? qg : kg;
#pragma unroll
            for (int nt = 0; nt < 4; ++nt) { const f32x4 gg = *(const f32x4*)(g + 16 * nt + 4 * fq); v[nt] = v[nt] * rstd * gg; }
            const int t = tpos(m), pr = t >> 6, pc = t & 63;
            const float sc = isq ? C2 : 1.0f;
            f32x4 o[4];
#pragma unroll
            for (int j = 0; j < 4; ++j) {
                const float2 cr = rope[pr * 16 + 4 * fq + j], cc = rope[pc * 16 + 4 * fq + j];
                o[0][j] = (v[0][j] * cr.x - v[1][j] * cr.y) * sc; o[1][j] = (v[1][j] * cr.x + v[0][j] * cr.y) * sc;
                o[2][j] = (v[2][j] * cc.x - v[3][j] * cc.y) * sc; o[3][j] = (v[3][j] * cc.x + v[2][j] * cc.y) * sc;
            }
            bf16* dst = isq ? Q + (size_t)m * 512 + c0 : K + (size_t)m * 128 + (c0 - 512);
#pragma unroll
            for (int nt = 0; nt < 4; ++nt) st_bf16x4(dst + 16 * nt + 4 * fq, o[nt]);
        } else {
            bf16* dst = c0 < 768 ? V + (size_t)m * 128 + (c0 - 640) : U + (size_t)m * 512 + (c0 - 768);
#pragma unroll
            for (int nt = 0; nt < 4; ++nt) st_bf16x4(dst + 16 * nt + 4 * fq, v[nt]);
        }
    }
};
struct EpiBf {
    bf16* O; int ld;
    __device__ __forceinline__ void seg64(int m, int c0, f32x4 (&v)[4], int fq) const {
#pragma unroll
        for (int nt = 0; nt < 4; ++nt) st_bf16x4(O + (size_t)m * ld + c0 + 16 * nt + 4 * fq, v[nt]);
    }
};
struct EpiRes {
    const float* base0; const float* base1; float* out; bf16* HB; float* SS;
    __device__ __forceinline__ void seg64(int m, int c0, f32x4 (&v)[4], int fq) const {
        const float* b = (m < MP ? base0 + (size_t)m * DM : base1 + (size_t)(m - MP) * DM) + c0 + 4 * fq;
        float* o = out + (size_t)m * DM + c0 + 4 * fq; bf16* hb = HB + (size_t)m * DM + c0 + 4 * fq; float ss = 0.f;
#pragma unroll
        for (int nt = 0; nt < 4; ++nt) { const f32x4 h = *(const f32x4*)(b + 16 * nt) + v[nt]; *(f32x4*)(o + 16 * nt) = h; st_bf16x4(hb + 16 * nt, h);
            ss += (h[0] * h[0] + h[1] * h[1]) + (h[2] * h[2] + h[3] * h[3]); }
        ss = quad_sum(ss);
        if (fq == 0) SS[(size_t)m * 16 + (c0 >> 6)] = ss;
    }
};
struct EpiUp {
    bf16* HM; const float* SS; int row0;
    __device__ __forceinline__ void seg64(int m, int c0, f32x4 (&v)[4], int fq) const {
        const float rstd = rstd_from_ss(SS + (size_t)m * 16);
        bf16* d = HM + (size_t)(m - row0) * DFF + c0 + 4 * fq;
#pragma unroll
        for (int nt = 0; nt < 4; ++nt) { f32x4 a = v[nt] * rstd;
#pragma unroll
            for (int j = 0; j < 4; ++j) { const float r = fmaxf(a[j], 0.f); a[j] = r * r; }
            st_bf16x4(d + 16 * nt, a); }
    }
};
struct EpiGate {
    const float* out; float* dst; const bf16* PP; const float* SS;
    __device__ __forceinline__ void seg64(int m, int c0, f32x4 (&v)[4], int fq) const {
        const float rstd = rstd_from_ss(SS + (size_t)m * 16);
        const float* o = out + (size_t)m * DM + c0 + 4 * fq; float* d = dst + (size_t)m * DM + c0 + 4 * fq; const bf16* pp = PP + (size_t)m * DM + c0 + 4 * fq;
#pragma unroll
        for (int nt = 0; nt < 4; ++nt) { const u32x2 w = *(const u32x2*)(pp + 16 * nt); f32x4 h = *(const f32x4*)(o + 16 * nt);
            const float p0 = bflo(w.x), p1 = bfhi(w.x), p2 = bflo(w.y), p3 = bfhi(w.y);
            h[0] += p0 / (1.0f + __expf(-v[nt][0] * rstd)); h[1] += p1 / (1.0f + __expf(-v[nt][1] * rstd));
            h[2] += p2 / (1.0f + __expf(-v[nt][2] * rstd)); h[3] += p3 / (1.0f + __expf(-v[nt][3] * rstd));
            *(f32x4*)(d + 16 * nt) = h; }
    }
};

namespace attn_body {
using bf16=__hip_bfloat16;
using bf16x8=__attribute__((ext_vector_type(8)))short;
using s16x4=__attribute__((ext_vector_type(4)))short;
using f32x16=__attribute__((ext_vector_type(16)))float;
using u32x4=__attribute__((ext_vector_type(4)))unsigned;
constexpr int D=64,QP=512,KP=128,OP=1024;
constexpr int NW=8,QBLK=32,QB=QBLK*NW,KVBLK=64;
constexpr int ATTN_UNIT_ROWS=QB;
__device__ __forceinline__ int crow(int r,int hi){return (r&3)+8*(r>>2)+4*hi;}
#define SBAR() __builtin_amdgcn_sched_barrier(0)

constexpr int NSLOT=3, SLOTB=8192;
constexpr int LDS_K=0, LDS_V=NSLOT*SLOTB, LDS_WS=2*NSLOT*SLOTB, LDS_OST=LDS_WS+NW*64*4, LDS_BYTES=LDS_OST+NW*4096;
constexpr float C2=0.125f*1.4426950408889634f;
__device__ __forceinline__ void glds16(const void*gsrc,unsigned lds_dst){unsigned keep;
  asm volatile("s_mov_b32 %0, m0\n\ts_mov_b32 m0, %2\n\ts_nop 0\n\tglobal_load_lds_dwordx4 %1, off\n\ts_mov_b32 m0, %0":"=&s"(keep):"v"(gsrc),"s"(lds_dst):"memory");}
__device__ __forceinline__ float max3f(float a,float b,float c){float r;asm("v_max3_f32 %0, %1, %2, %3":"=v"(r):"v"(a),"v"(b),"v"(c));return r;}
__device__ __forceinline__ float max2f(float a,float b){float r;asm("v_max_f32_e32 %0, %1, %2":"=v"(r):"v"(a),"v"(b));return r;}
__device__ __forceinline__ float fadd_s(float a,float b){float r;asm("v_add_f32_e32 %0, %1, %2":"=v"(r):"v"(a),"v"(b));return r;}
__device__ __forceinline__ float fsub_s(float a,float b){float r;asm("v_sub_f32_e32 %0, %1, %2":"=v"(r):"v"(a),"v"(b));return r;}
typedef float f32x2_t __attribute__((ext_vector_type(2))); typedef __bf16 bf16x2_t __attribute__((ext_vector_type(2)));
__device__ __forceinline__ unsigned cvtpk_s(float lo,float hi){f32x2_t v={lo,hi};bf16x2_t b=__builtin_convertvector(v,bf16x2_t);return __builtin_bit_cast(unsigned,b);}
#define WAIT_BAR(N) asm volatile("s_waitcnt vmcnt(" #N ") lgkmcnt(0)\n\ts_barrier":::"memory")

__device__ __forceinline__ void qkt(f32x16&p0,f32x16&p1,const char*Kslot,const bf16x8*qr,const f32x16&negm,int r32,int hi){
  const char*kb=Kslot+hi*1024+r32*16;
  #pragma unroll
  for(int d0=0;d0<4;++d0){
    const bf16x8 b0=*reinterpret_cast<const bf16x8*>(kb+d0*2048);
    const bf16x8 b1=*reinterpret_cast<const bf16x8*>(kb+d0*2048+512);
    if(d0==0){p0=__builtin_amdgcn_mfma_f32_32x32x16_bf16(b0,qr[0],negm,0,0,0);p1=__builtin_amdgcn_mfma_f32_32x32x16_bf16(b1,qr[0],negm,0,0,0);}
    else{p0=__builtin_amdgcn_mfma_f32_32x32x16_bf16(b0,qr[d0],p0,0,0,0);p1=__builtin_amdgcn_mfma_f32_32x32x16_bf16(b1,qr[d0],p1,0,0,0);}}
}
typedef __attribute__((address_space(3))) const char* lds_cptr;
typedef short v4i16_t __attribute__((ext_vector_type(4)));
__device__ __forceinline__ void kload8(bf16x8*kf,lds_cptr kp){
  kf[0]=*(const __attribute__((address_space(3))) bf16x8*)(kp);      kf[1]=*(const __attribute__((address_space(3))) bf16x8*)(kp+512);
  kf[2]=*(const __attribute__((address_space(3))) bf16x8*)(kp+2048); kf[3]=*(const __attribute__((address_space(3))) bf16x8*)(kp+2560);
  kf[4]=*(const __attribute__((address_space(3))) bf16x8*)(kp+4096); kf[5]=*(const __attribute__((address_space(3))) bf16x8*)(kp+4608);
  kf[6]=*(const __attribute__((address_space(3))) bf16x8*)(kp+6144); kf[7]=*(const __attribute__((address_space(3))) bf16x8*)(kp+6656);
}
__device__ __forceinline__ void kload2(bf16x8*kf,lds_cptr kp,int j){ kf[2*j]=*(const __attribute__((address_space(3))) bf16x8*)(kp+j*2048); kf[2*j+1]=*(const __attribute__((address_space(3))) bf16x8*)(kp+j*2048+512); }
__device__ __forceinline__ s16x4 vtr(lds_cptr p){ return __builtin_bit_cast(s16x4,__builtin_amdgcn_ds_read_tr16_b64_v4i16((__attribute__((address_space(3))) v4i16_t*)p)); }
__device__ __forceinline__ float rowmax(const f32x16&p0,const f32x16&p1){
  float a=max3f(p0[0],p0[1],p1[0]),b=max3f(p0[2],p0[3],p1[1]);a=max3f(a,p1[2],p1[3]);
  #pragma unroll
  for(int r=4;r<16;r+=4){a=max3f(a,p0[r],p0[r+1]);b=max3f(b,p0[r+2],p0[r+3]);a=max3f(a,p1[r],p1[r+1]);b=max3f(b,p1[r+2],p1[r+3]);}
  const float m=max2f(a,b);
  auto rr=__builtin_amdgcn_permlane32_swap(__float_as_uint(m),__float_as_uint(m),false,false);
  return max2f(__uint_as_float(rr[0]),__uint_as_float(rr[1]));
}
__device__ __forceinline__ void pv(f32x16*o,int vb,bf16x8 pa0,bf16x8 pa1,bf16x8 pa2,bf16x8 pa3){
  #pragma unroll
  for(int d0=0;d0<2;++d0){s16x4 lo[4],hi[4];
    #pragma unroll
    for(int ks=0;ks<4;++ks){
      asm volatile("ds_read_b64_tr_b16 %0,%1 offset:%c2":"=&v"(lo[ks]):"v"(vb),"i"(d0*4096+ks*1024):"memory");
      asm volatile("ds_read_b64_tr_b16 %0,%1 offset:%c2":"=&v"(hi[ks]):"v"(vb),"i"(d0*4096+ks*1024+512):"memory");}
    asm volatile("s_waitcnt lgkmcnt(0)":::"memory");SBAR();
    #define PK(k) (bf16x8){lo[k][0],lo[k][1],lo[k][2],lo[k][3],hi[k][0],hi[k][1],hi[k][2],hi[k][3]}
    o[d0]=__builtin_amdgcn_mfma_f32_32x32x16_bf16(pa0,PK(0),o[d0],0,0,0);
    o[d0]=__builtin_amdgcn_mfma_f32_32x32x16_bf16(pa1,PK(1),o[d0],0,0,0);
    o[d0]=__builtin_amdgcn_mfma_f32_32x32x16_bf16(pa2,PK(2),o[d0],0,0,0);
    o[d0]=__builtin_amdgcn_mfma_f32_32x32x16_bf16(pa3,PK(3),o[d0],0,0,0);
    #undef PK
  }
}

#ifndef ATTN_STORE16
#define ATTN_STORE16(p,v) (*(u32x4*)(p)=(v))
#endif
template<int THRL> __device__ __forceinline__ void attn_unit(int rowbase_,int T_,int h,int qb,const bf16*Q,const bf16*__restrict__ K,const bf16*__restrict__ V,bf16*O,char*shm){
  const int tid=threadIdx.x,lane=tid&63,r32=lane&31,hi=lane>>5; const int wid=__builtin_amdgcn_readfirstlane(tid>>6);
  const long rowbase=(long)rowbase_; const int q0=qb*QB; const int kvh=h>>2;
  const bf16*Qw=Q+(rowbase+q0+wid*QBLK)*QP+h*D;
  const bf16*Kh=K+rowbase*KP+kvh*D,*Vh=V+rowbase*KP+kvh*D;
  const unsigned lds0=(unsigned)(uintptr_t)shm;
  float*wsf=(float*)(shm+LDS_WS)+wid*64;
  const bf16*ksrc=Kh+(long)lane*KP+wid*8;
  const bf16*vsrc=Vh+(long)(16*(wid&3)+(lane>>2))*KP+(wid>>2)*32+(lane&3)*8;
  const unsigned kdst=lds0+LDS_K+wid*1024, vdst=lds0+LDS_V+wid*1024;
  #define DMA_K(t,slot) glds16(ksrc+(long)(t)*KVBLK*KP,(unsigned)__builtin_amdgcn_readfirstlane(kdst+(slot)))
  #define DMA_V(t,slot) glds16(vsrc+(long)(t)*KVBLK*KP,(unsigned)__builtin_amdgcn_readfirstlane(vdst+(slot)))
  const int vb0=(int)(lds0+LDS_V)+((lane>>4)&1)*32+(lane&3)*8+(4*hi+((lane&15)>>2))*64;
  const char*Kbase=shm+LDS_K; bf16x8 kf[8];
  const lds_cptr shm3=(lds_cptr)shm; const lds_cptr kp0=shm3+LDS_K+hi*1024+r32*16; const lds_cptr vp0=shm3+LDS_V+((lane>>4)&1)*32+(lane&3)*8+(4*hi+((lane&15)>>2))*64;
  const int NT=T_/KVBLK;
  DMA_K(0,0);DMA_V(0,0);DMA_K(1,SLOTB);
  bf16x8 qr[4];
  #pragma unroll
  for(int d0=0;d0<4;++d0)qr[d0]=*reinterpret_cast<const bf16x8*>(&Qw[(long)r32*QP+d0*16+hi*8]);
  float mhat=0.f,l_reg=0.f;f32x16 o[2];o[0]=f32x16{};o[1]=f32x16{};f32x16 negm=f32x16{};asm volatile("":"+v"(negm));
  const int qrel=wid*QBLK+r32;
  #define CMASK(P0,P1,t) do{}while(0)
  bool resc=false;
  #define START(P0,P1) do{ const float rm=rowmax(P0,P1); resc=false; \
    { const float dl=rm; mhat=fadd_s(mhat,dl); \
      _Pragma("unroll") for(int r=0;r<16;++r){P0[r]=fsub_s(P0[r],dl);P1[r]=fsub_s(P1[r],dl);} \
      _Pragma("unroll") for(int r=0;r<16;++r)negm[r]=-mhat; asm volatile("":"+v"(negm)); } \
    _Pragma("unroll") for(int r=0;r<16;++r)P0[r]=__builtin_amdgcn_exp2f(P0[r]); }while(0)
  #define RESC() do{ if(resc){ asm volatile("s_waitcnt lgkmcnt(0)":::"memory"); \
      _Pragma("unroll") for(int d_=0;d_<2;++d_) _Pragma("unroll") for(int r=0;r<16;++r)o[d_][r]*=wsf[crow(r,hi)]; } }while(0)
  f32x16 pA0,pA1,pB0,pB1;
  int sl_prev=0,sl_cur=0,sl_next=SLOTB;
  #define ROT() do{sl_prev=sl_cur;sl_cur=sl_next;sl_next=(sl_next==(NSLOT-1)*SLOTB)?0:sl_next+SLOTB;}while(0)
  DMA_K(2,2*SLOTB);
  WAIT_BAR(3);
  qkt(pA0,pA1,Kbase,qr,negm,r32,hi);asm volatile("s_nop 15\n\ts_nop 7":"+v"(pA0),"+v"(pA1));CMASK(pA0,pA1,0);
  START(pA0,pA1);
  _Pragma("unroll") for(int r=0;r<16;++r)pA1[r]=__builtin_amdgcn_exp2f(pA1[r]);
  WAIT_BAR(0);
  DMA_K(3,0);DMA_V(1,SLOTB);
  ROT();
  kload8(kf,kp0+sl_cur);
  WAIT_BAR(2);
  s16x4 vlo[8],vhi[8]; u32x4 pw0,pw1,pw2,pw3;
  #define PKW(P,B) cvtpk_s(P[B],P[B+1])
  #define PAF(k) __builtin_bit_cast(bf16x8,pw##k)
  #define VFR(i) (bf16x8){vlo[i][0],vlo[i][1],vlo[i][2],vlo[i][3],vhi[i][0],vhi[i][1],vhi[i][2],vhi[i][3]}
  #define PIN(x) asm volatile("":"+v"(x))
  #define MX3(a,b,c) __builtin_fmaxf(__builtin_fmaxf((a),(b)),(c))
  #define GAPA(MF,A0,A1,A2,A3,W0,W1,PW) do{ MF; sacc+=A0; sacc+=A1; sacc+=A2; sacc+=A3; PIN(sacc); W0; W1; PIN(PW); SBAR(); }while(0)
  #define EX(v) __builtin_amdgcn_exp2f(v)
  #define GAPB(MF,X,B) do{ MF; X[B]=EX(X[B]); X[B+1]=EX(X[B+1]); X[B+2]=EX(X[B+2]); X[B+3]=EX(X[B+3]); PIN(X); SBAR(); }while(0)
  #define VRD(i) do{ vlo[i]=vtr(vp_+(((i)>>2)*4096+((i)&3)*1024)); vhi[i]=vtr(vp_+(((i)>>2)*4096+((i)&3)*1024+512)); }while(0)
  #define KRD(G,j) do{ if(G){ kload2(kf,kp0+sl_next,j); SBAR(); } }while(0)
  #define STEP(C0,C1,P0,P1,t,GK,GV,GL) do{ SBAR(); \
    const lds_cptr vp_=vp0+sl_prev; \
    VRD(0); SBAR(); float sacc=(P0[0]+P0[1]); \
    GAPA(C0=__builtin_amdgcn_mfma_f32_32x32x16_bf16(kf[0],qr[0],negm,0,0,0), P0[2],P0[3],P0[4],P0[5],     pw0[0]=PKW(P0,0), pw0[1]=PKW(P0,2), pw0); \
    VRD(4); SBAR(); GAPA(C1=__builtin_amdgcn_mfma_f32_32x32x16_bf16(kf[1],qr[0],negm,0,0,0), P0[6],P0[7],P0[8],P0[9],     pw0[2]=PKW(P0,4), pw0[3]=PKW(P0,6), pw0); \
    VRD(1); SBAR(); GAPA(C0=__builtin_amdgcn_mfma_f32_32x32x16_bf16(kf[2],qr[1],C0,0,0,0),   P0[10],P0[11],P0[12],P0[13], pw1[0]=PKW(P0,8), pw1[1]=PKW(P0,10), pw1); \
    VRD(5); SBAR(); GAPA(C1=__builtin_amdgcn_mfma_f32_32x32x16_bf16(kf[3],qr[1],C1,0,0,0),   P0[14],P0[15],P1[0],P1[1],   pw1[2]=PKW(P0,12),pw1[3]=PKW(P0,14), pw1); \
    VRD(2); SBAR(); GAPA(C0=__builtin_amdgcn_mfma_f32_32x32x16_bf16(kf[4],qr[2],C0,0,0,0),   P1[2],P1[3],P1[4],P1[5],     pw2[0]=PKW(P1,0), pw2[1]=PKW(P1,2), pw2); \
    VRD(6); SBAR(); GAPA(C1=__builtin_amdgcn_mfma_f32_32x32x16_bf16(kf[5],qr[2],C1,0,0,0),   P1[6],P1[7],P1[8],P1[9],     pw2[2]=PKW(P1,4), pw2[3]=PKW(P1,6), pw2); \
    VRD(3); SBAR(); GAPA(C0=__builtin_amdgcn_mfma_f32_32x32x16_bf16(kf[6],qr[3],C0,0,0,0),   P1[10],P1[11],P1[12],P1[13], pw3[0]=PKW(P1,8), pw3[1]=PKW(P1,10), pw3); \
    VRD(7); SBAR(); GAPA(C1=__builtin_amdgcn_mfma_f32_32x32x16_bf16(kf[7],qr[3],C1,0,0,0),   P1[14],P1[15],0.f,0.f,       pw3[2]=PKW(P1,12),pw3[3]=PKW(P1,14), pw3); \
    l_reg+=sacc; \
    if(GK){DMA_K((t)+3,sl_cur);} if(GV){DMA_V((t)+1,sl_next);} \
    CMASK(C0,C1,t); \
    { float a=MX3(C0[0],C0[1],C1[0]),b=MX3(C0[2],C0[3],C1[1]); a=MX3(a,C1[2],C1[3]); \
      _Pragma("unroll") for(int r=4;r<16;r+=4){a=MX3(a,C0[r],C0[r+1]);b=MX3(b,C0[r+2],C0[r+3]);a=MX3(a,C1[r],C1[r+1]);b=MX3(b,C1[r+2],C1[r+3]);} \
      float rm=__builtin_fmaxf(a,b); { auto rr=__builtin_amdgcn_permlane32_swap(__float_as_uint(rm),__float_as_uint(rm),false,false); rm=__builtin_fmaxf(__uint_as_float(rr[0]),__uint_as_float(rr[1])); } \
      resc=false; \
      if(__builtin_expect(__any(rm>(float)THRL),0)){ const float dl=__builtin_fmaxf(rm,0.f); mhat+=dl; \
        _Pragma("unroll") for(int r=0;r<16;++r){C0[r]-=dl;C1[r]-=dl;} \
        _Pragma("unroll") for(int r=0;r<16;++r)negm[r]=-mhat; asm volatile("":"+v"(negm)); \
        const float f=__builtin_amdgcn_exp2f(-dl); l_reg*=f; if(hi==0)wsf[r32]=f; resc=true; } } \
    SBAR(); \
    GAPB(o[0]=__builtin_amdgcn_mfma_f32_32x32x16_bf16(PAF(0),VFR(0),o[0],0,0,0), C0,0); \
    GAPB(o[1]=__builtin_amdgcn_mfma_f32_32x32x16_bf16(PAF(0),VFR(4),o[1],0,0,0), C0,4); \
    KRD(GL,0); GAPB(o[0]=__builtin_amdgcn_mfma_f32_32x32x16_bf16(PAF(1),VFR(1),o[0],0,0,0), C0,8); \
    KRD(GL,1); GAPB(o[1]=__builtin_amdgcn_mfma_f32_32x32x16_bf16(PAF(1),VFR(5),o[1],0,0,0), C0,12); \
    KRD(GL,2); GAPB(o[0]=__builtin_amdgcn_mfma_f32_32x32x16_bf16(PAF(2),VFR(2),o[0],0,0,0), C1,0); \
    KRD(GL,3); GAPB(o[1]=__builtin_amdgcn_mfma_f32_32x32x16_bf16(PAF(2),VFR(6),o[1],0,0,0), C1,4); \
    GAPB(o[0]=__builtin_amdgcn_mfma_f32_32x32x16_bf16(PAF(3),VFR(3),o[0],0,0,0), C1,8); \
    GAPB(o[1]=__builtin_amdgcn_mfma_f32_32x32x16_bf16(PAF(3),VFR(7),o[1],0,0,0), C1,12); \
    }while(0)
  int t=1;
  #undef CMASK
  #define CMASK(P0,P1,t) do{}while(0)
  for(;t+5<NT;t+=2){
    STEP(pB0,pB1,pA0,pA1,t,true,true,true);     WAIT_BAR(2); RESC(); ROT();
    STEP(pA0,pA1,pB0,pB1,t+1,true,true,true);   WAIT_BAR(2); RESC(); ROT();
  }
  #undef CMASK
  #define CMASK(P0,P1,t) do{}while(0)
  #define ENDW(tt) do{ if((tt)+3<NT){WAIT_BAR(2);} else if((tt)+2<NT){WAIT_BAR(1);} else {WAIT_BAR(0);} }while(0)
  for(;t+1<NT;t+=2){
    STEP(pB0,pB1,pA0,pA1,t,(t+3<NT),(t+1<NT),(t+1<NT));       ENDW(t);   RESC(); ROT();
    STEP(pA0,pA1,pB0,pB1,t+1,(t+4<NT),(t+2<NT),(t+2<NT));     ENDW(t+1); RESC(); ROT();
  }
  STEP(pB0,pB1,pA0,pA1,NT-1,false,false,false); RESC();
  { float sacc=pB0[0]+pB0[1]; _Pragma("unroll") for(int r=2;r<16;++r)sacc+=pB0[r]; _Pragma("unroll") for(int r=0;r<16;++r)sacc+=pB1[r]; l_reg+=sacc;
    pw0=(u32x4){PKW(pB0,0),PKW(pB0,2),PKW(pB0,4),PKW(pB0,6)};pw1=(u32x4){PKW(pB0,8),PKW(pB0,10),PKW(pB0,12),PKW(pB0,14)};pw2=(u32x4){PKW(pB1,0),PKW(pB1,2),PKW(pB1,4),PKW(pB1,6)};pw3=(u32x4){PKW(pB1,8),PKW(pB1,10),PKW(pB1,12),PKW(pB1,14)};
    SBAR(); pv(o,vb0+sl_cur,PAF(0),PAF(1),PAF(2),PAF(3)); }
  #undef PKW
  #undef PAF
  #undef VFR
  #undef PIN
  #undef MX3
  #undef GAPA
  #undef GAPB
  #undef EX
  #undef VRD
  #undef KRD
  #undef STEP
  #undef ENDW
  {auto rr=__builtin_amdgcn_permlane32_swap(__float_as_uint(l_reg),__float_as_uint(l_reg),false,false);l_reg=__uint_as_float(rr[0])+__uint_as_float(rr[1]);}
  if(hi==0)wsf[32+r32]=l_reg;asm volatile("s_waitcnt lgkmcnt(0)":::"memory");
  float rli[16];
  #pragma unroll
  for(int r=0;r<16;++r)rli[r]=__builtin_amdgcn_rcpf(wsf[32+crow(r,hi)]);
  bf16*Ow=O+(rowbase+q0+wid*QBLK)*OP+h*D;
  { bf16*stg=(bf16*)(shm+LDS_OST)+wid*2048;
    #pragma unroll
    for(int r=0;r<16;++r){const int orow=crow(r,hi);
      #pragma unroll
      for(int d0=0;d0<2;++d0)stg[orow*64+d0*32+r32]=__float2bfloat16(o[d0][r]*rli[r]);}
    asm volatile("s_waitcnt lgkmcnt(0)":::"memory");
    #pragma unroll
    for(int i=0;i<4;++i){const int row=i*8+(lane>>3),ch=lane&7; const u32x4 v=*(const u32x4*)(stg+row*64+ch*8); ATTN_STORE16(Ow+(long)row*OP+ch*8,v);} }
  asm volatile("s_waitcnt lgkmcnt(0)\n\ts_barrier":::"memory");
  #undef DMA_K
  #undef DMA_V
  #undef CMASK
  #undef START
  #undef RESC
  #undef ROT
}
constexpr int ATTN_LDS_BYTES=LDS_BYTES;
struct AttnTensors { const bf16* Q; const bf16* K; const bf16* V; bf16* O; };
template<int THRL=8> __device__ __forceinline__ void attn_phase(char*lds,const AttnTensors&T,int vcu,int G){
  if(G==256){
    const int x=vcu>>5,j=vcu&31;
    for(int i=0;i<4;++i){ const int w=j*4+i,g=w>>5,qb=w&31; attn_unit<THRL>(16384+(x>>1)*8192,8192,(x&1)*4+g,qb,T.Q,T.K,T.V,T.O,lds); }
    for(int i=0;i<2;++i){ const int w=j*2+i,g=w>>4,qb=w&15; attn_unit<THRL>((x>>1)*4096,4096,(x&1)*4+g,qb,T.Q,T.K,T.V,T.O,lds); }
  } else {
    for(int u=vcu;u<1536;u+=G){
      if(u<1024){ const int qb=u&31,h=(u>>5)&7,s=u>>8; attn_unit<THRL>(16384+s*8192,8192,h,qb,T.Q,T.K,T.V,T.O,lds); }
      else { const int v=u-1024,qb=v&15,h=(v>>4)&7,s=v>>7; attn_unit<THRL>(s*4096,4096,h,qb,T.Q,T.K,T.V,T.O,lds); }
    }
  }
}
#undef SBAR
#undef WAIT_BAR
}

__device__ __forceinline__ void sattn_unit(const Frame& F, int seq, int h, int qb) {
    const int T = seq < 4 ? TP : TS; const int rowbase = seq < 4 ? seq * TP : MP + (seq - 4) * TS;
    const bf16* Q = (const bf16*)(F.ws + WS_Q); const bf16* Kb = (const bf16*)(F.ws + WS_K); const bf16* Vb = (const bf16*)(F.ws + WS_V); bf16* MIX = (bf16*)(F.ws + WS_MIX);
    const int kvh = h >> 2, m = rowbase + qb * 512 + F.tid;
    LAS float* Ks = (LAS float*)F.lds; LAS float* Vs = Ks + 64 * 64;
    float q[64], o[64];
    { const u32x4* qp = (const u32x4*)(Q + (size_t)m * 512 + h * 64);
#pragma unroll
      for (int i = 0; i < 8; ++i) { const u32x4 w = qp[i]; q[8 * i] = bflo(w.x); q[8 * i + 1] = bfhi(w.x); q[8 * i + 2] = bflo(w.y); q[8 * i + 3] = bfhi(w.y); q[8 * i + 4] = bflo(w.z); q[8 * i + 5] = bfhi(w.z); q[8 * i + 6] = bflo(w.w); q[8 * i + 7] = bfhi(w.w); } }
#pragma unroll
    for (int d = 0; d < 64; ++d) o[d] = 0.f;
    float mx = -1e30f, l = 0.f;
    const int lr = F.tid >> 3, lc = (F.tid & 7) * 8;
    for (int kt = 0; kt < T / 64; ++kt) {
        __syncthreads();
        { const size_t grow = (size_t)(rowbase + kt * 64 + lr) * 128 + kvh * 64 + lc;
          const u32x4 kw = *(const u32x4*)(Kb + grow), vw = *(const u32x4*)(Vb + grow);
          LAS f32x4* kd = (LAS f32x4*)(Ks + lr * 64 + lc); LAS f32x4* vd = (LAS f32x4*)(Vs + lr * 64 + lc);
          kd[0] = (f32x4){bflo(kw.x), bfhi(kw.x), bflo(kw.y), bfhi(kw.y)}; kd[1] = (f32x4){bflo(kw.z), bfhi(kw.z), bflo(kw.w), bfhi(kw.w)};
          vd[0] = (f32x4){bflo(vw.x), bfhi(vw.x), bflo(vw.y), bfhi(vw.y)}; vd[1] = (f32x4){bflo(vw.z), bfhi(vw.z), bflo(vw.w), bfhi(vw.w)}; }
        __syncthreads();
#pragma unroll 1
        for (int j = 0; j < 64; ++j) {
            const LAS f32x4* Kc = (const LAS f32x4*)(Ks + j * 64); const LAS f32x4* Vc = (const LAS f32x4*)(Vs + j * 64);
            float a = 0.f;
#pragma unroll
            for (int d4 = 0; d4 < 16; ++d4) { const f32x4 kv = Kc[d4]; a += q[4 * d4] * kv.x + q[4 * d4 + 1] * kv.y + q[4 * d4 + 2] * kv.z + q[4 * d4 + 3] * kv.w; }
            const float mn = fmaxf(mx, a), alpha = exp2f(mx - mn), p = exp2f(a - mn); mx = mn; l = l * alpha + p;
#pragma unroll
            for (int d4 = 0; d4 < 16; ++d4) { const f32x4 vv = Vc[d4]; o[4 * d4] = o[4 * d4] * alpha + p * vv.x; o[4 * d4 + 1] = o[4 * d4 + 1] * alpha + p * vv.y; o[4 * d4 + 2] = o[4 * d4 + 2] * alpha + p * vv.z; o[4 * d4 + 3] = o[4 * d4 + 3] * alpha + p * vv.w; }
        }
    }
    const float il = 1.0f / l;
    u32x4* op = (u32x4*)(MIX + (size_t)m * DM + h * 64);
#pragma unroll
    for (int i = 0; i < 8; ++i) { u32x4 w; w.x = pk2(o[8 * i] * il, o[8 * i + 1] * il); w.y = pk2(o[8 * i + 2] * il, o[8 * i + 3] * il); w.z = pk2(o[8 * i + 4] * il, o[8 * i + 5] * il); w.w = pk2(o[8 * i + 6] * il, o[8 * i + 7] * il); op[i] = w; }
}
__device__ __forceinline__ void sattn_phase(const Frame& F) {
    for (int u = F.vcu; u < 768; u += F.G) {
        if (u < 512) { const int qb = u & 15, h = (u >> 4) & 7, s = u >> 7; sattn_unit(F, 4 + s, h, qb); }
        else { const int v = u - 512, qb = v & 7, h = (v >> 3) & 7, s = v >> 6; sattn_unit(F, s, h, qb); }
    }
}
__device__ __forceinline__ void pool_phase(const Frame& F) {
    const bf16* U = (const bf16*)(F.ws + WS_U); bf16* MIX = (bf16*)(F.ws + WS_MIX);
    LAS u32x4* T = (LAS u32x4*)F.lds;
    const int g = F.wave & 3, half = 1 << g, ch = 16 * g + (F.lane & 15), rbase = 32 * (F.wave >> 2) + (F.lane >> 4);
    for (int u = F.vcu; u < M / 64; u += F.G) {
        const int r0 = u * 64, Tlen = r0 < MP ? TP : TS, t0 = tpos(r0);
        __syncthreads();
#pragma unroll
        for (int i = 0; i < 10; ++i) { const int e = F.tid + 512 * i, rr = e >> 6, cc = e & 63, t = t0 - 8 + rr;
            if (t >= 0 && t < Tlen) T[e] = *(const u32x4*)(U + (size_t)(r0 - 8 + rr) * 512 + cc * 8); }
        __syncthreads();
#pragma unroll 2
        for (int i = 0; i < 8; ++i) {
            const int r = rbase + 4 * i, t = t0 + r, lo = max(t - half, 0), hi = min(t + half, Tlen);
            float a[8];
#pragma unroll
            for (int k = 0; k < 8; ++k) a[k] = 0.f;
            for (int j = lo; j < hi; ++j) { const u32x4 w = T[(j - t0 + 8) * 64 + ch];
                a[0] += bflo(w.x); a[1] += bfhi(w.x); a[2] += bflo(w.y); a[3] += bfhi(w.y); a[4] += bflo(w.z); a[5] += bfhi(w.z); a[6] += bflo(w.w); a[7] += bfhi(w.w); }
            const float inv = 1.0f / (float)(hi - lo);
            const u32x4 w = T[(r + 8) * 64 + ch];
            u32x4 o; o.x = pk2(a[0] * inv - bflo(w.x), a[1] * inv - bfhi(w.x)); o.y = pk2(a[2] * inv - bflo(w.y), a[3] * inv - bfhi(w.y));
            o.z = pk2(a[4] * inv - bflo(w.z), a[5] * inv - bfhi(w.z)); o.w = pk2(a[6] * inv - bflo(w.w), a[7] * inv - bfhi(w.w));
            *(u32x4*)(MIX + (size_t)(r0 + r) * DM + 512 + ch * 8) = o;
        }
    }
    __syncthreads();
}
__device__ __forceinline__ void final_phase(const Frame& F, const float* src, float* out, const float* g) {
    const int gw = F.vcu * NWAVES + F.wave, NGW = F.G * NWAVES; const f32x4* gr = (const f32x4*)g + F.lane;
    for (int m = gw; m < M; m += NGW) {
        const f32x4* xs = (const f32x4*)(src + (size_t)m * DM) + F.lane; f32x4* xr = (f32x4*)(out + (size_t)m * DM) + F.lane; f32x4 v[4]; float s = 0.f;
#pragma unroll
        for (int j = 0; j < 4; ++j) { v[j] = xs[64 * j]; s += (v[j].x * v[j].x + v[j].y * v[j].y) + (v[j].z * v[j].z + v[j].w * v[j].w); }
        const float rstd = 1.0f / sqrtf(wave_sum(s) * (1.f / DM) + EPS);
#pragma unroll
        for (int j = 0; j < 4; ++j) xr[64 * j] = v[j] * rstd * gr[64 * j];
    }
}


constexpr int CW_BAR = 4096;
constexpr int LDSCTL_OFF = 131072, MISC_OFF = LDSCTL_OFF + 320;
#define XB_TMO      128
#define XB_XCNT(j)  (256  + 64 * (j))
#define XB_XSUB(j)  (1280 + 64 * (j))
#define XB_XGEN(j)  (2304 + 64 * (j))
#define XB_TOP      3328
#define XB_TOPGEN   3392
#define XCD_BAR_WORDS 3456
#define XB_SPIN_CAP (1u << 20)
__device__ __forceinline__ unsigned xb_ld(unsigned* p)              { return __hip_atomic_load(p, __ATOMIC_RELAXED, __HIP_MEMORY_SCOPE_AGENT); }
__device__ __forceinline__ unsigned xb_add(unsigned* p, unsigned v) { return __hip_atomic_fetch_add(p, v, __ATOMIC_RELAXED, __HIP_MEMORY_SCOPE_AGENT); }
__device__ __forceinline__ unsigned xb_xcc_id() { return (unsigned)__builtin_amdgcn_s_getreg((3 << 11) | 20) & 0xFu; }
#define XB_SPIN(cond, bar) do { unsigned _sp = 0; while (cond) { __builtin_amdgcn_s_sleep(1); \
    if ((++_sp & 255u) == 0u) { if (xb_ld(&(bar)[XB_TMO])) break; if (_sp > XB_SPIN_CAP) { atomicAdd(&(bar)[XB_TMO], 1u); break; } } } } while (0)
struct XcdBarrier { unsigned* bar; unsigned x; volatile LAS unsigned* st; };
__device__ __forceinline__ XcdBarrier xcd_barrier_post(unsigned* bar, volatile LAS unsigned* st) {
    XcdBarrier b; b.bar = bar; b.x = xb_xcc_id(); b.st = st;
    if (threadIdx.x == 0) (void)xb_add(&bar[XB_XCNT(b.x)], 1u);
    return b;
}
__device__ __forceinline__ void xcd_barrier_complete(unsigned* bar, unsigned x, unsigned& nloc, unsigned& nx) {
    const unsigned G = gridDim.x * gridDim.y * gridDim.z;
    unsigned sum, cnt, mine, sp = 0u;
    for (;;) {
        sum = 0u; cnt = 0u; mine = 0u;
#pragma unroll
        for (unsigned j = 0; j < 16; ++j) { const unsigned c = xb_ld(&bar[XB_XCNT(j)]); sum += c; cnt += (c > 0u) ? 1u : 0u; mine = (j == x) ? c : mine; }
        if (sum == G) break;
        __builtin_amdgcn_s_sleep(1);
        if ((++sp & 255u) == 0u) { if (xb_ld(&bar[XB_TMO])) break; if (sp > XB_SPIN_CAP) { atomicAdd(&bar[XB_TMO], 1u); break; } }
    }
    nloc = mine > 0u ? mine : 1u; nx = cnt > 0u ? cnt : 1u;
}
__device__ __forceinline__ void xcd_barrier(const XcdBarrier& b) {
    asm volatile("s_waitcnt vmcnt(0)" ::: "memory");
    __syncthreads();
    if (threadIdx.x == 0) {
        unsigned* bar = b.bar;
        __builtin_amdgcn_s_waitcnt(0);
        unsigned nloc = b.st[0], nx = b.st[1];
        if (nloc == 0u) { xcd_barrier_complete(bar, b.x, nloc, nx); b.st[0] = nloc; b.st[1] = nx; }
        const unsigned old = xb_add(&bar[XB_XSUB(b.x)], 1u);
        const unsigned gen = old / nloc;
        if (old + 1u == (gen + 1u) * nloc) {
            __builtin_amdgcn_fence(__ATOMIC_RELEASE, "agent");
            asm volatile("s_waitcnt vmcnt(0)" ::: "memory");
            const unsigned og = xb_add(&bar[XB_TOP], 1u);
            const unsigned tg = og / nx;
            if (og + 1u == (tg + 1u) * nx) xb_add(&bar[XB_TOPGEN], 1u);
            else XB_SPIN(xb_ld(&bar[XB_TOPGEN]) == tg, bar);
            __builtin_amdgcn_fence(__ATOMIC_ACQUIRE, "agent");
            xb_add(&bar[XB_XGEN(b.x)], 1u);
            asm volatile("s_waitcnt vmcnt(0)" ::: "memory");
        } else {
            XB_SPIN(xb_ld(&bar[XB_XGEN(b.x)]) == gen, bar);
            __builtin_amdgcn_fence(__ATOMIC_ACQUIRE, "agent");
            asm volatile("s_waitcnt vmcnt(0)" ::: "memory");
        }
    }
    __syncthreads();
}


template <class E>
__device__ __forceinline__ void fgemm(const Frame& F, const bf16* A, const bf16* Bt, int Mrows, int N, int K, int row0, const E& e) {
    pg8::Gemm g{A, Bt, Mrows, N, K}; pg8::StaticOrder S; S.init(Mrows, N, F.G, (int)blockIdx.x);
    pg8::EpiAdapt<E> EA{e, row0};
    pg8::gemm_phase<pg8::EpiAdapt<E>, pg8::StaticOrder, true, true>(F.lds, g, S, EA);
}

constexpr int CW_GRP = 8192;
constexpr int CW_GRP_TMO = 8192 + 64 * 64;
__device__ __forceinline__ void group_sync(unsigned* cnt, unsigned target, unsigned* tmo) {
    asm volatile("s_waitcnt vmcnt(0)" ::: "memory");
    __syncthreads();
    if (threadIdx.x == 0) {
        __builtin_amdgcn_fence(__ATOMIC_RELEASE, "agent");
        asm volatile("s_waitcnt vmcnt(0)" ::: "memory");
        (void)xb_add(cnt, 1u);
        unsigned sp = 0u;
        while (xb_ld(cnt) < target) { __builtin_amdgcn_s_sleep(1); if (++sp > (1u << 21)) { atomicAdd(tmo, 1u); break; } }
        __builtin_amdgcn_fence(__ATOMIC_ACQUIRE, "agent");
        asm volatile("s_waitcnt vmcnt(0)" ::: "memory");
    }
    __syncthreads();
}
__device__ __forceinline__ f32x4 ld_bf16x4(const bf16* p) { const u32x2 w = *(const u32x2*)p; return (f32x4){bflo(w.x), bfhi(w.x), bflo(w.y), bfhi(w.y)}; }
struct EpiResA {
    const float* x0; const float* x1; bf16* HB; float* SS;
    __device__ __forceinline__ void seg64(int m, int c0, f32x4 (&v)[4], int fq) const {
        const float* b = (m < MP ? x0 + (size_t)m * DM : x1 + (size_t)(m - MP) * DM) + c0 + 4 * fq;
        bf16* hb = HB + (size_t)m * DM + c0 + 4 * fq; float ss = 0.f;
#pragma unroll
        for (int nt = 0; nt < 4; ++nt) { const f32x4 h = *(const f32x4*)(b + 16 * nt) + v[nt]; st_bf16x4(hb + 16 * nt, h); ss += (h[0] * h[0] + h[1] * h[1]) + (h[2] * h[2] + h[3] * h[3]); }
        ss = quad_sum(ss);
        if (fq == 0) SS[(size_t)m * 16 + (c0 >> 6)] = ss;
    }
};
struct EpiResC {
    bf16* HB; float* SS;
    __device__ __forceinline__ void seg64(int m, int c0, f32x4 (&v)[4], int fq) const {
        bf16* hb = HB + (size_t)m * DM + c0 + 4 * fq; float ss = 0.f;
#pragma unroll
        for (int nt = 0; nt < 4; ++nt) { const f32x4 h = ld_bf16x4(hb + 16 * nt) + v[nt]; st_bf16x4(hb + 16 * nt, h); ss += (h[0] * h[0] + h[1] * h[1]) + (h[2] * h[2] + h[3] * h[3]); }
        ss = quad_sum(ss);
        if (fq == 0) SS[(size_t)m * 16 + (c0 >> 6)] = ss;
    }
};
namespace pg8 {
struct EpiGateFinal {
    static constexpr bool PERM = false, AFTER_DRAIN = true;
    const bf16* HB; const bf16* PP; const float* SS2; float* SS3; float* out; const float* fg; unsigned* cnt; unsigned target; unsigned* tmo; int row0;
    __device__ __forceinline__ void fused(f32x4 (&acc)[2][2][4][2], const Unit& u, int wr, int wc, int fr, int fq, PG8_LAS unsigned char* lds, int wid, int lane) const {
        const int c0 = u.pn * BM + wc * 64;
#pragma unroll
        for (int ai = 0; ai < 2; ++ai)
#pragma unroll
            for (int m = 0; m < 4; ++m) {
                const int row = row0 + ai * HALF + wr * 64 + m * 16 + fr;
                const float rstd = rstd_from_ss(SS2 + (size_t)row * 16);
                const bf16* hb = HB + (size_t)row * DM + c0 + 4 * fq; const bf16* pp = PP + (size_t)row * DM + c0 + 4 * fq; float ss = 0.f;
#pragma unroll
                for (int bj = 0; bj < 2; ++bj)
#pragma unroll
                    for (int n = 0; n < 2; ++n) { const int nt = 2 * bj + n; const ::f32x4 hv = ld_bf16x4(hb + 16 * nt), pv = ld_bf16x4(pp + 16 * nt); ::f32x4 a = acc[ai][bj][m][n], h;
#pragma unroll
                        for (int e = 0; e < 4; ++e) h[e] = hv[e] + pv[e] / (1.0f + __expf(-a[e] * rstd));
                        acc[ai][bj][m][n] = h; ss += (h[0] * h[0] + h[1] * h[1]) + (h[2] * h[2] + h[3] * h[3]); }
                ss = quad_sum(ss);
                if (fq == 0) SS3[(size_t)row * 16 + (c0 >> 6)] = ss;
                if (m & 1) asm volatile("" ::: "memory");
            }
        group_sync(cnt, target, tmo);
#pragma unroll
        for (int ai = 0; ai < 2; ++ai)
#pragma unroll
            for (int m = 0; m < 4; ++m) {
                const int row = row0 + ai * HALF + wr * 64 + m * 16 + fr;
                const float rstd = rstd_from_ss(SS3 + (size_t)row * 16);
                float* o = out + (size_t)row * DM + c0 + 4 * fq; const float* g = fg + c0 + 4 * fq;
#pragma unroll
                for (int bj = 0; bj < 2; ++bj)
#pragma unroll
                    for (int n = 0; n < 2; ++n) { const int nt = 2 * bj + n; *(::f32x4*)(o + 16 * nt) = acc[ai][bj][m][n] * rstd * *(const ::f32x4*)(g + 16 * nt); }
                if (m & 1) asm volatile("" ::: "memory");
            }
    }
};
struct ListOrder {
    int pn0, n;
    __device__ __forceinline__ bool next(int i, Unit& u) const { if (i >= n) return false; u.pm = 0; u.pn = pn0 + i; return true; }
    __device__ __forceinline__ void a_ready(const Unit&) const {}
    __device__ __forceinline__ void done(const Unit&) const {}
};
}
template <class E>
__device__ __forceinline__ void lgemm(const Frame& F, const bf16* A, const bf16* Bt, int N, int K, int row0, int pn0, int n, const E& e) {
    pg8::Gemm g{A, Bt, 256, N, K}; pg8::ListOrder S{pn0, n};
    pg8::EpiAdapt<E> EA{e, row0};
    pg8::gemm_phase<pg8::EpiAdapt<E>, pg8::ListOrder, true, true>(F.lds, g, S, EA);
}
__device__ __forceinline__ void tail_phase(const Frame& F, const Args& args) {
    unsigned char* ws = F.ws;
    bf16* HB = (bf16*)(ws + WS_XN); const bf16* PP = (const bf16*)(ws + WS_PP); const bf16* MIX = (const bf16*)(ws + WS_MIX);
    float* SS1 = (float*)(ws + WS_SS1); float* SS2 = (float*)(ws + WS_SS2);
    const int gidx = F.vcu >> 2, mem = F.vcu & 3, cls = gidx & 3;
    bf16* HMg = (bf16*)(ws + WS_HM) + (size_t)gidx * 256 * DFF;
    unsigned* cnt = (unsigned*)(ws + WS_CTL) + CW_GRP + 64 * gidx; unsigned* tmo = (unsigned*)(ws + WS_CTL) + CW_GRP_TMO; unsigned nsync = 0u;
    const unsigned long long order = cls == 0 ? 0xEA62D951C840ull : cls == 1 ? 0xEA6D295C8410ull : cls == 2 ? 0xEAD629C58140ull : 0xEDCA69584210ull;
#pragma unroll 1
    for (int s = 0; s < 12; ++s) {
        const int code = (int)((order >> (4 * s)) & 15ull), st = code >> 2, c = code & 3, row0 = (c * 64 + gidx) * 256;
        if (st == 0) { EpiResA E{args.in[0], args.in[1], HB, SS1}; lgemm(F, MIX + (size_t)row0 * DM, (const bf16*)(ws + WS_WOUT), DM, DM, row0, mem, 1, E); group_sync(cnt, 4u * (++nsync), tmo); }
        else if (st == 1) { EpiUp E{HMg, SS1, row0}; lgemm(F, HB + (size_t)row0 * DM, (const bf16*)(ws + WS_WUP), DFF, DM, row0, 4 * mem, 4, E); group_sync(cnt, 4u * (++nsync), tmo); }
        else if (st == 2) { EpiResC E{HB, SS2}; lgemm(F, HMg, (const bf16*)(ws + WS_WDOWN), DM, DFF, row0, mem, 1, E); group_sync(cnt, 4u * (++nsync), tmo); }
        else { pg8::Gemm g{HB + (size_t)row0 * DM, (const bf16*)(ws + WS_WGATE), 256, DM, DM}; pg8::ListOrder S{mem, 1};
               pg8::EpiGateFinal E{HB, PP, SS2, SS1, args.out, args.in[17], cnt, 4u * (++nsync), tmo, row0};
               pg8::gemm_phase<pg8::EpiGateFinal, pg8::ListOrder, false, true>(F.lds, g, S, E); }
    }
}
constexpr int NPHASE = 4;
__global__ void __launch_bounds__(NWAVES * 64, 2) fwd_kernel(Args args) {
    extern __shared__ __attribute__((aligned(16))) unsigned char lds[];
    Frame F;
    F.lds = (LAS unsigned char*)lds; F.tid = threadIdx.x; F.lane = F.tid & 63; F.wave = __builtin_amdgcn_readfirstlane(F.tid >> 6);
    F.G = gridDim.x; { const int bx = blockIdx.x; F.vcu = (F.G % 8 == 0) ? (bx % 8) * (F.G / 8) + bx / 8 : bx; }
    F.ws = args.ws;
    unsigned char* ws = args.ws;
    for (int u = F.tid; u < (LDS_BYTES - LDSCTL_OFF) / 4; u += NWAVES * 64) ((LAS unsigned*)(F.lds + LDSCTL_OFF))[u] = 0u;
    __syncthreads();
    XcdBarrier bar; bar.bar = (unsigned*)(ws + WS_CTL) + CW_BAR; bar.x = 0; bar.st = nullptr;
    if (args.ph_hi - args.ph_lo > 1) bar = xcd_barrier_post((unsigned*)(ws + WS_CTL) + CW_BAR, (volatile LAS unsigned*)(F.lds + MISC_OFF) + 8);
    bf16* XN = (bf16*)(ws + WS_XN); bf16* PP = (bf16*)(ws + WS_PP); bf16* MIX = (bf16*)(ws + WS_MIX); bf16* HM = (bf16*)(ws + WS_HM);
    float* SS1 = (float*)(ws + WS_SS1); float* SS2 = (float*)(ws + WS_SS2);
    const int lo = args.ph_lo, hi = args.ph_hi;
#define IN(k) (lo <= (k) && (k) < hi)
#define SEAM(k) do { if (IN(k) && IN((k) + 1)) xcd_barrier(bar); } while (0)
#define NREP(k) ((PROBE_REPEAT == (k)) ? 2 : 1)
#define REPBAR() do { if (rep) xcd_barrier(bar); } while (0)
    float* const dry = (float*)(ws + WS_HM);
    if (IN(0)) {
#pragma unroll 1
        for (int rep = 0; rep < NREP(0); ++rep) { REPBAR(); p0_prologue(F, args); } } SEAM(0);
    if (IN(1)) {
#pragma unroll 1
        for (int rep = 0; rep < NREP(1); ++rep) { REPBAR();
        EpiIn E{(bf16*)(ws + WS_Q), (bf16*)(ws + WS_K), (bf16*)(ws + WS_V), (bf16*)(ws + WS_U), args.in[6], args.in[7], (const float2*)(ws + WS_ROPE)};
        fgemm(F, XN, (const bf16*)(ws + WS_WIN), M, INW, DM, 0, E); }
#pragma unroll 1
        for (int rep = 0; rep < NREP(13); ++rep) { REPBAR();
        EpiBf E2{PP, DM};
        fgemm(F, (const bf16*)(ws + WS_PB), (const bf16*)(ws + WS_WPROJ), M, DM, PLE, 0, E2); }
    } SEAM(1);
    if (IN(2)) {
        const attn_body::AttnTensors AT{(const attn_body::bf16*)(ws + WS_Q), (const attn_body::bf16*)(ws + WS_K), (const attn_body::bf16*)(ws + WS_V), (attn_body::bf16*)MIX};
#pragma unroll 1
        for (int rep = 0; rep < NREP(2); ++rep) { REPBAR(); attn_body::attn_phase<8>((char*)lds, AT, F.vcu, F.G); }
#pragma unroll 1
        for (int rep = 0; rep < NREP(12); ++rep) { REPBAR(); pool_phase(F); }
    } SEAM(2);
    if (IN(3)) tail_phase(F, args);
#undef NREP
#undef REPBAR
#undef IN
#undef SEAM
}

extern "C" void kernel_launch(void* const* d_in, const int* in_sizes, int n_in, void* d_out, int out_size, void* d_ws, size_t ws_size, hipStream_t stream) {
    static int grid = 0;
    if (grid == 0) {
        if (n_in != 18 || out_size != M * DM || ws_size < WS_END) { fprintf(stderr, "kernel_launch: unexpected shapes (n_in %d out %d ws %zu)\n", n_in, out_size, ws_size); grid = -1; return; }
        if (hipFuncSetAttribute((const void*)fwd_kernel, hipFuncAttributeMaxDynamicSharedMemorySize, LDS_BYTES) != hipSuccess) { fprintf(stderr, "kernel_launch: hipFuncSetAttribute failed\n"); grid = -1; return; }
        int dev = 0, cus = 0; (void)hipGetDevice(&dev); (void)hipDeviceGetAttribute(&cus, hipDeviceAttributeMultiprocessorCount, dev);
        grid = cus > 0 ? cus : 256;
    }
    if (grid < 0) return;
    Args a{};
    for (int i = 0; i < 18; ++i) a.in[i] = (const float*)d_in[i];
    a.out = (float*)d_out; a.ws = (unsigned char*)d_ws;
#if MK_ONE_LAUNCH
    if (hipMemsetAsync((char*)d_ws + WS_CTL, 0, 65536, stream) != hipSuccess) { fprintf(stderr, "kernel_launch: memset failed\n"); return; }
    a.ph_lo = 0; a.ph_hi = NPHASE; hipLaunchKernelGGL(fwd_kernel, dim3(grid), dim3(NWAVES * 64), LDS_BYTES, stream, a);
#else
    for (int ph = 0; ph < NPHASE; ++ph) { a.ph_lo = ph; a.ph_hi = ph + 1; hipLaunchKernelGGL(fwd_kernel, dim3(grid), dim3(NWAVES * 64), LDS_BYTES, stream, a); }
#endif
}
```

```cpp
#include <hip/hip_runtime.h>
#include <cstdio>
#include <cstdint>
#include <hip/hip_bf16.h>
#include <cmath>

#ifndef PROBE_REPEAT
#define PROBE_REPEAT (-1)
#endif
#ifndef TAIL_REP
#define TAIL_REP (-1)
#endif
#ifndef TAIL_CLS
#define TAIL_CLS 0
#endif
#ifndef MK_ONE_LAUNCH
#define MK_ONE_LAUNCH 1
#endif

constexpr int DM = 1024, TP = 4096, TS = 8192, MP = 4 * TP, MS = 4 * TS, M = MP + MS;
constexpr int INW = 1280, DFF = 4096, PLE = 256;
constexpr int CHUNK = 16384, NCHUNK = M / CHUNK;
constexpr float EPS = 1e-6f;
constexpr float C2 = 0.125f * 1.4426950408889634f;

typedef unsigned short bf16;
typedef short bf16x8 __attribute__((ext_vector_type(8)));
typedef float f32x4 __attribute__((ext_vector_type(4)));
typedef unsigned u32x4 __attribute__((ext_vector_type(4)));
typedef unsigned u32x2 __attribute__((ext_vector_type(2)));
#define LAS __attribute__((address_space(3)))
#define GAS __attribute__((address_space(1)))

constexpr size_t MiB = 1u << 20;
constexpr size_t WS_CTL = 0, CTL_ZERO_BYTES = 1 * MiB;
constexpr size_t WS_ROPE = 1 * MiB;
constexpr size_t WS_SS1 = 2 * MiB, WS_SS2 = 5 * MiB;
constexpr size_t WS_WIN = 8 * MiB, WS_WOUT = 11 * MiB, WS_WUP = 13 * MiB, WS_WDOWN = 21 * MiB, WS_WGATE = 29 * MiB, WS_WPROJ = 31 * MiB;
constexpr size_t WS_PP = 32 * MiB;
constexpr size_t WS_XN = 128 * MiB;
constexpr size_t WS_PB = 464 * MiB;
constexpr size_t WS_Q = 248 * MiB, WS_K = 296 * MiB, WS_V = 308 * MiB, WS_U = 320 * MiB;
constexpr size_t WS_MIX = 368 * MiB;
constexpr size_t WS_HM = 224 * MiB;
constexpr size_t WS_END = 488 * MiB;

constexpr int LDS_BYTES = 147456;
constexpr int NWAVES = 8;

__device__ __forceinline__ unsigned f2bf(float f) { unsigned u = __builtin_bit_cast(unsigned, f); return (u + 0x7fffu + ((u >> 16) & 1u)) >> 16; }
__device__ __forceinline__ unsigned pk2(float lo, float hi) { return f2bf(lo) | (f2bf(hi) << 16); }
__device__ __forceinline__ float bf2f(unsigned short b) { return __builtin_bit_cast(float, (unsigned)b << 16); }
__device__ __forceinline__ float bflo(unsigned w) { return __builtin_bit_cast(float, w << 16); }
__device__ __forceinline__ float bfhi(unsigned w) { return __builtin_bit_cast(float, w & 0xffff0000u); }
__device__ __forceinline__ float wave_sum(float v) {
#pragma unroll
    for (int o = 1; o < 64; o <<= 1) v += __shfl_xor(v, o);
    return v;
}
__host__ __device__ __forceinline__ int inv_head(int n) { const int pn = n >> 8, r = n & 255, wc = r >> 6, bj = (r >> 5) & 1, j = r & 31; return pn * 256 + bj * 128 + wc * 32 + j; }

struct Args { const float* in[18]; float* out; unsigned char* ws; int ph_lo, ph_hi; };

struct Frame {
    LAS unsigned char* lds;
    int tid, lane, wave, vcu, G;
    unsigned char* ws;
};
__device__ __forceinline__ const float* xrow(const Args& A, int m) { return m < MP ? A.in[0] + (size_t)m * DM : A.in[1] + (size_t)(m - MP) * DM; }
__device__ __forceinline__ const float* prow(const Args& A, int m) { return m < MP ? A.in[2] + (size_t)m * PLE : A.in[3] + (size_t)(m - MP) * PLE; }
__device__ __forceinline__ int tpos(int m) { return m < MP ? (m & (TP - 1)) : ((m - MP) & (TS - 1)); }

__device__ __forceinline__ void p0_transpose_item(const float* W, int ldw, int K, int ncols, bf16* WT, LAS float* scr, int item, int lane, const float* kscale, bool headmap) {
    const int nblk = ncols / 32, kb = item / nblk, nb = item % nblk, k0 = 64 * kb, n0 = 32 * nb;
#pragma unroll 8
    for (int i = 0; i < 32; ++i) { const int kk = 2 * i + (lane >> 5); float v = W[(size_t)(k0 + kk) * ldw + n0 + (lane & 31)]; if (kscale) v *= kscale[k0 + kk]; scr[kk * 33 + (lane & 31)] = v; }
    asm volatile("s_waitcnt lgkmcnt(0)" ::: "memory");
    const int c = lane & 7;
#pragma unroll
    for (int j = 0; j < 4; ++j) { const int n = (lane >> 3) + 8 * j; const LAS float* s = scr + (8 * c) * 33 + n;
        u32x4 o; o.x = pk2(s[0 * 33], s[1 * 33]); o.y = pk2(s[2 * 33], s[3 * 33]); o.z = pk2(s[4 * 33], s[5 * 33]); o.w = pk2(s[6 * 33], s[7 * 33]);
        const int dr = headmap ? inv_head(n0 + n) : (n0 + n);
        *(u32x4*)(WT + (size_t)dr * K + k0 + 8 * c) = o; }
    asm volatile("s_waitcnt lgkmcnt(0)" ::: "memory");
}
__device__ __forceinline__ void p0_fold_item(const float* Win, const float* Wp, const float* psc, bf16* WT, LAS float* scr, int item, int lane) {
    const int g = item & 3, k0 = (item >> 2) * 16;
#pragma unroll
    for (int i = 0; i < 32; ++i) { const int e = i * 64 + lane, kk = e >> 7, c = e & 127; scr[e] = Win[(size_t)(k0 + kk) * INW + 768 + 128 * g + c]; }
    asm volatile("s_waitcnt lgkmcnt(0)" ::: "memory");
    float a0[16], a1[16];
#pragma unroll
    for (int kk = 0; kk < 16; ++kk) { a0[kk] = 0.f; a1[kk] = 0.f; }
    const float* wp = Wp + (size_t)g * 128 * 128;
    for (int c = 0; c < 128; ++c) {
        const float w0 = wp[c * 128 + lane], w1 = wp[c * 128 + 64 + lane];
#pragma unroll
        for (int kk = 0; kk < 16; ++kk) { const float a = scr[kk * 128 + c]; a0[kk] += a * w0; a1[kk] += a * w1; }
    }
    const float s0 = psc[128 * g + lane], s1 = psc[128 * g + 64 + lane];
    { u32x4 o0, o1; o0.x = pk2(a0[0] * s0, a0[1] * s0); o0.y = pk2(a0[2] * s0, a0[3] * s0); o0.z = pk2(a0[4] * s0, a0[5] * s0); o0.w = pk2(a0[6] * s0, a0[7] * s0);
      o1.x = pk2(a0[8] * s0, a0[9] * s0); o1.y = pk2(a0[10] * s0, a0[11] * s0); o1.z = pk2(a0[12] * s0, a0[13] * s0); o1.w = pk2(a0[14] * s0, a0[15] * s0);
      bf16* d = WT + (size_t)inv_head(768 + 128 * g + lane) * DM + k0; *(u32x4*)d = o0; *(u32x4*)(d + 8) = o1; }
    { u32x4 o0, o1; o0.x = pk2(a1[0] * s1, a1[1] * s1); o0.y = pk2(a1[2] * s1, a1[3] * s1); o0.z = pk2(a1[4] * s1, a1[5] * s1); o0.w = pk2(a1[6] * s1, a1[7] * s1);
      o1.x = pk2(a1[8] * s1, a1[9] * s1); o1.y = pk2(a1[10] * s1, a1[11] * s1); o1.z = pk2(a1[12] * s1, a1[13] * s1); o1.w = pk2(a1[14] * s1, a1[15] * s1);
      bf16* d = WT + (size_t)inv_head(768 + 128 * g + 64 + lane) * DM + k0; *(u32x4*)d = o0; *(u32x4*)(d + 8) = o1; }
    asm volatile("s_waitcnt lgkmcnt(0)" ::: "memory");
}
__device__ __forceinline__ void rms_row_to_bf16(const float* xr_, const float* g, bf16* orow, int lane) {
    const f32x4* xr = (const f32x4*)xr_ + lane; const f32x4* gr = (const f32x4*)g + lane;
    f32x4 v[4]; float s = 0.f;
#pragma unroll
    for (int j = 0; j < 4; ++j) { v[j] = xr[64 * j]; s += (v[j].x * v[j].x + v[j].y * v[j].y) + (v[j].z * v[j].z + v[j].w * v[j].w); }
    const float rstd = 1.0f / sqrtf(wave_sum(s) * (1.f / DM) + EPS);
    unsigned long long* o8 = (unsigned long long*)orow + lane;
#pragma unroll
    for (int j = 0; j < 4; ++j) { const f32x4 gg = gr[64 * j];
        o8[64 * j] = (unsigned long long)pk2(v[j].x * rstd * gg.x, v[j].y * rstd * gg.y) | ((unsigned long long)pk2(v[j].z * rstd * gg.z, v[j].w * rstd * gg.w) << 32); }
}
__device__ __forceinline__ void p0_prologue(const Frame& F, const Args& A) {
    LAS float* scr = (LAS float*)(F.lds + F.wave * 16384);
    const int gw = F.vcu * NWAVES + F.wave, NGW = F.G * NWAVES;
    bf16* Bin = (bf16*)(F.ws + WS_WIN); bf16* Bout = (bf16*)(F.ws + WS_WOUT); bf16* Bup = (bf16*)(F.ws + WS_WUP);
    bf16* Bdown = (bf16*)(F.ws + WS_WDOWN); bf16* Bgate = (bf16*)(F.ws + WS_WGATE); bf16* Bproj = (bf16*)(F.ws + WS_WPROJ);
    constexpr int I_FOLD = 64 * 4, I_IN = (DM / 64) * (768 / 32), I_OUT = (DM / 64) * (DM / 32), I_UP = (DM / 64) * (DFF / 32), I_DOWN = (DFF / 64) * (DM / 32), I_GATE = I_OUT, I_PROJ = (PLE / 64) * (DM / 32);
    constexpr int NITEMS = I_FOLD + I_IN + I_OUT + I_UP + I_DOWN + I_GATE + I_PROJ;
    for (int it = gw; it < NITEMS; it += NGW) {
        int r = it;
        if (r < I_FOLD) { p0_fold_item(A.in[5], A.in[8], A.in[9], Bin, scr, r, F.lane); continue; } r -= I_FOLD;
        if (r < I_IN) { p0_transpose_item(A.in[5], INW, DM, 768, Bin, scr, r, F.lane, nullptr, true); continue; } r -= I_IN;
        if (r < I_OUT) { p0_transpose_item(A.in[10], DM, DM, DM, Bout, scr, r, F.lane, nullptr, true); continue; } r -= I_OUT;
        if (r < I_UP) { p0_transpose_item(A.in[12], DFF, DM, DFF, Bup, scr, r, F.lane, A.in[11], true); continue; } r -= I_UP;
        if (r < I_DOWN) { p0_transpose_item(A.in[13], DM, DFF, DM, Bdown, scr, r, F.lane, nullptr, true); continue; } r -= I_DOWN;
        if (r < I_GATE) { p0_transpose_item(A.in[15], DM, DM, DM, Bgate, scr, r, F.lane, A.in[14], true); continue; } r -= I_GATE;
        p0_transpose_item(A.in[16], DM, PLE, DM, Bproj, scr, r, F.lane, nullptr, true);
    }
    bf16* XN = (bf16*)(F.ws + WS_XN); bf16* PB = (bf16*)(F.ws + WS_PB);
    for (int m = gw; m < M; m += 2 * NGW) {
        const int m1 = m + NGW;
        const f32x4* x0 = (const f32x4*)xrow(A, m) + F.lane; const f32x4* x1 = (const f32x4*)xrow(A, m1) + F.lane; const f32x4* gr = (const f32x4*)A.in[4] + F.lane;
        f32x4 v0[4], v1[4];
#pragma unroll
        for (int j = 0; j < 4; ++j) { v0[j] = x0[64 * j]; v1[j] = x1[64 * j]; }
        const f32x4 pv0 = *((const f32x4*)prow(A, m) + F.lane), pv1 = *((const f32x4*)prow(A, m1) + F.lane);
        float s0 = 0.f, s1 = 0.f;
#pragma unroll
        for (int j = 0; j < 4; ++j) { s0 += (v0[j].x * v0[j].x + v0[j].y * v0[j].y) + (v0[j].z * v0[j].z + v0[j].w * v0[j].w); s1 += (v1[j].x * v1[j].x + v1[j].y * v1[j].y) + (v1[j].z * v1[j].z + v1[j].w * v1[j].w); }
        const float r0 = 1.0f / sqrtf(wave_sum(s0) * (1.f / DM) + EPS), r1 = 1.0f / sqrtf(wave_sum(s1) * (1.f / DM) + EPS);
        unsigned long long* o0 = (unsigned long long*)(XN + (size_t)m * DM) + F.lane; unsigned long long* o1 = (unsigned long long*)(XN + (size_t)m1 * DM) + F.lane;
#pragma unroll
        for (int j = 0; j < 4; ++j) { const f32x4 gg = gr[64 * j];
            o0[64 * j] = (unsigned long long)pk2(v0[j].x * r0 * gg.x, v0[j].y * r0 * gg.y) | ((unsigned long long)pk2(v0[j].z * r0 * gg.z, v0[j].w * r0 * gg.w) << 32);
            o1[64 * j] = (unsigned long long)pk2(v1[j].x * r1 * gg.x, v1[j].y * r1 * gg.y) | ((unsigned long long)pk2(v1[j].z * r1 * gg.z, v1[j].w * r1 * gg.w) << 32); }
        *((unsigned long long*)(PB + (size_t)m * PLE) + F.lane) = (unsigned long long)pk2(pv0.x, pv0.y) | ((unsigned long long)pk2(pv0.z, pv0.w) << 32);
        *((unsigned long long*)(PB + (size_t)m1 * PLE) + F.lane) = (unsigned long long)pk2(pv1.x, pv1.y) | ((unsigned long long)pk2(pv1.z, pv1.w) << 32);
    }
    { const int gt = F.vcu * 512 + F.tid;
      if (gt < 2048) { const int p = gt >> 4, i = gt & 15; const float inv = exp2f(-(float)i * (13.287712379549449f / 16.0f)); const float a = (float)p * inv;
          float2* R = (float2*)(F.ws + WS_ROPE); R[gt] = make_float2(cosf(a), sinf(a)); } }
}

namespace pg8 {
#define PG8_LAS __attribute__((address_space(3)))
typedef unsigned short bf16_t;
typedef short bf16x8 __attribute__((ext_vector_type(8)));
typedef float f32x4 __attribute__((ext_vector_type(4)));
typedef unsigned u32x4 __attribute__((ext_vector_type(4)));
constexpr int BM = 256, BK = 64, HALF = 128, HTB = HALF * BK * 2  , STAGE_BYTES = 8 * HTB, NXCD = 8, WGM = 8;

__host__ __device__ __forceinline__ int lds_byte(int r, int c) { const int st = (r >> 4) * 2 + (c >> 5), rr = r & 15, cc = c & 31, ob = rr * 64 + cc * 2; return st * 1024 + (ob ^ (((ob >> 9) & 1) << 5)); }
__host__ __device__ __forceinline__ void stage_rc(int b, int& R, int& C) { const int st = b / 1024, sb = b % 1024, swz = sb ^ (((sb >> 9) & 1) << 5); R = (st >> 1) * 16 + swz / 64; C = (st & 1) * 32 + (swz % 64) / 2; }
__host__ __device__ __forceinline__ int perm32(int rho) { const int n = rho >> 4, i = rho & 15; return 8 * (i >> 2) + 4 * n + (i & 3); }

struct Unit { int pm, pn; };
struct Gemm { const bf16_t* A; const bf16_t* Bt; int M, N, K; };

struct StaticOrder {
    int nM, nN, nwg, G, c;
    __host__ __device__ void init(int M, int N, int G_, int c_) { nM = M / BM; nN = N / BM; nwg = nM * nN; G = G_; c = c_; }
    __host__ __device__ bool next(int i, Unit& u) const {
        const long L = (long)i * G + c; if (L >= nwg) return false;
        int wgid = (int)L; { const int q = nwg / NXCD, r = nwg % NXCD, xcd = wgid % NXCD, off = wgid / NXCD; wgid = (xcd < r ? xcd * (q + 1) : r * (q + 1) + (xcd - r) * q) + off; }
        const int nig = WGM * nN, gid = wgid / nig, fm = gid * WGM, gsz = (nM - fm) < WGM ? (nM - fm) : WGM;
        u.pm = fm + ((wgid % nig) % gsz); u.pn = (wgid % nig) / gsz; return true;
    }
    __device__ __forceinline__ void a_ready(const Unit&) const {}
    __device__ __forceinline__ void done(const Unit&) const {}
};

template <class E> struct EpiAdapt {
    static constexpr bool PERM = false, AFTER_DRAIN = false;
    E e; int row0;
    __device__ __forceinline__ void operator()(f32x4 (&acc)[2][2][4][2], const Unit& u, int wr, int wc, int fr, int fq) const {
        const int c0 = u.pn * BM + wc * 64;
#pragma unroll
        for (int ai = 0; ai < 2; ++ai)
#pragma unroll
            for (int m = 0; m < 4; ++m) {
                ::f32x4 v[4] = {acc[ai][0][m][0], acc[ai][0][m][1], acc[ai][1][m][0], acc[ai][1][m][1]};
                e.seg64(row0 + u.pm * BM + ai * HALF + wr * 64 + m * 16 + fr, c0, v, fq);
                if (m & 1) asm volatile("" ::: "memory");
            }
    }
};
template <class Epi, class Sched, bool ALIGN_EPI = false, bool SP2 = false>
__device__ __forceinline__ void gemm_phase(PG8_LAS unsigned char* lds, const Gemm g, const Sched& S, const Epi& E) {
    int tid_ = threadIdx.x; asm volatile("" : "+v"(tid_));
    const int tid = tid_, wid = __builtin_amdgcn_readfirstlane(tid >> 6), lane = tid & 63, wr = wid >> 2, wc = wid & 3, fr = lane & 15, fq = lane >> 4;
    const int K = g.K, nt = K / BK;
    unsigned voffA[2], voffB[2];
#pragma unroll
    for (int i = 0; i < 2; ++i) { int R, C; stage_rc(tid * 16 + i * 8192, R, C); const int Rb = Epi::PERM ? ((R & ~31) + perm32(R & 31)) : R;
        voffA[i] = (unsigned)(R * K + C) * 2u; voffB[i] = (unsigned)(Rb * K + C) * 2u; }
    const size_t kstep = (size_t)(BK * 2);
    const size_t hstep = (size_t)HALF * K * 2;
    const size_t tstep = 2 * hstep;
    const unsigned ldsw = (unsigned)wid * 1024u;
    const int aoff = lds_byte(wr * 64 + fr, fq * 8), boff = lds_byte(wc * 32 + fr, fq * 8);
#define PG8_SA(b, h) (((b) * 2 + (h)) * HTB)
#define PG8_SB(b, h) ((4 + (b) * 2 + (h)) * HTB)
#define PG8_STAGE(bufoff, gbase, voff) do { _Pragma("unroll") for (int _i = 0; _i < 2; ++_i) { unsigned _vo = (voff)[_i]; asm volatile("" : "+v"(_vo)); \
        __builtin_amdgcn_global_load_lds((const unsigned*)((const char*)(gbase) + _vo), (PG8_LAS unsigned*)(lds + (bufoff) + ldsw + _i * 8192), 16, 0, 0); } } while (0)
#define PG8_LDA(dst, b, h) do { _Pragma("unroll") for (int m = 0; m < 4; ++m) _Pragma("unroll") for (int k = 0; k < 2; ++k) dst[m][k] = *(const PG8_LAS bf16x8*)(lds + PG8_SA(b, h) + aoff + m * 2048 + k * 1024); } while (0)
#define PG8_LDB(dst, b, h) do { _Pragma("unroll") for (int n = 0; n < 2; ++n) _Pragma("unroll") for (int k = 0; k < 2; ++k) dst[n][k] = *(const PG8_LAS bf16x8*)(lds + PG8_SB(b, h) + boff + n * 2048 + k * 1024); } while (0)
#define PG8_MMA(ai, bj, At, Bt) do { __builtin_amdgcn_s_setprio(1); _Pragma("unroll") for (int m = 0; m < 4; ++m) _Pragma("unroll") for (int n = 0; n < 2; ++n) _Pragma("unroll") for (int k = 0; k < 2; ++k) \
        acc[ai][bj][m][n] = __builtin_amdgcn_mfma_f32_16x16x32_bf16(Bt[n][k], At[m][k], acc[ai][bj][m][n], 0, 0, 0); __builtin_amdgcn_s_setprio(0); } while (0)
#define PG8_WAIT_V(n) asm volatile("s_waitcnt vmcnt(" #n ")" ::: "memory")
#define PG8_WAIT_L(n) asm volatile("s_waitcnt lgkmcnt(" #n ")" ::: "memory")
#define PG8_BAR __builtin_amdgcn_s_barrier()
#define PG8_SCHED __builtin_amdgcn_sched_barrier(0)
    Unit cur, nxt; int ui = 0;
    if (!S.next(0, cur)) return;
    f32x4 acc[2][2][4][2];
#pragma unroll
    for (int a = 0; a < 2; ++a)
#pragma unroll
        for (int b = 0; b < 2; ++b)
#pragma unroll
            for (int m = 0; m < 4; ++m)
#pragma unroll
                for (int n = 0; n < 2; ++n) acc[a][b][m][n] = (f32x4){0.f, 0.f, 0.f, 0.f};
    bf16x8 At[4][2], B0[2][2], B1[2][2];
    const char* cA = (const char*)g.A + (size_t)cur.pm * tstep; const char* cB = (const char*)g.Bt + (size_t)cur.pn * tstep;
    S.a_ready(cur);
    if constexpr (SP2) {
        PG8_STAGE(PG8_SB(0, 0), cB, voffB); PG8_STAGE(PG8_SB(0, 1), cB + hstep, voffB); PG8_STAGE(PG8_SA(0, 0), cA, voffA); PG8_STAGE(PG8_SA(0, 1), cA + hstep, voffA);
        if (wr == 1) PG8_BAR;
        PG8_WAIT_V(2); PG8_BAR;
        PG8_STAGE(PG8_SB(1, 0), cB + kstep, voffB); PG8_STAGE(PG8_SA(1, 0), cA + kstep, voffA); PG8_STAGE(PG8_SB(1, 1), cB + hstep + kstep, voffB);
        PG8_WAIT_V(6); PG8_BAR;
    } else {
        PG8_STAGE(PG8_SB(0, 0), cB, voffB); PG8_STAGE(PG8_SA(0, 0), cA, voffA); PG8_STAGE(PG8_SB(0, 1), cB + hstep, voffB); PG8_STAGE(PG8_SA(0, 1), cA + hstep, voffA);
        if (wr == 1) PG8_BAR;
        PG8_WAIT_V(4); PG8_BAR;
        PG8_STAGE(PG8_SB(1, 0), cB + kstep, voffB); PG8_STAGE(PG8_SA(1, 0), cA + kstep, voffA); PG8_STAGE(PG8_SB(1, 1), cB + hstep + kstep, voffB);
        PG8_WAIT_V(6); PG8_BAR;
    }
    for (;;) {
        const bool has_next = S.next(ui + 1, nxt);
        const char* nA = has_next ? (const char*)g.A + (size_t)nxt.pm * tstep : cA; const char* nB = has_next ? (const char*)g.Bt + (size_t)nxt.pn * tstep : cB;
        for (int t = 0; t < nt; t += 2) {
            const bool last = (t == nt - 2);
            const char* a1 = cA + (size_t)(t + 1) * kstep;
            const char* a2 = last ? nA : cA + (size_t)(t + 2) * kstep; const char* b2 = last ? nB : cB + (size_t)(t + 2) * kstep;
            const char* a3 = a2 + kstep; const char* b3 = b2 + kstep;
            if (last && has_next) S.a_ready(nxt);
            if constexpr (SP2) {
            PG8_LDB(B0, 0, 0); PG8_LDB(B1, 0, 1); PG8_SCHED; PG8_LDA(At, 0, 0); PG8_STAGE(PG8_SA(1, 1), a1 + hstep, voffA);
            PG8_WAIT_V(8); PG8_WAIT_L(0); PG8_BAR; PG8_MMA(0, 0, At, B0); PG8_MMA(0, 1, At, B1); PG8_BAR; PG8_SCHED;
            PG8_LDA(At, 0, 1); PG8_STAGE(PG8_SB(0, 0), b2, voffB); PG8_STAGE(PG8_SB(0, 1), b2 + hstep, voffB); PG8_STAGE(PG8_SA(0, 0), a2, voffA);
            PG8_WAIT_V(8); PG8_WAIT_L(0); PG8_BAR; PG8_MMA(1, 0, At, B0); PG8_MMA(1, 1, At, B1); PG8_BAR; PG8_SCHED;
            PG8_LDB(B0, 1, 0); PG8_LDB(B1, 1, 1); PG8_SCHED; PG8_LDA(At, 1, 0); PG8_STAGE(PG8_SA(0, 1), a2 + hstep, voffA);
            PG8_WAIT_V(8); PG8_WAIT_L(0); PG8_BAR; PG8_MMA(0, 0, At, B0); PG8_MMA(0, 1, At, B1); PG8_BAR; PG8_SCHED;
            PG8_LDA(At, 1, 1); PG8_STAGE(PG8_SB(1, 0), b3, voffB); PG8_STAGE(PG8_SB(1, 1), b3 + hstep, voffB); PG8_STAGE(PG8_SA(1, 0), a3, voffA);
            PG8_WAIT_V(8); PG8_WAIT_L(0); PG8_BAR; PG8_MMA(1, 0, At, B0); PG8_MMA(1, 1, At, B1); PG8_BAR; PG8_SCHED;
            } else {
            PG8_LDB(B0, 0, 0); PG8_SCHED; PG8_LDA(At, 0, 0); PG8_STAGE(PG8_SA(1, 1), a1 + hstep, voffA);
            PG8_WAIT_L(8); PG8_BAR; PG8_WAIT_L(0); PG8_MMA(0, 0, At, B0); PG8_BAR; PG8_SCHED;
            PG8_LDB(B1, 0, 1); PG8_STAGE(PG8_SB(0, 0), b2, voffB);
            PG8_BAR; PG8_WAIT_L(0); PG8_MMA(0, 1, At, B1); PG8_BAR;
            PG8_LDA(At, 0, 1); PG8_STAGE(PG8_SA(0, 0), a2, voffA);
            PG8_BAR; PG8_WAIT_L(0); PG8_MMA(1, 0, At, B0); PG8_BAR; PG8_SCHED;
            PG8_STAGE(PG8_SB(0, 1), b2 + hstep, voffB);
            PG8_WAIT_V(6); PG8_BAR; PG8_MMA(1, 1, At, B1); PG8_BAR;
            PG8_LDB(B0, 1, 0); PG8_SCHED; PG8_LDA(At, 1, 0); PG8_STAGE(PG8_SA(0, 1), a2 + hstep, voffA);
            PG8_WAIT_L(8); PG8_BAR; PG8_WAIT_L(0); PG8_MMA(0, 0, At, B0); PG8_BAR; PG8_SCHED;
            PG8_LDB(B1, 1, 1); PG8_STAGE(PG8_SB(1, 0), b3, voffB);
            PG8_BAR; PG8_WAIT_L(0); PG8_MMA(0, 1, At, B1); PG8_BAR;
            PG8_LDA(At, 1, 1); PG8_STAGE(PG8_SA(1, 0), a3, voffA);
            PG8_BAR; PG8_WAIT_L(0); PG8_MMA(1, 0, At, B0); PG8_BAR; PG8_SCHED;
            PG8_STAGE(PG8_SB(1, 1), b3 + hstep, voffB);
            PG8_WAIT_V(6); PG8_BAR; PG8_MMA(1, 1, At, B1); PG8_BAR;
            }
        }
        if constexpr (ALIGN_EPI) { if (wr == 0) PG8_BAR; }
        if constexpr (!Epi::AFTER_DRAIN) { E(acc, cur, wr, wc, fr, fq); S.done(cur); }
        if (!has_next) break;
#pragma unroll
        for (int a = 0; a < 2; ++a)
#pragma unroll
            for (int b = 0; b < 2; ++b)
#pragma unroll
                for (int m = 0; m < 4; ++m)
#pragma unroll
                    for (int n = 0; n < 2; ++n) acc[a][b][m][n] = (f32x4){0.f, 0.f, 0.f, 0.f};
        cur = nxt; cA = nA; cB = nB; ++ui;
        if constexpr (ALIGN_EPI) { if (wr == 1) PG8_BAR; }
    }
    PG8_WAIT_V(0);
    if constexpr (!ALIGN_EPI) { if (wr == 0) PG8_BAR; }
    PG8_BAR;
    if constexpr (Epi::AFTER_DRAIN) { E.fused(acc, cur, wr, wc, fr, fq, lds, wid, lane); S.done(cur); }
#undef PG8_SA
#undef PG8_SB
#undef PG8_STAGE
#undef PG8_LDA
#undef PG8_LDB
#undef PG8_MMA
#undef PG8_WAIT_V
#undef PG8_WAIT_L
#undef PG8_BAR
#undef PG8_SCHED
}
}

template <class Epi>
__device__ __forceinline__ void sgemm(const bf16* A, int lda, int a_row_sub, const bf16* Bt, int K, int row0, int nrows, int N, bool headmap, const Epi& E, const Frame& F) {
    const int nN = N / 64, nU = (nrows / 256) * nN, fr = F.lane & 15, fq = F.lane >> 4;
    for (int u = F.vcu; u < nU; u += F.G) {
        const int pm = u / nN, pn = u % nN, r0 = row0 + pm * 256 + F.wave * 32, c0 = pn * 64;
        f32x4 acc[2][4];
#pragma unroll
        for (int a = 0; a < 2; ++a)
#pragma unroll
            for (int b = 0; b < 4; ++b) acc[a][b] = (f32x4){0.f, 0.f, 0.f, 0.f};
        const bf16* ap0 = A + (size_t)(r0 - a_row_sub + fr) * lda + 8 * fq; const bf16* ap1 = ap0 + (size_t)16 * lda;
        const bf16* bp[4];
#pragma unroll
        for (int nt = 0; nt < 4; ++nt) { const int n = c0 + 16 * nt + fr; bp[nt] = Bt + (size_t)(headmap ? inv_head(n) : n) * K + 8 * fq; }
        for (int k0 = 0; k0 < K; k0 += 32) {
            const bf16x8 a0 = *(const bf16x8*)(ap0 + k0), a1 = *(const bf16x8*)(ap1 + k0);
            bf16x8 b[4];
#pragma unroll
            for (int nt = 0; nt < 4; ++nt) b[nt] = *(const bf16x8*)(bp[nt] + k0);
#pragma unroll
            for (int nt = 0; nt < 4; ++nt) { acc[0][nt] = __builtin_amdgcn_mfma_f32_16x16x32_bf16(b[nt], a0, acc[0][nt], 0, 0, 0); acc[1][nt] = __builtin_amdgcn_mfma_f32_16x16x32_bf16(b[nt], a1, acc[1][nt], 0, 0, 0); }
        }
        E.seg64(r0 + fr, c0, acc[0], fq); E.seg64(r0 + 16 + fr, c0, acc[1], fq);
    }
}

__device__ __forceinline__ void st_bf16x4(bf16* p, f32x4 v) { u32x2 w; w.x = pk2(v[0], v[1]); w.y = pk2(v[2], v[3]); *(u32x2*)p = w; }
__device__ __forceinline__ float quad_sum(float s) { s += __shfl_xor(s, 16); s += __shfl_xor(s, 32); return s; }
__device__ __forceinline__ float rstd_from_ss(const float* ss16) {
    const f32x4* p = (const f32x4*)ss16; const f32x4 a = p[0], b = p[1], c = p[2], d = p[3];
    const float s = ((a.x + a.y) + (a.z + a.w)) + ((b.x + b.y) + (b.z + b.w)) + ((c.x + c.y) + (c.z + c.w)) + ((d.x + d.y) + (d.z + d.w));
    return 1.0f / sqrtf(s * (1.f / DM) + EPS);
}

struct EpiIn {
    bf16 *Q, *K, *V, *U; const float *qg, *kg; const float2* rope;
    __device__ __forceinline__ void seg64(int m, int c0, f32x4 (&v)[4], int fq) const {
        if (c0 < 640) {
            const bool isq = c0 < 512;
            float ss = 0.f;
#pragma unroll
            for (int nt = 0; nt < 4; ++nt) ss += (v[nt][0] * v[nt][0] + v[nt][1] * v[nt][1]) + (v[nt][2] * v[nt][2] + v[nt][3] * v[nt][3]);
            ss = quad_sum(ss);
            const float rstd = 1.0f / sqrtf(ss * (1.f / 64.f) + EPS);
            const float* g = isq ? qg : kg;
#pragma unroll
            for (int nt = 0; nt < 4; ++nt) { const f32x4 gg = *(const f32x4*)(g + 16 * nt + 4 * fq); v[nt] = v[nt] * rstd * gg; }
            const int t = tpos(m), pr = t >> 6, pc = t & 63;
            const float sc = isq ? C2 : 1.0f;
            f32x4 o[4];
#pragma unroll
            for (int j = 0; j < 4; ++j) {
                const float2 cr = rope[pr * 16 + 4 * fq + j], cc = rope[pc * 16 + 4 * fq + j];
                o[0][j] = (v[0][j] * cr.x - v[1][j] * cr.y) * sc; o[1][j] = (v[1][j] * cr.x + v[0][j] * cr.y) * sc;
                o[2][j] = (v[2][j] * cc.x - v[3][j] * cc.y) * sc; o[3][j] = (v[3][j] * cc.x + v[2][j] * cc.y) * sc;
            }
            bf16* dst = isq ? Q + (size_t)m * 512 + c0 : K + (size_t)m * 128 + (c0 - 512);
#pragma unroll
            for (int nt = 0; nt < 4; ++nt) st_bf16x4(dst + 16 * nt + 4 * fq, o[nt]);
        } else {
            bf16* dst = c0 < 768 ? V + (size_t)m * 128 + (c0 - 640) : U + (size_t)m * 512 + (c0 - 768);
#pragma unroll
            for (int nt = 0; nt < 4; ++nt) st_bf16x4(dst + 16 * nt + 4 * fq, v[nt]);
        }
    }
};
struct EpiBf {
    bf16* O; int ld;
    __device__ __forceinline__ void seg64(int m, int c0, f32x4 (&v)[4], int fq) const {
#pragma unroll
        for (int nt = 0; nt < 4; ++nt) st_bf16x4(O + (size_t)m * ld + c0 + 16 * nt + 4 * fq, v[nt]);
    }
};
struct EpiRes {
    const float* base0; const float* base1; float* out; bf16* HB; float* SS;
    __device__ __forceinline__ void seg64(int m, int c0, f32x4 (&v)[4], int fq) const {
        const float* b = (m < MP ? base0 + (size_t)m * DM : base1 + (size_t)(m - MP) * DM) + c0 + 4 * fq;
        float* o = out + (size_t)m * DM + c0 + 4 * fq; bf16* hb = HB + (size_t)m * DM + c0 + 4 * fq; float ss = 0.f;
#pragma unroll
        for (int nt = 0; nt < 4; ++nt) { const f32x4 h = *(const f32x4*)(b + 16 * nt) + v[nt]; *(f32x4*)(o + 16 * nt) = h; st_bf16x4(hb + 16 * nt, h);
            ss += (h[0] * h[0] + h[1] * h[1]) + (h[2] * h[2] + h[3] * h[3]); }
        ss = quad_sum(ss);
        if (fq == 0) SS[(size_t)m * 16 + (c0 >> 6)] = ss;
    }
};
constexpr int RSTD_OFF = 131072 + 1024;
struct EpiUp {
    bf16* HM; const LAS float* rs; int row0;
    __device__ __forceinline__ void seg64(int m, int c0, f32x4 (&v)[4], int fq) const {
        const float rstd = rs[m - row0];
        bf16* d = HM + (size_t)(m - row0) * DFF + c0 + 4 * fq;
#pragma unroll
        for (int nt = 0; nt < 4; ++nt) { f32x4 a = v[nt] * rstd;
#pragma unroll
            for (int j = 0; j < 4; ++j) { const float r = fmaxf(a[j], 0.f); a[j] = r * r; }
            st_bf16x4(d + 16 * nt, a); }
    }
};
__device__ __forceinline__ void rstd_table(const Frame& F, const float* SS, int row0) {
    if (F.tid < 256) ((LAS float*)(F.lds + RSTD_OFF))[F.tid] = rstd_from_ss(SS + (size_t)(row0 + F.tid) * 16);
    __syncthreads();
}
struct EpiGate {
    const float* out; float* dst; const bf16* PP; const float* SS;
    __device__ __forceinline__ void seg64(int m, int c0, f32x4 (&v)[4], int fq) const {
        const float rstd = rstd_from_ss(SS + (size_t)m * 16);
        const float* o = out + (size_t)m * DM + c0 + 4 * fq; float* d = dst + (size_t)m * DM + c0 + 4 * fq; const bf16* pp = PP + (size_t)m * DM + c0 + 4 * fq;
#pragma unroll
        for (int nt = 0; nt < 4; ++nt) { const u32x2 w = *(const u32x2*)(pp + 16 * nt); f32x4 h = *(const f32x4*)(o + 16 * nt);
            const float p0 = bflo(w.x), p1 = bfhi(w.x), p2 = bflo(w.y), p3 = bfhi(w.y);
            h[0] += p0 / (1.0f + __expf(-v[nt][0] * rstd)); h[1] += p1 / (1.0f + __expf(-v[nt][1] * rstd));
            h[2] += p2 / (1.0f + __expf(-v[nt][2] * rstd)); h[3] += p3 / (1.0f + __expf(-v[nt][3] * rstd));
            *(f32x4*)(d + 16 * nt) = h; }
    }
};

namespace attn_body {
using bf16=__hip_bfloat16;
using bf16x8=__attribute__((ext_vector_type(8)))short;
using s16x4=__attribute__((ext_vector_type(4)))short;
using f32x16=__attribute__((ext_vector_type(16)))float;
using u32x4=__attribute__((ext_vector_type(4)))unsigned;
constexpr int D=64,QP=512,KP=128,OP=1024;
constexpr int NW=8,QBLK=32,QB=QBLK*NW,KVBLK=64;
constexpr int ATTN_UNIT_ROWS=QB;
__device__ __forceinline__ int crow(int r,int hi){return (r&3)+8*(r>>2)+4*hi;}
#define SBAR() __builtin_amdgcn_sched_barrier(0)

constexpr int NSLOT=3, SLOTB=8192;
constexpr int LDS_K=0, LDS_V=NSLOT*SLOTB, LDS_WS=2*NSLOT*SLOTB, LDS_OST=LDS_WS+NW*64*4, LDS_BYTES=LDS_OST+NW*4096;
constexpr float C2=0.125f*1.4426950408889634f;
__device__ __forceinline__ void glds16(const void*gsrc,unsigned lds_dst){unsigned keep;
  asm volatile("s_mov_b32 %0, m0\n\ts_mov_b32 m0, %2\n\ts_nop 0\n\tglobal_load_lds_dwordx4 %1, off\n\ts_mov_b32 m0, %0":"=&s"(keep):"v"(gsrc),"s"(lds_dst):"memory");}
__device__ __forceinline__ float max3f(float a,float b,float c){float r;asm("v_max3_f32 %0, %1, %2, %3":"=v"(r):"v"(a),"v"(b),"v"(c));return r;}
__device__ __forceinline__ float max2f(float a,float b){float r;asm("v_max_f32_e32 %0, %1, %2":"=v"(r):"v"(a),"v"(b));return r;}
__device__ __forceinline__ float fadd_s(float a,float b){float r;asm("v_add_f32_e32 %0, %1, %2":"=v"(r):"v"(a),"v"(b));return r;}
__device__ __forceinline__ float fsub_s(float a,float b){float r;asm("v_sub_f32_e32 %0, %1, %2":"=v"(r):"v"(a),"v"(b));return r;}
typedef float f32x2_t __attribute__((ext_vector_type(2))); typedef __bf16 bf16x2_t __attribute__((ext_vector_type(2)));
__device__ __forceinline__ unsigned cvtpk_s(float lo,float hi){f32x2_t v={lo,hi};bf16x2_t b=__builtin_convertvector(v,bf16x2_t);return __builtin_bit_cast(unsigned,b);}
#define WAIT_BAR(N) asm volatile("s_waitcnt vmcnt(" #N ") lgkmcnt(0)\n\ts_barrier":::"memory")

__device__ __forceinline__ void qkt(f32x16&p0,f32x16&p1,const char*Kslot,const bf16x8*qr,const f32x16&negm,int r32,int hi){
  const char*kb=Kslot+hi*1024+r32*16;
  #pragma unroll
  for(int d0=0;d0<4;++d0){
    const bf16x8 b0=*reinterpret_cast<const bf16x8*>(kb+d0*2048);
    const bf16x8 b1=*reinterpret_cast<const bf16x8*>(kb+d0*2048+512);
    if(d0==0){p0=__builtin_amdgcn_mfma_f32_32x32x16_bf16(b0,qr[0],negm,0,0,0);p1=__builtin_amdgcn_mfma_f32_32x32x16_bf16(b1,qr[0],negm,0,0,0);}
    else{p0=__builtin_amdgcn_mfma_f32_32x32x16_bf16(b0,qr[d0],p0,0,0,0);p1=__builtin_amdgcn_mfma_f32_32x32x16_bf16(b1,qr[d0],p1,0,0,0);}}
}
typedef __attribute__((address_space(3))) const char* lds_cptr;
typedef short v4i16_t __attribute__((ext_vector_type(4)));
__device__ __forceinline__ void kload8(bf16x8*kf,lds_cptr kp){
  kf[0]=*(const __attribute__((address_space(3))) bf16x8*)(kp);      kf[1]=*(const __attribute__((address_space(3))) bf16x8*)(kp+512);
  kf[2]=*(const __attribute__((address_space(3))) bf16x8*)(kp+2048); kf[3]=*(const __attribute__((address_space(3))) bf16x8*)(kp+2560);
  kf[4]=*(const __attribute__((address_space(3))) bf16x8*)(kp+4096); kf[5]=*(const __attribute__((address_space(3))) bf16x8*)(kp+4608);
  kf[6]=*(const __attribute__((address_space(3))) bf16x8*)(kp+6144); kf[7]=*(const __attribute__((address_space(3))) bf16x8*)(kp+6656);
}
__device__ __forceinline__ void kload2(bf16x8*kf,lds_cptr kp,int j){ kf[2*j]=*(const __attribute__((address_space(3))) bf16x8*)(kp+j*2048); kf[2*j+1]=*(const __attribute__((address_space(3))) bf16x8*)(kp+j*2048+512); }
__device__ __forceinline__ s16x4 vtr(lds_cptr p){ return __builtin_bit_cast(s16x4,__builtin_amdgcn_ds_read_tr16_b64_v4i16((__attribute__((address_space(3))) v4i16_t*)p)); }
__device__ __forceinline__ float rowmax(const f32x16&p0,const f32x16&p1){
  float a=max3f(p0[0],p0[1],p1[0]),b=max3f(p0[2],p0[3],p1[1]);a=max3f(a,p1[2],p1[3]);
  #pragma unroll
  for(int r=4;r<16;r+=4){a=max3f(a,p0[r],p0[r+1]);b=max3f(b,p0[r+2],p0[r+3]);a=max3f(a,p1[r],p1[r+1]);b=max3f(b,p1[r+2],p1[r+3]);}
  const float m=max2f(a,b);
  auto rr=__builtin_amdgcn_permlane32_swap(__float_as_uint(m),__float_as_uint(m),false,false);
  return max2f(__uint_as_float(rr[0]),__uint_as_float(rr[1]));
}
__device__ __forceinline__ void pv(f32x16*o,int vb,bf16x8 pa0,bf16x8 pa1,bf16x8 pa2,bf16x8 pa3){
  #pragma unroll
  for(int d0=0;d0<2;++d0){s16x4 lo[4],hi[4];
    #pragma unroll
    for(int ks=0;ks<4;++ks){
      asm volatile("ds_read_b64_tr_b16 %0,%1 offset:%c2":"=&v"(lo[ks]):"v"(vb),"i"(d0*4096+ks*1024):"memory");
      asm volatile("ds_read_b64_tr_b16 %0,%1 offset:%c2":"=&v"(hi[ks]):"v"(vb),"i"(d0*4096+ks*1024+512):"memory");}
    asm volatile("s_waitcnt lgkmcnt(0)":::"memory");SBAR();
    #define PK(k) (bf16x8){lo[k][0],lo[k][1],lo[k][2],lo[k][3],hi[k][0],hi[k][1],hi[k][2],hi[k][3]}
    o[d0]=__builtin_amdgcn_mfma_f32_32x32x16_bf16(pa0,PK(0),o[d0],0,0,0);
    o[d0]=__builtin_amdgcn_mfma_f32_32x32x16_bf16(pa1,PK(1),o[d0],0,0,0);
    o[d0]=__builtin_amdgcn_mfma_f32_32x32x16_bf16(pa2,PK(2),o[d0],0,0,0);
    o[d0]=__builtin_amdgcn_mfma_f32_32x32x16_bf16(pa3,PK(3),o[d0],0,0,0);
    #undef PK
  }
}

#ifndef ATTN_STORE16
#define ATTN_STORE16(p,v) (*(u32x4*)(p)=(v))
#endif
template<int THRL> __device__ __forceinline__ void attn_unit(int rowbase_,int T_,int h,int qb,const bf16*Q,const bf16*__restrict__ K,const bf16*__restrict__ V,bf16*O,char*shm){
  const int tid=threadIdx.x,lane=tid&63,r32=lane&31,hi=lane>>5; const int wid=__builtin_amdgcn_readfirstlane(tid>>6);
  const long rowbase=(long)rowbase_; const int q0=qb*QB; const int kvh=h>>2;
  const bf16*Qw=Q+(rowbase+q0+wid*QBLK)*QP+h*D;
  const bf16*Kh=K+rowbase*KP+kvh*D,*Vh=V+rowbase*KP+kvh*D;
  const unsigned lds0=(unsigned)(uintptr_t)shm;
  float*wsf=(float*)(shm+LDS_WS)+wid*64;
  const bf16*ksrc=Kh+(long)lane*KP+wid*8;
  const bf16*vsrc=Vh+(long)(16*(wid&3)+(lane>>2))*KP+(wid>>2)*32+(lane&3)*8;
  const unsigned kdst=lds0+LDS_K+wid*1024, vdst=lds0+LDS_V+wid*1024;
  #define DMA_K(t,slot) glds16(ksrc+(long)(t)*KVBLK*KP,(unsigned)__builtin_amdgcn_readfirstlane(kdst+(slot)))
  #define DMA_V(t,slot) glds16(vsrc+(long)(t)*KVBLK*KP,(unsigned)__builtin_amdgcn_readfirstlane(vdst+(slot)))
  const int vb0=(int)(lds0+LDS_V)+((lane>>4)&1)*32+(lane&3)*8+(4*hi+((lane&15)>>2))*64;
  const char*Kbase=shm+LDS_K; bf16x8 kf[8];
  const lds_cptr shm3=(lds_cptr)shm; const lds_cptr kp0=shm3+LDS_K+hi*1024+r32*16; const lds_cptr vp0=shm3+LDS_V+((lane>>4)&1)*32+(lane&3)*8+(4*hi+((lane&15)>>2))*64;
  const int NT=T_/KVBLK;
  DMA_K(0,0);DMA_V(0,0);DMA_K(1,SLOTB);
  bf16x8 qr[4];
  #pragma unroll
  for(int d0=0;d0<4;++d0)qr[d0]=*reinterpret_cast<const bf16x8*>(&Qw[(long)r32*QP+d0*16+hi*8]);
  float mhat=0.f,l_reg=0.f;f32x16 o[2];o[0]=f32x16{};o[1]=f32x16{};f32x16 negm=f32x16{};asm volatile("":"+v"(negm));
  const int qrel=wid*QBLK+r32;
  #define CMASK(P0,P1,t) do{}while(0)
  bool resc=false;
  #define START(P0,P1) do{ const float rm=rowmax(P0,P1); resc=false; \
    { const float dl=rm; mhat=fadd_s(mhat,dl); \
      _Pragma("unroll") for(int r=0;r<16;++r){P0[r]=fsub_s(P0[r],dl);P1[r]=fsub_s(P1[r],dl);} \
      _Pragma("unroll") for(int r=0;r<16;++r)negm[r]=-mhat; asm volatile("":"+v"(negm)); } \
    _Pragma("unroll") for(int r=0;r<16;++r)P0[r]=__builtin_amdgcn_exp2f(P0[r]); }while(0)
  #define RESC() do{ if(resc){ asm volatile("s_waitcnt lgkmcnt(0)":::"memory"); \
      _Pragma("unroll") for(int d_=0;d_<2;++d_) _Pragma("unroll") for(int r=0;r<16;++r)o[d_][r]*=wsf[crow(r,hi)]; } }while(0)
  f32x16 pA0,pA1,pB0,pB1;
  int sl_prev=0,sl_cur=0,sl_next=SLOTB;
  #define ROT() do{sl_prev=sl_cur;sl_cur=sl_next;sl_next=(sl_next==(NSLOT-1)*SLOTB)?0:sl_next+SLOTB;}while(0)
  DMA_K(2,2*SLOTB);
  WAIT_BAR(3);
  qkt(pA0,pA1,Kbase,qr,negm,r32,hi);asm volatile("s_nop 15\n\ts_nop 7":"+v"(pA0),"+v"(pA1));CMASK(pA0,pA1,0);
  START(pA0,pA1);
  _Pragma("unroll") for(int r=0;r<16;++r)pA1[r]=__builtin_amdgcn_exp2f(pA1[r]);
  WAIT_BAR(0);
  DMA_K(3,0);DMA_V(1,SLOTB);
  ROT();
  kload8(kf,kp0+sl_cur);
  WAIT_BAR(2);
  s16x4 vlo[8],vhi[8]; u32x4 pw0,pw1,pw2,pw3;
  #define PKW(P,B) cvtpk_s(P[B],P[B+1])
  #define PAF(k) __builtin_bit_cast(bf16x8,pw##k)
  #define VFR(i) (bf16x8){vlo[i][0],vlo[i][1],vlo[i][2],vlo[i][3],vhi[i][0],vhi[i][1],vhi[i][2],vhi[i][3]}
  #define PIN(x) asm volatile("":"+v"(x))
  #define MX3(a,b,c) __builtin_fmaxf(__builtin_fmaxf((a),(b)),(c))
  #define GAPA(MF,A0,A1,A2,A3,W0,W1,PW) do{ MF; sacc+=A0; sacc+=A1; sacc+=A2; sacc+=A3; PIN(sacc); W0; W1; PIN(PW); SBAR(); }while(0)
  #define EX(v) __builtin_amdgcn_exp2f(v)
  #define GAPB(MF,X,B) do{ MF; X[B]=EX(X[B]); X[B+1]=EX(X[B+1]); X[B+2]=EX(X[B+2]); X[B+3]=EX(X[B+3]); PIN(X); SBAR(); }while(0)
  #define VRD(i) do{ vlo[i]=vtr(vp_+(((i)>>2)*4096+((i)&3)*1024)); vhi[i]=vtr(vp_+(((i)>>2)*4096+((i)&3)*1024+512)); }while(0)
  #define KRD(G,j) do{ if(G){ kload2(kf,kp0+sl_next,j); SBAR(); } }while(0)
  #define STEP(C0,C1,P0,P1,t,GK,GV,GL) do{ SBAR(); \
    const lds_cptr vp_=vp0+sl_prev; \
    VRD(0); SBAR(); float sacc=(P0[0]+P0[1]); \
    GAPA(C0=__builtin_amdgcn_mfma_f32_32x32x16_bf16(kf[0],qr[0],negm,0,0,0), P0[2],P0[3],P0[4],P0[5],     pw0[0]=PKW(P0,0), pw0[1]=PKW(P0,2), pw0); \
    VRD(4); SBAR(); GAPA(C1=__builtin_amdgcn_mfma_f32_32x32x16_bf16(kf[1],qr[0],negm,0,0,0), P0[6],P0[7],P0[8],P0[9],     pw0[2]=PKW(P0,4), pw0[3]=PKW(P0,6), pw0); \
    VRD(1); SBAR(); GAPA(C0=__builtin_amdgcn_mfma_f32_32x32x16_bf16(kf[2],qr[1],C0,0,0,0),   P0[10],P0[11],P0[12],P0[13], pw1[0]=PKW(P0,8), pw1[1]=PKW(P0,10), pw1); \
    VRD(5); SBAR(); GAPA(C1=__builtin_amdgcn_mfma_f32_32x32x16_bf16(kf[3],qr[1],C1,0,0,0),   P0[14],P0[15],P1[0],P1[1],   pw1[2]=PKW(P0,12),pw1[3]=PKW(P0,14), pw1); \
    VRD(2); SBAR(); GAPA(C0=__builtin_amdgcn_mfma_f32_32x32x16_bf16(kf[4],qr[2],C0,0,0,0),   P1[2],P1[3],P1[4],P1[5],     pw2[0]=PKW(P1,0), pw2[1]=PKW(P1,2), pw2); \
    VRD(6); SBAR(); GAPA(C1=__builtin_amdgcn_mfma_f32_32x32x16_bf16(kf[5],qr[2],C1,0,0,0),   P1[6],P1[7],P1[8],P1[9],     pw2[2]=PKW(P1,4), pw2[3]=PKW(P1,6), pw2); \
    VRD(3); SBAR(); GAPA(C0=__builtin_amdgcn_mfma_f32_32x32x16_bf16(kf[6],qr[3],C0,0,0,0),   P1[10],P1[11],P1[12],P1[13], pw3[0]=PKW(P1,8), pw3[1]=PKW(P1,10), pw3); \
    VRD(7); SBAR(); GAPA(C1=__builtin_amdgcn_mfma_f32_32x32x16_bf16(kf[7],qr[3],C1,0,0,0),   P1[14],P1[15],0.f,0.f,       pw3[2]=PKW(P1,12),pw3[3]=PKW(P1,14), pw3); \
    l_reg+=sacc; \
    if(GK){DMA_K((t)+3,sl_cur);} if(GV){DMA_V((t)+1,sl_next);} \
    CMASK(C0,C1,t); \
    { float a=MX3(C0[0],C0[1],C1[0]),b=MX3(C0[2],C0[3],C1[1]); a=MX3(a,C1[2],C1[3]); \
      _Pragma("unroll") for(int r=4;r<16;r+=4){a=MX3(a,C0[r],C0[r+1]);b=MX3(b,C0[r+2],C0[r+3]);a=MX3(a,C1[r],C1[r+1]);b=MX3(b,C1[r+2],C1[r+3]);} \
      float rm=__builtin_fmaxf(a,b); { auto rr=__builtin_amdgcn_permlane32_swap(__float_as_uint(rm),__float_as_uint(rm),false,false); rm=__builtin_fmaxf(__uint_as_float(rr[0]),__uint_as_float(rr[1])); } \
      resc=false; \
      if(__builtin_expect(__any(rm>(float)THRL),0)){ const float dl=__builtin_fmaxf(rm,0.f); mhat+=dl; \
        _Pragma("unroll") for(int r=0;r<16;++r){C0[r]-=dl;C1[r]-=dl;} \
        _Pragma("unroll") for(int r=0;r<16;++r)negm[r]=-mhat; asm volatile("":"+v"(negm)); \
        const float f=__builtin_amdgcn_exp2f(-dl); l_reg*=f; if(hi==0)wsf[r32]=f; resc=true; } } \
    SBAR(); \
    GAPB(o[0]=__builtin_amdgcn_mfma_f32_32x32x16_bf16(PAF(0),VFR(0),o[0],0,0,0), C0,0); \
    GAPB(o[1]=__builtin_amdgcn_mfma_f32_32x32x16_bf16(PAF(0),VFR(4),o[1],0,0,0), C0,4); \
    KRD(GL,0); GAPB(o[0]=__builtin_amdgcn_mfma_f32_32x32x16_bf16(PAF(1),VFR(1),o[0],0,0,0), C0,8); \
    KRD(GL,1); GAPB(o[1]=__builtin_amdgcn_mfma_f32_32x32x16_bf16(PAF(1),VFR(5),o[1],0,0,0), C0,12); \
    KRD(GL,2); GAPB(o[0]=__builtin_amdgcn_mfma_f32_32x32x16_bf16(PAF(2),VFR(2),o[0],0,0,0), C1,0); \
    KRD(GL,3); GAPB(o[1]=__builtin_amdgcn_mfma_f32_32x32x16_bf16(PAF(2),VFR(6),o[1],0,0,0), C1,4); \
    GAPB(o[0]=__builtin_amdgcn_mfma_f32_32x32x16_bf16(PAF(3),VFR(3),o[0],0,0,0), C1,8); \
    GAPB(o[1]=__builtin_amdgcn_mfma_f32_32x32x16_bf16(PAF(3),VFR(7),o[1],0,0,0), C1,12); \
    }while(0)
  int t=1;
  #undef CMASK
  #define CMASK(P0,P1,t) do{}while(0)
  for(;t+5<NT;t+=2){
    STEP(pB0,pB1,pA0,pA1,t,true,true,true);     WAIT_BAR(2); RESC(); ROT();
    STEP(pA0,pA1,pB0,pB1,t+1,true,true,true);   WAIT_BAR(2); RESC(); ROT();
  }
  #undef CMASK
  #define CMASK(P0,P1,t) do{}while(0)
  #define ENDW(tt) do{ if((tt)+3<NT){WAIT_BAR(2);} else if((tt)+2<NT){WAIT_BAR(1);} else {WAIT_BAR(0);} }while(0)
  for(;t+1<NT;t+=2){
    STEP(pB0,pB1,pA0,pA1,t,(t+3<NT),(t+1<NT),(t+1<NT));       ENDW(t);   RESC(); ROT();
    STEP(pA0,pA1,pB0,pB1,t+1,(t+4<NT),(t+2<NT),(t+2<NT));     ENDW(t+1); RESC(); ROT();
  }
  STEP(pB0,pB1,pA0,pA1,NT-1,false,false,false); RESC();
  { float sacc=pB0[0]+pB0[1]; _Pragma("unroll") for(int r=2;r<16;++r)sacc+=pB0[r]; _Pragma("unroll") for(int r=0;r<16;++r)sacc+=pB1[r]; l_reg+=sacc;
    pw0=(u32x4){PKW(pB0,0),PKW(pB0,2),PKW(pB0,4),PKW(pB0,6)};pw1=(u32x4){PKW(pB0,8),PKW(pB0,10),PKW(pB0,12),PKW(pB0,14)};pw2=(u32x4){PKW(pB1,0),PKW(pB1,2),PKW(pB1,4),PKW(pB1,6)};pw3=(u32x4){PKW(pB1,8),PKW(pB1,10),PKW(pB1,12),PKW(pB1,14)};
    SBAR(); pv(o,vb0+sl_cur,PAF(0),PAF(1),PAF(2),PAF(3)); }
  #undef PKW
  #undef PAF
  #undef VFR
  #undef PIN
  #undef MX3
  #undef GAPA
  #undef GAPB
  #undef EX
  #undef VRD
  #undef KRD
  #undef STEP
  #undef ENDW
  {auto rr=__builtin_amdgcn_permlane32_swap(__float_as_uint(l_reg),__float_as_uint(l_reg),false,false);l_reg=__uint_as_float(rr[0])+__uint_as_float(rr[1]);}
  if(hi==0)wsf[32+r32]=l_reg;asm volatile("s_waitcnt lgkmcnt(0)":::"memory");
  float rli[16];
  #pragma unroll
  for(int r=0;r<16;++r)rli[r]=__builtin_amdgcn_rcpf(wsf[32+crow(r,hi)]);
  bf16*Ow=O+(rowbase+q0+wid*QBLK)*OP+h*D;
  { bf16*stg=(bf16*)(shm+LDS_OST)+wid*2048;
    #pragma unroll
    for(int r=0;r<16;++r){const int orow=crow(r,hi);
      #pragma unroll
      for(int d0=0;d0<2;++d0)stg[orow*64+d0*32+r32]=__float2bfloat16(o[d0][r]*rli[r]);}
    asm volatile("s_waitcnt lgkmcnt(0)":::"memory");
    #pragma unroll
    for(int i=0;i<4;++i){const int row=i*8+(lane>>3),ch=lane&7; const u32x4 v=*(const u32x4*)(stg+row*64+ch*8); ATTN_STORE16(Ow+(long)row*OP+ch*8,v);} }
  asm volatile("s_waitcnt lgkmcnt(0)\n\ts_barrier":::"memory");
  #undef DMA_K
  #undef DMA_V
  #undef CMASK
  #undef START
  #undef RESC
  #undef ROT
}
constexpr int ATTN_LDS_BYTES=LDS_BYTES;
struct AttnTensors { const bf16* Q; const bf16* K; const bf16* V; bf16* O; };
template<int THRL=8> __device__ __forceinline__ void attn_phase(char*lds,const AttnTensors&T,int vcu,int G){
  if(G==256){
    const int x=vcu>>5,j=vcu&31;
    for(int i=0;i<4;++i){ const int w=j*4+i,g=w>>5,qb=w&31; attn_unit<THRL>(16384+(x>>1)*8192,8192,(x&1)*4+g,qb,T.Q,T.K,T.V,T.O,lds); }
    for(int i=0;i<2;++i){ const int w=j*2+i,g=w>>4,qb=w&15; attn_unit<THRL>((x>>1)*4096,4096,(x&1)*4+g,qb,T.Q,T.K,T.V,T.O,lds); }
  } else {
    for(int u=vcu;u<1536;u+=G){
      if(u<1024){ const int qb=u&31,h=(u>>5)&7,s=u>>8; attn_unit<THRL>(16384+s*8192,8192,h,qb,T.Q,T.K,T.V,T.O,lds); }
      else { const int v=u-1024,qb=v&15,h=(v>>4)&7,s=v>>7; attn_unit<THRL>(s*4096,4096,h,qb,T.Q,T.K,T.V,T.O,lds); }
    }
  }
}
#undef SBAR
#undef WAIT_BAR
}

__device__ __forceinline__ void sattn_unit(const Frame& F, int seq, int h, int qb) {
    const int T = seq < 4 ? TP : TS; const int rowbase = seq < 4 ? seq * TP : MP + (seq - 4) * TS;
    const bf16* Q = (const bf16*)(F.ws + WS_Q); const bf16* Kb = (const bf16*)(F.ws + WS_K); const bf16* Vb = (const bf16*)(F.ws + WS_V); bf16* MIX = (bf16*)(F.ws + WS_MIX);
    const int kvh = h >> 2, m = rowbase + qb * 512 + F.tid;
    LAS float* Ks = (LAS float*)F.lds; LAS float* Vs = Ks + 64 * 64;
    float q[64], o[64];
    { const u32x4* qp = (const u32x4*)(Q + (size_t)m * 512 + h * 64);
#pragma unroll
      for (int i = 0; i < 8; ++i) { const u32x4 w = qp[i]; q[8 * i] = bflo(w.x); q[8 * i + 1] = bfhi(w.x); q[8 * i + 2] = bflo(w.y); q[8 * i + 3] = bfhi(w.y); q[8 * i + 4] = bflo(w.z); q[8 * i + 5] = bfhi(w.z); q[8 * i + 6] = bflo(w.w); q[8 * i + 7] = bfhi(w.w); } }
#pragma unroll
    for (int d = 0; d < 64; ++d) o[d] = 0.f;
    float mx = -1e30f, l = 0.f;
    const int lr = F.tid >> 3, lc = (F.tid & 7) * 8;
    for (int kt = 0; kt < T / 64; ++kt) {
        __syncthreads();
        { const size_t grow = (size_t)(rowbase + kt * 64 + lr) * 128 + kvh * 64 + lc;
          const u32x4 kw = *(const u32x4*)(Kb + grow), vw = *(const u32x4*)(Vb + grow);
          LAS f32x4* kd = (LAS f32x4*)(Ks + lr * 64 + lc); LAS f32x4* vd = (LAS f32x4*)(Vs + lr * 64 + lc);
          kd[0] = (f32x4){bflo(kw.x), bfhi(kw.x), bflo(kw.y), bfhi(kw.y)}; kd[1] = (f32x4){bflo(kw.z), bfhi(kw.z), bflo(kw.w), bfhi(kw.w)};
          vd[0] = (f32x4){bflo(vw.x), bfhi(vw.x), bflo(vw.y), bfhi(vw.y)}; vd[1] = (f32x4){bflo(vw.z), bfhi(vw.z), bflo(vw.w), bfhi(vw.w)}; }
        __syncthreads();
#pragma unroll 1
        for (int j = 0; j < 64; ++j) {
            const LAS f32x4* Kc = (const LAS f32x4*)(Ks + j * 64); const LAS f32x4* Vc = (const LAS f32x4*)(Vs + j * 64);
            float a = 0.f;
#pragma unroll
            for (int d4 = 0; d4 < 16; ++d4) { const f32x4 kv = Kc[d4]; a += q[4 * d4] * kv.x + q[4 * d4 + 1] * kv.y + q[4 * d4 + 2] * kv.z + q[4 * d4 + 3] * kv.w; }
            const float mn = fmaxf(mx, a), alpha = exp2f(mx - mn), p = exp2f(a - mn); mx = mn; l = l * alpha + p;
#pragma unroll
            for (int d4 = 0; d4 < 16; ++d4) { const f32x4 vv = Vc[d4]; o[4 * d4] = o[4 * d4] * alpha + p * vv.x; o[4 * d4 + 1] = o[4 * d4 + 1] * alpha + p * vv.y; o[4 * d4 + 2] = o[4 * d4 + 2] * alpha + p * vv.z; o[4 * d4 + 3] = o[4 * d4 + 3] * alpha + p * vv.w; }
        }
    }
    const float il = 1.0f / l;
    u32x4* op = (u32x4*)(MIX + (size_t)m * DM + h * 64);
#pragma unroll
    for (int i = 0; i < 8; ++i) { u32x4 w; w.x = pk2(o[8 * i] * il, o[8 * i + 1] * il); w.y = pk2(o[8 * i + 2] * il, o[8 * i + 3] * il); w.z = pk2(o[8 * i + 4] * il, o[8 * i + 5] * il); w.w = pk2(o[8 * i + 6] * il, o[8 * i + 7] * il); op[i] = w; }
}
__device__ __forceinline__ void sattn_phase(const Frame& F) {
    for (int u = F.vcu; u < 768; u += F.G) {
        if (u < 512) { const int qb = u & 15, h = (u >> 4) & 7, s = u >> 7; sattn_unit(F, 4 + s, h, qb); }
        else { const int v = u - 512, qb = v & 7, h = (v >> 3) & 7, s = v >> 6; sattn_unit(F, s, h, qb); }
    }
}
__device__ __forceinline__ void pool_phase(const Frame& F) {
    const bf16* U = (const bf16*)(F.ws + WS_U); bf16* MIX = (bf16*)(F.ws + WS_MIX);
    LAS u32x4* T = (LAS u32x4*)F.lds;
    const int g = F.wave & 3, half = 1 << g, ch = 16 * g + (F.lane & 15), rbase = 32 * (F.wave >> 2) + (F.lane >> 4);
    for (int u = F.vcu; u < M / 64; u += F.G) {
        const int r0 = u * 64, Tlen = r0 < MP ? TP : TS, t0 = tpos(r0);
        __syncthreads();
#pragma unroll
        for (int i = 0; i < 10; ++i) { const int e = F.tid + 512 * i, rr = e >> 6, cc = e & 63, t = t0 - 8 + rr;
            if (t >= 0 && t < Tlen) T[e] = *(const u32x4*)(U + (size_t)(r0 - 8 + rr) * 512 + cc * 8); }
        __syncthreads();
#pragma unroll 2
        for (int i = 0; i < 8; ++i) {
            const int r = rbase + 4 * i, t = t0 + r, lo = max(t - half, 0), hi = min(t + half, Tlen);
            float a[8];
#pragma unroll
            for (int k = 0; k < 8; ++k) a[k] = 0.f;
            for (int j = lo; j < hi; ++j) { const u32x4 w = T[(j - t0 + 8) * 64 + ch];
                a[0] += bflo(w.x); a[1] += bfhi(w.x); a[2] += bflo(w.y); a[3] += bfhi(w.y); a[4] += bflo(w.z); a[5] += bfhi(w.z); a[6] += bflo(w.w); a[7] += bfhi(w.w); }
            const float inv = 1.0f / (float)(hi - lo);
            const u32x4 w = T[(r + 8) * 64 + ch];
            u32x4 o; o.x = pk2(a[0] * inv - bflo(w.x), a[1] * inv - bfhi(w.x)); o.y = pk2(a[2] * inv - bflo(w.y), a[3] * inv - bfhi(w.y));
            o.z = pk2(a[4] * inv - bflo(w.z), a[5] * inv - bfhi(w.z)); o.w = pk2(a[6] * inv - bflo(w.w), a[7] * inv - bfhi(w.w));
            *(u32x4*)(MIX + (size_t)(r0 + r) * DM + 512 + ch * 8) = o;
        }
    }
    __syncthreads();
}
__device__ __forceinline__ void final_phase(const Frame& F, const float* src, float* out, const float* g) {
    const int gw = F.vcu * NWAVES + F.wave, NGW = F.G * NWAVES; const f32x4* gr = (const f32x4*)g + F.lane;
    for (int m = gw; m < M; m += NGW) {
        const f32x4* xs = (const f32x4*)(src + (size_t)m * DM) + F.lane; f32x4* xr = (f32x4*)(out + (size_t)m * DM) + F.lane; f32x4 v[4]; float s = 0.f;
#pragma unroll
        for (int j = 0; j < 4; ++j) { v[j] = xs[64 * j]; s += (v[j].x * v[j].x + v[j].y * v[j].y) + (v[j].z * v[j].z + v[j].w * v[j].w); }
        const float rstd = 1.0f / sqrtf(wave_sum(s) * (1.f / DM) + EPS);
#pragma unroll
        for (int j = 0; j < 4; ++j) xr[64 * j] = v[j] * rstd * gr[64 * j];
    }
}


constexpr int CW_BAR = 4096;
constexpr int LDSCTL_OFF = 131072, MISC_OFF = LDSCTL_OFF + 320;
#define XB_TMO      128
#define XB_XCNT(j)  (256  + 64 * (j))
#define XB_XSUB(j)  (1280 + 64 * (j))
#define XB_XGEN(j)  (2304 + 64 * (j))
#define XB_TOP      3328
#define XB_TOPGEN   3392
#define XCD_BAR_WORDS 3456
#define XB_SPIN_CAP (1u << 20)
__device__ __forceinline__ unsigned xb_ld(unsigned* p)              { return __hip_atomic_load(p, __ATOMIC_RELAXED, __HIP_MEMORY_SCOPE_AGENT); }
__device__ __forceinline__ unsigned xb_add(unsigned* p, unsigned v) { return __hip_atomic_fetch_add(p, v, __ATOMIC_RELAXED, __HIP_MEMORY_SCOPE_AGENT); }
__device__ __forceinline__ unsigned xb_xcc_id() { return (unsigned)__builtin_amdgcn_s_getreg((3 << 11) | 20) & 0xFu; }
#define XB_SPIN(cond, bar) do { unsigned _sp = 0; while (cond) { __builtin_amdgcn_s_sleep(1); \
    if ((++_sp & 255u) == 0u) { if (xb_ld(&(bar)[XB_TMO])) break; if (_sp > XB_SPIN_CAP) { atomicAdd(&(bar)[XB_TMO], 1u); break; } } } } while (0)
struct XcdBarrier { unsigned* bar; unsigned x; volatile LAS unsigned* st; };
__device__ __forceinline__ XcdBarrier xcd_barrier_post(unsigned* bar, volatile LAS unsigned* st) {
    XcdBarrier b; b.bar = bar; b.x = xb_xcc_id(); b.st = st;
    if (threadIdx.x == 0) (void)xb_add(&bar[XB_XCNT(b.x)], 1u);
    return b;
}
__device__ __forceinline__ void xcd_barrier_complete(unsigned* bar, unsigned x, unsigned& nloc, unsigned& nx) {
    const unsigned G = gridDim.x * gridDim.y * gridDim.z;
    unsigned sum, cnt, mine, sp = 0u;
    for (;;) {
        sum = 0u; cnt = 0u; mine = 0u;
#pragma unroll
        for (unsigned j = 0; j < 16; ++j) { const unsigned c = xb_ld(&bar[XB_XCNT(j)]); sum += c; cnt += (c > 0u) ? 1u : 0u; mine = (j == x) ? c : mine; }
        if (sum == G) break;
        __builtin_amdgcn_s_sleep(1);
        if ((++sp & 255u) == 0u) { if (xb_ld(&bar[XB_TMO])) break; if (sp > XB_SPIN_CAP) { atomicAdd(&bar[XB_TMO], 1u); break; } }
    }
    nloc = mine > 0u ? mine : 1u; nx = cnt > 0u ? cnt : 1u;
}
__device__ __forceinline__ void xcd_barrier(const XcdBarrier& b) {
    asm volatile("s_waitcnt vmcnt(0)" ::: "memory");
    __syncthreads();
    if (threadIdx.x == 0) {
        unsigned* bar = b.bar;
        __builtin_amdgcn_s_waitcnt(0);
        unsigned nloc = b.st[0], nx = b.st[1];
        if (nloc == 0u) { xcd_barrier_complete(bar, b.x, nloc, nx); b.st[0] = nloc; b.st[1] = nx; }
        const unsigned old = xb_add(&bar[XB_XSUB(b.x)], 1u);
        const unsigned gen = old / nloc;
        if (old + 1u == (gen + 1u) * nloc) {
            __builtin_amdgcn_fence(__ATOMIC_RELEASE, "agent");
            asm volatile("s_waitcnt vmcnt(0)" ::: "memory");
            const unsigned og = xb_add(&bar[XB_TOP], 1u);
            const unsigned tg = og / nx;
            if (og + 1u == (tg + 1u) * nx) xb_add(&bar[XB_TOPGEN], 1u);
            else XB_SPIN(xb_ld(&bar[XB_TOPGEN]) == tg, bar);
            __builtin_amdgcn_fence(__ATOMIC_ACQUIRE, "agent");
            xb_add(&bar[XB_XGEN(b.x)], 1u);
            asm volatile("s_waitcnt vmcnt(0)" ::: "memory");
        } else {
            XB_SPIN(xb_ld(&bar[XB_XGEN(b.x)]) == gen, bar);
            __builtin_amdgcn_fence(__ATOMIC_ACQUIRE, "agent");
            asm volatile("s_waitcnt vmcnt(0)" ::: "memory");
        }
    }
    __syncthreads();
}


template <class E>
__device__ __forceinline__ void fgemm(const Frame& F, const bf16* A, const bf16* Bt, int Mrows, int N, int K, int row0, const E& e) {
    pg8::Gemm g{A, Bt, Mrows, N, K}; pg8::StaticOrder S; S.init(Mrows, N, F.G, (int)blockIdx.x);
    pg8::EpiAdapt<E> EA{e, row0};
    pg8::gemm_phase<pg8::EpiAdapt<E>, pg8::StaticOrder, true, true>(F.lds, g, S, EA);
}

constexpr int CW_GRP = 8192;
constexpr int CW_GRP_TMO = 8192 + 64 * 64;
__device__ __forceinline__ void group_sync(unsigned* cnt, unsigned target, unsigned* tmo) {
    asm volatile("s_waitcnt vmcnt(0)" ::: "memory");
    __syncthreads();
    if (threadIdx.x == 0) {
        __builtin_amdgcn_fence(__ATOMIC_RELEASE, "agent");
        asm volatile("s_waitcnt vmcnt(0)" ::: "memory");
        (void)xb_add(cnt, 1u);
        unsigned sp = 0u;
        while (xb_ld(cnt) < target) { __builtin_amdgcn_s_sleep(1); if (++sp > (1u << 21)) { atomicAdd(tmo, 1u); break; } }
        __builtin_amdgcn_fence(__ATOMIC_ACQUIRE, "agent");
        asm volatile("s_waitcnt vmcnt(0)" ::: "memory");
    }
    __syncthreads();
}
__device__ __forceinline__ f32x4 ld_bf16x4(const bf16* p) { const u32x2 w = *(const u32x2*)p; return (f32x4){bflo(w.x), bfhi(w.x), bflo(w.y), bfhi(w.y)}; }
struct EpiResA {
    const float* x0; const float* x1; bf16* HB; float* SS;
    __device__ __forceinline__ void seg64(int m, int c0, f32x4 (&v)[4], int fq) const {
        const float* b = (m < MP ? x0 + (size_t)m * DM : x1 + (size_t)(m - MP) * DM) + c0 + 4 * fq;
        bf16* hb = HB + (size_t)m * DM + c0 + 4 * fq; float ss = 0.f;
#pragma unroll
        for (int nt = 0; nt < 4; ++nt) { const f32x4 h = *(const f32x4*)(b + 16 * nt) + v[nt]; st_bf16x4(hb + 16 * nt, h); ss += (h[0] * h[0] + h[1] * h[1]) + (h[2] * h[2] + h[3] * h[3]); }
        ss = quad_sum(ss);
        if (fq == 0) SS[(size_t)m * 16 + (c0 >> 6)] = ss;
    }
};
struct EpiResC {
    bf16* HB; float* SS;
    __device__ __forceinline__ void seg64(int m, int c0, f32x4 (&v)[4], int fq) const {
        bf16* hb = HB + (size_t)m * DM + c0 + 4 * fq; float ss = 0.f;
#pragma unroll
        for (int nt = 0; nt < 4; ++nt) { const f32x4 h = ld_bf16x4(hb + 16 * nt) + v[nt]; st_bf16x4(hb + 16 * nt, h); ss += (h[0] * h[0] + h[1] * h[1]) + (h[2] * h[2] + h[3] * h[3]); }
        ss = quad_sum(ss);
        if (fq == 0) SS[(size_t)m * 16 + (c0 >> 6)] = ss;
    }
};
namespace pg8 {
struct EpiGateFinal {
    static constexpr bool PERM = false, AFTER_DRAIN = true;
    const bf16* HB; const bf16* PP; const float* SS2; float* SS3; float* out; const float* fg; unsigned* cnt; unsigned target; unsigned* tmo; int row0;
    __device__ __forceinline__ void fused(f32x4 (&acc)[2][2][4][2], const Unit& u, int wr, int wc, int fr, int fq, PG8_LAS unsigned char* lds, int wid, int lane) const {
        const int c0 = u.pn * BM + wc * 64;
#pragma unroll
        for (int ai = 0; ai < 2; ++ai)
#pragma unroll
            for (int m = 0; m < 4; ++m) {
                const int row = row0 + ai * HALF + wr * 64 + m * 16 + fr;
                const float rstd = ((const PG8_LAS float*)(lds + RSTD_OFF))[row - row0];
                const bf16* hb = HB + (size_t)row * DM + c0 + 4 * fq; const bf16* pp = PP + (size_t)row * DM + c0 + 4 * fq; float ss = 0.f;
#pragma unroll
                for (int bj = 0; bj < 2; ++bj)
#pragma unroll
                    for (int n = 0; n < 2; ++n) { const int nt = 2 * bj + n; const ::f32x4 hv = ld_bf16x4(hb + 16 * nt), pv = ld_bf16x4(pp + 16 * nt); ::f32x4 a = acc[ai][bj][m][n], h;
#pragma unroll
                        for (int e = 0; e < 4; ++e) h[e] = hv[e] + pv[e] / (1.0f + __expf(-a[e] * rstd));
                        acc[ai][bj][m][n] = h; ss += (h[0] * h[0] + h[1] * h[1]) + (h[2] * h[2] + h[3] * h[3]); }
                ss = quad_sum(ss);
                if (fq == 0) SS3[(size_t)row * 16 + (c0 >> 6)] = ss;
                if (m & 1) asm volatile("" ::: "memory");
            }
        group_sync(cnt, target, tmo);
        if (threadIdx.x < 256) ((PG8_LAS float*)(lds + RSTD_OFF))[threadIdx.x] = rstd_from_ss(SS3 + (size_t)(row0 + threadIdx.x) * 16);
        __syncthreads();
#pragma unroll
        for (int ai = 0; ai < 2; ++ai)
#pragma unroll
            for (int m = 0; m < 4; ++m) {
                const int row = row0 + ai * HALF + wr * 64 + m * 16 + fr;
                const float rstd = ((const PG8_LAS float*)(lds + RSTD_OFF))[row - row0];
                float* o = out + (size_t)row * DM + c0 + 4 * fq; const float* g = fg + c0 + 4 * fq;
#pragma unroll
                for (int bj = 0; bj < 2; ++bj)
#pragma unroll
                    for (int n = 0; n < 2; ++n) { const int nt = 2 * bj + n; *(::f32x4*)(o + 16 * nt) = acc[ai][bj][m][n] * rstd * *(const ::f32x4*)(g + 16 * nt); }
                if (m & 1) asm volatile("" ::: "memory");
            }
    }
};
struct ListOrder {
    int pn0, n;
    __device__ __forceinline__ bool next(int i, Unit& u) const { if (i >= n) return false; u.pm = 0; u.pn = pn0 + i; return true; }
    __device__ __forceinline__ void a_ready(const Unit&) const {}
    __device__ __forceinline__ void done(const Unit&) const {}
};
}
template <class E>
__device__ __forceinline__ void lgemm(const Frame& F, const bf16* A, const bf16* Bt, int N, int K, int row0, int pn0, int n, const E& e) {
    pg8::Gemm g{A, Bt, 256, N, K}; pg8::ListOrder S{pn0, n};
    pg8::EpiAdapt<E> EA{e, row0};
    pg8::gemm_phase<pg8::EpiAdapt<E>, pg8::ListOrder, true, true>(F.lds, g, S, EA);
}
__device__ __forceinline__ void tail_phase(const Frame& F, const Args& args) {
    const int gidx = F.vcu >> 2, mem = F.vcu & 3;
    unsigned nsync = 0u;
#pragma unroll 1
    for (int c = 0; c < 4; ++c) {
        unsigned char* ws = F.ws; asm volatile("" : "+s"(ws));
        bf16* HB = (bf16*)(ws + WS_XN); const bf16* PP = (const bf16*)(ws + WS_PP); const bf16* MIX = (const bf16*)(ws + WS_MIX);
        float* SS1 = (float*)(ws + WS_SS1); float* SS2 = (float*)(ws + WS_SS2);
        bf16* HMg = (bf16*)(ws + WS_HM) + (size_t)gidx * 256 * DFF;
        unsigned* cnt = (unsigned*)(ws + WS_CTL) + CW_GRP + 64 * gidx; unsigned* tmo = (unsigned*)(ws + WS_CTL) + CW_GRP_TMO;
        const LAS float* rs = (const LAS float*)(F.lds + RSTD_OFF);
        const bf16* PB = (const bf16*)(ws + WS_PB); bf16* PPw = (bf16*)(ws + WS_PP);
        const int row0 = (c * 64 + gidx) * 256, rowp = row0 - 64 * 256;
        if (c < 3) { EpiResA E{args.in[0], args.in[1], HB, SS1}; lgemm(F, MIX + (size_t)row0 * DM, (const bf16*)(ws + WS_WOUT), DM, DM, row0, mem, 1, E); }
        if (c > 0) {
            { EpiBf E{PPw, DM}; lgemm(F, PB + (size_t)rowp * PLE, (const bf16*)(ws + WS_WPROJ), DM, PLE, rowp, mem, 1, E); }
            rstd_table(F, SS2, rowp);
            pg8::Gemm g{HB + (size_t)rowp * DM, (const bf16*)(ws + WS_WGATE), 256, DM, DM}; pg8::ListOrder S{mem, 1};
            pg8::EpiGateFinal E{HB, PP, SS2, SS1, args.out, args.in[17], cnt, 4u * (++nsync), tmo, rowp};
            pg8::gemm_phase<pg8::EpiGateFinal, pg8::ListOrder, false, true>(F.lds, g, S, E);
        }
        if (c < 3) {
            if (c == 0) group_sync(cnt, 4u * (++nsync), tmo);
            rstd_table(F, SS1, row0);
            { EpiUp E{HMg, rs, row0}; lgemm(F, HB + (size_t)row0 * DM, (const bf16*)(ws + WS_WUP), DFF, DM, row0, 4 * mem, 4, E); }
            group_sync(cnt, 4u * (++nsync), tmo);
            { EpiResC E{HB, SS2}; lgemm(F, HMg, (const bf16*)(ws + WS_WDOWN), DM, DFF, row0, mem, 1, E); }
            group_sync(cnt, 4u * (++nsync), tmo);
        }
    }
}

constexpr int NPHASE = 4;
__global__ void __launch_bounds__(NWAVES * 64, 2) fwd_kernel(Args args) {
    extern __shared__ __attribute__((aligned(16))) unsigned char lds[];
    Frame F;
    F.lds = (LAS unsigned char*)lds; F.tid = threadIdx.x; F.lane = F.tid & 63; F.wave = __builtin_amdgcn_readfirstlane(F.tid >> 6);
    F.G = gridDim.x; { const int bx = blockIdx.x; F.vcu = (F.G % 8 == 0) ? (bx % 8) * (F.G / 8) + bx / 8 : bx; }
    F.ws = args.ws;
    unsigned char* ws = args.ws;
    for (int u = F.tid; u < (LDS_BYTES - LDSCTL_OFF) / 4; u += NWAVES * 64) ((LAS unsigned*)(F.lds + LDSCTL_OFF))[u] = 0u;
    __syncthreads();
    XcdBarrier bar; bar.bar = (unsigned*)(ws + WS_CTL) + CW_BAR; bar.x = 0; bar.st = nullptr;
    if (args.ph_hi - args.ph_lo > 1) bar = xcd_barrier_post((unsigned*)(ws + WS_CTL) + CW_BAR, (volatile LAS unsigned*)(F.lds + MISC_OFF) + 8);
    bf16* XN = (bf16*)(ws + WS_XN); bf16* PP = (bf16*)(ws + WS_PP); bf16* MIX = (bf16*)(ws + WS_MIX); bf16* HM = (bf16*)(ws + WS_HM);
    float* SS1 = (float*)(ws + WS_SS1); float* SS2 = (float*)(ws + WS_SS2);
    const int lo = args.ph_lo, hi = args.ph_hi;
#define IN(k) (lo <= (k) && (k) < hi)
#define SEAM(k) do { if (IN(k) && IN((k) + 1)) xcd_barrier(bar); } while (0)
#define NREP(k) ((PROBE_REPEAT == (k)) ? 2 : 1)
#define REPBAR() do { if (rep) xcd_barrier(bar); } while (0)
    float* const dry = (float*)(ws + WS_HM);
    if (IN(0)) {
#pragma unroll 1
        for (int rep = 0; rep < NREP(0); ++rep) { REPBAR(); p0_prologue(F, args); } } SEAM(0);
    if (IN(1)) {
#pragma unroll 1
        for (int rep = 0; rep < NREP(1); ++rep) { REPBAR();
        EpiIn E{(bf16*)(ws + WS_Q), (bf16*)(ws + WS_K), (bf16*)(ws + WS_V), (bf16*)(ws + WS_U), args.in[6], args.in[7], (const float2*)(ws + WS_ROPE)};
        fgemm(F, XN, (const bf16*)(ws + WS_WIN), M, INW, DM, 0, E); }
    } SEAM(1);
    if (IN(2)) {
        const attn_body::AttnTensors AT{(const attn_body::bf16*)(ws + WS_Q), (const attn_body::bf16*)(ws + WS_K), (const attn_body::bf16*)(ws + WS_V), (attn_body::bf16*)MIX};
#pragma unroll 1
        for (int rep = 0; rep < NREP(2); ++rep) { REPBAR(); attn_body::attn_phase<8>((char*)lds, AT, F.vcu, F.G); }
#pragma unroll 1
        for (int rep = 0; rep < NREP(12); ++rep) { REPBAR(); pool_phase(F); }
    } SEAM(2);
    if (IN(3)) tail_phase(F, args);
#undef NREP
#undef REPBAR
#undef IN
#undef SEAM
}

extern "C" void kernel_launch(void* const* d_in, const int* in_sizes, int n_in, void* d_out, int out_size, void* d_ws, size_t ws_size, hipStream_t stream) {
    static int grid = 0;
    if (grid == 0) {
        if (n_in != 18 || out_size != M * DM || ws_size < WS_END) { fprintf(stderr, "kernel_launch: unexpected shapes (n_in %d out %d ws %zu)\n", n_in, out_size, ws_size); grid = -1; return; }
        if (hipFuncSetAttribute((const void*)fwd_kernel, hipFuncAttributeMaxDynamicSharedMemorySize, LDS_BYTES) != hipSuccess) { fprintf(stderr, "kernel_launch: hipFuncSetAttribute failed\n"); grid = -1; return; }
        int dev = 0, cus = 0; (void)hipGetDevice(&dev); (void)hipDeviceGetAttribute(&cus, hipDeviceAttributeMultiprocessorCount, dev);
        grid = cus > 0 ? cus : 256;
    }
    if (grid < 0) return;
    Args a{};
    for (int i = 0; i < 18; ++i) a.in[i] = (const float*)d_in[i];
    a.out = (float*)d_out; a.ws = (unsigned char*)d_ws;
#if MK_ONE_LAUNCH
    if (hipMemsetAsync((char*)d_ws + WS_CTL, 0, 65536, stream) != hipSuccess) { fprintf(stderr, "kernel_launch: memset failed\n"); return; }
    a.ph_lo = 0; a.ph_hi = NPHASE; hipLaunchKernelGGL(fwd_kernel, dim3(grid), dim3(NWAVES * 64), LDS_BYTES, stream, a);
#else
    for (int ph = 0; ph < NPHASE; ++ph) { a.ph_lo = ph; a.ph_hi = ph + 1; hipLaunchKernelGGL(fwd_kernel, dim3(grid), dim3(NWAVES * 64), LDS_BYTES, stream, a); }
#endif
}
```

```cpp
#include <hip/hip_runtime.h>
#include <cstdio>
#include <cstdint>
#include <hip/hip_bf16.h>
#include <cmath>

#ifndef PROBE_REPEAT
#define PROBE_REPEAT (-1)
#endif
#ifndef TAIL_REP
#define TAIL_REP (-1)
#endif
#ifndef TAIL_CLS
#define TAIL_CLS 0
#endif
#ifndef ATTN_NOMAX
#define ATTN_NOMAX 1
#endif
#ifndef MK_ONE_LAUNCH
#define MK_ONE_LAUNCH 1
#endif

constexpr int DM = 1024, TP = 4096, TS = 8192, MP = 4 * TP, MS = 4 * TS, M = MP + MS;
constexpr int INW = 1280, DFF = 4096, PLE = 256;
constexpr int CHUNK = 16384, NCHUNK = M / CHUNK;
constexpr float EPS = 1e-6f;
constexpr float C2 = 0.125f * 1.4426950408889634f;

typedef unsigned short bf16;
typedef short bf16x8 __attribute__((ext_vector_type(8)));
typedef float f32x4 __attribute__((ext_vector_type(4)));
typedef unsigned u32x4 __attribute__((ext_vector_type(4)));
typedef unsigned u32x2 __attribute__((ext_vector_type(2)));
#define LAS __attribute__((address_space(3)))
#define GAS __attribute__((address_space(1)))

constexpr size_t MiB = 1u << 20;
constexpr size_t WS_CTL = 0, CTL_ZERO_BYTES = 1 * MiB;
constexpr size_t WS_ROPE = 1 * MiB;
constexpr size_t WS_SS1 = 2 * MiB, WS_SS2 = 5 * MiB;
constexpr size_t WS_WIN = 8 * MiB, WS_WOUT = 11 * MiB, WS_WUP = 13 * MiB, WS_WDOWN = 21 * MiB, WS_WGATE = 29 * MiB, WS_WPROJ = 31 * MiB;
constexpr size_t WS_PP = 32 * MiB;
constexpr size_t WS_XN = 128 * MiB;
constexpr size_t WS_PB = 464 * MiB;
constexpr size_t WS_Q = 248 * MiB, WS_K = 296 * MiB, WS_V = 308 * MiB, WS_U = 320 * MiB;
constexpr size_t WS_MIX = 368 * MiB;
constexpr size_t WS_HM = 224 * MiB;
constexpr size_t WS_END = 488 * MiB;

constexpr int LDS_BYTES = 147456;
constexpr int NWAVES = 8;

__device__ __forceinline__ unsigned f2bf(float f) { unsigned u = __builtin_bit_cast(unsigned, f); return (u + 0x7fffu + ((u >> 16) & 1u)) >> 16; }
__device__ __forceinline__ unsigned pk2(float lo, float hi) { return f2bf(lo) | (f2bf(hi) << 16); }
__device__ __forceinline__ float bf2f(unsigned short b) { return __builtin_bit_cast(float, (unsigned)b << 16); }
__device__ __forceinline__ float bflo(unsigned w) { return __builtin_bit_cast(float, w << 16); }
__device__ __forceinline__ float bfhi(unsigned w) { return __builtin_bit_cast(float, w & 0xffff0000u); }
__device__ __forceinline__ float wave_sum(float v) {
#pragma unroll
    for (int o = 1; o < 64; o <<= 1) v += __shfl_xor(v, o);
    return v;
}
__host__ __device__ __forceinline__ int inv_head(int n) { const int pn = n >> 8, r = n & 255, wc = r >> 6, bj = (r >> 5) & 1, j = r & 31; return pn * 256 + bj * 128 + wc * 32 + j; }

struct Args { const float* in[18]; float* out; unsigned char* ws; int ph_lo, ph_hi; };

struct Frame {
    LAS unsigned char* lds;
    int tid, lane, wave, vcu, G;
    unsigned char* ws;
};
__device__ __forceinline__ const float* xrow(const Args& A, int m) { return m < MP ? A.in[0] + (size_t)m * DM : A.in[1] + (size_t)(m - MP) * DM; }
__device__ __forceinline__ const float* prow(const Args& A, int m) { return m < MP ? A.in[2] + (size_t)m * PLE : A.in[3] + (size_t)(m - MP) * PLE; }
__device__ __forceinline__ int tpos(int m) { return m < MP ? (m & (TP - 1)) : ((m - MP) & (TS - 1)); }

__device__ __forceinline__ void p0_transpose_item(const float* W, int ldw, int K, int ncols, bf16* WT, LAS float* scr, int item, int lane, const float* kscale, bool headmap) {
    const int nblk = ncols / 32, kb = item / nblk, nb = item % nblk, k0 = 64 * kb, n0 = 32 * nb;
#pragma unroll 8
    for (int i = 0; i < 32; ++i) { const int kk = 2 * i + (lane >> 5); float v = W[(size_t)(k0 + kk) * ldw + n0 + (lane & 31)]; if (kscale) v *= kscale[k0 + kk]; scr[kk * 33 + (lane & 31)] = v; }
    asm volatile("s_waitcnt lgkmcnt(0)" ::: "memory");
    const int c = lane & 7;
#pragma unroll
    for (int j = 0; j < 4; ++j) { const int n = (lane >> 3) + 8 * j; const LAS float* s = scr + (8 * c) * 33 + n;
        u32x4 o; o.x = pk2(s[0 * 33], s[1 * 33]); o.y = pk2(s[2 * 33], s[3 * 33]); o.z = pk2(s[4 * 33], s[5 * 33]); o.w = pk2(s[6 * 33], s[7 * 33]);
        const int dr = headmap ? inv_head(n0 + n) : (n0 + n);
        *(u32x4*)(WT + (size_t)dr * K + k0 + 8 * c) = o; }
    asm volatile("s_waitcnt lgkmcnt(0)" ::: "memory");
}
__device__ __forceinline__ void p0_fold_item(const float* Win, const float* Wp, const float* psc, bf16* WT, LAS float* scr, int item, int lane) {
    const int g = item & 3, k0 = (item >> 2) * 16;
#pragma unroll
    for (int i = 0; i < 32; ++i) { const int e = i * 64 + lane, kk = e >> 7, c = e & 127; scr[e] = Win[(size_t)(k0 + kk) * INW + 768 + 128 * g + c]; }
    asm volatile("s_waitcnt lgkmcnt(0)" ::: "memory");
    float a0[16], a1[16];
#pragma unroll
    for (int kk = 0; kk < 16; ++kk) { a0[kk] = 0.f; a1[kk] = 0.f; }
    const float* wp = Wp + (size_t)g * 128 * 128;
    for (int c = 0; c < 128; ++c) {
        const float w0 = wp[c * 128 + lane], w1 = wp[c * 128 + 64 + lane];
#pragma unroll
        for (int kk = 0; kk < 16; ++kk) { const float a = scr[kk * 128 + c]; a0[kk] += a * w0; a1[kk] += a * w1; }
    }
    const float s0 = psc[128 * g + lane], s1 = psc[128 * g + 64 + lane];
    { u32x4 o0, o1; o0.x = pk2(a0[0] * s0, a0[1] * s0); o0.y = pk2(a0[2] * s0, a0[3] * s0); o0.z = pk2(a0[4] * s0, a0[5] * s0); o0.w = pk2(a0[6] * s0, a0[7] * s0);
      o1.x = pk2(a0[8] * s0, a0[9] * s0); o1.y = pk2(a0[10] * s0, a0[11] * s0); o1.z = pk2(a0[12] * s0, a0[13] * s0); o1.w = pk2(a0[14] * s0, a0[15] * s0);
      bf16* d = WT + (size_t)inv_head(768 + 128 * g + lane) * DM + k0; *(u32x4*)d = o0; *(u32x4*)(d + 8) = o1; }
    { u32x4 o0, o1; o0.x = pk2(a1[0] * s1, a1[1] * s1); o0.y = pk2(a1[2] * s1, a1[3] * s1); o0.z = pk2(a1[4] * s1, a1[5] * s1); o0.w = pk2(a1[6] * s1, a1[7] * s1);
      o1.x = pk2(a1[8] * s1, a1[9] * s1); o1.y = pk2(a1[10] * s1, a1[11] * s1); o1.z = pk2(a1[12] * s1, a1[13] * s1); o1.w = pk2(a1[14] * s1, a1[15] * s1);
      bf16* d = WT + (size_t)inv_head(768 + 128 * g + 64 + lane) * DM + k0; *(u32x4*)d = o0; *(u32x4*)(d + 8) = o1; }
    asm volatile("s_waitcnt lgkmcnt(0)" ::: "memory");
}
__device__ __forceinline__ void rms_row_to_bf16(const float* xr_, const float* g, bf16* orow, int lane) {
    const f32x4* xr = (const f32x4*)xr_ + lane; const f32x4* gr = (const f32x4*)g + lane;
    f32x4 v[4]; float s = 0.f;
#pragma unroll
    for (int j = 0; j < 4; ++j) { v[j] = xr[64 * j]; s += (v[j].x * v[j].x + v[j].y * v[j].y) + (v[j].z * v[j].z + v[j].w * v[j].w); }
    const float rstd = 1.0f / sqrtf(wave_sum(s) * (1.f / DM) + EPS);
    unsigned long long* o8 = (unsigned long long*)orow + lane;
#pragma unroll
    for (int j = 0; j < 4; ++j) { const f32x4 gg = gr[64 * j];
        o8[64 * j] = (unsigned long long)pk2(v[j].x * rstd * gg.x, v[j].y * rstd * gg.y) | ((unsigned long long)pk2(v[j].z * rstd * gg.z, v[j].w * rstd * gg.w) << 32); }
}
__device__ __forceinline__ void p0_prologue(const Frame& F, const Args& A) {
    LAS float* scr = (LAS float*)(F.lds + F.wave * 16384);
    const int gw = F.vcu * NWAVES + F.wave, NGW = F.G * NWAVES;
    bf16* Bin = (bf16*)(F.ws + WS_WIN); bf16* Bout = (bf16*)(F.ws + WS_WOUT); bf16* Bup = (bf16*)(F.ws + WS_WUP);
    bf16* Bdown = (bf16*)(F.ws + WS_WDOWN); bf16* Bgate = (bf16*)(F.ws + WS_WGATE); bf16* Bproj = (bf16*)(F.ws + WS_WPROJ);
    constexpr int I_FOLD = 64 * 4, I_IN = (DM / 64) * (768 / 32), I_OUT = (DM / 64) * (DM / 32), I_UP = (DM / 64) * (DFF / 32), I_DOWN = (DFF / 64) * (DM / 32), I_GATE = I_OUT, I_PROJ = (PLE / 64) * (DM / 32);
    constexpr int NITEMS = I_FOLD + I_IN + I_OUT + I_UP + I_DOWN + I_GATE + I_PROJ;
    for (int it = gw; it < NITEMS; it += NGW) {
        int r = it;
        if (r < I_FOLD) { p0_fold_item(A.in[5], A.in[8], A.in[9], Bin, scr, r, F.lane); continue; } r -= I_FOLD;
        if (r < I_IN) { p0_transpose_item(A.in[5], INW, DM, 768, Bin, scr, r, F.lane, nullptr, true); continue; } r -= I_IN;
        if (r < I_OUT) { p0_transpose_item(A.in[10], DM, DM, DM, Bout, scr, r, F.lane, nullptr, true); continue; } r -= I_OUT;
        if (r < I_UP) { p0_transpose_item(A.in[12], DFF, DM, DFF, Bup, scr, r, F.lane, A.in[11], true); continue; } r -= I_UP;
        if (r < I_DOWN) { p0_transpose_item(A.in[13], DM, DFF, DM, Bdown, scr, r, F.lane, nullptr, true); continue; } r -= I_DOWN;
        if (r < I_GATE) { p0_transpose_item(A.in[15], DM, DM, DM, Bgate, scr, r, F.lane, A.in[14], true); continue; } r -= I_GATE;
        p0_transpose_item(A.in[16], DM, PLE, DM, Bproj, scr, r, F.lane, nullptr, true);
    }
    bf16* XN = (bf16*)(F.ws + WS_XN); bf16* PB = (bf16*)(F.ws + WS_PB);
    for (int m = gw; m < M; m += 2 * NGW) {
        const int m1 = m + NGW;
        const f32x4* x0 = (const f32x4*)xrow(A, m) + F.lane; const f32x4* x1 = (const f32x4*)xrow(A, m1) + F.lane; const f32x4* gr = (const f32x4*)A.in[4] + F.lane;
        f32x4 v0[4], v1[4];
#pragma unroll
        for (int j = 0; j < 4; ++j) { v0[j] = x0[64 * j]; v1[j] = x1[64 * j]; }
        const f32x4 pv0 = *((const f32x4*)prow(A, m) + F.lane), pv1 = *((const f32x4*)prow(A, m1) + F.lane);
        float s0 = 0.f, s1 = 0.f;
#pragma unroll
        for (int j = 0; j < 4; ++j) { s0 += (v0[j].x * v0[j].x + v0[j].y * v0[j].y) + (v0[j].z * v0[j].z + v0[j].w * v0[j].w); s1 += (v1[j].x * v1[j].x + v1[j].y * v1[j].y) + (v1[j].z * v1[j].z + v1[j].w * v1[j].w); }
        const float r0 = 1.0f / sqrtf(wave_sum(s0) * (1.f / DM) + EPS), r1 = 1.0f / sqrtf(wave_sum(s1) * (1.f / DM) + EPS);
        unsigned long long* o0 = (unsigned long long*)(XN + (size_t)m * DM) + F.lane; unsigned long long* o1 = (unsigned long long*)(XN + (size_t)m1 * DM) + F.lane;
#pragma unroll
        for (int j = 0; j < 4; ++j) { const f32x4 gg = gr[64 * j];
            o0[64 * j] = (unsigned long long)pk2(v0[j].x * r0 * gg.x, v0[j].y * r0 * gg.y) | ((unsigned long long)pk2(v0[j].z * r0 * gg.z, v0[j].w * r0 * gg.w) << 32);
            o1[64 * j] = (unsigned long long)pk2(v1[j].x * r1 * gg.x, v1[j].y * r1 * gg.y) | ((unsigned long long)pk2(v1[j].z * r1 * gg.z, v1[j].w * r1 * gg.w) << 32); }
        *((unsigned long long*)(PB + (size_t)m * PLE) + F.lane) = (unsigned long long)pk2(pv0.x, pv0.y) | ((unsigned long long)pk2(pv0.z, pv0.w) << 32);
        *((unsigned long long*)(PB + (size_t)m1 * PLE) + F.lane) = (unsigned long long)pk2(pv1.x, pv1.y) | ((unsigned long long)pk2(pv1.z, pv1.w) << 32);
    }
    { const int gt = F.vcu * 512 + F.tid;
      if (gt < 2048) { const int p = gt >> 4, i = gt & 15; const float inv = exp2f(-(float)i * (13.287712379549449f / 16.0f)); const float a = (float)p * inv;
          float2* R = (float2*)(F.ws + WS_ROPE); R[gt] = make_float2(cosf(a), sinf(a)); } }
}

namespace pg8 {
#define PG8_LAS __attribute__((address_space(3)))
typedef unsigned short bf16_t;
typedef short bf16x8 __attribute__((ext_vector_type(8)));
typedef float f32x4 __attribute__((ext_vector_type(4)));
typedef unsigned u32x4 __attribute__((ext_vector_type(4)));
constexpr int BM = 256, BK = 64, HALF = 128, HTB = HALF * BK * 2  , STAGE_BYTES = 8 * HTB, NXCD = 8, WGM = 8;

__host__ __device__ __forceinline__ int lds_byte(int r, int c) { const int st = (r >> 4) * 2 + (c >> 5), rr = r & 15, cc = c & 31, ob = rr * 64 + cc * 2; return st * 1024 + (ob ^ (((ob >> 9) & 1) << 5)); }
__host__ __device__ __forceinline__ void stage_rc(int b, int& R, int& C) { const int st = b / 1024, sb = b % 1024, swz = sb ^ (((sb >> 9) & 1) << 5); R = (st >> 1) * 16 + swz / 64; C = (st & 1) * 32 + (swz % 64) / 2; }
__host__ __device__ __forceinline__ int perm32(int rho) { const int n = rho >> 4, i = rho & 15; return 8 * (i >> 2) + 4 * n + (i & 3); }

struct Unit { int pm, pn; };
struct Gemm { const bf16_t* A; const bf16_t* Bt; int M, N, K; };

struct StaticOrder {
    int nM, nN, nwg, G, c;
    __host__ __device__ void init(int M, int N, int G_, int c_) { nM = M / BM; nN = N / BM; nwg = nM * nN; G = G_; c = c_; }
    __host__ __device__ bool next(int i, Unit& u) const {
        const long L = (long)i * G + c; if (L >= nwg) return false;
        int wgid = (int)L; { const int q = nwg / NXCD, r = nwg % NXCD, xcd = wgid % NXCD, off = wgid / NXCD; wgid = (xcd < r ? xcd * (q + 1) : r * (q + 1) + (xcd - r) * q) + off; }
        const int nig = WGM * nN, gid = wgid / nig, fm = gid * WGM, gsz = (nM - fm) < WGM ? (nM - fm) : WGM;
        u.pm = fm + ((wgid % nig) % gsz); u.pn = (wgid % nig) / gsz; return true;
    }
    __device__ __forceinline__ void a_ready(const Unit&) const {}
    __device__ __forceinline__ void done(const Unit&) const {}
};

template <class E, bool PERMV = false> struct EpiAdapt {
    static constexpr bool PERM = PERMV, AFTER_DRAIN = false;
    E e; int row0;
    __device__ __forceinline__ void operator()(f32x4 (&acc)[2][2][4][2], const Unit& u, int wr, int wc, int fr, int fq) const {
        const int c0 = u.pn * BM + wc * 64;
#pragma unroll
        for (int ai = 0; ai < 2; ++ai)
#pragma unroll
            for (int m = 0; m < 4; ++m) {
                ::f32x4 v[4] = {acc[ai][0][m][0], acc[ai][0][m][1], acc[ai][1][m][0], acc[ai][1][m][1]};
                e.seg64(row0 + u.pm * BM + ai * HALF + wr * 64 + m * 16 + fr, c0, v, fq);
                if (m & 1) asm volatile("" ::: "memory");
            }
    }
};
template <class Epi, class Sched, bool ALIGN_EPI = false, bool SP2 = false>
__device__ __forceinline__ void gemm_phase(PG8_LAS unsigned char* lds, const Gemm g, const Sched& S, const Epi& E) {
    int tid_ = threadIdx.x; asm volatile("" : "+v"(tid_));
    const int tid = tid_, wid = __builtin_amdgcn_readfirstlane(tid >> 6), lane = tid & 63, wr = wid >> 2, wc = wid & 3, fr = lane & 15, fq = lane >> 4;
    const int K = g.K, nt = K / BK;
    unsigned voffA[2], voffB[2];
#pragma unroll
    for (int i = 0; i < 2; ++i) { int R, C; stage_rc(tid * 16 + i * 8192, R, C); const int Rb = Epi::PERM ? ((R & ~31) + perm32(R & 31)) : R;
        voffA[i] = (unsigned)(R * K + C) * 2u; voffB[i] = (unsigned)(Rb * K + C) * 2u; }
    const size_t kstep = (size_t)(BK * 2);
    const size_t hstep = (size_t)HALF * K * 2;
    const size_t tstep = 2 * hstep;
    const unsigned ldsw = (unsigned)wid * 1024u;
    const int aoff = lds_byte(wr * 64 + fr, fq * 8), boff = lds_byte(wc * 32 + fr, fq * 8);
#define PG8_SA(b, h) (((b) * 2 + (h)) * HTB)
#define PG8_SB(b, h) ((4 + (b) * 2 + (h)) * HTB)
#define PG8_STAGE(bufoff, gbase, voff) do { _Pragma("unroll") for (int _i = 0; _i < 2; ++_i) { unsigned _vo = (voff)[_i]; asm volatile("" : "+v"(_vo)); \
        __builtin_amdgcn_global_load_lds((const unsigned*)((const char*)(gbase) + _vo), (PG8_LAS unsigned*)(lds + (bufoff) + ldsw + _i * 8192), 16, 0, 0); } } while (0)
#define PG8_LDA(dst, b, h) do { _Pragma("unroll") for (int m = 0; m < 4; ++m) _Pragma("unroll") for (int k = 0; k < 2; ++k) dst[m][k] = *(const PG8_LAS bf16x8*)(lds + PG8_SA(b, h) + aoff + m * 2048 + k * 1024); } while (0)
#define PG8_LDB(dst, b, h) do { _Pragma("unroll") for (int n = 0; n < 2; ++n) _Pragma("unroll") for (int k = 0; k < 2; ++k) dst[n][k] = *(const PG8_LAS bf16x8*)(lds + PG8_SB(b, h) + boff + n * 2048 + k * 1024); } while (0)
#define PG8_MMA(ai, bj, At, Bt) do { __builtin_amdgcn_s_setprio(1); _Pragma("unroll") for (int m = 0; m < 4; ++m) _Pragma("unroll") for (int n = 0; n < 2; ++n) _Pragma("unroll") for (int k = 0; k < 2; ++k) \
        acc[ai][bj][m][n] = __builtin_amdgcn_mfma_f32_16x16x32_bf16(Bt[n][k], At[m][k], acc[ai][bj][m][n], 0, 0, 0); __builtin_amdgcn_s_setprio(0); } while (0)
#define PG8_WAIT_V(n) asm volatile("s_waitcnt vmcnt(" #n ")" ::: "memory")
#define PG8_WAIT_L(n) asm volatile("s_waitcnt lgkmcnt(" #n ")" ::: "memory")
#define PG8_BAR __builtin_amdgcn_s_barrier()
#define PG8_SCHED __builtin_amdgcn_sched_barrier(0)
    Unit cur, nxt; int ui = 0;
    if (!S.next(0, cur)) return;
    f32x4 acc[2][2][4][2];
#pragma unroll
    for (int a = 0; a < 2; ++a)
#pragma unroll
        for (int b = 0; b < 2; ++b)
#pragma unroll
            for (int m = 0; m < 4; ++m)
#pragma unroll
                for (int n = 0; n < 2; ++n) acc[a][b][m][n] = (f32x4){0.f, 0.f, 0.f, 0.f};
    bf16x8 At[4][2], B0[2][2], B1[2][2];
    const char* cA = (const char*)g.A + (size_t)cur.pm * tstep; const char* cB = (const char*)g.Bt + (size_t)cur.pn * tstep;
    S.a_ready(cur);
    if constexpr (SP2) {
        PG8_STAGE(PG8_SB(0, 0), cB, voffB); PG8_STAGE(PG8_SB(0, 1), cB + hstep, voffB); PG8_STAGE(PG8_SA(0, 0), cA, voffA); PG8_STAGE(PG8_SA(0, 1), cA + hstep, voffA);
        if (wr == 1) PG8_BAR;
        PG8_WAIT_V(2); PG8_BAR;
        PG8_STAGE(PG8_SB(1, 0), cB + kstep, voffB); PG8_STAGE(PG8_SA(1, 0), cA + kstep, voffA); PG8_STAGE(PG8_SB(1, 1), cB + hstep + kstep, voffB);
        PG8_WAIT_V(6); PG8_BAR;
    } else {
        PG8_STAGE(PG8_SB(0, 0), cB, voffB); PG8_STAGE(PG8_SA(0, 0), cA, voffA); PG8_STAGE(PG8_SB(0, 1), cB + hstep, voffB); PG8_STAGE(PG8_SA(0, 1), cA + hstep, voffA);
        if (wr == 1) PG8_BAR;
        PG8_WAIT_V(4); PG8_BAR;
        PG8_STAGE(PG8_SB(1, 0), cB + kstep, voffB); PG8_STAGE(PG8_SA(1, 0), cA + kstep, voffA); PG8_STAGE(PG8_SB(1, 1), cB + hstep + kstep, voffB);
        PG8_WAIT_V(6); PG8_BAR;
    }
    for (;;) {
        const bool has_next = S.next(ui + 1, nxt);
        const char* nA = has_next ? (const char*)g.A + (size_t)nxt.pm * tstep : cA; const char* nB = has_next ? (const char*)g.Bt + (size_t)nxt.pn * tstep : cB;
        for (int t = 0; t < nt; t += 2) {
            const bool last = (t == nt - 2);
            const char* a1 = cA + (size_t)(t + 1) * kstep;
            const char* a2 = last ? nA : cA + (size_t)(t + 2) * kstep; const char* b2 = last ? nB : cB + (size_t)(t + 2) * kstep;
            const char* a3 = a2 + kstep; const char* b3 = b2 + kstep;
            if (last && has_next) S.a_ready(nxt);
            if constexpr (SP2) {
            PG8_LDB(B0, 0, 0); PG8_LDB(B1, 0, 1); PG8_SCHED; PG8_LDA(At, 0, 0); PG8_STAGE(PG8_SA(1, 1), a1 + hstep, voffA);
            PG8_WAIT_V(8); PG8_WAIT_L(0); PG8_BAR; PG8_MMA(0, 0, At, B0); PG8_MMA(0, 1, At, B1); PG8_BAR; PG8_SCHED;
            PG8_LDA(At, 0, 1); PG8_STAGE(PG8_SB(0, 0), b2, voffB); PG8_STAGE(PG8_SB(0, 1), b2 + hstep, voffB); PG8_STAGE(PG8_SA(0, 0), a2, voffA);
            PG8_WAIT_V(8); PG8_WAIT_L(0); PG8_BAR; PG8_MMA(1, 0, At, B0); PG8_MMA(1, 1, At, B1); PG8_BAR; PG8_SCHED;
            PG8_LDB(B0, 1, 0); PG8_LDB(B1, 1, 1); PG8_SCHED; PG8_LDA(At, 1, 0); PG8_STAGE(PG8_SA(0, 1), a2 + hstep, voffA);
            PG8_WAIT_V(8); PG8_WAIT_L(0); PG8_BAR; PG8_MMA(0, 0, At, B0); PG8_MMA(0, 1, At, B1); PG8_BAR; PG8_SCHED;
            PG8_LDA(At, 1, 1); PG8_STAGE(PG8_SB(1, 0), b3, voffB); PG8_STAGE(PG8_SB(1, 1), b3 + hstep, voffB); PG8_STAGE(PG8_SA(1, 0), a3, voffA);
            PG8_WAIT_V(8); PG8_WAIT_L(0); PG8_BAR; PG8_MMA(1, 0, At, B0); PG8_MMA(1, 1, At, B1); PG8_BAR; PG8_SCHED;
            } else {
            PG8_LDB(B0, 0, 0); PG8_SCHED; PG8_LDA(At, 0, 0); PG8_STAGE(PG8_SA(1, 1), a1 + hstep, voffA);
            PG8_WAIT_L(8); PG8_BAR; PG8_WAIT_L(0); PG8_MMA(0, 0, At, B0); PG8_BAR; PG8_SCHED;
            PG8_LDB(B1, 0, 1); PG8_STAGE(PG8_SB(0, 0), b2, voffB);
            PG8_BAR; PG8_WAIT_L(0); PG8_MMA(0, 1, At, B1); PG8_BAR;
            PG8_LDA(At, 0, 1); PG8_STAGE(PG8_SA(0, 0), a2, voffA);
            PG8_BAR; PG8_WAIT_L(0); PG8_MMA(1, 0, At, B0); PG8_BAR; PG8_SCHED;
            PG8_STAGE(PG8_SB(0, 1), b2 + hstep, voffB);
            PG8_WAIT_V(6); PG8_BAR; PG8_MMA(1, 1, At, B1); PG8_BAR;
            PG8_LDB(B0, 1, 0); PG8_SCHED; PG8_LDA(At, 1, 0); PG8_STAGE(PG8_SA(0, 1), a2 + hstep, voffA);
            PG8_WAIT_L(8); PG8_BAR; PG8_WAIT_L(0); PG8_MMA(0, 0, At, B0); PG8_BAR; PG8_SCHED;
            PG8_LDB(B1, 1, 1); PG8_STAGE(PG8_SB(1, 0), b3, voffB);
            PG8_BAR; PG8_WAIT_L(0); PG8_MMA(0, 1, At, B1); PG8_BAR;
            PG8_LDA(At, 1, 1); PG8_STAGE(PG8_SA(1, 0), a3, voffA);
            PG8_BAR; PG8_WAIT_L(0); PG8_MMA(1, 0, At, B0); PG8_BAR; PG8_SCHED;
            PG8_STAGE(PG8_SB(1, 1), b3 + hstep, voffB);
            PG8_WAIT_V(6); PG8_BAR; PG8_MMA(1, 1, At, B1); PG8_BAR;
            }
        }
        if constexpr (ALIGN_EPI) { if (wr == 0) PG8_BAR; }
        if constexpr (!Epi::AFTER_DRAIN) { E(acc, cur, wr, wc, fr, fq); S.done(cur); }
        if (!has_next) break;
#pragma unroll
        for (int a = 0; a < 2; ++a)
#pragma unroll
            for (int b = 0; b < 2; ++b)
#pragma unroll
                for (int m = 0; m < 4; ++m)
#pragma unroll
                    for (int n = 0; n < 2; ++n) acc[a][b][m][n] = (f32x4){0.f, 0.f, 0.f, 0.f};
        cur = nxt; cA = nA; cB = nB; ++ui;
        if constexpr (ALIGN_EPI) { if (wr == 1) PG8_BAR; }
    }
    PG8_WAIT_V(0);
    if constexpr (!ALIGN_EPI) { if (wr == 0) PG8_BAR; }
    PG8_BAR;
    if constexpr (Epi::AFTER_DRAIN) { E.fused(acc, cur, wr, wc, fr, fq, lds, wid, lane); S.done(cur); }
#undef PG8_SA
#undef PG8_SB
#undef PG8_STAGE
#undef PG8_LDA
#undef PG8_LDB
#undef PG8_MMA
#undef PG8_WAIT_V
#undef PG8_WAIT_L
#undef PG8_BAR
#undef PG8_SCHED
}
}

template <class Epi>
__device__ __forceinline__ void sgemm(const bf16* A, int lda, int a_row_sub, const bf16* Bt, int K, int row0, int nrows, int N, bool headmap, const Epi& E, const Frame& F) {
    const int nN = N / 64, nU = (nrows / 256) * nN, fr = F.lane & 15, fq = F.lane >> 4;
    for (int u = F.vcu; u < nU; u += F.G) {
        const int pm = u / nN, pn = u % nN, r0 = row0 + pm * 256 + F.wave * 32, c0 = pn * 64;
        f32x4 acc[2][4];
#pragma unroll
        for (int a = 0; a < 2; ++a)
#pragma unroll
            for (int b = 0; b < 4; ++b) acc[a][b] = (f32x4){0.f, 0.f, 0.f, 0.f};
        const bf16* ap0 = A + (size_t)(r0 - a_row_sub + fr) * lda + 8 * fq; const bf16* ap1 = ap0 + (size_t)16 * lda;
        const bf16* bp[4];
#pragma unroll
        for (int nt = 0; nt < 4; ++nt) { const int n = c0 + 16 * nt + fr; bp[nt] = Bt + (size_t)(headmap ? inv_head(n) : n) * K + 8 * fq; }
        for (int k0 = 0; k0 < K; k0 += 32) {
            const bf16x8 a0 = *(const bf16x8*)(ap0 + k0), a1 = *(const bf16x8*)(ap1 + k0);
            bf16x8 b[4];
#pragma unroll
            for (int nt = 0; nt < 4; ++nt) b[nt] = *(const bf16x8*)(bp[nt] + k0);
#pragma unroll
            for (int nt = 0; nt < 4; ++nt) { acc[0][nt] = __builtin_amdgcn_mfma_f32_16x16x32_bf16(b[nt], a0, acc[0][nt], 0, 0, 0); acc[1][nt] = __builtin_amdgcn_mfma_f32_16x16x32_bf16(b[nt], a1, acc[1][nt], 0, 0, 0); }
        }
        E.seg64(r0 + fr, c0, acc[0], fq); E.seg64(r0 + 16 + fr, c0, acc[1], fq);
    }
}

typedef float f32x2_k __attribute__((ext_vector_type(2))); typedef __bf16 bf16x2_k __attribute__((ext_vector_type(2)));
__device__ __forceinline__ unsigned cvtpk(float lo, float hi) { f32x2_k v = {lo, hi}; bf16x2_k b = __builtin_convertvector(v, bf16x2_k); return __builtin_bit_cast(unsigned, b); }
__device__ __forceinline__ void st_bf16x4(bf16* p, f32x4 v) { u32x2 w; w.x = cvtpk(v[0], v[1]); w.y = cvtpk(v[2], v[3]); *(u32x2*)p = w; }
__device__ __forceinline__ void st_bf16x8(bf16* p, f32x4 a, f32x4 b) { u32x4 w; w.x = cvtpk(a[0], a[1]); w.y = cvtpk(a[2], a[3]); w.z = cvtpk(b[0], b[1]); w.w = cvtpk(b[2], b[3]); *(u32x4*)p = w; }
__device__ __forceinline__ void ld_bf16x8(const bf16* p, f32x4& a, f32x4& b) { const u32x4 w = *(const u32x4*)p; a = (f32x4){bflo(w.x), bfhi(w.x), bflo(w.y), bfhi(w.y)}; b = (f32x4){bflo(w.z), bfhi(w.z), bflo(w.w), bfhi(w.w)}; }
__device__ __forceinline__ float quad_sum(float s) { s += __shfl_xor(s, 16); s += __shfl_xor(s, 32); return s; }
__device__ __forceinline__ float rstd_from_ss(const float* ss16) {
    const f32x4* p = (const f32x4*)ss16; const f32x4 a = p[0], b = p[1], c = p[2], d = p[3];
    const float s = ((a.x + a.y) + (a.z + a.w)) + ((b.x + b.y) + (b.z + b.w)) + ((c.x + c.y) + (c.z + c.w)) + ((d.x + d.y) + (d.z + d.w));
    return 1.0f / sqrtf(s * (1.f / DM) + EPS);
}

struct EpiIn {
    bf16 *Q, *K, *V, *U; const float *qg, *kg; const float2* rope;
    __device__ __forceinline__ void seg64(int m, int c0, f32x4 (&v)[4], int fq) const {
        if (c0 < 640) {
            const bool isq = c0 < 512;
            float ss = 0.f;
#pragma unroll
            for (int nt = 0; nt < 4; ++nt) ss += (v[nt][0] * v[nt][0] + v[nt][1] * v[nt][1]) + (v[nt][2] * v[nt][2] + v[nt][3] * v[nt][3]);
            ss = quad_sum(ss);
            const float rstd = 1.0f / sqrtf(ss * (1.f / 64.f) + EPS);
            const float* g = isq ? qg : kg;
#pragma unroll
            for (int nt = 0; nt < 4; ++nt) { const f32x4 gg = *(const f32x4*)(g + 16 * nt + 4 * fq); v[nt] = v[nt] * rstd * gg; }
            const int t = tpos(m), pr = t >> 6, pc = t & 63;
            const float sc = isq ? C2 : 1.0f;
            f32x4 o[4];
#pragma unroll
            for (int j = 0; j < 4; ++j) {
                const float2 cr = rope[pr * 16 + 4 * fq + j], cc = rope[pc * 16 + 4 * fq + j];
                o[0][j] = (v[0][j] * cr.x - v[1][j] * cr.y) * sc; o[1][j] = (v[1][j] * cr.x + v[0][j] * cr.y) * sc;
                o[2][j] = (v[2][j] * cc.x - v[3][j] * cc.y) * sc; o[3][j] = (v[3][j] * cc.x + v[2][j] * cc.y) * sc;
            }
            bf16* dst = isq ? Q + (size_t)m * 512 + c0 : K + (size_t)m * 128 + (c0 - 512);
#pragma unroll
            for (int nt = 0; nt < 4; ++nt) st_bf16x4(dst + 16 * nt + 4 * fq, o[nt]);
        } else {
            bf16* dst = c0 < 768 ? V + (size_t)m * 128 + (c0 - 640) : U + (size_t)m * 512 + (c0 - 768);
#pragma unroll
            for (int nt = 0; nt < 4; ++nt) st_bf16x4(dst + 16 * nt + 4 * fq, v[nt]);
        }
    }
};
struct EpiBf {
    bf16* O; int ld;
    __device__ __forceinline__ void seg64(int m, int c0, f32x4 (&v)[4], int fq) const {
#pragma unroll
        for (int nt = 0; nt < 4; ++nt) st_bf16x4(O + (size_t)m * ld + c0 + 16 * nt + 4 * fq, v[nt]);
    }
};
struct EpiRes {
    const float* base0; const float* base1; float* out; bf16* HB; float* SS;
    __device__ __forceinline__ void seg64(int m, int c0, f32x4 (&v)[4], int fq) const {
        const float* b = (m < MP ? base0 + (size_t)m * DM : base1 + (size_t)(m - MP) * DM) + c0 + 4 * fq;
        float* o = out + (size_t)m * DM + c0 + 4 * fq; bf16* hb = HB + (size_t)m * DM + c0 + 4 * fq; float ss = 0.f;
#pragma unroll
        for (int nt = 0; nt < 4; ++nt) { const f32x4 h = *(const f32x4*)(b + 16 * nt) + v[nt]; *(f32x4*)(o + 16 * nt) = h; st_bf16x4(hb + 16 * nt, h);
            ss += (h[0] * h[0] + h[1] * h[1]) + (h[2] * h[2] + h[3] * h[3]); }
        ss = quad_sum(ss);
        if (fq == 0) SS[(size_t)m * 16 + (c0 >> 6)] = ss;
    }
};
constexpr int RSTD_OFF = 131072 + 1024;
struct EpiUp {
    bf16* HM; const LAS float* rs; int row0;
    __device__ __forceinline__ void seg64(int m, int c0, f32x4 (&v)[4], int fq) const {
        const float rstd = rs[m - row0];
        bf16* d = HM + (size_t)(m - row0) * DFF + c0 + 4 * fq;
#pragma unroll
        for (int nt = 0; nt < 4; ++nt) { f32x4 a = v[nt] * rstd;
#pragma unroll
            for (int j = 0; j < 4; ++j) { const float r = fmaxf(a[j], 0.f); a[j] = r * r; }
            st_bf16x4(d + 16 * nt, a); }
    }
};
__device__ __forceinline__ void rstd_table(const Frame& F, const float* SS, int row0) {
    if (F.tid < 256) ((LAS float*)(F.lds + RSTD_OFF))[F.tid] = rstd_from_ss(SS + (size_t)(row0 + F.tid) * 16);
    __syncthreads();
}
struct EpiGate {
    const float* out; float* dst; const bf16* PP; const float* SS;
    __device__ __forceinline__ void seg64(int m, int c0, f32x4 (&v)[4], int fq) const {
        const float rstd = rstd_from_ss(SS + (size_t)m * 16);
        const float* o = out + (size_t)m * DM + c0 + 4 * fq; float* d = dst + (size_t)m * DM + c0 + 4 * fq; const bf16* pp = PP + (size_t)m * DM + c0 + 4 * fq;
#pragma unroll
        for (int nt = 0; nt < 4; ++nt) { const u32x2 w = *(const u32x2*)(pp + 16 * nt); f32x4 h = *(const f32x4*)(o + 16 * nt);
            const float p0 = bflo(w.x), p1 = bfhi(w.x), p2 = bflo(w.y), p3 = bfhi(w.y);
            h[0] += p0 / (1.0f + __expf(-v[nt][0] * rstd)); h[1] += p1 / (1.0f + __expf(-v[nt][1] * rstd));
            h[2] += p2 / (1.0f + __expf(-v[nt][2] * rstd)); h[3] += p3 / (1.0f + __expf(-v[nt][3] * rstd));
            *(f32x4*)(d + 16 * nt) = h; }
    }
};

namespace attn_body {
using bf16=__hip_bfloat16;
using bf16x8=__attribute__((ext_vector_type(8)))short;
using s16x4=__attribute__((ext_vector_type(4)))short;
using f32x16=__attribute__((ext_vector_type(16)))float;
using u32x4=__attribute__((ext_vector_type(4)))unsigned;
constexpr int D=64,QP=512,KP=128,OP=1024;
constexpr int NW=8,QBLK=32,QB=QBLK*NW,KVBLK=64;
constexpr int ATTN_UNIT_ROWS=QB;
__device__ __forceinline__ int crow(int r,int hi){return (r&3)+8*(r>>2)+4*hi;}
#define SBAR() __builtin_amdgcn_sched_barrier(0)

constexpr int NSLOT=3, SLOTB=8192;
constexpr int LDS_K=0, LDS_V=NSLOT*SLOTB, LDS_WS=2*NSLOT*SLOTB, LDS_OST=LDS_WS+NW*64*4, LDS_BYTES=LDS_OST+NW*4096;
constexpr float C2=0.125f*1.4426950408889634f;
__device__ __forceinline__ void glds16(const void*gsrc,unsigned lds_dst){unsigned keep;
  asm volatile("s_mov_b32 %0, m0\n\ts_mov_b32 m0, %2\n\ts_nop 0\n\tglobal_load_lds_dwordx4 %1, off\n\ts_mov_b32 m0, %0":"=&s"(keep):"v"(gsrc),"s"(lds_dst):"memory");}
__device__ __forceinline__ float max3f(float a,float b,float c){float r;asm("v_max3_f32 %0, %1, %2, %3":"=v"(r):"v"(a),"v"(b),"v"(c));return r;}
__device__ __forceinline__ float max2f(float a,float b){float r;asm("v_max_f32_e32 %0, %1, %2":"=v"(r):"v"(a),"v"(b));return r;}
__device__ __forceinline__ float fadd_s(float a,float b){float r;asm("v_add_f32_e32 %0, %1, %2":"=v"(r):"v"(a),"v"(b));return r;}
__device__ __forceinline__ float fsub_s(float a,float b){float r;asm("v_sub_f32_e32 %0, %1, %2":"=v"(r):"v"(a),"v"(b));return r;}
typedef float f32x2_t __attribute__((ext_vector_type(2))); typedef __bf16 bf16x2_t __attribute__((ext_vector_type(2)));
__device__ __forceinline__ unsigned cvtpk_s(float lo,float hi){f32x2_t v={lo,hi};bf16x2_t b=__builtin_convertvector(v,bf16x2_t);return __builtin_bit_cast(unsigned,b);}
#define WAIT_BAR(N) asm volatile("s_waitcnt vmcnt(" #N ") lgkmcnt(0)\n\ts_barrier":::"memory")

__device__ __forceinline__ void qkt(f32x16&p0,f32x16&p1,const char*Kslot,const bf16x8*qr,const f32x16&negm,int r32,int hi){
  const char*kb=Kslot+hi*1024+r32*16;
  #pragma unroll
  for(int d0=0;d0<4;++d0){
    const bf16x8 b0=*reinterpret_cast<const bf16x8*>(kb+d0*2048);
    const bf16x8 b1=*reinterpret_cast<const bf16x8*>(kb+d0*2048+512);
    if(d0==0){p0=__builtin_amdgcn_mfma_f32_32x32x16_bf16(b0,qr[0],negm,0,0,0);p1=__builtin_amdgcn_mfma_f32_32x32x16_bf16(b1,qr[0],negm,0,0,0);}
    else{p0=__builtin_amdgcn_mfma_f32_32x32x16_bf16(b0,qr[d0],p0,0,0,0);p1=__builtin_amdgcn_mfma_f32_32x32x16_bf16(b1,qr[d0],p1,0,0,0);}}
}
typedef __attribute__((address_space(3))) const char* lds_cptr;
typedef short v4i16_t __attribute__((ext_vector_type(4)));
__device__ __forceinline__ void kload8(bf16x8*kf,lds_cptr kp){
  kf[0]=*(const __attribute__((address_space(3))) bf16x8*)(kp);      kf[1]=*(const __attribute__((address_space(3))) bf16x8*)(kp+512);
  kf[2]=*(const __attribute__((address_space(3))) bf16x8*)(kp+2048); kf[3]=*(const __attribute__((address_space(3))) bf16x8*)(kp+2560);
  kf[4]=*(const __attribute__((address_space(3))) bf16x8*)(kp+4096); kf[5]=*(const __attribute__((address_space(3))) bf16x8*)(kp+4608);
  kf[6]=*(const __attribute__((address_space(3))) bf16x8*)(kp+6144); kf[7]=*(const __attribute__((address_space(3))) bf16x8*)(kp+6656);
}
__device__ __forceinline__ void kload2(bf16x8*kf,lds_cptr kp,int j){ kf[2*j]=*(const __attribute__((address_space(3))) bf16x8*)(kp+j*2048); kf[2*j+1]=*(const __attribute__((address_space(3))) bf16x8*)(kp+j*2048+512); }
__device__ __forceinline__ s16x4 vtr(lds_cptr p){ return __builtin_bit_cast(s16x4,__builtin_amdgcn_ds_read_tr16_b64_v4i16((__attribute__((address_space(3))) v4i16_t*)p)); }
__device__ __forceinline__ float rowmax(const f32x16&p0,const f32x16&p1){
  float a=max3f(p0[0],p0[1],p1[0]),b=max3f(p0[2],p0[3],p1[1]);a=max3f(a,p1[2],p1[3]);
  #pragma unroll
  for(int r=4;r<16;r+=4){a=max3f(a,p0[r],p0[r+1]);b=max3f(b,p0[r+2],p0[r+3]);a=max3f(a,p1[r],p1[r+1]);b=max3f(b,p1[r+2],p1[r+3]);}
  const float m=max2f(a,b);
  auto rr=__builtin_amdgcn_permlane32_swap(__float_as_uint(m),__float_as_uint(m),false,false);
  return max2f(__uint_as_float(rr[0]),__uint_as_float(rr[1]));
}
__device__ __forceinline__ void pv(f32x16*o,int vb,bf16x8 pa0,bf16x8 pa1,bf16x8 pa2,bf16x8 pa3){
  #pragma unroll
  for(int d0=0;d0<2;++d0){s16x4 lo[4],hi[4];
    #pragma unroll
    for(int ks=0;ks<4;++ks){
      asm volatile("ds_read_b64_tr_b16 %0,%1 offset:%c2":"=&v"(lo[ks]):"v"(vb),"i"(d0*4096+ks*1024):"memory");
      asm volatile("ds_read_b64_tr_b16 %0,%1 offset:%c2":"=&v"(hi[ks]):"v"(vb),"i"(d0*4096+ks*1024+512):"memory");}
    asm volatile("s_waitcnt lgkmcnt(0)":::"memory");SBAR();
    #define PK(k) (bf16x8){lo[k][0],lo[k][1],lo[k][2],lo[k][3],hi[k][0],hi[k][1],hi[k][2],hi[k][3]}
    o[d0]=__builtin_amdgcn_mfma_f32_32x32x16_bf16(pa0,PK(0),o[d0],0,0,0);
    o[d0]=__builtin_amdgcn_mfma_f32_32x32x16_bf16(pa1,PK(1),o[d0],0,0,0);
    o[d0]=__builtin_amdgcn_mfma_f32_32x32x16_bf16(pa2,PK(2),o[d0],0,0,0);
    o[d0]=__builtin_amdgcn_mfma_f32_32x32x16_bf16(pa3,PK(3),o[d0],0,0,0);
    #undef PK
  }
}

#ifndef ATTN_STORE16
#define ATTN_STORE16(p,v) (*(u32x4*)(p)=(v))
#endif
template<int THRL> __device__ __forceinline__ void attn_unit(int rowbase_,int T_,int h,int qb,const bf16*Q,const bf16*__restrict__ K,const bf16*__restrict__ V,bf16*O,char*shm){
  const int tid=threadIdx.x,lane=tid&63,r32=lane&31,hi=lane>>5; const int wid=__builtin_amdgcn_readfirstlane(tid>>6);
  const long rowbase=(long)rowbase_; const int q0=qb*QB; const int kvh=h>>2;
  const bf16*Qw=Q+(rowbase+q0+wid*QBLK)*QP+h*D;
  const bf16*Kh=K+rowbase*KP+kvh*D,*Vh=V+rowbase*KP+kvh*D;
  const unsigned lds0=(unsigned)(uintptr_t)shm;
  float*wsf=(float*)(shm+LDS_WS)+wid*64;
  const bf16*ksrc=Kh+(long)lane*KP+wid*8;
  const bf16*vsrc=Vh+(long)(16*(wid&3)+(lane>>2))*KP+(wid>>2)*32+(lane&3)*8;
  const unsigned kdst=lds0+LDS_K+wid*1024, vdst=lds0+LDS_V+wid*1024;
  #define DMA_K(t,slot) glds16(ksrc+(long)(t)*KVBLK*KP,(unsigned)__builtin_amdgcn_readfirstlane(kdst+(slot)))
  #define DMA_V(t,slot) glds16(vsrc+(long)(t)*KVBLK*KP,(unsigned)__builtin_amdgcn_readfirstlane(vdst+(slot)))
  const int vb0=(int)(lds0+LDS_V)+((lane>>4)&1)*32+(lane&3)*8+(4*hi+((lane&15)>>2))*64;
  const char*Kbase=shm+LDS_K; bf16x8 kf[8];
  const lds_cptr shm3=(lds_cptr)shm; const lds_cptr kp0=shm3+LDS_K+hi*1024+r32*16; const lds_cptr vp0=shm3+LDS_V+((lane>>4)&1)*32+(lane&3)*8+(4*hi+((lane&15)>>2))*64;
  const int NT=T_/KVBLK;
  DMA_K(0,0);DMA_V(0,0);DMA_K(1,SLOTB);
  bf16x8 qr[4];
  #pragma unroll
  for(int d0=0;d0<4;++d0)qr[d0]=*reinterpret_cast<const bf16x8*>(&Qw[(long)r32*QP+d0*16+hi*8]);
  float mhat=0.f,l_reg=0.f;f32x16 o[2];o[0]=f32x16{};o[1]=f32x16{};f32x16 negm=f32x16{};
#if !ATTN_NOMAX
  asm volatile("":"+v"(negm));
#endif

  const int qrel=wid*QBLK+r32;
  #define CMASK(P0,P1,t) do{}while(0)
  bool resc=false;
#if ATTN_NOMAX
  #define START(P0,P1) do{ _Pragma("unroll") for(int r=0;r<16;++r)P0[r]=__builtin_amdgcn_exp2f(P0[r]); }while(0)
#else
  #define START(P0,P1) do{ const float rm=rowmax(P0,P1); resc=false; \
    { const float dl=rm; mhat=fadd_s(mhat,dl); \
      _Pragma("unroll") for(int r=0;r<16;++r){P0[r]=fsub_s(P0[r],dl);P1[r]=fsub_s(P1[r],dl);} \
      _Pragma("unroll") for(int r=0;r<16;++r)negm[r]=-mhat; asm volatile("":"+v"(negm)); } \
    _Pragma("unroll") for(int r=0;r<16;++r)P0[r]=__builtin_amdgcn_exp2f(P0[r]); }while(0)
#endif
#if ATTN_NOMAX
  #define RESC() do{}while(0)
#else
  #define RESC() do{ if(resc){ asm volatile("s_waitcnt lgkmcnt(0)":::"memory"); \
      _Pragma("unroll") for(int d_=0;d_<2;++d_) _Pragma("unroll") for(int r=0;r<16;++r)o[d_][r]*=wsf[crow(r,hi)]; } }while(0)
#endif
  f32x16 pA0,pA1,pB0,pB1;
  int sl_prev=0,sl_cur=0,sl_next=SLOTB;
  #define ROT() do{sl_prev=sl_cur;sl_cur=sl_next;sl_next=(sl_next==(NSLOT-1)*SLOTB)?0:sl_next+SLOTB;}while(0)
  DMA_K(2,2*SLOTB);
  WAIT_BAR(3);
  qkt(pA0,pA1,Kbase,qr,negm,r32,hi);asm volatile("s_nop 15\n\ts_nop 7":"+v"(pA0),"+v"(pA1));CMASK(pA0,pA1,0);
  START(pA0,pA1);
  _Pragma("unroll") for(int r=0;r<16;++r)pA1[r]=__builtin_amdgcn_exp2f(pA1[r]);
  WAIT_BAR(0);
  DMA_K(3,0);DMA_V(1,SLOTB);
  ROT();
  kload8(kf,kp0+sl_cur);
  WAIT_BAR(2);
  s16x4 vlo[8],vhi[8]; u32x4 pw0,pw1,pw2,pw3;
  #define PKW(P,B) cvtpk_s(P[B],P[B+1])
  #define PAF(k) __builtin_bit_cast(bf16x8,pw##k)
  #define VFR(i) (bf16x8){vlo[i][0],vlo[i][1],vlo[i][2],vlo[i][3],vhi[i][0],vhi[i][1],vhi[i][2],vhi[i][3]}
  #define PIN(x) asm volatile("":"+v"(x))
  #define MX3(a,b,c) __builtin_fmaxf(__builtin_fmaxf((a),(b)),(c))
  #define GAPA(MF,A0,A1,A2,A3,W0,W1,PW) do{ MF; sacc+=A0; sacc+=A1; sacc+=A2; sacc+=A3; PIN(sacc); W0; W1; PIN(PW); SBAR(); }while(0)
  #define EX(v) __builtin_amdgcn_exp2f(v)
  #define GAPB(MF,X,B) do{ MF; X[B]=EX(X[B]); X[B+1]=EX(X[B+1]); X[B+2]=EX(X[B+2]); X[B+3]=EX(X[B+3]); PIN(X); SBAR(); }while(0)
  #define VRD(i) do{ vlo[i]=vtr(vp_+(((i)>>2)*4096+((i)&3)*1024)); vhi[i]=vtr(vp_+(((i)>>2)*4096+((i)&3)*1024+512)); }while(0)
  #define KRD(G,j) do{ if(G){ kload2(kf,kp0+sl_next,j); SBAR(); } }while(0)
#if ATTN_NOMAX
  #define MAXBLOCK(C0,C1) do{}while(0)
#else
  #define MAXBLOCK(C0,C1) \
    { float a=MX3(C0[0],C0[1],C1[0]),b=MX3(C0[2],C0[3],C1[1]); a=MX3(a,C1[2],C1[3]); \
      _Pragma("unroll") for(int r=4;r<16;r+=4){a=MX3(a,C0[r],C0[r+1]);b=MX3(b,C0[r+2],C0[r+3]);a=MX3(a,C1[r],C1[r+1]);b=MX3(b,C1[r+2],C1[r+3]);} \
      float rm=__builtin_fmaxf(a,b); { auto rr=__builtin_amdgcn_permlane32_swap(__float_as_uint(rm),__float_as_uint(rm),false,false); rm=__builtin_fmaxf(__uint_as_float(rr[0]),__uint_as_float(rr[1])); } \
      resc=false; \
      if(__builtin_expect(__any(rm>(float)THRL),0)){ const float dl=__builtin_fmaxf(rm,0.f); mhat+=dl; \
        _Pragma("unroll") for(int r=0;r<16;++r){C0[r]-=dl;C1[r]-=dl;} \
        _Pragma("unroll") for(int r=0;r<16;++r)negm[r]=-mhat; asm volatile("":"+v"(negm)); \
        const float f=__builtin_amdgcn_exp2f(-dl); l_reg*=f; if(hi==0)wsf[r32]=f; resc=true; } }
#endif
  #define STEP(C0,C1,P0,P1,t,GK,GV,GL) do{ SBAR(); \
    const lds_cptr vp_=vp0+sl_prev; \
    VRD(0); SBAR(); float sacc=(P0[0]+P0[1]); \
    GAPA(C0=__builtin_amdgcn_mfma_f32_32x32x16_bf16(kf[0],qr[0],negm,0,0,0), P0[2],P0[3],P0[4],P0[5],     pw0[0]=PKW(P0,0), pw0[1]=PKW(P0,2), pw0); \
    VRD(4); SBAR(); GAPA(C1=__builtin_amdgcn_mfma_f32_32x32x16_bf16(kf[1],qr[0],negm,0,0,0), P0[6],P0[7],P0[8],P0[9],     pw0[2]=PKW(P0,4), pw0[3]=PKW(P0,6), pw0); \
    VRD(1); SBAR(); GAPA(C0=__builtin_amdgcn_mfma_f32_32x32x16_bf16(kf[2],qr[1],C0,0,0,0),   P0[10],P0[11],P0[12],P0[13], pw1[0]=PKW(P0,8), pw1[1]=PKW(P0,10), pw1); \
    VRD(5); SBAR(); GAPA(C1=__builtin_amdgcn_mfma_f32_32x32x16_bf16(kf[3],qr[1],C1,0,0,0),   P0[14],P0[15],P1[0],P1[1],   pw1[2]=PKW(P0,12),pw1[3]=PKW(P0,14), pw1); \
    VRD(2); SBAR(); GAPA(C0=__builtin_amdgcn_mfma_f32_32x32x16_bf16(kf[4],qr[2],C0,0,0,0),   P1[2],P1[3],P1[4],P1[5],     pw2[0]=PKW(P1,0), pw2[1]=PKW(P1,2), pw2); \
    VRD(6); SBAR(); GAPA(C1=__builtin_amdgcn_mfma_f32_32x32x16_bf16(kf[5],qr[2],C1,0,0,0),   P1[6],P1[7],P1[8],P1[9],     pw2[2]=PKW(P1,4), pw2[3]=PKW(P1,6), pw2); \
    VRD(3); SBAR(); GAPA(C0=__builtin_amdgcn_mfma_f32_32x32x16_bf16(kf[6],qr[3],C0,0,0,0),   P1[10],P1[11],P1[12],P1[13], pw3[0]=PKW(P1,8), pw3[1]=PKW(P1,10), pw3); \
    VRD(7); SBAR(); GAPA(C1=__builtin_amdgcn_mfma_f32_32x32x16_bf16(kf[7],qr[3],C1,0,0,0),   P1[14],P1[15],0.f,0.f,       pw3[2]=PKW(P1,12),pw3[3]=PKW(P1,14), pw3); \
    l_reg+=sacc; \
    if(GK){DMA_K((t)+3,sl_cur);} if(GV){DMA_V((t)+1,sl_next);} \
    CMASK(C0,C1,t); \
    MAXBLOCK(C0,C1); \
    SBAR(); \
    GAPB(o[0]=__builtin_amdgcn_mfma_f32_32x32x16_bf16(PAF(0),VFR(0),o[0],0,0,0), C0,0); \
    GAPB(o[1]=__builtin_amdgcn_mfma_f32_32x32x16_bf16(PAF(0),VFR(4),o[1],0,0,0), C0,4); \
    KRD(GL,0); GAPB(o[0]=__builtin_amdgcn_mfma_f32_32x32x16_bf16(PAF(1),VFR(1),o[0],0,0,0), C0,8); \
    KRD(GL,1); GAPB(o[1]=__builtin_amdgcn_mfma_f32_32x32x16_bf16(PAF(1),VFR(5),o[1],0,0,0), C0,12); \
    KRD(GL,2); GAPB(o[0]=__builtin_amdgcn_mfma_f32_32x32x16_bf16(PAF(2),VFR(2),o[0],0,0,0), C1,0); \
    KRD(GL,3); GAPB(o[1]=__builtin_amdgcn_mfma_f32_32x32x16_bf16(PAF(2),VFR(6),o[1],0,0,0), C1,4); \
    GAPB(o[0]=__builtin_amdgcn_mfma_f32_32x32x16_bf16(PAF(3),VFR(3),o[0],0,0,0), C1,8); \
    GAPB(o[1]=__builtin_amdgcn_mfma_f32_32x32x16_bf16(PAF(3),VFR(7),o[1],0,0,0), C1,12); \
    }while(0)
  int t=1;
  #undef CMASK
  #define CMASK(P0,P1,t) do{}while(0)
  for(;t+5<NT;t+=2){
    STEP(pB0,pB1,pA0,pA1,t,true,true,true);     WAIT_BAR(2); RESC(); ROT();
    STEP(pA0,pA1,pB0,pB1,t+1,true,true,true);   WAIT_BAR(2); RESC(); ROT();
  }
  #undef CMASK
  #define CMASK(P0,P1,t) do{}while(0)
  #define ENDW(tt) do{ if((tt)+3<NT){WAIT_BAR(2);} else if((tt)+2<NT){WAIT_BAR(1);} else {WAIT_BAR(0);} }while(0)
  for(;t+1<NT;t+=2){
    STEP(pB0,pB1,pA0,pA1,t,(t+3<NT),(t+1<NT),(t+1<NT));       ENDW(t);   RESC(); ROT();
    STEP(pA0,pA1,pB0,pB1,t+1,(t+4<NT),(t+2<NT),(t+2<NT));     ENDW(t+1); RESC(); ROT();
  }
  STEP(pB0,pB1,pA0,pA1,NT-1,false,false,false); RESC();
  { float sacc=pB0[0]+pB0[1]; _Pragma("unroll") for(int r=2;r<16;++r)sacc+=pB0[r]; _Pragma("unroll") for(int r=0;r<16;++r)sacc+=pB1[r]; l_reg+=sacc;
    pw0=(u32x4){PKW(pB0,0),PKW(pB0,2),PKW(pB0,4),PKW(pB0,6)};pw1=(u32x4){PKW(pB0,8),PKW(pB0,10),PKW(pB0,12),PKW(pB0,14)};pw2=(u32x4){PKW(pB1,0),PKW(pB1,2),PKW(pB1,4),PKW(pB1,6)};pw3=(u32x4){PKW(pB1,8),PKW(pB1,10),PKW(pB1,12),PKW(pB1,14)};
    SBAR(); pv(o,vb0+sl_cur,PAF(0),PAF(1),PAF(2),PAF(3)); }
  #undef PKW
  #undef PAF
  #undef VFR
  #undef PIN
  #undef MX3
  #undef GAPA
  #undef GAPB
  #undef EX
  #undef VRD
  #undef KRD
  #undef STEP
  #undef ENDW
  {auto rr=__builtin_amdgcn_permlane32_swap(__float_as_uint(l_reg),__float_as_uint(l_reg),false,false);l_reg=__uint_as_float(rr[0])+__uint_as_float(rr[1]);}
  if(hi==0)wsf[32+r32]=l_reg;asm volatile("s_waitcnt lgkmcnt(0)":::"memory");
  float rli[16];
  #pragma unroll
  for(int r=0;r<16;++r)rli[r]=__builtin_amdgcn_rcpf(wsf[32+crow(r,hi)]);
  bf16*Ow=O+(rowbase+q0+wid*QBLK)*OP+h*D;
  { bf16*stg=(bf16*)(shm+LDS_OST)+wid*2048;
    #pragma unroll
    for(int r=0;r<16;++r){const int orow=crow(r,hi);
      #pragma unroll
      for(int d0=0;d0<2;++d0)stg[orow*64+d0*32+r32]=__float2bfloat16(o[d0][r]*rli[r]);}
    asm volatile("s_waitcnt lgkmcnt(0)":::"memory");
    #pragma unroll
    for(int i=0;i<4;++i){const int row=i*8+(lane>>3),ch=lane&7; const u32x4 v=*(const u32x4*)(stg+row*64+ch*8); ATTN_STORE16(Ow+(long)row*OP+ch*8,v);} }
  asm volatile("s_waitcnt lgkmcnt(0)\n\ts_barrier":::"memory");
  #undef DMA_K
  #undef DMA_V
  #undef CMASK
  #undef START
  #undef RESC
  #undef ROT
}
constexpr int ATTN_LDS_BYTES=LDS_BYTES;
struct AttnTensors { const bf16* Q; const bf16* K; const bf16* V; bf16* O; };
template<int THRL=8> __device__ __forceinline__ void attn_phase(char*lds,const AttnTensors&T,int vcu,int G){
  if(G==256){
    const int x=vcu>>5,j=vcu&31;
    for(int i=0;i<4;++i){ const int w=j*4+i,g=w>>5,qb=w&31; attn_unit<THRL>(16384+(x>>1)*8192,8192,(x&1)*4+g,qb,T.Q,T.K,T.V,T.O,lds); }
    for(int i=0;i<2;++i){ const int w=j*2+i,g=w>>4,qb=w&15; attn_unit<THRL>((x>>1)*4096,4096,(x&1)*4+g,qb,T.Q,T.K,T.V,T.O,lds); }
  } else {
    for(int u=vcu;u<1536;u+=G){
      if(u<1024){ const int qb=u&31,h=(u>>5)&7,s=u>>8; attn_unit<THRL>(16384+s*8192,8192,h,qb,T.Q,T.K,T.V,T.O,lds); }
      else { const int v=u-1024,qb=v&15,h=(v>>4)&7,s=v>>7; attn_unit<THRL>(s*4096,4096,h,qb,T.Q,T.K,T.V,T.O,lds); }
    }
  }
}
#undef SBAR
#undef WAIT_BAR
}

__device__ __forceinline__ void sattn_unit(const Frame& F, int seq, int h, int qb) {
    const int T = seq < 4 ? TP : TS; const int rowbase = seq < 4 ? seq * TP : MP + (seq - 4) * TS;
    const bf16* Q = (const bf16*)(F.ws + WS_Q); const bf16* Kb = (const bf16*)(F.ws + WS_K); const bf16* Vb = (const bf16*)(F.ws + WS_V); bf16* MIX = (bf16*)(F.ws + WS_MIX);
    const int kvh = h >> 2, m = rowbase + qb * 512 + F.tid;
    LAS float* Ks = (LAS float*)F.lds; LAS float* Vs = Ks + 64 * 64;
    float q[64], o[64];
    { const u32x4* qp = (const u32x4*)(Q + (size_t)m * 512 + h * 64);
#pragma unroll
      for (int i = 0; i < 8; ++i) { const u32x4 w = qp[i]; q[8 * i] = bflo(w.x); q[8 * i + 1] = bfhi(w.x); q[8 * i + 2] = bflo(w.y); q[8 * i + 3] = bfhi(w.y); q[8 * i + 4] = bflo(w.z); q[8 * i + 5] = bfhi(w.z); q[8 * i + 6] = bflo(w.w); q[8 * i + 7] = bfhi(w.w); } }
#pragma unroll
    for (int d = 0; d < 64; ++d) o[d] = 0.f;
    float mx = -1e30f, l = 0.f;
    const int lr = F.tid >> 3, lc = (F.tid & 7) * 8;
    for (int kt = 0; kt < T / 64; ++kt) {
        __syncthreads();
        { const size_t grow = (size_t)(rowbase + kt * 64 + lr) * 128 + kvh * 64 + lc;
          const u32x4 kw = *(const u32x4*)(Kb + grow), vw = *(const u32x4*)(Vb + grow);
          LAS f32x4* kd = (LAS f32x4*)(Ks + lr * 64 + lc); LAS f32x4* vd = (LAS f32x4*)(Vs + lr * 64 + lc);
          kd[0] = (f32x4){bflo(kw.x), bfhi(kw.x), bflo(kw.y), bfhi(kw.y)}; kd[1] = (f32x4){bflo(kw.z), bfhi(kw.z), bflo(kw.w), bfhi(kw.w)};
          vd[0] = (f32x4){bflo(vw.x), bfhi(vw.x), bflo(vw.y), bfhi(vw.y)}; vd[1] = (f32x4){bflo(vw.z), bfhi(vw.z), bflo(vw.w), bfhi(vw.w)}; }
        __syncthreads();
#pragma unroll 1
        for (int j = 0; j < 64; ++j) {
            const LAS f32x4* Kc = (const LAS f32x4*)(Ks + j * 64); const LAS f32x4* Vc = (const LAS f32x4*)(Vs + j * 64);
            float a = 0.f;
#pragma unroll
            for (int d4 = 0; d4 < 16; ++d4) { const f32x4 kv = Kc[d4]; a += q[4 * d4] * kv.x + q[4 * d4 + 1] * kv.y + q[4 * d4 + 2] * kv.z + q[4 * d4 + 3] * kv.w; }
            const float mn = fmaxf(mx, a), alpha = exp2f(mx - mn), p = exp2f(a - mn); mx = mn; l = l * alpha + p;
#pragma unroll
            for (int d4 = 0; d4 < 16; ++d4) { const f32x4 vv = Vc[d4]; o[4 * d4] = o[4 * d4] * alpha + p * vv.x; o[4 * d4 + 1] = o[4 * d4 + 1] * alpha + p * vv.y; o[4 * d4 + 2] = o[4 * d4 + 2] * alpha + p * vv.z; o[4 * d4 + 3] = o[4 * d4 + 3] * alpha + p * vv.w; }
        }
    }
    const float il = 1.0f / l;
    u32x4* op = (u32x4*)(MIX + (size_t)m * DM + h * 64);
#pragma unroll
    for (int i = 0; i < 8; ++i) { u32x4 w; w.x = pk2(o[8 * i] * il, o[8 * i + 1] * il); w.y = pk2(o[8 * i + 2] * il, o[8 * i + 3] * il); w.z = pk2(o[8 * i + 4] * il, o[8 * i + 5] * il); w.w = pk2(o[8 * i + 6] * il, o[8 * i + 7] * il); op[i] = w; }
}
__device__ __forceinline__ void sattn_phase(const Frame& F) {
    for (int u = F.vcu; u < 768; u += F.G) {
        if (u < 512) { const int qb = u & 15, h = (u >> 4) & 7, s = u >> 7; sattn_unit(F, 4 + s, h, qb); }
        else { const int v = u - 512, qb = v & 7, h = (v >> 3) & 7, s = v >> 6; sattn_unit(F, s, h, qb); }
    }
}
__device__ __forceinline__ void pool_phase(const Frame& F) {
    const bf16* U = (const bf16*)(F.ws + WS_U); bf16* MIX = (bf16*)(F.ws + WS_MIX);
    LAS u32x4* T = (LAS u32x4*)F.lds;
    const int g = F.wave & 3, half = 1 << g, ch = 16 * g + (F.lane & 15), rbase = 32 * (F.wave >> 2) + (F.lane >> 4);
    for (int u = F.vcu; u < M / 64; u += F.G) {
        const int r0 = u * 64, Tlen = r0 < MP ? TP : TS, t0 = tpos(r0);
        __syncthreads();
#pragma unroll
        for (int i = 0; i < 10; ++i) { const int e = F.tid + 512 * i, rr = e >> 6, cc = e & 63, t = t0 - 8 + rr;
            if (t >= 0 && t < Tlen) T[e] = *(const u32x4*)(U + (size_t)(r0 - 8 + rr) * 512 + cc * 8); }
        __syncthreads();
#pragma unroll 2
        for (int i = 0; i < 8; ++i) {
            const int r = rbase + 4 * i, t = t0 + r, lo = max(t - half, 0), hi = min(t + half, Tlen);
            float a[8];
#pragma unroll
            for (int k = 0; k < 8; ++k) a[k] = 0.f;
            for (int j = lo; j < hi; ++j) { const u32x4 w = T[(j - t0 + 8) * 64 + ch];
                a[0] += bflo(w.x); a[1] += bfhi(w.x); a[2] += bflo(w.y); a[3] += bfhi(w.y); a[4] += bflo(w.z); a[5] += bfhi(w.z); a[6] += bflo(w.w); a[7] += bfhi(w.w); }
            const float inv = 1.0f / (float)(hi - lo);
            const u32x4 w = T[(r + 8) * 64 + ch];
            u32x4 o; o.x = pk2(a[0] * inv - bflo(w.x), a[1] * inv - bfhi(w.x)); o.y = pk2(a[2] * inv - bflo(w.y), a[3] * inv - bfhi(w.y));
            o.z = pk2(a[4] * inv - bflo(w.z), a[5] * inv - bfhi(w.z)); o.w = pk2(a[6] * inv - bflo(w.w), a[7] * inv - bfhi(w.w));
            *(u32x4*)(MIX + (size_t)(r0 + r) * DM + 512 + ch * 8) = o;
        }
    }
    __syncthreads();
}
__device__ __forceinline__ void final_phase(const Frame& F, const float* src, float* out, const float* g) {
    const int gw = F.vcu * NWAVES + F.wave, NGW = F.G * NWAVES; const f32x4* gr = (const f32x4*)g + F.lane;
    for (int m = gw; m < M; m += NGW) {
        const f32x4* xs = (const f32x4*)(src + (size_t)m * DM) + F.lane; f32x4* xr = (f32x4*)(out + (size_t)m * DM) + F.lane; f32x4 v[4]; float s = 0.f;
#pragma unroll
        for (int j = 0; j < 4; ++j) { v[j] = xs[64 * j]; s += (v[j].x * v[j].x + v[j].y * v[j].y) + (v[j].z * v[j].z + v[j].w * v[j].w); }
        const float rstd = 1.0f / sqrtf(wave_sum(s) * (1.f / DM) + EPS);
#pragma unroll
        for (int j = 0; j < 4; ++j) xr[64 * j] = v[j] * rstd * gr[64 * j];
    }
}


constexpr int CW_BAR = 4096;
constexpr int LDSCTL_OFF = 131072, MISC_OFF = LDSCTL_OFF + 320;
#define XB_TMO      128
#define XB_XCNT(j)  (256  + 64 * (j))
#define XB_XSUB(j)  (1280 + 64 * (j))
#define XB_XGEN(j)  (2304 + 64 * (j))
#define XB_TOP      3328
#define XB_TOPGEN   3392
#define XCD_BAR_WORDS 3456
#define XB_SPIN_CAP (1u << 20)
__device__ __forceinline__ unsigned xb_ld(unsigned* p)              { return __hip_atomic_load(p, __ATOMIC_RELAXED, __HIP_MEMORY_SCOPE_AGENT); }
__device__ __forceinline__ unsigned xb_add(unsigned* p, unsigned v) { return __hip_atomic_fetch_add(p, v, __ATOMIC_RELAXED, __HIP_MEMORY_SCOPE_AGENT); }
__device__ __forceinline__ unsigned xb_xcc_id() { return (unsigned)__builtin_amdgcn_s_getreg((3 << 11) | 20) & 0xFu; }
#define XB_SPIN(cond, bar) do { unsigned _sp = 0; while (cond) { __builtin_amdgcn_s_sleep(1); \
    if ((++_sp & 255u) == 0u) { if (xb_ld(&(bar)[XB_TMO])) break; if (_sp > XB_SPIN_CAP) { atomicAdd(&(bar)[XB_TMO], 1u); break; } } } } while (0)
struct XcdBarrier { unsigned* bar; unsigned x; volatile LAS unsigned* st; };
__device__ __forceinline__ XcdBarrier xcd_barrier_post(unsigned* bar, volatile LAS unsigned* st) {
    XcdBarrier b; b.bar = bar; b.x = xb_xcc_id(); b.st = st;
    if (threadIdx.x == 0) (void)xb_add(&bar[XB_XCNT(b.x)], 1u);
    return b;
}
__device__ __forceinline__ void xcd_barrier_complete(unsigned* bar, unsigned x, unsigned& nloc, unsigned& nx) {
    const unsigned G = gridDim.x * gridDim.y * gridDim.z;
    unsigned sum, cnt, mine, sp = 0u;
    for (;;) {
        sum = 0u; cnt = 0u; mine = 0u;
#pragma unroll
        for (unsigned j = 0; j < 16; ++j) { const unsigned c = xb_ld(&bar[XB_XCNT(j)]); sum += c; cnt += (c > 0u) ? 1u : 0u; mine = (j == x) ? c : mine; }
        if (sum == G) break;
        __builtin_amdgcn_s_sleep(1);
        if ((++sp & 255u) == 0u) { if (xb_ld(&bar[XB_TMO])) break; if (sp > XB_SPIN_CAP) { atomicAdd(&bar[XB_TMO], 1u); break; } }
    }
    nloc = mine > 0u ? mine : 1u; nx = cnt > 0u ? cnt : 1u;
}
__device__ __forceinline__ void xcd_barrier(const XcdBarrier& b) {
    asm volatile("s_waitcnt vmcnt(0)" ::: "memory");
    __syncthreads();
    if (threadIdx.x == 0) {
        unsigned* bar = b.bar;
        __builtin_amdgcn_s_waitcnt(0);
        unsigned nloc = b.st[0], nx = b.st[1];
        if (nloc == 0u) { xcd_barrier_complete(bar, b.x, nloc, nx); b.st[0] = nloc; b.st[1] = nx; }
        const unsigned old = xb_add(&bar[XB_XSUB(b.x)], 1u);
        const unsigned gen = old / nloc;
        if (old + 1u == (gen + 1u) * nloc) {
            __builtin_amdgcn_fence(__ATOMIC_RELEASE, "agent");
            asm volatile("s_waitcnt vmcnt(0)" ::: "memory");
            const unsigned og = xb_add(&bar[XB_TOP], 1u);
            const unsigned tg = og / nx;
            if (og + 1u == (tg + 1u) * nx) xb_add(&bar[XB_TOPGEN], 1u);
            else XB_SPIN(xb_ld(&bar[XB_TOPGEN]) == tg, bar);
            __builtin_amdgcn_fence(__ATOMIC_ACQUIRE, "agent");
            xb_add(&bar[XB_XGEN(b.x)], 1u);
            asm volatile("s_waitcnt vmcnt(0)" ::: "memory");
        } else {
            XB_SPIN(xb_ld(&bar[XB_XGEN(b.x)]) == gen, bar);
            __builtin_amdgcn_fence(__ATOMIC_ACQUIRE, "agent");
            asm volatile("s_waitcnt vmcnt(0)" ::: "memory");
        }
    }
    __syncthreads();
}


template <class E>
__device__ __forceinline__ void fgemm(const Frame& F, const bf16* A, const bf16* Bt, int Mrows, int N, int K, int row0, const E& e) {
    pg8::Gemm g{A, Bt, Mrows, N, K}; pg8::StaticOrder S; S.init(Mrows, N, F.G, (int)blockIdx.x);
    pg8::EpiAdapt<E> EA{e, row0};
    pg8::gemm_phase<pg8::EpiAdapt<E>, pg8::StaticOrder, true, true>(F.lds, g, S, EA);
}

constexpr int CW_GRP = 8192;
constexpr int CW_GRP_TMO = 8192 + 64 * 64;
__device__ __forceinline__ void group_sync(unsigned* cnt, unsigned target, unsigned* tmo) {
    asm volatile("s_waitcnt vmcnt(0)" ::: "memory");
    __syncthreads();
    if (threadIdx.x == 0) {
        __builtin_amdgcn_fence(__ATOMIC_RELEASE, "agent");
        asm volatile("s_waitcnt vmcnt(0)" ::: "memory");
        (void)xb_add(cnt, 1u);
        unsigned sp = 0u;
        while (xb_ld(cnt) < target) { __builtin_amdgcn_s_sleep(1); if (++sp > (1u << 21)) { atomicAdd(tmo, 1u); break; } }
        __builtin_amdgcn_fence(__ATOMIC_ACQUIRE, "agent");
        asm volatile("s_waitcnt vmcnt(0)" ::: "memory");
    }
    __syncthreads();
}
__device__ __forceinline__ f32x4 ld_bf16x4(const bf16* p) { const u32x2 w = *(const u32x2*)p; return (f32x4){bflo(w.x), bfhi(w.x), bflo(w.y), bfhi(w.y)}; }
__device__ __forceinline__ float ssq8(f32x4 a, f32x4 b) { return ((a[0] * a[0] + a[1] * a[1]) + (a[2] * a[2] + a[3] * a[3])) + ((b[0] * b[0] + b[1] * b[1]) + (b[2] * b[2] + b[3] * b[3])); }
struct EpiResA {
    const float* x0; const float* x1; bf16* HB; float* SS;
    __device__ __forceinline__ void seg64(int m, int c0, f32x4 (&v)[4], int fq) const {
        const float* b = (m < MP ? x0 + (size_t)m * DM : x1 + (size_t)(m - MP) * DM) + c0 + 8 * fq;
        bf16* hb = HB + (size_t)m * DM + c0 + 8 * fq; float ss = 0.f;
#pragma unroll
        for (int h = 0; h < 2; ++h) { const f32x4 h0 = *(const f32x4*)(b + 32 * h) + v[2 * h], h1 = *(const f32x4*)(b + 32 * h + 4) + v[2 * h + 1]; st_bf16x8(hb + 32 * h, h0, h1); ss += ssq8(h0, h1); }
        ss = quad_sum(ss);
        if (fq == 0) SS[(size_t)m * 16 + (c0 >> 6)] = ss;
    }
};
struct EpiResC {
    bf16* HB; float* SS;
    __device__ __forceinline__ void seg64(int m, int c0, f32x4 (&v)[4], int fq) const {
        bf16* hb = HB + (size_t)m * DM + c0 + 8 * fq; float ss = 0.f;
#pragma unroll
        for (int h = 0; h < 2; ++h) { f32x4 h0, h1; ld_bf16x8(hb + 32 * h, h0, h1); h0 = h0 + v[2 * h]; h1 = h1 + v[2 * h + 1]; st_bf16x8(hb + 32 * h, h0, h1); ss += ssq8(h0, h1); }
        ss = quad_sum(ss);
        if (fq == 0) SS[(size_t)m * 16 + (c0 >> 6)] = ss;
    }
};
struct EpiUpP {
    bf16* HM; const LAS float* rs; int row0;
    __device__ __forceinline__ void seg64(int m, int c0, f32x4 (&v)[4], int fq) const {
        const float rstd = rs[m - row0];
        bf16* d = HM + (size_t)(m - row0) * DFF + c0 + 8 * fq;
#pragma unroll
        for (int h = 0; h < 2; ++h) { f32x4 a = v[2 * h] * rstd, b = v[2 * h + 1] * rstd;
#pragma unroll
            for (int j = 0; j < 4; ++j) { const float r = fmaxf(a[j], 0.f), q = fmaxf(b[j], 0.f); a[j] = r * r; b[j] = q * q; }
            st_bf16x8(d + 32 * h, a, b); }
    }
};
struct EpiBfP {
    bf16* O; int ld;
    __device__ __forceinline__ void seg64(int m, int c0, f32x4 (&v)[4], int fq) const {
        bf16* d = O + (size_t)m * ld + c0 + 8 * fq;
        st_bf16x8(d, v[0], v[1]); st_bf16x8(d + 32, v[2], v[3]);
    }
};
namespace pg8 {
struct EpiGateFinal {
    static constexpr bool PERM = true, AFTER_DRAIN = true;
    const bf16* HB; const bf16* PP; const float* SS2; float* SS3; float* out; const float* fg; unsigned* cnt; unsigned target; unsigned* tmo; int row0;
    __device__ __forceinline__ void fused(f32x4 (&acc)[2][2][4][2], const Unit& u, int wr, int wc, int fr, int fq, PG8_LAS unsigned char* lds, int wid, int lane) const {
        const int c0 = u.pn * BM + wc * 64;
#pragma unroll
        for (int ai = 0; ai < 2; ++ai)
#pragma unroll
            for (int m = 0; m < 4; ++m) {
                const int row = row0 + ai * HALF + wr * 64 + m * 16 + fr;
                const float rstd = ((const PG8_LAS float*)(lds + RSTD_OFF))[row - row0];
                const bf16* hb = HB + (size_t)row * DM + c0 + 8 * fq; const bf16* pp = PP + (size_t)row * DM + c0 + 8 * fq; float ss = 0.f;
#pragma unroll
                for (int bj = 0; bj < 2; ++bj) { ::f32x4 hv[2], pv[2]; ld_bf16x8(hb + 32 * bj, hv[0], hv[1]); ld_bf16x8(pp + 32 * bj, pv[0], pv[1]);
#pragma unroll
                    for (int n = 0; n < 2; ++n) { const ::f32x4 a = acc[ai][bj][m][n]; ::f32x4 h;
#pragma unroll
                        for (int e = 0; e < 4; ++e) h[e] = hv[n][e] + pv[n][e] / (1.0f + __expf(-a[e] * rstd));
                        acc[ai][bj][m][n] = h; ss += (h[0] * h[0] + h[1] * h[1]) + (h[2] * h[2] + h[3] * h[3]); } }
                ss = quad_sum(ss);
                if (fq == 0) SS3[(size_t)row * 16 + (c0 >> 6)] = ss;
                if (m & 1) asm volatile("" ::: "memory");
            }
        group_sync(cnt, target, tmo);
        if (threadIdx.x < 256) ((PG8_LAS float*)(lds + RSTD_OFF))[threadIdx.x] = rstd_from_ss(SS3 + (size_t)(row0 + threadIdx.x) * 16);
        __syncthreads();
#pragma unroll
        for (int ai = 0; ai < 2; ++ai)
#pragma unroll
            for (int m = 0; m < 4; ++m) {
                const int row = row0 + ai * HALF + wr * 64 + m * 16 + fr;
                const float rstd = ((const PG8_LAS float*)(lds + RSTD_OFF))[row - row0];
                float* o = out + (size_t)row * DM + c0 + 8 * fq; const float* g = fg + c0 + 8 * fq;
#pragma unroll
                for (int bj = 0; bj < 2; ++bj)
#pragma unroll
                    for (int n = 0; n < 2; ++n) *(::f32x4*)(o + 32 * bj + 4 * n) = acc[ai][bj][m][n] * rstd * *(const ::f32x4*)(g + 32 * bj + 4 * n);
                if (m & 1) asm volatile("" ::: "memory");
            }
    }
};
struct ListOrder {
    int pn0, n;
    __device__ __forceinline__ bool next(int i, Unit& u) const { if (i >= n) return false; u.pm = 0; u.pn = pn0 + i; return true; }
    __device__ __forceinline__ void a_ready(const Unit&) const {}
    __device__ __forceinline__ void done(const Unit&) const {}
};
}
template <class E>
__device__ __forceinline__ void lgemm(const Frame& F, const bf16* A, const bf16* Bt, int N, int K, int row0, int pn0, int n, const E& e) {
    pg8::Gemm g{A, Bt, 256, N, K}; pg8::ListOrder S{pn0, n};
    pg8::EpiAdapt<E, true> EA{e, row0};
    pg8::gemm_phase<pg8::EpiAdapt<E, true>, pg8::ListOrder, true, true>(F.lds, g, S, EA);
}
__device__ __forceinline__ void tail_phase(const Frame& F, const Args& args) {
    const int gidx = F.vcu >> 2, mem = F.vcu & 3;
    unsigned nsync = 0u;
#pragma unroll 1
    for (int c = 0; c < 4; ++c) {
        unsigned char* ws = F.ws; asm volatile("" : "+s"(ws));
        bf16* HB = (bf16*)(ws + WS_XN); const bf16* PP = (const bf16*)(ws + WS_PP); const bf16* MIX = (const bf16*)(ws + WS_MIX);
        float* SS1 = (float*)(ws + WS_SS1); float* SS2 = (float*)(ws + WS_SS2);
        bf16* HMg = (bf16*)(ws + WS_HM) + (size_t)gidx * 256 * DFF;
        unsigned* cnt = (unsigned*)(ws + WS_CTL) + CW_GRP + 64 * gidx; unsigned* tmo = (unsigned*)(ws + WS_CTL) + CW_GRP_TMO;
        const LAS float* rs = (const LAS float*)(F.lds + RSTD_OFF);
        const bf16* PB = (const bf16*)(ws + WS_PB); bf16* PPw = (bf16*)(ws + WS_PP);
        const int row0 = (c * 64 + gidx) * 256, rowp = row0 - 64 * 256;
        if (c < 3) { EpiResA E{args.in[0], args.in[1], HB, SS1}; lgemm(F, MIX + (size_t)row0 * DM, (const bf16*)(ws + WS_WOUT), DM, DM, row0, mem, 1, E); }
        if (c > 0) {
            { EpiBfP E{PPw, DM}; lgemm(F, PB + (size_t)rowp * PLE, (const bf16*)(ws + WS_WPROJ), DM, PLE, rowp, mem, 1, E); }
            rstd_table(F, SS2, rowp);
            pg8::Gemm g{HB + (size_t)rowp * DM, (const bf16*)(ws + WS_WGATE), 256, DM, DM}; pg8::ListOrder S{mem, 1};
            pg8::EpiGateFinal E{HB, PP, SS2, SS1, args.out, args.in[17], cnt, 4u * (++nsync), tmo, rowp};
            pg8::gemm_phase<pg8::EpiGateFinal, pg8::ListOrder, false, true>(F.lds, g, S, E);
        }
        if (c < 3) {
            if (c == 0) group_sync(cnt, 4u * (++nsync), tmo);
            rstd_table(F, SS1, row0);
            { EpiUpP E{HMg, rs, row0}; lgemm(F, HB + (size_t)row0 * DM, (const bf16*)(ws + WS_WUP), DFF, DM, row0, 4 * mem, 4, E); }
            group_sync(cnt, 4u * (++nsync), tmo);
            { EpiResC E{HB, SS2}; lgemm(F, HMg, (const bf16*)(ws + WS_WDOWN), DM, DFF, row0, mem, 1, E); }
            group_sync(cnt, 4u * (++nsync), tmo);
        }
    }
}

constexpr int NPHASE = 4;
__global__ void __launch_bounds__(NWAVES * 64, 2) fwd_kernel(Args args) {
    extern __shared__ __attribute__((aligned(16))) unsigned char lds[];
    Frame F;
    F.lds = (LAS unsigned char*)lds; F.tid = threadIdx.x; F.lane = F.tid & 63; F.wave = __builtin_amdgcn_readfirstlane(F.tid >> 6);
    F.G = gridDim.x; { const int bx = blockIdx.x; F.vcu = (F.G % 8 == 0) ? (bx % 8) * (F.G / 8) + bx / 8 : bx; }
    F.ws = args.ws;
    unsigned char* ws = args.ws;
    for (int u = F.tid; u < (LDS_BYTES - LDSCTL_OFF) / 4; u += NWAVES * 64) ((LAS unsigned*)(F.lds + LDSCTL_OFF))[u] = 0u;
    __syncthreads();
    XcdBarrier bar; bar.bar = (unsigned*)(ws + WS_CTL) + CW_BAR; bar.x = 0; bar.st = nullptr;
    if (args.ph_hi - args.ph_lo > 1) bar = xcd_barrier_post((unsigned*)(ws + WS_CTL) + CW_BAR, (volatile LAS unsigned*)(F.lds + MISC_OFF) + 8);
    bf16* XN = (bf16*)(ws + WS_XN); bf16* PP = (bf16*)(ws + WS_PP); bf16* MIX = (bf16*)(ws + WS_MIX); bf16* HM = (bf16*)(ws + WS_HM);
    float* SS1 = (float*)(ws + WS_SS1); float* SS2 = (float*)(ws + WS_SS2);
    const int lo = args.ph_lo, hi = args.ph_hi;
#define IN(k) (lo <= (k) && (k) < hi)
#define SEAM(k) do { if (IN(k) && IN((k) + 1)) xcd_barrier(bar); } while (0)
#define NREP(k) ((PROBE_REPEAT == (k)) ? 2 : 1)
#define REPBAR() do { if (rep) xcd_barrier(bar); } while (0)
    float* const dry = (float*)(ws + WS_HM);
    if (IN(0)) {
#pragma unroll 1
        for (int rep = 0; rep < NREP(0); ++rep) { REPBAR(); p0_prologue(F, args); } } SEAM(0);
    if (IN(1)) {
#pragma unroll 1
        for (int rep = 0; rep < NREP(1); ++rep) { REPBAR();
        EpiIn E{(bf16*)(ws + WS_Q), (bf16*)(ws + WS_K), (bf16*)(ws + WS_V), (bf16*)(ws + WS_U), args.in[6], args.in[7], (const float2*)(ws + WS_ROPE)};
        fgemm(F, XN, (const bf16*)(ws + WS_WIN), M, INW, DM, 0, E); }
    } SEAM(1);
    if (IN(2)) {
        const attn_body::AttnTensors AT{(const attn_body::bf16*)(ws + WS_Q), (const attn_body::bf16*)(ws + WS_K), (const attn_body::bf16*)(ws + WS_V), (attn_body::bf16*)MIX};
#pragma unroll 1
        for (int rep = 0; rep < NREP(2); ++rep) { REPBAR(); attn_body::attn_phase<8>((char*)lds, AT, F.vcu, F.G); }
#pragma unroll 1
        for (int rep = 0; rep < NREP(12); ++rep) { REPBAR(); pool_phase(F); }
    } SEAM(2);
    if (IN(3)) tail_phase(F, args);
#undef NREP
#undef REPBAR
#undef IN
#undef SEAM
}

extern "C" void kernel_launch(void* const* d_in, const int* in_sizes, int n_in, void* d_out, int out_size, void* d_ws, size_t ws_size, hipStream_t stream) {
    static int grid = 0;
    if (grid == 0) {
        if (n_in != 18 || out_size != M * DM || ws_size < WS_END) { fprintf(stderr, "kernel_launch: unexpected shapes (n_in %d out %d ws %zu)\n", n_in, out_size, ws_size); grid = -1; return; }
        if (hipFuncSetAttribute((const void*)fwd_kernel, hipFuncAttributeMaxDynamicSharedMemorySize, LDS_BYTES) != hipSuccess) { fprintf(stderr, "kernel_launch: hipFuncSetAttribute failed\n"); grid = -1; return; }
        int dev = 0, cus = 0; (void)hipGetDevice(&dev); (void)hipDeviceGetAttribute(&cus, hipDeviceAttributeMultiprocessorCount, dev);
        grid = cus > 0 ? cus : 256;
    }
    if (grid < 0) return;
    Args a{};
    for (int i = 0; i < 18; ++i) a.in[i] = (const float*)d_in[i];
    a.out = (float*)d_out; a.ws = (unsigned char*)d_ws;
#if MK_ONE_LAUNCH
    if (hipMemsetAsync((char*)d_ws + WS_CTL, 0, 65536, stream) != hipSuccess) { fprintf(stderr, "kernel_launch: memset failed\n"); return; }
    a.ph_lo = 0; a.ph_hi = NPHASE; hipLaunchKernelGGL(fwd_kernel, dim3(grid), dim3(NWAVES * 64), LDS_BYTES, stream, a);
#else
    for (int ph = 0; ph < NPHASE; ++ph) { a.ph_lo = ph; a.ph_hi = ph + 1; hipLaunchKernelGGL(fwd_kernel, dim3(grid), dim3(NWAVES * 64), LDS_BYTES, stream, a); }
#endif
}
```

```cpp
#include <hip/hip_runtime.h>
#include <cstdio>
#include <cstdint>
#include <hip/hip_bf16.h>
#include <cmath>

#ifndef PROBE_REPEAT
#define PROBE_REPEAT (-1)
#endif
#ifndef TAIL_REP
#define TAIL_REP (-1)
#endif
#ifndef TAIL_CLS
#define TAIL_CLS 0
#endif
#ifndef ATTN_NOMAX
#define ATTN_NOMAX 1
#endif
#ifndef MK_ONE_LAUNCH
#define MK_ONE_LAUNCH 1
#endif

constexpr int DM = 1024, TP = 4096, TS = 8192, MP = 4 * TP, MS = 4 * TS, M = MP + MS;
constexpr int INW = 1280, DFF = 4096, PLE = 256;
constexpr int CHUNK = 16384, NCHUNK = M / CHUNK;
constexpr float EPS = 1e-6f;
constexpr float C2 = 0.125f * 1.4426950408889634f;

typedef unsigned short bf16;
typedef short bf16x8 __attribute__((ext_vector_type(8)));
typedef float f32x4 __attribute__((ext_vector_type(4)));
typedef unsigned u32x4 __attribute__((ext_vector_type(4)));
typedef unsigned u32x2 __attribute__((ext_vector_type(2)));
#define LAS __attribute__((address_space(3)))
#define GAS __attribute__((address_space(1)))

constexpr size_t MiB = 1u << 20;
constexpr size_t WS_CTL = 0, CTL_ZERO_BYTES = 1 * MiB;
constexpr size_t WS_ROPE = 1 * MiB;
constexpr size_t WS_SS1 = 2 * MiB, WS_SS2 = 5 * MiB;
constexpr size_t WS_WIN = 8 * MiB, WS_WOUT = 11 * MiB, WS_WUP = 13 * MiB, WS_WDOWN = 21 * MiB, WS_WGATE = 29 * MiB, WS_WPROJ = 31 * MiB;
constexpr size_t WS_PP = 32 * MiB;
constexpr size_t WS_XN = 128 * MiB;
constexpr size_t WS_PB = 464 * MiB;
constexpr size_t WS_Q = 248 * MiB, WS_K = 296 * MiB, WS_V = 308 * MiB, WS_U = 320 * MiB;
constexpr size_t WS_MIX = 368 * MiB;
constexpr size_t WS_HM = 224 * MiB;
constexpr size_t WS_END = 488 * MiB;

constexpr int LDS_BYTES = 147456;
constexpr int NWAVES = 8;

__device__ __forceinline__ unsigned f2bf(float f) { unsigned u = __builtin_bit_cast(unsigned, f); return (u + 0x7fffu + ((u >> 16) & 1u)) >> 16; }
__device__ __forceinline__ unsigned pk2(float lo, float hi) { return f2bf(lo) | (f2bf(hi) << 16); }
__device__ __forceinline__ float bf2f(unsigned short b) { return __builtin_bit_cast(float, (unsigned)b << 16); }
__device__ __forceinline__ float bflo(unsigned w) { return __builtin_bit_cast(float, w << 16); }
__device__ __forceinline__ float bfhi(unsigned w) { return __builtin_bit_cast(float, w & 0xffff0000u); }
typedef float f32x2_k __attribute__((ext_vector_type(2))); typedef __bf16 bf16x2_k __attribute__((ext_vector_type(2)));
__device__ __forceinline__ unsigned cvtpk(float lo, float hi) { f32x2_k v = {lo, hi}; bf16x2_k b = __builtin_convertvector(v, bf16x2_k); return __builtin_bit_cast(unsigned, b); }
__device__ __forceinline__ float wave_sum(float v) {
#pragma unroll
    for (int o = 1; o < 64; o <<= 1) v += __shfl_xor(v, o);
    return v;
}
__host__ __device__ __forceinline__ int inv_head(int n) { const int pn = n >> 8, r = n & 255, wc = r >> 6, bj = (r >> 5) & 1, j = r & 31; return pn * 256 + bj * 128 + wc * 32 + j; }

struct Args { const float* in[18]; float* out; unsigned char* ws; int ph_lo, ph_hi; };

struct Frame {
    LAS unsigned char* lds;
    int tid, lane, wave, vcu, G;
    unsigned char* ws;
};
__device__ __forceinline__ const float* xrow(const Args& A, int m) { return m < MP ? A.in[0] + (size_t)m * DM : A.in[1] + (size_t)(m - MP) * DM; }
__device__ __forceinline__ const float* prow(const Args& A, int m) { return m < MP ? A.in[2] + (size_t)m * PLE : A.in[3] + (size_t)(m - MP) * PLE; }
__device__ __forceinline__ int tpos(int m) { return m < MP ? (m & (TP - 1)) : ((m - MP) & (TS - 1)); }

__device__ __forceinline__ void p0_transpose_item(const float* W, int ldw, int K, int ncols, bf16* WT, LAS float* scr, int item, int lane, const float* kscale, bool headmap) {
    const int nblk = ncols / 32, kb = item / nblk, nb = item % nblk, k0 = 64 * kb, n0 = 32 * nb;
#pragma unroll 8
    for (int i = 0; i < 32; ++i) { const int kk = 2 * i + (lane >> 5); float v = W[(size_t)(k0 + kk) * ldw + n0 + (lane & 31)]; if (kscale) v *= kscale[k0 + kk]; scr[kk * 33 + (lane & 31)] = v; }
    asm volatile("s_waitcnt lgkmcnt(0)" ::: "memory");
    const int c = lane & 7;
#pragma unroll
    for (int j = 0; j < 4; ++j) { const int n = (lane >> 3) + 8 * j; const LAS float* s = scr + (8 * c) * 33 + n;
        u32x4 o; o.x = pk2(s[0 * 33], s[1 * 33]); o.y = pk2(s[2 * 33], s[3 * 33]); o.z = pk2(s[4 * 33], s[5 * 33]); o.w = pk2(s[6 * 33], s[7 * 33]);
        const int dr = headmap ? inv_head(n0 + n) : (n0 + n);
        *(u32x4*)(WT + (size_t)dr * K + k0 + 8 * c) = o; }
    asm volatile("s_waitcnt lgkmcnt(0)" ::: "memory");
}
__device__ __forceinline__ void p0_fold_item(const float* Win, const float* Wp, const float* psc, bf16* WT, LAS float* scr, int item, int lane) {
    const int g = item & 3, k0 = (item >> 2) * 16;
#pragma unroll
    for (int i = 0; i < 32; ++i) { const int e = i * 64 + lane, kk = e >> 7, c = e & 127; scr[e] = Win[(size_t)(k0 + kk) * INW + 768 + 128 * g + c]; }
    asm volatile("s_waitcnt lgkmcnt(0)" ::: "memory");
    float a0[16], a1[16];
#pragma unroll
    for (int kk = 0; kk < 16; ++kk) { a0[kk] = 0.f; a1[kk] = 0.f; }
    const float* wp = Wp + (size_t)g * 128 * 128;
    for (int c = 0; c < 128; ++c) {
        const float w0 = wp[c * 128 + lane], w1 = wp[c * 128 + 64 + lane];
#pragma unroll
        for (int kk = 0; kk < 16; ++kk) { const float a = scr[kk * 128 + c]; a0[kk] += a * w0; a1[kk] += a * w1; }
    }
    const float s0 = psc[128 * g + lane], s1 = psc[128 * g + 64 + lane];
    { u32x4 o0, o1; o0.x = pk2(a0[0] * s0, a0[1] * s0); o0.y = pk2(a0[2] * s0, a0[3] * s0); o0.z = pk2(a0[4] * s0, a0[5] * s0); o0.w = pk2(a0[6] * s0, a0[7] * s0);
      o1.x = pk2(a0[8] * s0, a0[9] * s0); o1.y = pk2(a0[10] * s0, a0[11] * s0); o1.z = pk2(a0[12] * s0, a0[13] * s0); o1.w = pk2(a0[14] * s0, a0[15] * s0);
      bf16* d = WT + (size_t)inv_head(768 + 128 * g + lane) * DM + k0; *(u32x4*)d = o0; *(u32x4*)(d + 8) = o1; }
    { u32x4 o0, o1; o0.x = pk2(a1[0] * s1, a1[1] * s1); o0.y = pk2(a1[2] * s1, a1[3] * s1); o0.z = pk2(a1[4] * s1, a1[5] * s1); o0.w = pk2(a1[6] * s1, a1[7] * s1);
      o1.x = pk2(a1[8] * s1, a1[9] * s1); o1.y = pk2(a1[10] * s1, a1[11] * s1); o1.z = pk2(a1[12] * s1, a1[13] * s1); o1.w = pk2(a1[14] * s1, a1[15] * s1);
      bf16* d = WT + (size_t)inv_head(768 + 128 * g + 64 + lane) * DM + k0; *(u32x4*)d = o0; *(u32x4*)(d + 8) = o1; }
    asm volatile("s_waitcnt lgkmcnt(0)" ::: "memory");
}
__device__ __forceinline__ void rms_row_to_bf16(const float* xr_, const float* g, bf16* orow, int lane) {
    const f32x4* xr = (const f32x4*)xr_ + lane; const f32x4* gr = (const f32x4*)g + lane;
    f32x4 v[4]; float s = 0.f;
#pragma unroll
    for (int j = 0; j < 4; ++j) { v[j] = xr[64 * j]; s += (v[j].x * v[j].x + v[j].y * v[j].y) + (v[j].z * v[j].z + v[j].w * v[j].w); }
    const float rstd = 1.0f / sqrtf(wave_sum(s) * (1.f / DM) + EPS);
    unsigned long long* o8 = (unsigned long long*)orow + lane;
#pragma unroll
    for (int j = 0; j < 4; ++j) { const f32x4 gg = gr[64 * j];
        o8[64 * j] = (unsigned long long)pk2(v[j].x * rstd * gg.x, v[j].y * rstd * gg.y) | ((unsigned long long)pk2(v[j].z * rstd * gg.z, v[j].w * rstd * gg.w) << 32); }
}
__device__ __forceinline__ void p0_prologue(const Frame& F, const Args& A) {
    LAS float* scr = (LAS float*)(F.lds + F.wave * 16384);
    const int gw = F.vcu * NWAVES + F.wave, NGW = F.G * NWAVES;
    bf16* Bin = (bf16*)(F.ws + WS_WIN); bf16* Bout = (bf16*)(F.ws + WS_WOUT); bf16* Bup = (bf16*)(F.ws + WS_WUP);
    bf16* Bdown = (bf16*)(F.ws + WS_WDOWN); bf16* Bgate = (bf16*)(F.ws + WS_WGATE); bf16* Bproj = (bf16*)(F.ws + WS_WPROJ);
    constexpr int I_FOLD = 64 * 4, I_IN = (DM / 64) * (768 / 32), I_OUT = (DM / 64) * (DM / 32), I_UP = (DM / 64) * (DFF / 32), I_DOWN = (DFF / 64) * (DM / 32), I_GATE = I_OUT, I_PROJ = (PLE / 64) * (DM / 32);
    constexpr int NITEMS = I_FOLD + I_IN + I_OUT + I_UP + I_DOWN + I_GATE + I_PROJ;
    for (int it = gw; it < NITEMS; it += NGW) {
        int r = it;
        if (r < I_FOLD) { p0_fold_item(A.in[5], A.in[8], A.in[9], Bin, scr, r, F.lane); continue; } r -= I_FOLD;
        if (r < I_IN) { p0_transpose_item(A.in[5], INW, DM, 768, Bin, scr, r, F.lane, nullptr, true); continue; } r -= I_IN;
        if (r < I_OUT) { p0_transpose_item(A.in[10], DM, DM, DM, Bout, scr, r, F.lane, nullptr, true); continue; } r -= I_OUT;
        if (r < I_UP) { p0_transpose_item(A.in[12], DFF, DM, DFF, Bup, scr, r, F.lane, A.in[11], true); continue; } r -= I_UP;
        if (r < I_DOWN) { p0_transpose_item(A.in[13], DM, DFF, DM, Bdown, scr, r, F.lane, nullptr, true); continue; } r -= I_DOWN;
        if (r < I_GATE) { p0_transpose_item(A.in[15], DM, DM, DM, Bgate, scr, r, F.lane, A.in[14], true); continue; } r -= I_GATE;
        p0_transpose_item(A.in[16], DM, PLE, DM, Bproj, scr, r, F.lane, nullptr, true);
    }
    bf16* XN = (bf16*)(F.ws + WS_XN); bf16* PB = (bf16*)(F.ws + WS_PB);
    constexpr int RIF = 4;
    for (int m = gw; m < M; m += RIF * NGW) {
        const f32x4* gr = (const f32x4*)A.in[4] + F.lane;
        f32x4 v[RIF][4], pv[RIF]; float rs[RIF];
#pragma unroll
        for (int r = 0; r < RIF; ++r) { const f32x4* xr = (const f32x4*)xrow(A, m + r * NGW) + F.lane;
#pragma unroll
            for (int j = 0; j < 4; ++j) v[r][j] = xr[64 * j];
            pv[r] = *((const f32x4*)prow(A, m + r * NGW) + F.lane); }
#pragma unroll
        for (int r = 0; r < RIF; ++r) { float q = 0.f;
#pragma unroll
            for (int j = 0; j < 4; ++j) q += (v[r][j].x * v[r][j].x + v[r][j].y * v[r][j].y) + (v[r][j].z * v[r][j].z + v[r][j].w * v[r][j].w);
            rs[r] = 1.0f / sqrtf(wave_sum(q) * (1.f / DM) + EPS); }
#pragma unroll
        for (int r = 0; r < RIF; ++r) { const int mr = m + r * NGW; u32x2* o = (u32x2*)(XN + (size_t)mr * DM) + F.lane;
#pragma unroll
            for (int j = 0; j < 4; ++j) { const f32x4 gg = gr[64 * j], w = v[r][j] * rs[r] * gg; u32x2 t; t.x = cvtpk(w.x, w.y); t.y = cvtpk(w.z, w.w); o[64 * j] = t; }
            u32x2 t; t.x = cvtpk(pv[r].x, pv[r].y); t.y = cvtpk(pv[r].z, pv[r].w); *((u32x2*)(PB + (size_t)mr * PLE) + F.lane) = t; }
    }
    { const int gt = F.vcu * 512 + F.tid;
      if (gt < 2048) { const int p = gt >> 4, i = gt & 15; const float inv = exp2f(-(float)i * (13.287712379549449f / 16.0f)); const float a = (float)p * inv;
          float2* R = (float2*)(F.ws + WS_ROPE); R[gt] = make_float2(cosf(a), sinf(a)); } }
}

namespace pg8 {
#define PG8_LAS __attribute__((address_space(3)))
typedef unsigned short bf16_t;
typedef short bf16x8 __attribute__((ext_vector_type(8)));
typedef float f32x4 __attribute__((ext_vector_type(4)));
typedef unsigned u32x4 __attribute__((ext_vector_type(4)));
constexpr int BM = 256, BK = 64, HALF = 128, HTB = HALF * BK * 2  , STAGE_BYTES = 8 * HTB, NXCD = 8, WGM = 8;

__host__ __device__ __forceinline__ int lds_byte(int r, int c) { const int st = (r >> 4) * 2 + (c >> 5), rr = r & 15, cc = c & 31, ob = rr * 64 + cc * 2; return st * 1024 + (ob ^ (((ob >> 9) & 1) << 5)); }
__host__ __device__ __forceinline__ void stage_rc(int b, int& R, int& C) { const int st = b / 1024, sb = b % 1024, swz = sb ^ (((sb >> 9) & 1) << 5); R = (st >> 1) * 16 + swz / 64; C = (st & 1) * 32 + (swz % 64) / 2; }
__host__ __device__ __forceinline__ int perm32(int rho) { const int n = rho >> 4, i = rho & 15; return 8 * (i >> 2) + 4 * n + (i & 3); }

struct Unit { int pm, pn; };
struct Gemm { const bf16_t* A; const bf16_t* Bt; int M, N, K; };

struct StaticOrder {
    int nM, nN, nwg, G, c;
    __host__ __device__ void init(int M, int N, int G_, int c_) { nM = M / BM; nN = N / BM; nwg = nM * nN; G = G_; c = c_; }
    __host__ __device__ bool next(int i, Unit& u) const {
        const long L = (long)i * G + c; if (L >= nwg) return false;
        int wgid = (int)L; { const int q = nwg / NXCD, r = nwg % NXCD, xcd = wgid % NXCD, off = wgid / NXCD; wgid = (xcd < r ? xcd * (q + 1) : r * (q + 1) + (xcd - r) * q) + off; }
        const int nig = WGM * nN, gid = wgid / nig, fm = gid * WGM, gsz = (nM - fm) < WGM ? (nM - fm) : WGM;
        u.pm = fm + ((wgid % nig) % gsz); u.pn = (wgid % nig) / gsz; return true;
    }
    __device__ __forceinline__ void a_ready(const Unit&) const {}
    __device__ __forceinline__ void done(const Unit&) const {}
};

template <class E, bool PERMV = false> struct EpiAdapt {
    static constexpr bool PERM = PERMV, AFTER_DRAIN = false;
    E e; int row0;
    __device__ __forceinline__ void operator()(f32x4 (&acc)[2][2][4][2], const Unit& u, int wr, int wc, int fr, int fq) const {
        const int c0 = u.pn * BM + wc * 64;
#pragma unroll
        for (int ai = 0; ai < 2; ++ai)
#pragma unroll
            for (int m = 0; m < 4; ++m) {
                ::f32x4 v[4] = {acc[ai][0][m][0], acc[ai][0][m][1], acc[ai][1][m][0], acc[ai][1][m][1]};
                e.seg64(row0 + u.pm * BM + ai * HALF + wr * 64 + m * 16 + fr, c0, v, fq);
                if (m & 1) asm volatile("" ::: "memory");
            }
    }
};
template <class Epi, class Sched, bool ALIGN_EPI = false, bool SP2 = false>
__device__ __forceinline__ void gemm_phase(PG8_LAS unsigned char* lds, const Gemm g, const Sched& S, const Epi& E) {
    int tid_ = threadIdx.x; asm volatile("" : "+v"(tid_));
    const int tid = tid_, wid = __builtin_amdgcn_readfirstlane(tid >> 6), lane = tid & 63, wr = wid >> 2, wc = wid & 3, fr = lane & 15, fq = lane >> 4;
    const int K = g.K, nt = K / BK;
    unsigned voffA[2], voffB[2];
#pragma unroll
    for (int i = 0; i < 2; ++i) { int R, C; stage_rc(tid * 16 + i * 8192, R, C); const int Rb = Epi::PERM ? ((R & ~31) + perm32(R & 31)) : R;
        voffA[i] = (unsigned)(R * K + C) * 2u; voffB[i] = (unsigned)(Rb * K + C) * 2u; }
    const size_t kstep = (size_t)(BK * 2);
    const size_t hstep = (size_t)HALF * K * 2;
    const size_t tstep = 2 * hstep;
    const unsigned ldsw = (unsigned)wid * 1024u;
    const int aoff = lds_byte(wr * 64 + fr, fq * 8), boff = lds_byte(wc * 32 + fr, fq * 8);
#define PG8_SA(b, h) (((b) * 2 + (h)) * HTB)
#define PG8_SB(b, h) ((4 + (b) * 2 + (h)) * HTB)
#define PG8_STAGE(bufoff, gbase, voff) do { _Pragma("unroll") for (int _i = 0; _i < 2; ++_i) { unsigned _vo = (voff)[_i]; asm volatile("" : "+v"(_vo)); \
        __builtin_amdgcn_global_load_lds((const unsigned*)((const char*)(gbase) + _vo), (PG8_LAS unsigned*)(lds + (bufoff) + ldsw + _i * 8192), 16, 0, 0); } } while (0)
#define PG8_LDA(dst, b, h) do { _Pragma("unroll") for (int m = 0; m < 4; ++m) _Pragma("unroll") for (int k = 0; k < 2; ++k) dst[m][k] = *(const PG8_LAS bf16x8*)(lds + PG8_SA(b, h) + aoff + m * 2048 + k * 1024); } while (0)
#define PG8_LDB(dst, b, h) do { _Pragma("unroll") for (int n = 0; n < 2; ++n) _Pragma("unroll") for (int k = 0; k < 2; ++k) dst[n][k] = *(const PG8_LAS bf16x8*)(lds + PG8_SB(b, h) + boff + n * 2048 + k * 1024); } while (0)
#define PG8_MMA(ai, bj, At, Bt) do { __builtin_amdgcn_s_setprio(1); _Pragma("unroll") for (int m = 0; m < 4; ++m) _Pragma("unroll") for (int n = 0; n < 2; ++n) _Pragma("unroll") for (int k = 0; k < 2; ++k) \
        acc[ai][bj][m][n] = __builtin_amdgcn_mfma_f32_16x16x32_bf16(Bt[n][k], At[m][k], acc[ai][bj][m][n], 0, 0, 0); __builtin_amdgcn_s_setprio(0); } while (0)
#define PG8_WAIT_V(n) asm volatile("s_waitcnt vmcnt(" #n ")" ::: "memory")
#define PG8_WAIT_L(n) asm volatile("s_waitcnt lgkmcnt(" #n ")" ::: "memory")
#define PG8_BAR __builtin_amdgcn_s_barrier()
#define PG8_SCHED __builtin_amdgcn_sched_barrier(0)
    Unit cur, nxt; int ui = 0;
    if (!S.next(0, cur)) return;
    f32x4 acc[2][2][4][2];
#pragma unroll
    for (int a = 0; a < 2; ++a)
#pragma unroll
        for (int b = 0; b < 2; ++b)
#pragma unroll
            for (int m = 0; m < 4; ++m)
#pragma unroll
                for (int n = 0; n < 2; ++n) acc[a][b][m][n] = (f32x4){0.f, 0.f, 0.f, 0.f};
    bf16x8 At[4][2], B0[2][2], B1[2][2];
    const char* cA = (const char*)g.A + (size_t)cur.pm * tstep; const char* cB = (const char*)g.Bt + (size_t)cur.pn * tstep;
    S.a_ready(cur);
    if constexpr (SP2) {
        PG8_STAGE(PG8_SB(0, 0), cB, voffB); PG8_STAGE(PG8_SB(0, 1), cB + hstep, voffB); PG8_STAGE(PG8_SA(0, 0), cA, voffA); PG8_STAGE(PG8_SA(0, 1), cA + hstep, voffA);
        if (wr == 1) PG8_BAR;
        PG8_WAIT_V(2); PG8_BAR;
        PG8_STAGE(PG8_SB(1, 0), cB + kstep, voffB); PG8_STAGE(PG8_SA(1, 0), cA + kstep, voffA); PG8_STAGE(PG8_SB(1, 1), cB + hstep + kstep, voffB);
        PG8_WAIT_V(6); PG8_BAR;
    } else {
        PG8_STAGE(PG8_SB(0, 0), cB, voffB); PG8_STAGE(PG8_SA(0, 0), cA, voffA); PG8_STAGE(PG8_SB(0, 1), cB + hstep, voffB); PG8_STAGE(PG8_SA(0, 1), cA + hstep, voffA);
        if (wr == 1) PG8_BAR;
        PG8_WAIT_V(4); PG8_BAR;
        PG8_STAGE(PG8_SB(1, 0), cB + kstep, voffB); PG8_STAGE(PG8_SA(1, 0), cA + kstep, voffA); PG8_STAGE(PG8_SB(1, 1), cB + hstep + kstep, voffB);
        PG8_WAIT_V(6); PG8_BAR;
    }
    for (;;) {
        const bool has_next = S.next(ui + 1, nxt);
        const char* nA = has_next ? (const char*)g.A + (size_t)nxt.pm * tstep : cA; const char* nB = has_next ? (const char*)g.Bt + (size_t)nxt.pn * tstep : cB;
        for (int t = 0; t < nt; t += 2) {
            const bool last = (t == nt - 2);
            const char* a1 = cA + (size_t)(t + 1) * kstep;
            const char* a2 = last ? nA : cA + (size_t)(t + 2) * kstep; const char* b2 = last ? nB : cB + (size_t)(t + 2) * kstep;
            const char* a3 = a2 + kstep; const char* b3 = b2 + kstep;
            if (last && has_next) S.a_ready(nxt);
            if constexpr (SP2) {
            PG8_LDB(B0, 0, 0); PG8_LDB(B1, 0, 1); PG8_SCHED; PG8_LDA(At, 0, 0); PG8_STAGE(PG8_SA(1, 1), a1 + hstep, voffA);
            PG8_WAIT_V(8); PG8_WAIT_L(0); PG8_BAR; PG8_MMA(0, 0, At, B0); PG8_MMA(0, 1, At, B1); PG8_BAR; PG8_SCHED;
            PG8_LDA(At, 0, 1); PG8_STAGE(PG8_SB(0, 0), b2, voffB); PG8_STAGE(PG8_SB(0, 1), b2 + hstep, voffB); PG8_STAGE(PG8_SA(0, 0), a2, voffA);
            PG8_WAIT_V(8); PG8_WAIT_L(0); PG8_BAR; PG8_MMA(1, 0, At, B0); PG8_MMA(1, 1, At, B1); PG8_BAR; PG8_SCHED;
            PG8_LDB(B0, 1, 0); PG8_LDB(B1, 1, 1); PG8_SCHED; PG8_LDA(At, 1, 0); PG8_STAGE(PG8_SA(0, 1), a2 + hstep, voffA);
            PG8_WAIT_V(8); PG8_WAIT_L(0); PG8_BAR; PG8_MMA(0, 0, At, B0); PG8_MMA(0, 1, At, B1); PG8_BAR; PG8_SCHED;
            PG8_LDA(At, 1, 1); PG8_STAGE(PG8_SB(1, 0), b3, voffB); PG8_STAGE(PG8_SB(1, 1), b3 + hstep, voffB); PG8_STAGE(PG8_SA(1, 0), a3, voffA);
            PG8_WAIT_V(8); PG8_WAIT_L(0); PG8_BAR; PG8_MMA(1, 0, At, B0); PG8_MMA(1, 1, At, B1); PG8_BAR; PG8_SCHED;
            } else {
            PG8_LDB(B0, 0, 0); PG8_SCHED; PG8_LDA(At, 0, 0); PG8_STAGE(PG8_SA(1, 1), a1 + hstep, voffA);
            PG8_WAIT_L(8); PG8_BAR; PG8_WAIT_L(0); PG8_MMA(0, 0, At, B0); PG8_BAR; PG8_SCHED;
            PG8_LDB(B1, 0, 1); PG8_STAGE(PG8_SB(0, 0), b2, voffB);
            PG8_BAR; PG8_WAIT_L(0); PG8_MMA(0, 1, At, B1); PG8_BAR;
            PG8_LDA(At, 0, 1); PG8_STAGE(PG8_SA(0, 0), a2, voffA);
            PG8_BAR; PG8_WAIT_L(0); PG8_MMA(1, 0, At, B0); PG8_BAR; PG8_SCHED;
            PG8_STAGE(PG8_SB(0, 1), b2 + hstep, voffB);
            PG8_WAIT_V(6); PG8_BAR; PG8_MMA(1, 1, At, B1); PG8_BAR;
            PG8_LDB(B0, 1, 0); PG8_SCHED; PG8_LDA(At, 1, 0); PG8_STAGE(PG8_SA(0, 1), a2 + hstep, voffA);
            PG8_WAIT_L(8); PG8_BAR; PG8_WAIT_L(0); PG8_MMA(0, 0, At, B0); PG8_BAR; PG8_SCHED;
            PG8_LDB(B1, 1, 1); PG8_STAGE(PG8_SB(1, 0), b3, voffB);
            PG8_BAR; PG8_WAIT_L(0); PG8_MMA(0, 1, At, B1); PG8_BAR;
            PG8_LDA(At, 1, 1); PG8_STAGE(PG8_SA(1, 0), a3, voffA);
            PG8_BAR; PG8_WAIT_L(0); PG8_MMA(1, 0, At, B0); PG8_BAR; PG8_SCHED;
            PG8_STAGE(PG8_SB(1, 1), b3 + hstep, voffB);
            PG8_WAIT_V(6); PG8_BAR; PG8_MMA(1, 1, At, B1); PG8_BAR;
            }
        }
        if constexpr (ALIGN_EPI) { if (wr == 0) PG8_BAR; }
        if constexpr (!Epi::AFTER_DRAIN) { E(acc, cur, wr, wc, fr, fq); S.done(cur); }
        if (!has_next) break;
#pragma unroll
        for (int a = 0; a < 2; ++a)
#pragma unroll
            for (int b = 0; b < 2; ++b)
#pragma unroll
                for (int m = 0; m < 4; ++m)
#pragma unroll
                    for (int n = 0; n < 2; ++n) acc[a][b][m][n] = (f32x4){0.f, 0.f, 0.f, 0.f};
        cur = nxt; cA = nA; cB = nB; ++ui;
        if constexpr (ALIGN_EPI) { if (wr == 1) PG8_BAR; }
    }
    PG8_WAIT_V(0);
    if constexpr (!ALIGN_EPI) { if (wr == 0) PG8_BAR; }
    PG8_BAR;
    if constexpr (Epi::AFTER_DRAIN) { E.fused(acc, cur, wr, wc, fr, fq, lds, wid, lane); S.done(cur); }
#undef PG8_SA
#undef PG8_SB
#undef PG8_STAGE
#undef PG8_LDA
#undef PG8_LDB
#undef PG8_MMA
#undef PG8_WAIT_V
#undef PG8_WAIT_L
#undef PG8_BAR
#undef PG8_SCHED
}
}

template <class Epi>
__device__ __forceinline__ void sgemm(const bf16* A, int lda, int a_row_sub, const bf16* Bt, int K, int row0, int nrows, int N, bool headmap, const Epi& E, const Frame& F) {
    const int nN = N / 64, nU = (nrows / 256) * nN, fr = F.lane & 15, fq = F.lane >> 4;
    for (int u = F.vcu; u < nU; u += F.G) {
        const int pm = u / nN, pn = u % nN, r0 = row0 + pm * 256 + F.wave * 32, c0 = pn * 64;
        f32x4 acc[2][4];
#pragma unroll
        for (int a = 0; a < 2; ++a)
#pragma unroll
            for (int b = 0; b < 4; ++b) acc[a][b] = (f32x4){0.f, 0.f, 0.f, 0.f};
        const bf16* ap0 = A + (size_t)(r0 - a_row_sub + fr) * lda + 8 * fq; const bf16* ap1 = ap0 + (size_t)16 * lda;
        const bf16* bp[4];
#pragma unroll
        for (int nt = 0; nt < 4; ++nt) { const int n = c0 + 16 * nt + fr; bp[nt] = Bt + (size_t)(headmap ? inv_head(n) : n) * K + 8 * fq; }
        for (int k0 = 0; k0 < K; k0 += 32) {
            const bf16x8 a0 = *(const bf16x8*)(ap0 + k0), a1 = *(const bf16x8*)(ap1 + k0);
            bf16x8 b[4];
#pragma unroll
            for (int nt = 0; nt < 4; ++nt) b[nt] = *(const bf16x8*)(bp[nt] + k0);
#pragma unroll
            for (int nt = 0; nt < 4; ++nt) { acc[0][nt] = __builtin_amdgcn_mfma_f32_16x16x32_bf16(b[nt], a0, acc[0][nt], 0, 0, 0); acc[1][nt] = __builtin_amdgcn_mfma_f32_16x16x32_bf16(b[nt], a1, acc[1][nt], 0, 0, 0); }
        }
        E.seg64(r0 + fr, c0, acc[0], fq); E.seg64(r0 + 16 + fr, c0, acc[1], fq);
    }
}

__device__ __forceinline__ void st_bf16x4(bf16* p, f32x4 v) { u32x2 w; w.x = cvtpk(v[0], v[1]); w.y = cvtpk(v[2], v[3]); *(u32x2*)p = w; }
__device__ __forceinline__ void st_bf16x8(bf16* p, f32x4 a, f32x4 b) { u32x4 w; w.x = cvtpk(a[0], a[1]); w.y = cvtpk(a[2], a[3]); w.z = cvtpk(b[0], b[1]); w.w = cvtpk(b[2], b[3]); *(u32x4*)p = w; }
__device__ __forceinline__ void ld_bf16x8(const bf16* p, f32x4& a, f32x4& b) { const u32x4 w = *(const u32x4*)p; a = (f32x4){bflo(w.x), bfhi(w.x), bflo(w.y), bfhi(w.y)}; b = (f32x4){bflo(w.z), bfhi(w.z), bflo(w.w), bfhi(w.w)}; }
__device__ __forceinline__ float quad_sum(float s) { s += __shfl_xor(s, 16); s += __shfl_xor(s, 32); return s; }
__device__ __forceinline__ float rstd_from_ss(const float* ss16) {
    const f32x4* p = (const f32x4*)ss16; const f32x4 a = p[0], b = p[1], c = p[2], d = p[3];
    const float s = ((a.x + a.y) + (a.z + a.w)) + ((b.x + b.y) + (b.z + b.w)) + ((c.x + c.y) + (c.z + c.w)) + ((d.x + d.y) + (d.z + d.w));
    return 1.0f / sqrtf(s * (1.f / DM) + EPS);
}

struct EpiIn {
    bf16 *Q, *K, *V, *U; const float *qg, *kg; const float2* rope;
    __device__ __forceinline__ void seg64(int m, int c0, f32x4 (&v)[4], int fq) const {
        if (c0 < 640) {
            const bool isq = c0 < 512;
            float ss = 0.f;
#pragma unroll
            for (int nt = 0; nt < 4; ++nt) ss += (v[nt][0] * v[nt][0] + v[nt][1] * v[nt][1]) + (v[nt][2] * v[nt][2] + v[nt][3] * v[nt][3]);
            ss = quad_sum(ss);
            const float rstd = 1.0f / sqrtf(ss * (1.f / 64.f) + EPS);
            const float* g = isq ? qg : kg;
#pragma unroll
            for (int nt = 0; nt < 4; ++nt) { const f32x4 gg = *(const f32x4*)(g + 16 * nt + 4 * fq); v[nt] = v[nt] * rstd * gg; }
            const int t = tpos(m), pr = t >> 6, pc = t & 63;
            const float sc = isq ? C2 : 1.0f;
            f32x4 o[4];
#pragma unroll
            for (int j = 0; j < 4; ++j) {
                const float2 cr = rope[pr * 16 + 4 * fq + j], cc = rope[pc * 16 + 4 * fq + j];
                o[0][j] = (v[0][j] * cr.x - v[1][j] * cr.y) * sc; o[1][j] = (v[1][j] * cr.x + v[0][j] * cr.y) * sc;
                o[2][j] = (v[2][j] * cc.x - v[3][j] * cc.y) * sc; o[3][j] = (v[3][j] * cc.x + v[2][j] * cc.y) * sc;
            }
            bf16* dst = isq ? Q + (size_t)m * 512 + c0 : K + (size_t)m * 128 + (c0 - 512);
#pragma unroll
            for (int nt = 0; nt < 4; ++nt) st_bf16x4(dst + 16 * nt + 4 * fq, o[nt]);
        } else {
            bf16* dst = c0 < 768 ? V + (size_t)m * 128 + (c0 - 640) : U + (size_t)m * 512 + (c0 - 768);
#pragma unroll
            for (int nt = 0; nt < 4; ++nt) st_bf16x4(dst + 16 * nt + 4 * fq, v[nt]);
        }
    }
};
struct EpiBf {
    bf16* O; int ld;
    __device__ __forceinline__ void seg64(int m, int c0, f32x4 (&v)[4], int fq) const {
#pragma unroll
        for (int nt = 0; nt < 4; ++nt) st_bf16x4(O + (size_t)m * ld + c0 + 16 * nt + 4 * fq, v[nt]);
    }
};
struct EpiRes {
    const float* base0; const float* base1; float* out; bf16* HB; float* SS;
    __device__ __forceinline__ void seg64(int m, int c0, f32x4 (&v)[4], int fq) const {
        const float* b = (m < MP ? base0 + (size_t)m * DM : base1 + (size_t)(m - MP) * DM) + c0 + 4 * fq;
        float* o = out + (size_t)m * DM + c0 + 4 * fq; bf16* hb = HB + (size_t)m * DM + c0 + 4 * fq; float ss = 0.f;
#pragma unroll
        for (int nt = 0; nt < 4; ++nt) { const f32x4 h = *(const f32x4*)(b + 16 * nt) + v[nt]; *(f32x4*)(o + 16 * nt) = h; st_bf16x4(hb + 16 * nt, h);
            ss += (h[0] * h[0] + h[1] * h[1]) + (h[2] * h[2] + h[3] * h[3]); }
        ss = quad_sum(ss);
        if (fq == 0) SS[(size_t)m * 16 + (c0 >> 6)] = ss;
    }
};
constexpr int RSTD_OFF = 131072 + 1024;
struct EpiUp {
    bf16* HM; const LAS float* rs; int row0;
    __device__ __forceinline__ void seg64(int m, int c0, f32x4 (&v)[4], int fq) const {
        const float rstd = rs[m - row0];
        bf16* d = HM + (size_t)(m - row0) * DFF + c0 + 4 * fq;
#pragma unroll
        for (int nt = 0; nt < 4; ++nt) { f32x4 a = v[nt] * rstd;
#pragma unroll
            for (int j = 0; j < 4; ++j) { const float r = fmaxf(a[j], 0.f); a[j] = r * r; }
            st_bf16x4(d + 16 * nt, a); }
    }
};
__device__ __forceinline__ void rstd_table(const Frame& F, const float* SS, int row0) {
    if (F.tid < 256) ((LAS float*)(F.lds + RSTD_OFF))[F.tid] = rstd_from_ss(SS + (size_t)(row0 + F.tid) * 16);
    __syncthreads();
}
struct EpiGate {
    const float* out; float* dst; const bf16* PP; const float* SS;
    __device__ __forceinline__ void seg64(int m, int c0, f32x4 (&v)[4], int fq) const {
        const float rstd = rstd_from_ss(SS + (size_t)m * 16);
        const float* o = out + (size_t)m * DM + c0 + 4 * fq; float* d = dst + (size_t)m * DM + c0 + 4 * fq; const bf16* pp = PP + (size_t)m * DM + c0 + 4 * fq;
#pragma unroll
        for (int nt = 0; nt < 4; ++nt) { const u32x2 w = *(const u32x2*)(pp + 16 * nt); f32x4 h = *(const f32x4*)(o + 16 * nt);
            const float p0 = bflo(w.x), p1 = bfhi(w.x), p2 = bflo(w.y), p3 = bfhi(w.y);
            h[0] += p0 / (1.0f + __expf(-v[nt][0] * rstd)); h[1] += p1 / (1.0f + __expf(-v[nt][1] * rstd));
            h[2] += p2 / (1.0f + __expf(-v[nt][2] * rstd)); h[3] += p3 / (1.0f + __expf(-v[nt][3] * rstd));
            *(f32x4*)(d + 16 * nt) = h; }
    }
};

namespace attn_body {
using bf16=__hip_bfloat16;
using bf16x8=__attribute__((ext_vector_type(8)))short;
using s16x4=__attribute__((ext_vector_type(4)))short;
using f32x16=__attribute__((ext_vector_type(16)))float;
using u32x4=__attribute__((ext_vector_type(4)))unsigned;
constexpr int D=64,QP=512,KP=128,OP=1024;
constexpr int NW=8,QBLK=32,QB=QBLK*NW,KVBLK=64;
constexpr int ATTN_UNIT_ROWS=QB;
__device__ __forceinline__ int crow(int r,int hi){return (r&3)+8*(r>>2)+4*hi;}
#define SBAR() __builtin_amdgcn_sched_barrier(0)

constexpr int NSLOT=3, SLOTB=8192;
constexpr int LDS_K=0, LDS_V=NSLOT*SLOTB, LDS_WS=2*NSLOT*SLOTB, LDS_OST=LDS_WS+NW*64*4, LDS_BYTES=LDS_OST+NW*4096;
constexpr float C2=0.125f*1.4426950408889634f;
__device__ __forceinline__ void glds16(const void*gsrc,unsigned lds_dst){unsigned keep;
  asm volatile("s_mov_b32 %0, m0\n\ts_mov_b32 m0, %2\n\ts_nop 0\n\tglobal_load_lds_dwordx4 %1, off\n\ts_mov_b32 m0, %0":"=&s"(keep):"v"(gsrc),"s"(lds_dst):"memory");}
__device__ __forceinline__ float max3f(float a,float b,float c){float r;asm("v_max3_f32 %0, %1, %2, %3":"=v"(r):"v"(a),"v"(b),"v"(c));return r;}
__device__ __forceinline__ float max2f(float a,float b){float r;asm("v_max_f32_e32 %0, %1, %2":"=v"(r):"v"(a),"v"(b));return r;}
__device__ __forceinline__ float fadd_s(float a,float b){float r;asm("v_add_f32_e32 %0, %1, %2":"=v"(r):"v"(a),"v"(b));return r;}
__device__ __forceinline__ float fsub_s(float a,float b){float r;asm("v_sub_f32_e32 %0, %1, %2":"=v"(r):"v"(a),"v"(b));return r;}
typedef float f32x2_t __attribute__((ext_vector_type(2))); typedef __bf16 bf16x2_t __attribute__((ext_vector_type(2)));
__device__ __forceinline__ unsigned cvtpk_s(float lo,float hi){f32x2_t v={lo,hi};bf16x2_t b=__builtin_convertvector(v,bf16x2_t);return __builtin_bit_cast(unsigned,b);}
#define WAIT_BAR(N) asm volatile("s_waitcnt vmcnt(" #N ") lgkmcnt(0)\n\ts_barrier":::"memory")

__device__ __forceinline__ void qkt(f32x16&p0,f32x16&p1,const char*Kslot,const bf16x8*qr,const f32x16&negm,int r32,int hi){
  const char*kb=Kslot+hi*1024+r32*16;
  #pragma unroll
  for(int d0=0;d0<4;++d0){
    const bf16x8 b0=*reinterpret_cast<const bf16x8*>(kb+d0*2048);
    const bf16x8 b1=*reinterpret_cast<const bf16x8*>(kb+d0*2048+512);
    if(d0==0){p0=__builtin_amdgcn_mfma_f32_32x32x16_bf16(b0,qr[0],negm,0,0,0);p1=__builtin_amdgcn_mfma_f32_32x32x16_bf16(b1,qr[0],negm,0,0,0);}
    else{p0=__builtin_amdgcn_mfma_f32_32x32x16_bf16(b0,qr[d0],p0,0,0,0);p1=__builtin_amdgcn_mfma_f32_32x32x16_bf16(b1,qr[d0],p1,0,0,0);}}
}
typedef __attribute__((address_space(3))) const char* lds_cptr;
typedef short v4i16_t __attribute__((ext_vector_type(4)));
__device__ __forceinline__ void kload8(bf16x8*kf,lds_cptr kp){
  kf[0]=*(const __attribute__((address_space(3))) bf16x8*)(kp);      kf[1]=*(const __attribute__((address_space(3))) bf16x8*)(kp+512);
  kf[2]=*(const __attribute__((address_space(3))) bf16x8*)(kp+2048); kf[3]=*(const __attribute__((address_space(3))) bf16x8*)(kp+2560);
  kf[4]=*(const __attribute__((address_space(3))) bf16x8*)(kp+4096); kf[5]=*(const __attribute__((address_space(3))) bf16x8*)(kp+4608);
  kf[6]=*(const __attribute__((address_space(3))) bf16x8*)(kp+6144); kf[7]=*(const __attribute__((address_space(3))) bf16x8*)(kp+6656);
}
__device__ __forceinline__ void kload2(bf16x8*kf,lds_cptr kp,int j){ kf[2*j]=*(const __attribute__((address_space(3))) bf16x8*)(kp+j*2048); kf[2*j+1]=*(const __attribute__((address_space(3))) bf16x8*)(kp+j*2048+512); }
__device__ __forceinline__ s16x4 vtr(lds_cptr p){ return __builtin_bit_cast(s16x4,__builtin_amdgcn_ds_read_tr16_b64_v4i16((__attribute__((address_space(3))) v4i16_t*)p)); }
__device__ __forceinline__ float rowmax(const f32x16&p0,const f32x16&p1){
  float a=max3f(p0[0],p0[1],p1[0]),b=max3f(p0[2],p0[3],p1[1]);a=max3f(a,p1[2],p1[3]);
  #pragma unroll
  for(int r=4;r<16;r+=4){a=max3f(a,p0[r],p0[r+1]);b=max3f(b,p0[r+2],p0[r+3]);a=max3f(a,p1[r],p1[r+1]);b=max3f(b,p1[r+2],p1[r+3]);}
  const float m=max2f(a,b);
  auto rr=__builtin_amdgcn_permlane32_swap(__float_as_uint(m),__float_as_uint(m),false,false);
  return max2f(__uint_as_float(rr[0]),__uint_as_float(rr[1]));
}
__device__ __forceinline__ void pv(f32x16*o,int vb,bf16x8 pa0,bf16x8 pa1,bf16x8 pa2,bf16x8 pa3){
  #pragma unroll
  for(int d0=0;d0<2;++d0){s16x4 lo[4],hi[4];
    #pragma unroll
    for(int ks=0;ks<4;++ks){
      asm volatile("ds_read_b64_tr_b16 %0,%1 offset:%c2":"=&v"(lo[ks]):"v"(vb),"i"(d0*4096+ks*1024):"memory");
      asm volatile("ds_read_b64_tr_b16 %0,%1 offset:%c2":"=&v"(hi[ks]):"v"(vb),"i"(d0*4096+ks*1024+512):"memory");}
    asm volatile("s_waitcnt lgkmcnt(0)":::"memory");SBAR();
    #define PK(k) (bf16x8){lo[k][0],lo[k][1],lo[k][2],lo[k][3],hi[k][0],hi[k][1],hi[k][2],hi[k][3]}
    o[d0]=__builtin_amdgcn_mfma_f32_32x32x16_bf16(pa0,PK(0),o[d0],0,0,0);
    o[d0]=__builtin_amdgcn_mfma_f32_32x32x16_bf16(pa1,PK(1),o[d0],0,0,0);
    o[d0]=__builtin_amdgcn_mfma_f32_32x32x16_bf16(pa2,PK(2),o[d0],0,0,0);
    o[d0]=__builtin_amdgcn_mfma_f32_32x32x16_bf16(pa3,PK(3),o[d0],0,0,0);
    #undef PK
  }
}

#ifndef ATTN_STORE16
#define ATTN_STORE16(p,v) (*(u32x4*)(p)=(v))
#endif
template<int THRL> __device__ __forceinline__ void attn_unit(int rowbase_,int T_,int h,int qb,const bf16*Q,const bf16*__restrict__ K,const bf16*__restrict__ V,bf16*O,char*shm){
  const int tid=threadIdx.x,lane=tid&63,r32=lane&31,hi=lane>>5; const int wid=__builtin_amdgcn_readfirstlane(tid>>6);
  const long rowbase=(long)rowbase_; const int q0=qb*QB; const int kvh=h>>2;
  const bf16*Qw=Q+(rowbase+q0+wid*QBLK)*QP+h*D;
  const bf16*Kh=K+rowbase*KP+kvh*D,*Vh=V+rowbase*KP+kvh*D;
  const unsigned lds0=(unsigned)(uintptr_t)shm;
  float*wsf=(float*)(shm+LDS_WS)+wid*64;
  const bf16*ksrc=Kh+(long)lane*KP+wid*8;
  const bf16*vsrc=Vh+(long)(16*(wid&3)+(lane>>2))*KP+(wid>>2)*32+(lane&3)*8;
  const unsigned kdst=lds0+LDS_K+wid*1024, vdst=lds0+LDS_V+wid*1024;
  #define DMA_K(t,slot) glds16(ksrc+(long)(t)*KVBLK*KP,(unsigned)__builtin_amdgcn_readfirstlane(kdst+(slot)))
  #define DMA_V(t,slot) glds16(vsrc+(long)(t)*KVBLK*KP,(unsigned)__builtin_amdgcn_readfirstlane(vdst+(slot)))
  const int vb0=(int)(lds0+LDS_V)+((lane>>4)&1)*32+(lane&3)*8+(4*hi+((lane&15)>>2))*64;
  const char*Kbase=shm+LDS_K; bf16x8 kf[8];
  const lds_cptr shm3=(lds_cptr)shm; const lds_cptr kp0=shm3+LDS_K+hi*1024+r32*16; const lds_cptr vp0=shm3+LDS_V+((lane>>4)&1)*32+(lane&3)*8+(4*hi+((lane&15)>>2))*64;
  const int NT=T_/KVBLK;
  DMA_K(0,0);DMA_V(0,0);DMA_K(1,SLOTB);
  bf16x8 qr[4];
  #pragma unroll
  for(int d0=0;d0<4;++d0)qr[d0]=*reinterpret_cast<const bf16x8*>(&Qw[(long)r32*QP+d0*16+hi*8]);
  float mhat=0.f,l_reg=0.f;f32x16 o[2];o[0]=f32x16{};o[1]=f32x16{};f32x16 negm=f32x16{};
#if !ATTN_NOMAX
  asm volatile("":"+v"(negm));
#endif

  const int qrel=wid*QBLK+r32;
  #define CMASK(P0,P1,t) do{}while(0)
  bool resc=false;
#if ATTN_NOMAX
  #define START(P0,P1) do{ _Pragma("unroll") for(int r=0;r<16;++r)P0[r]=__builtin_amdgcn_exp2f(P0[r]); }while(0)
#else
  #define START(P0,P1) do{ const float rm=rowmax(P0,P1); resc=false; \
    { const float dl=rm; mhat=fadd_s(mhat,dl); \
      _Pragma("unroll") for(int r=0;r<16;++r){P0[r]=fsub_s(P0[r],dl);P1[r]=fsub_s(P1[r],dl);} \
      _Pragma("unroll") for(int r=0;r<16;++r)negm[r]=-mhat; asm volatile("":"+v"(negm)); } \
    _Pragma("unroll") for(int r=0;r<16;++r)P0[r]=__builtin_amdgcn_exp2f(P0[r]); }while(0)
#endif
#if ATTN_NOMAX
  #define RESC() do{}while(0)
#else
  #define RESC() do{ if(resc){ asm volatile("s_waitcnt lgkmcnt(0)":::"memory"); \
      _Pragma("unroll") for(int d_=0;d_<2;++d_) _Pragma("unroll") for(int r=0;r<16;++r)o[d_][r]*=wsf[crow(r,hi)]; } }while(0)
#endif
  f32x16 pA0,pA1,pB0,pB1;
  int sl_prev=0,sl_cur=0,sl_next=SLOTB;
  #define ROT() do{sl_prev=sl_cur;sl_cur=sl_next;sl_next=(sl_next==(NSLOT-1)*SLOTB)?0:sl_next+SLOTB;}while(0)
  DMA_K(2,2*SLOTB);
  WAIT_BAR(3);
  qkt(pA0,pA1,Kbase,qr,negm,r32,hi);asm volatile("s_nop 15\n\ts_nop 7":"+v"(pA0),"+v"(pA1));CMASK(pA0,pA1,0);
  START(pA0,pA1);
  _Pragma("unroll") for(int r=0;r<16;++r)pA1[r]=__builtin_amdgcn_exp2f(pA1[r]);
  WAIT_BAR(0);
  DMA_K(3,0);DMA_V(1,SLOTB);
  ROT();
  kload8(kf,kp0+sl_cur);
  WAIT_BAR(2);
  s16x4 vlo[8],vhi[8]; u32x4 pw0,pw1,pw2,pw3;
  #define PKW(P,B) cvtpk_s(P[B],P[B+1])
  #define PAF(k) __builtin_bit_cast(bf16x8,pw##k)
  #define VFR(i) (bf16x8){vlo[i][0],vlo[i][1],vlo[i][2],vlo[i][3],vhi[i][0],vhi[i][1],vhi[i][2],vhi[i][3]}
  #define PIN(x) asm volatile("":"+v"(x))
  #define MX3(a,b,c) __builtin_fmaxf(__builtin_fmaxf((a),(b)),(c))
  #define GAPA(MF,A0,A1,A2,A3,W0,W1,PW) do{ MF; sacc+=A0; sacc+=A1; sacc+=A2; sacc+=A3; PIN(sacc); W0; W1; PIN(PW); SBAR(); }while(0)
  #define EX(v) __builtin_amdgcn_exp2f(v)
  #define GAPB(MF,X,B) do{ MF; X[B]=EX(X[B]); X[B+1]=EX(X[B+1]); X[B+2]=EX(X[B+2]); X[B+3]=EX(X[B+3]); PIN(X); SBAR(); }while(0)
  #define VRD(i) do{ vlo[i]=vtr(vp_+(((i)>>2)*4096+((i)&3)*1024)); vhi[i]=vtr(vp_+(((i)>>2)*4096+((i)&3)*1024+512)); }while(0)
  #define KRD(G,j) do{ if(G){ kload2(kf,kp0+sl_next,j); SBAR(); } }while(0)
#if ATTN_NOMAX
  #define MAXBLOCK(C0,C1) do{}while(0)
#else
  #define MAXBLOCK(C0,C1) \
    { float a=MX3(C0[0],C0[1],C1[0]),b=MX3(C0[2],C0[3],C1[1]); a=MX3(a,C1[2],C1[3]); \
      _Pragma("unroll") for(int r=4;r<16;r+=4){a=MX3(a,C0[r],C0[r+1]);b=MX3(b,C0[r+2],C0[r+3]);a=MX3(a,C1[r],C1[r+1]);b=MX3(b,C1[r+2],C1[r+3]);} \
      float rm=__builtin_fmaxf(a,b); { auto rr=__builtin_amdgcn_permlane32_swap(__float_as_uint(rm),__float_as_uint(rm),false,false); rm=__builtin_fmaxf(__uint_as_float(rr[0]),__uint_as_float(rr[1])); } \
      resc=false; \
      if(__builtin_expect(__any(rm>(float)THRL),0)){ const float dl=__builtin_fmaxf(rm,0.f); mhat+=dl; \
        _Pragma("unroll") for(int r=0;r<16;++r){C0[r]-=dl;C1[r]-=dl;} \
        _Pragma("unroll") for(int r=0;r<16;++r)negm[r]=-mhat; asm volatile("":"+v"(negm)); \
        const float f=__builtin_amdgcn_exp2f(-dl); l_reg*=f; if(hi==0)wsf[r32]=f; resc=true; } }
#endif
  #define STEP(C0,C1,P0,P1,t,GK,GV,GL) do{ SBAR(); \
    const lds_cptr vp_=vp0+sl_prev; \
    VRD(0); SBAR(); float sacc=(P0[0]+P0[1]); \
    GAPA(C0=__builtin_amdgcn_mfma_f32_32x32x16_bf16(kf[0],qr[0],negm,0,0,0), P0[2],P0[3],P0[4],P0[5],     pw0[0]=PKW(P0,0), pw0[1]=PKW(P0,2), pw0); \
    VRD(4); SBAR(); GAPA(C1=__builtin_amdgcn_mfma_f32_32x32x16_bf16(kf[1],qr[0],negm,0,0,0), P0[6],P0[7],P0[8],P0[9],     pw0[2]=PKW(P0,4), pw0[3]=PKW(P0,6), pw0); \
    VRD(1); SBAR(); GAPA(C0=__builtin_amdgcn_mfma_f32_32x32x16_bf16(kf[2],qr[1],C0,0,0,0),   P0[10],P0[11],P0[12],P0[13], pw1[0]=PKW(P0,8), pw1[1]=PKW(P0,10), pw1); \
    VRD(5); SBAR(); GAPA(C1=__builtin_amdgcn_mfma_f32_32x32x16_bf16(kf[3],qr[1],C1,0,0,0),   P0[14],P0[15],P1[0],P1[1],   pw1[2]=PKW(P0,12),pw1[3]=PKW(P0,14), pw1); \
    VRD(2); SBAR(); GAPA(C0=__builtin_amdgcn_mfma_f32_32x32x16_bf16(kf[4],qr[2],C0,0,0,0),   P1[2],P1[3],P1[4],P1[5],     pw2[0]=PKW(P1,0), pw2[1]=PKW(P1,2), pw2); \
    VRD(6); SBAR(); GAPA(C1=__builtin_amdgcn_mfma_f32_32x32x16_bf16(kf[5],qr[2],C1,0,0,0),   P1[6],P1[7],P1[8],P1[9],     pw2[2]=PKW(P1,4), pw2[3]=PKW(P1,6), pw2); \
    VRD(3); SBAR(); GAPA(C0=__builtin_amdgcn_mfma_f32_32x32x16_bf16(kf[6],qr[3],C0,0,0,0),   P1[10],P1[11],P1[12],P1[13], pw3[0]=PKW(P1,8), pw3[1]=PKW(P1,10), pw3); \
    VRD(7); SBAR(); GAPA(C1=__builtin_amdgcn_mfma_f32_32x32x16_bf16(kf[7],qr[3],C1,0,0,0),   P1[14],P1[15],0.f,0.f,       pw3[2]=PKW(P1,12),pw3[3]=PKW(P1,14), pw3); \
    l_reg+=sacc; \
    if(GK){DMA_K((t)+3,sl_cur);} if(GV){DMA_V((t)+1,sl_next);} \
    CMASK(C0,C1,t); \
    MAXBLOCK(C0,C1); \
    SBAR(); \
    GAPB(o[0]=__builtin_amdgcn_mfma_f32_32x32x16_bf16(PAF(0),VFR(0),o[0],0,0,0), C0,0); \
    GAPB(o[1]=__builtin_amdgcn_mfma_f32_32x32x16_bf16(PAF(0),VFR(4),o[1],0,0,0), C0,4); \
    KRD(GL,0); GAPB(o[0]=__builtin_amdgcn_mfma_f32_32x32x16_bf16(PAF(1),VFR(1),o[0],0,0,0), C0,8); \
    KRD(GL,1); GAPB(o[1]=__builtin_amdgcn_mfma_f32_32x32x16_bf16(PAF(1),VFR(5),o[1],0,0,0), C0,12); \
    KRD(GL,2); GAPB(o[0]=__builtin_amdgcn_mfma_f32_32x32x16_bf16(PAF(2),VFR(2),o[0],0,0,0), C1,0); \
    KRD(GL,3); GAPB(o[1]=__builtin_amdgcn_mfma_f32_32x32x16_bf16(PAF(2),VFR(6),o[1],0,0,0), C1,4); \
    GAPB(o[0]=__builtin_amdgcn_mfma_f32_32x32x16_bf16(PAF(3),VFR(3),o[0],0,0,0), C1,8); \
    GAPB(o[1]=__builtin_amdgcn_mfma_f32_32x32x16_bf16(PAF(3),VFR(7),o[1],0,0,0), C1,12); \
    }while(0)
  int t=1;
  #undef CMASK
  #define CMASK(P0,P1,t) do{}while(0)
  for(;t+5<NT;t+=2){
    STEP(pB0,pB1,pA0,pA1,t,true,true,true);     WAIT_BAR(2); RESC(); ROT();
    STEP(pA0,pA1,pB0,pB1,t+1,true,true,true);   WAIT_BAR(2); RESC(); ROT();
  }
  #undef CMASK
  #define CMASK(P0,P1,t) do{}while(0)
  #define ENDW(tt) do{ if((tt)+3<NT){WAIT_BAR(2);} else if((tt)+2<NT){WAIT_BAR(1);} else {WAIT_BAR(0);} }while(0)
  for(;t+1<NT;t+=2){
    STEP(pB0,pB1,pA0,pA1,t,(t+3<NT),(t+1<NT),(t+1<NT));       ENDW(t);   RESC(); ROT();
    STEP(pA0,pA1,pB0,pB1,t+1,(t+4<NT),(t+2<NT),(t+2<NT));     ENDW(t+1); RESC(); ROT();
  }
  STEP(pB0,pB1,pA0,pA1,NT-1,false,false,false); RESC();
  { float sacc=pB0[0]+pB0[1]; _Pragma("unroll") for(int r=2;r<16;++r)sacc+=pB0[r]; _Pragma("unroll") for(int r=0;r<16;++r)sacc+=pB1[r]; l_reg+=sacc;
    pw0=(u32x4){PKW(pB0,0),PKW(pB0,2),PKW(pB0,4),PKW(pB0,6)};pw1=(u32x4){PKW(pB0,8),PKW(pB0,10),PKW(pB0,12),PKW(pB0,14)};pw2=(u32x4){PKW(pB1,0),PKW(pB1,2),PKW(pB1,4),PKW(pB1,6)};pw3=(u32x4){PKW(pB1,8),PKW(pB1,10),PKW(pB1,12),PKW(pB1,14)};
    SBAR(); pv(o,vb0+sl_cur,PAF(0),PAF(1),PAF(2),PAF(3)); }
  #undef PKW
  #undef PAF
  #undef VFR
  #undef PIN
  #undef MX3
  #undef GAPA
  #undef GAPB
  #undef EX
  #undef VRD
  #undef KRD
  #undef STEP
  #undef ENDW
  {auto rr=__builtin_amdgcn_permlane32_swap(__float_as_uint(l_reg),__float_as_uint(l_reg),false,false);l_reg=__uint_as_float(rr[0])+__uint_as_float(rr[1]);}
  if(hi==0)wsf[32+r32]=l_reg;asm volatile("s_waitcnt lgkmcnt(0)":::"memory");
  float rli[16];
  #pragma unroll
  for(int r=0;r<16;++r)rli[r]=__builtin_amdgcn_rcpf(wsf[32+crow(r,hi)]);
  bf16*Ow=O+(rowbase+q0+wid*QBLK)*OP+h*D;
  { bf16*stg=(bf16*)(shm+LDS_OST)+wid*2048;
    #pragma unroll
    for(int r=0;r<16;++r){const int orow=crow(r,hi);
      #pragma unroll
      for(int d0=0;d0<2;++d0)stg[orow*64+d0*32+r32]=__float2bfloat16(o[d0][r]*rli[r]);}
    asm volatile("s_waitcnt lgkmcnt(0)":::"memory");
    #pragma unroll
    for(int i=0;i<4;++i){const int row=i*8+(lane>>3),ch=lane&7; const u32x4 v=*(const u32x4*)(stg+row*64+ch*8); ATTN_STORE16(Ow+(long)row*OP+ch*8,v);} }
  asm volatile("s_waitcnt lgkmcnt(0)\n\ts_barrier":::"memory");
  #undef DMA_K
  #undef DMA_V
  #undef CMASK
  #undef START
  #undef RESC
  #undef ROT
}
constexpr int ATTN_LDS_BYTES=LDS_BYTES;
struct AttnTensors { const bf16* Q; const bf16* K; const bf16* V; bf16* O; };
template<int THRL=8> __device__ __forceinline__ void attn_phase(char*lds,const AttnTensors&T,int vcu,int G){
  if(G==256){
    const int x=vcu>>5,j=vcu&31;
    for(int i=0;i<4;++i){ const int w=j*4+i,g=w>>5,qb=w&31; attn_unit<THRL>(16384+(x>>1)*8192,8192,(x&1)*4+g,qb,T.Q,T.K,T.V,T.O,lds); }
    for(int i=0;i<2;++i){ const int w=j*2+i,g=w>>4,qb=w&15; attn_unit<THRL>((x>>1)*4096,4096,(x&1)*4+g,qb,T.Q,T.K,T.V,T.O,lds); }
  } else {
    for(int u=vcu;u<1536;u+=G){
      if(u<1024){ const int qb=u&31,h=(u>>5)&7,s=u>>8; attn_unit<THRL>(16384+s*8192,8192,h,qb,T.Q,T.K,T.V,T.O,lds); }
      else { const int v=u-1024,qb=v&15,h=(v>>4)&7,s=v>>7; attn_unit<THRL>(s*4096,4096,h,qb,T.Q,T.K,T.V,T.O,lds); }
    }
  }
}
#undef SBAR
#undef WAIT_BAR
}

__device__ __forceinline__ void sattn_unit(const Frame& F, int seq, int h, int qb) {
    const int T = seq < 4 ? TP : TS; const int rowbase = seq < 4 ? seq * TP : MP + (seq - 4) * TS;
    const bf16* Q = (const bf16*)(F.ws + WS_Q); const bf16* Kb = (const bf16*)(F.ws + WS_K); const bf16* Vb = (const bf16*)(F.ws + WS_V); bf16* MIX = (bf16*)(F.ws + WS_MIX);
    const int kvh = h >> 2, m = rowbase + qb * 512 + F.tid;
    LAS float* Ks = (LAS float*)F.lds; LAS float* Vs = Ks + 64 * 64;
    float q[64], o[64];
    { const u32x4* qp = (const u32x4*)(Q + (size_t)m * 512 + h * 64);
#pragma unroll
      for (int i = 0; i < 8; ++i) { const u32x4 w = qp[i]; q[8 * i] = bflo(w.x); q[8 * i + 1] = bfhi(w.x); q[8 * i + 2] = bflo(w.y); q[8 * i + 3] = bfhi(w.y); q[8 * i + 4] = bflo(w.z); q[8 * i + 5] = bfhi(w.z); q[8 * i + 6] = bflo(w.w); q[8 * i + 7] = bfhi(w.w); } }
#pragma unroll
    for (int d = 0; d < 64; ++d) o[d] = 0.f;
    float mx = -1e30f, l = 0.f;
    const int lr = F.tid >> 3, lc = (F.tid & 7) * 8;
    for (int kt = 0; kt < T / 64; ++kt) {
        __syncthreads();
        { const size_t grow = (size_t)(rowbase + kt * 64 + lr) * 128 + kvh * 64 + lc;
          const u32x4 kw = *(const u32x4*)(Kb + grow), vw = *(const u32x4*)(Vb + grow);
          LAS f32x4* kd = (LAS f32x4*)(Ks + lr * 64 + lc); LAS f32x4* vd = (LAS f32x4*)(Vs + lr * 64 + lc);
          kd[0] = (f32x4){bflo(kw.x), bfhi(kw.x), bflo(kw.y), bfhi(kw.y)}; kd[1] = (f32x4){bflo(kw.z), bfhi(kw.z), bflo(kw.w), bfhi(kw.w)};
          vd[0] = (f32x4){bflo(vw.x), bfhi(vw.x), bflo(vw.y), bfhi(vw.y)}; vd[1] = (f32x4){bflo(vw.z), bfhi(vw.z), bflo(vw.w), bfhi(vw.w)}; }
        __syncthreads();
#pragma unroll 1
        for (int j = 0; j < 64; ++j) {
            const LAS f32x4* Kc = (const LAS f32x4*)(Ks + j * 64); const LAS f32x4* Vc = (const LAS f32x4*)(Vs + j * 64);
            float a = 0.f;
#pragma unroll
            for (int d4 = 0; d4 < 16; ++d4) { const f32x4 kv = Kc[d4]; a += q[4 * d4] * kv.x + q[4 * d4 + 1] * kv.y + q[4 * d4 + 2] * kv.z + q[4 * d4 + 3] * kv.w; }
            const float mn = fmaxf(mx, a), alpha = exp2f(mx - mn), p = exp2f(a - mn); mx = mn; l = l * alpha + p;
#pragma unroll
            for (int d4 = 0; d4 < 16; ++d4) { const f32x4 vv = Vc[d4]; o[4 * d4] = o[4 * d4] * alpha + p * vv.x; o[4 * d4 + 1] = o[4 * d4 + 1] * alpha + p * vv.y; o[4 * d4 + 2] = o[4 * d4 + 2] * alpha + p * vv.z; o[4 * d4 + 3] = o[4 * d4 + 3] * alpha + p * vv.w; }
        }
    }
    const float il = 1.0f / l;
    u32x4* op = (u32x4*)(MIX + (size_t)m * DM + h * 64);
#pragma unroll
    for (int i = 0; i < 8; ++i) { u32x4 w; w.x = pk2(o[8 * i] * il, o[8 * i + 1] * il); w.y = pk2(o[8 * i + 2] * il, o[8 * i + 3] * il); w.z = pk2(o[8 * i + 4] * il, o[8 * i + 5] * il); w.w = pk2(o[8 * i + 6] * il, o[8 * i + 7] * il); op[i] = w; }
}
__device__ __forceinline__ void sattn_phase(const Frame& F) {
    for (int u = F.vcu; u < 768; u += F.G) {
        if (u < 512) { const int qb = u & 15, h = (u >> 4) & 7, s = u >> 7; sattn_unit(F, 4 + s, h, qb); }
        else { const int v = u - 512, qb = v & 7, h = (v >> 3) & 7, s = v >> 6; sattn_unit(F, s, h, qb); }
    }
}
__device__ __forceinline__ void pool_phase(const Frame& F) {
    const bf16* U = (const bf16*)(F.ws + WS_U); bf16* MIX = (bf16*)(F.ws + WS_MIX);
    LAS u32x4* T = (LAS u32x4*)F.lds;
    const int g = F.wave & 3, half = 1 << g, ch = 16 * g + (F.lane & 15), rbase = 32 * (F.wave >> 2) + (F.lane >> 4);
    for (int u = F.vcu; u < M / 64; u += F.G) {
        const int r0 = u * 64, Tlen = r0 < MP ? TP : TS, t0 = tpos(r0);
        __syncthreads();
#pragma unroll
        for (int i = 0; i < 10; ++i) { const int e = F.tid + 512 * i, rr = e >> 6, cc = e & 63, t = t0 - 8 + rr;
            if (t >= 0 && t < Tlen) T[e] = *(const u32x4*)(U + (size_t)(r0 - 8 + rr) * 512 + cc * 8); }
        __syncthreads();
#pragma unroll 2
        for (int i = 0; i < 8; ++i) {
            const int r = rbase + 4 * i, t = t0 + r, lo = max(t - half, 0), hi = min(t + half, Tlen);
            float a[8];
#pragma unroll
            for (int k = 0; k < 8; ++k) a[k] = 0.f;
            for (int j = lo; j < hi; ++j) { const u32x4 w = T[(j - t0 + 8) * 64 + ch];
                a[0] += bflo(w.x); a[1] += bfhi(w.x); a[2] += bflo(w.y); a[3] += bfhi(w.y); a[4] += bflo(w.z); a[5] += bfhi(w.z); a[6] += bflo(w.w); a[7] += bfhi(w.w); }
            const float inv = 1.0f / (float)(hi - lo);
            const u32x4 w = T[(r + 8) * 64 + ch];
            u32x4 o; o.x = pk2(a[0] * inv - bflo(w.x), a[1] * inv - bfhi(w.x)); o.y = pk2(a[2] * inv - bflo(w.y), a[3] * inv - bfhi(w.y));
            o.z = pk2(a[4] * inv - bflo(w.z), a[5] * inv - bfhi(w.z)); o.w = pk2(a[6] * inv - bflo(w.w), a[7] * inv - bfhi(w.w));
            *(u32x4*)(MIX + (size_t)(r0 + r) * DM + 512 + ch * 8) = o;
        }
    }
    __syncthreads();
}
__device__ __forceinline__ void final_phase(const Frame& F, const float* src, float* out, const float* g) {
    const int gw = F.vcu * NWAVES + F.wave, NGW = F.G * NWAVES; const f32x4* gr = (const f32x4*)g + F.lane;
    for (int m = gw; m < M; m += NGW) {
        const f32x4* xs = (const f32x4*)(src + (size_t)m * DM) + F.lane; f32x4* xr = (f32x4*)(out + (size_t)m * DM) + F.lane; f32x4 v[4]; float s = 0.f;
#pragma unroll
        for (int j = 0; j < 4; ++j) { v[j] = xs[64 * j]; s += (v[j].x * v[j].x + v[j].y * v[j].y) + (v[j].z * v[j].z + v[j].w * v[j].w); }
        const float rstd = 1.0f / sqrtf(wave_sum(s) * (1.f / DM) + EPS);
#pragma unroll
        for (int j = 0; j < 4; ++j) xr[64 * j] = v[j] * rstd * gr[64 * j];
    }
}


constexpr int CW_BAR = 4096;
constexpr int LDSCTL_OFF = 131072, MISC_OFF = LDSCTL_OFF + 320;
#define XB_TMO      128
#define XB_XCNT(j)  (256  + 64 * (j))
#define XB_XSUB(j)  (1280 + 64 * (j))
#define XB_XGEN(j)  (2304 + 64 * (j))
#define XB_TOP      3328
#define XB_TOPGEN   3392
#define XCD_BAR_WORDS 3456
#define XB_SPIN_CAP (1u << 20)
__device__ __forceinline__ unsigned xb_ld(unsigned* p)              { return __hip_atomic_load(p, __ATOMIC_RELAXED, __HIP_MEMORY_SCOPE_AGENT); }
__device__ __forceinline__ unsigned xb_add(unsigned* p, unsigned v) { return __hip_atomic_fetch_add(p, v, __ATOMIC_RELAXED, __HIP_MEMORY_SCOPE_AGENT); }
__device__ __forceinline__ unsigned xb_xcc_id() { return (unsigned)__builtin_amdgcn_s_getreg((3 << 11) | 20) & 0xFu; }
#define XB_SPIN(cond, bar) do { unsigned _sp = 0; while (cond) { __builtin_amdgcn_s_sleep(1); \
    if ((++_sp & 255u) == 0u) { if (xb_ld(&(bar)[XB_TMO])) break; if (_sp > XB_SPIN_CAP) { atomicAdd(&(bar)[XB_TMO], 1u); break; } } } } while (0)
struct XcdBarrier { unsigned* bar; unsigned x; volatile LAS unsigned* st; };
__device__ __forceinline__ XcdBarrier xcd_barrier_post(unsigned* bar, volatile LAS unsigned* st) {
    XcdBarrier b; b.bar = bar; b.x = xb_xcc_id(); b.st = st;
    if (threadIdx.x == 0) (void)xb_add(&bar[XB_XCNT(b.x)], 1u);
    return b;
}
__device__ __forceinline__ void xcd_barrier_complete(unsigned* bar, unsigned x, unsigned& nloc, unsigned& nx) {
    const unsigned G = gridDim.x * gridDim.y * gridDim.z;
    unsigned sum, cnt, mine, sp = 0u;
    for (;;) {
        sum = 0u; cnt = 0u; mine = 0u;
#pragma unroll
        for (unsigned j = 0; j < 16; ++j) { const unsigned c = xb_ld(&bar[XB_XCNT(j)]); sum += c; cnt += (c > 0u) ? 1u : 0u; mine = (j == x) ? c : mine; }
        if (sum == G) break;
        __builtin_amdgcn_s_sleep(1);
        if ((++sp & 255u) == 0u) { if (xb_ld(&bar[XB_TMO])) break; if (sp > XB_SPIN_CAP) { atomicAdd(&bar[XB_TMO], 1u); break; } }
    }
    nloc = mine > 0u ? mine : 1u; nx = cnt > 0u ? cnt : 1u;
}
__device__ __forceinline__ void xcd_barrier(const XcdBarrier& b) {
    asm volatile("s_waitcnt vmcnt(0)" ::: "memory");
    __syncthreads();
    if (threadIdx.x == 0) {
        unsigned* bar = b.bar;
        __builtin_amdgcn_s_waitcnt(0);
        unsigned nloc = b.st[0], nx = b.st[1];
        if (nloc == 0u) { xcd_barrier_complete(bar, b.x, nloc, nx); b.st[0] = nloc; b.st[1] = nx; }
        const unsigned old = xb_add(&bar[XB_XSUB(b.x)], 1u);
        const unsigned gen = old / nloc;
        if (old + 1u == (gen + 1u) * nloc) {
            __builtin_amdgcn_fence(__ATOMIC_RELEASE, "agent");
            asm volatile("s_waitcnt vmcnt(0)" ::: "memory");
            const unsigned og = xb_add(&bar[XB_TOP], 1u);
            const unsigned tg = og / nx;
            if (og + 1u == (tg + 1u) * nx) xb_add(&bar[XB_TOPGEN], 1u);
            else XB_SPIN(xb_ld(&bar[XB_TOPGEN]) == tg, bar);
            __builtin_amdgcn_fence(__ATOMIC_ACQUIRE, "agent");
            xb_add(&bar[XB_XGEN(b.x)], 1u);
            asm volatile("s_waitcnt vmcnt(0)" ::: "memory");
        } else {
            XB_SPIN(xb_ld(&bar[XB_XGEN(b.x)]) == gen, bar);
            __builtin_amdgcn_fence(__ATOMIC_ACQUIRE, "agent");
            asm volatile("s_waitcnt vmcnt(0)" ::: "memory");
        }
    }
    __syncthreads();
}


template <class E>
__device__ __forceinline__ void fgemm(const Frame& F, const bf16* A, const bf16* Bt, int Mrows, int N, int K, int row0, const E& e) {
    pg8::Gemm g{A, Bt, Mrows, N, K}; pg8::StaticOrder S; S.init(Mrows, N, F.G, (int)blockIdx.x);
    pg8::EpiAdapt<E> EA{e, row0};
    pg8::gemm_phase<pg8::EpiAdapt<E>, pg8::StaticOrder, true, true>(F.lds, g, S, EA);
}

constexpr int CW_GRP = 8192;
constexpr int CW_GRP_TMO = 8192 + 64 * 64;
__device__ __forceinline__ void group_sync(unsigned* cnt, unsigned target, unsigned* tmo) {
    asm volatile("s_waitcnt vmcnt(0)" ::: "memory");
    __syncthreads();
    if (threadIdx.x == 0) {
        __builtin_amdgcn_fence(__ATOMIC_RELEASE, "agent");
        asm volatile("s_waitcnt vmcnt(0)" ::: "memory");
        (void)xb_add(cnt, 1u);
        unsigned sp = 0u;
        while (xb_ld(cnt) < target) { __builtin_amdgcn_s_sleep(1); if (++sp > (1u << 21)) { atomicAdd(tmo, 1u); break; } }
        __builtin_amdgcn_fence(__ATOMIC_ACQUIRE, "agent");
        asm volatile("s_waitcnt vmcnt(0)" ::: "memory");
    }
    __syncthreads();
}
__device__ __forceinline__ f32x4 ld_bf16x4(const bf16* p) { const u32x2 w = *(const u32x2*)p; return (f32x4){bflo(w.x), bfhi(w.x), bflo(w.y), bfhi(w.y)}; }
__device__ __forceinline__ float ssq8(f32x4 a, f32x4 b) { return ((a[0] * a[0] + a[1] * a[1]) + (a[2] * a[2] + a[3] * a[3])) + ((b[0] * b[0] + b[1] * b[1]) + (b[2] * b[2] + b[3] * b[3])); }
struct EpiResA {
    const float* x0; const float* x1; bf16* HB; float* SS;
    __device__ __forceinline__ void seg64(int m, int c0, f32x4 (&v)[4], int fq) const {
        const float* b = (m < MP ? x0 + (size_t)m * DM : x1 + (size_t)(m - MP) * DM) + c0 + 8 * fq;
        bf16* hb = HB + (size_t)m * DM + c0 + 8 * fq; float ss = 0.f;
#pragma unroll
        for (int h = 0; h < 2; ++h) { const f32x4 h0 = *(const f32x4*)(b + 32 * h) + v[2 * h], h1 = *(const f32x4*)(b + 32 * h + 4) + v[2 * h + 1]; st_bf16x8(hb + 32 * h, h0, h1); ss += ssq8(h0, h1); }
        ss = quad_sum(ss);
        if (fq == 0) SS[(size_t)m * 16 + (c0 >> 6)] = ss;
    }
};
struct EpiResC {
    bf16* HB; float* SS;
    __device__ __forceinline__ void seg64(int m, int c0, f32x4 (&v)[4], int fq) const {
        bf16* hb = HB + (size_t)m * DM + c0 + 8 * fq; float ss = 0.f;
#pragma unroll
        for (int h = 0; h < 2; ++h) { f32x4 h0, h1; ld_bf16x8(hb + 32 * h, h0, h1); h0 = h0 + v[2 * h]; h1 = h1 + v[2 * h + 1]; st_bf16x8(hb + 32 * h, h0, h1); ss += ssq8(h0, h1); }
        ss = quad_sum(ss);
        if (fq == 0) SS[(size_t)m * 16 + (c0 >> 6)] = ss;
    }
};
struct EpiUpP {
    bf16* HM; const LAS float* rs; int row0;
    __device__ __forceinline__ void seg64(int m, int c0, f32x4 (&v)[4], int fq) const {
        const float rstd = rs[m - row0];
        bf16* d = HM + (size_t)(m - row0) * DFF + c0 + 8 * fq;
#pragma unroll
        for (int h = 0; h < 2; ++h) { f32x4 a = v[2 * h] * rstd, b = v[2 * h + 1] * rstd;
#pragma unroll
            for (int j = 0; j < 4; ++j) { const float r = fmaxf(a[j], 0.f), q = fmaxf(b[j], 0.f); a[j] = r * r; b[j] = q * q; }
            st_bf16x8(d + 32 * h, a, b); }
    }
};
struct EpiBfP {
    bf16* O; int ld;
    __device__ __forceinline__ void seg64(int m, int c0, f32x4 (&v)[4], int fq) const {
        bf16* d = O + (size_t)m * ld + c0 + 8 * fq;
        st_bf16x8(d, v[0], v[1]); st_bf16x8(d + 32, v[2], v[3]);
    }
};
namespace pg8 {
struct EpiGateFinal {
    static constexpr bool PERM = true, AFTER_DRAIN = true;
    const bf16* HB; const bf16* PP; const float* SS2; float* SS3; float* out; const float* fg; unsigned* cnt; unsigned target; unsigned* tmo; int row0;
    __device__ __forceinline__ void fused(f32x4 (&acc)[2][2][4][2], const Unit& u, int wr, int wc, int fr, int fq, PG8_LAS unsigned char* lds, int wid, int lane) const {
        const int c0 = u.pn * BM + wc * 64;
#pragma unroll
        for (int ai = 0; ai < 2; ++ai)
#pragma unroll
            for (int m = 0; m < 4; ++m) {
                const int row = row0 + ai * HALF + wr * 64 + m * 16 + fr;
                const float rstd = ((const PG8_LAS float*)(lds + RSTD_OFF))[row - row0];
                const bf16* hb = HB + (size_t)row * DM + c0 + 8 * fq; const bf16* pp = PP + (size_t)row * DM + c0 + 8 * fq; float ss = 0.f;
#pragma unroll
                for (int bj = 0; bj < 2; ++bj) { ::f32x4 hv[2], pv[2]; ld_bf16x8(hb + 32 * bj, hv[0], hv[1]); ld_bf16x8(pp + 32 * bj, pv[0], pv[1]);
#pragma unroll
                    for (int n = 0; n < 2; ++n) { const ::f32x4 a = acc[ai][bj][m][n]; ::f32x4 h;
#pragma unroll
                        for (int e = 0; e < 4; ++e) h[e] = hv[n][e] + pv[n][e] / (1.0f + __expf(-a[e] * rstd));
                        acc[ai][bj][m][n] = h; ss += (h[0] * h[0] + h[1] * h[1]) + (h[2] * h[2] + h[3] * h[3]); } }
                ss = quad_sum(ss);
                if (fq == 0) SS3[(size_t)row * 16 + (c0 >> 6)] = ss;
                if (m & 1) asm volatile("" ::: "memory");
            }
        group_sync(cnt, target, tmo);
        if (threadIdx.x < 256) ((PG8_LAS float*)(lds + RSTD_OFF))[threadIdx.x] = rstd_from_ss(SS3 + (size_t)(row0 + threadIdx.x) * 16);
        __syncthreads();
#pragma unroll
        for (int ai = 0; ai < 2; ++ai)
#pragma unroll
            for (int m = 0; m < 4; ++m) {
                const int row = row0 + ai * HALF + wr * 64 + m * 16 + fr;
                const float rstd = ((const PG8_LAS float*)(lds + RSTD_OFF))[row - row0];
                float* o = out + (size_t)row * DM + c0 + 8 * fq; const float* g = fg + c0 + 8 * fq;
#pragma unroll
                for (int bj = 0; bj < 2; ++bj)
#pragma unroll
                    for (int n = 0; n < 2; ++n) *(::f32x4*)(o + 32 * bj + 4 * n) = acc[ai][bj][m][n] * rstd * *(const ::f32x4*)(g + 32 * bj + 4 * n);
                if (m & 1) asm volatile("" ::: "memory");
            }
    }
};
struct ListOrder {
    int pn0, n;
    __device__ __forceinline__ bool next(int i, Unit& u) const { if (i >= n) return false; u.pm = 0; u.pn = pn0 + i; return true; }
    __device__ __forceinline__ void a_ready(const Unit&) const {}
    __device__ __forceinline__ void done(const Unit&) const {}
};
}
template <class E>
__device__ __forceinline__ void lgemm(const Frame& F, const bf16* A, const bf16* Bt, int N, int K, int row0, int pn0, int n, const E& e) {
    pg8::Gemm g{A, Bt, 256, N, K}; pg8::ListOrder S{pn0, n};
    pg8::EpiAdapt<E, true> EA{e, row0};
    pg8::gemm_phase<pg8::EpiAdapt<E, true>, pg8::ListOrder, true, true>(F.lds, g, S, EA);
}
__device__ __forceinline__ void tail_phase(const Frame& F, const Args& args) {
    const int gidx = F.vcu >> 2, mem = F.vcu & 3;
    unsigned nsync = 0u;
#pragma unroll 1
    for (int c = 0; c < 4; ++c) {
        unsigned char* ws = F.ws; asm volatile("" : "+s"(ws));
        bf16* HB = (bf16*)(ws + WS_XN); const bf16* PP = (const bf16*)(ws + WS_PP); const bf16* MIX = (const bf16*)(ws + WS_MIX);
        float* SS1 = (float*)(ws + WS_SS1); float* SS2 = (float*)(ws + WS_SS2);
        bf16* HMg = (bf16*)(ws + WS_HM) + (size_t)gidx * 256 * DFF;
        unsigned* cnt = (unsigned*)(ws + WS_CTL) + CW_GRP + 64 * gidx; unsigned* tmo = (unsigned*)(ws + WS_CTL) + CW_GRP_TMO;
        const LAS float* rs = (const LAS float*)(F.lds + RSTD_OFF);
        const bf16* PB = (const bf16*)(ws + WS_PB); bf16* PPw = (bf16*)(ws + WS_PP);
        const int row0 = (c * 64 + gidx) * 256, rowp = row0 - 64 * 256;
        if (c < 3) { EpiResA E{args.in[0], args.in[1], HB, SS1}; lgemm(F, MIX + (size_t)row0 * DM, (const bf16*)(ws + WS_WOUT), DM, DM, row0, mem, 1, E); }
        if (c > 0) {
            { EpiBfP E{PPw, DM}; lgemm(F, PB + (size_t)rowp * PLE, (const bf16*)(ws + WS_WPROJ), DM, PLE, rowp, mem, 1, E); }
            rstd_table(F, SS2, rowp);
            pg8::Gemm g{HB + (size_t)rowp * DM, (const bf16*)(ws + WS_WGATE), 256, DM, DM}; pg8::ListOrder S{mem, 1};
            pg8::EpiGateFinal E{HB, PP, SS2, SS1, args.out, args.in[17], cnt, 4u * (++nsync), tmo, rowp};
            pg8::gemm_phase<pg8::EpiGateFinal, pg8::ListOrder, false, true>(F.lds, g, S, E);
        }
        if (c < 3) {
            if (c == 0) group_sync(cnt, 4u * (++nsync), tmo);
            rstd_table(F, SS1, row0);
            { EpiUpP E{HMg, rs, row0}; lgemm(F, HB + (size_t)row0 * DM, (const bf16*)(ws + WS_WUP), DFF, DM, row0, 4 * mem, 4, E); }
            group_sync(cnt, 4u * (++nsync), tmo);
            { EpiResC E{HB, SS2}; lgemm(F, HMg, (const bf16*)(ws + WS_WDOWN), DM, DFF, row0, mem, 1, E); }
            group_sync(cnt, 4u * (++nsync), tmo);
        }
    }
}

constexpr int NPHASE = 4;
__global__ void __launch_bounds__(NWAVES * 64, 2) fwd_kernel(Args args) {
    extern __shared__ __attribute__((aligned(16))) unsigned char lds[];
    Frame F;
    F.lds = (LAS unsigned char*)lds; F.tid = threadIdx.x; F.lane = F.tid & 63; F.wave = __builtin_amdgcn_readfirstlane(F.tid >> 6);
    F.G = gridDim.x; { const int bx = blockIdx.x; F.vcu = (F.G % 8 == 0) ? (bx % 8) * (F.G / 8) + bx / 8 : bx; }
    F.ws = args.ws;
    unsigned char* ws = args.ws;
    for (int u = F.tid; u < (LDS_BYTES - LDSCTL_OFF) / 4; u += NWAVES * 64) ((LAS unsigned*)(F.lds + LDSCTL_OFF))[u] = 0u;
    __syncthreads();
    XcdBarrier bar; bar.bar = (unsigned*)(ws + WS_CTL) + CW_BAR; bar.x = 0; bar.st = nullptr;
    if (args.ph_hi - args.ph_lo > 1) bar = xcd_barrier_post((unsigned*)(ws + WS_CTL) + CW_BAR, (volatile LAS unsigned*)(F.lds + MISC_OFF) + 8);
    bf16* XN = (bf16*)(ws + WS_XN); bf16* PP = (bf16*)(ws + WS_PP); bf16* MIX = (bf16*)(ws + WS_MIX); bf16* HM = (bf16*)(ws + WS_HM);
    float* SS1 = (float*)(ws + WS_SS1); float* SS2 = (float*)(ws + WS_SS2);
    const int lo = args.ph_lo, hi = args.ph_hi;
#define IN(k) (lo <= (k) && (k) < hi)
#define SEAM(k) do { if (IN(k) && IN((k) + 1)) xcd_barrier(bar); } while (0)
#define NREP(k) ((PROBE_REPEAT == (k)) ? 2 : 1)
#define REPBAR() do { if (rep) xcd_barrier(bar); } while (0)
    float* const dry = (float*)(ws + WS_HM);
    if (IN(0)) {
#pragma unroll 1
        for (int rep = 0; rep < NREP(0); ++rep) { REPBAR(); p0_prologue(F, args); } } SEAM(0);
    if (IN(1)) {
#pragma unroll 1
        for (int rep = 0; rep < NREP(1); ++rep) { REPBAR();
        EpiIn E{(bf16*)(ws + WS_Q), (bf16*)(ws + WS_K), (bf16*)(ws + WS_V), (bf16*)(ws + WS_U), args.in[6], args.in[7], (const float2*)(ws + WS_ROPE)};
        fgemm(F, XN, (const bf16*)(ws + WS_WIN), M, INW, DM, 0, E); }
    } SEAM(1);
    if (IN(2)) {
        const attn_body::AttnTensors AT{(const attn_body::bf16*)(ws + WS_Q), (const attn_body::bf16*)(ws + WS_K), (const attn_body::bf16*)(ws + WS_V), (attn_body::bf16*)MIX};
#pragma unroll 1
        for (int rep = 0; rep < NREP(2); ++rep) { REPBAR(); attn_body::attn_phase<8>((char*)lds, AT, F.vcu, F.G); }
#pragma unroll 1
        for (int rep = 0; rep < NREP(12); ++rep) { REPBAR(); pool_phase(F); }
    } SEAM(2);
    if (IN(3)) tail_phase(F, args);
#undef NREP
#undef REPBAR
#undef IN
#undef SEAM
}

extern "C" void kernel_launch(void* const* d_in, const int* in_sizes, int n_in, void* d_out, int out_size, void* d_ws, size_t ws_size, hipStream_t stream) {
    static int grid = 0;
    if (grid == 0) {
        if (n_in != 18 || out_size != M * DM || ws_size < WS_END) { fprintf(stderr, "kernel_launch: unexpected shapes (n_in %d out %d ws %zu)\n", n_in, out_size, ws_size); grid = -1; return; }
        if (hipFuncSetAttribute((const void*)fwd_kernel, hipFuncAttributeMaxDynamicSharedMemorySize, LDS_BYTES) != hipSuccess) { fprintf(stderr, "kernel_launch: hipFuncSetAttribute failed\n"); grid = -1; return; }
        int dev = 0, cus = 0; (void)hipGetDevice(&dev); (void)hipDeviceGetAttribute(&cus, hipDeviceAttributeMultiprocessorCount, dev);
        grid = cus > 0 ? cus : 256;
    }
    if (grid < 0) return;
    Args a{};
    for (int i = 0; i < 18; ++i) a.in[i] = (const float*)d_in[i];
    a.out = (float*)d_out; a.ws = (unsigned char*)d_ws;
#if MK_ONE_LAUNCH
    if (hipMemsetAsync((char*)d_ws + WS_CTL, 0, 65536, stream) != hipSuccess) { fprintf(stderr, "kernel_launch: memset failed\n"); return; }
    a.ph_lo = 0; a.ph_hi = NPHASE; hipLaunchKernelGGL(fwd_kernel, dim3(grid), dim3(NWAVES * 64), LDS_BYTES, stream, a);
#else
    for (int ph = 0; ph < NPHASE; ++ph) { a.ph_lo = ph; a.ph_hi = ph + 1; hipLaunchKernelGGL(fwd_kernel, dim3(grid), dim3(NWAVES * 64), LDS_BYTES, stream, a); }
#endif
}
```

```cpp
#include <hip/hip_runtime.h>
#include <cstdio>
#include <cstdint>
#include <hip/hip_bf16.h>
#include <cmath>

#ifndef PROBE_REPEAT
#define PROBE_REPEAT (-1)
#endif
#ifndef TAIL_REP
#define TAIL_REP (-1)
#endif
#ifndef TAIL_CLS
#define TAIL_CLS 0
#endif
#ifndef ATTN_NOMAX
#define ATTN_NOMAX 1
#endif
#ifndef MK_ONE_LAUNCH
#define MK_ONE_LAUNCH 1
#endif

constexpr int DM = 1024, TP = 4096, TS = 8192, MP = 4 * TP, MS = 4 * TS, M = MP + MS;
constexpr int INW = 1280, DFF = 4096, PLE = 256;
constexpr int CHUNK = 16384, NCHUNK = M / CHUNK;
constexpr float EPS = 1e-6f;
constexpr float C2 = 0.125f * 1.4426950408889634f;

typedef unsigned short bf16;
typedef short bf16x8 __attribute__((ext_vector_type(8)));
typedef float f32x4 __attribute__((ext_vector_type(4)));
typedef unsigned u32x4 __attribute__((ext_vector_type(4)));
typedef unsigned u32x2 __attribute__((ext_vector_type(2)));
#define LAS __attribute__((address_space(3)))
#define GAS __attribute__((address_space(1)))

constexpr size_t MiB = 1u << 20;
constexpr size_t WS_CTL = 0, CTL_ZERO_BYTES = 1 * MiB;
constexpr size_t WS_ROPE = 1 * MiB;
constexpr size_t WS_SS1 = 2 * MiB, WS_SS2 = 5 * MiB;
constexpr size_t WS_WIN = 8 * MiB, WS_WOUT = 11 * MiB, WS_WUP = 13 * MiB, WS_WDOWN = 21 * MiB, WS_WGATE = 29 * MiB, WS_WPROJ = 31 * MiB;
constexpr size_t WS_PP = 32 * MiB;
constexpr size_t WS_XN = 128 * MiB;
constexpr size_t WS_PB = 464 * MiB;
constexpr size_t WS_Q = 248 * MiB, WS_K = 296 * MiB, WS_V = 308 * MiB, WS_U = 320 * MiB;
constexpr size_t WS_MIX = 368 * MiB;
constexpr size_t WS_HM = 224 * MiB;
constexpr size_t WS_END = 488 * MiB;

constexpr int LDS_BYTES = 147456;
constexpr int NWAVES = 8;

__device__ __forceinline__ unsigned f2bf(float f) { unsigned u = __builtin_bit_cast(unsigned, f); return (u + 0x7fffu + ((u >> 16) & 1u)) >> 16; }
__device__ __forceinline__ unsigned pk2(float lo, float hi) { return f2bf(lo) | (f2bf(hi) << 16); }
__device__ __forceinline__ float bf2f(unsigned short b) { return __builtin_bit_cast(float, (unsigned)b << 16); }
__device__ __forceinline__ float bflo(unsigned w) { return __builtin_bit_cast(float, w << 16); }
__device__ __forceinline__ float bfhi(unsigned w) { return __builtin_bit_cast(float, w & 0xffff0000u); }
typedef float f32x2_k __attribute__((ext_vector_type(2))); typedef __bf16 bf16x2_k __attribute__((ext_vector_type(2)));
__device__ __forceinline__ unsigned cvtpk(float lo, float hi) { f32x2_k v = {lo, hi}; bf16x2_k b = __builtin_convertvector(v, bf16x2_k); return __builtin_bit_cast(unsigned, b); }
__device__ __forceinline__ float wave_sum(float v) {
#pragma unroll
    for (int o = 1; o < 64; o <<= 1) v += __shfl_xor(v, o);
    return v;
}
__host__ __device__ __forceinline__ int inv_head(int n) { const int pn = n >> 8, r = n & 255, wc = r >> 6, bj = (r >> 5) & 1, j = r & 31; return pn * 256 + bj * 128 + wc * 32 + j; }

struct Args { const float* in[18]; float* out; unsigned char* ws; int ph_lo, ph_hi; };

struct Frame {
    LAS unsigned char* lds;
    int tid, lane, wave, vcu, G;
    unsigned char* ws;
};
__device__ __forceinline__ const float* xrow(const Args& A, int m) { return m < MP ? A.in[0] + (size_t)m * DM : A.in[1] + (size_t)(m - MP) * DM; }
__device__ __forceinline__ const float* prow(const Args& A, int m) { return m < MP ? A.in[2] + (size_t)m * PLE : A.in[3] + (size_t)(m - MP) * PLE; }
__device__ __forceinline__ int tpos(int m) { return m < MP ? (m & (TP - 1)) : ((m - MP) & (TS - 1)); }

__device__ __forceinline__ void p0_transpose_item(const float* W, int ldw, int K, int ncols, bf16* WT, LAS float* scr, int item, int lane, const float* kscale, bool headmap) {
    const int nblk = ncols / 32, kb = item / nblk, nb = item % nblk, k0 = 64 * kb, n0 = 32 * nb;
#pragma unroll 8
    for (int i = 0; i < 32; ++i) { const int kk = 2 * i + (lane >> 5); float v = W[(size_t)(k0 + kk) * ldw + n0 + (lane & 31)]; if (kscale) v *= kscale[k0 + kk]; scr[kk * 33 + (lane & 31)] = v; }
    asm volatile("s_waitcnt lgkmcnt(0)" ::: "memory");
    const int c = lane & 7;
#pragma unroll
    for (int j = 0; j < 4; ++j) { const int n = (lane >> 3) + 8 * j; const LAS float* s = scr + (8 * c) * 33 + n;
        u32x4 o; o.x = pk2(s[0 * 33], s[1 * 33]); o.y = pk2(s[2 * 33], s[3 * 33]); o.z = pk2(s[4 * 33], s[5 * 33]); o.w = pk2(s[6 * 33], s[7 * 33]);
        const int dr = headmap ? inv_head(n0 + n) : (n0 + n);
        *(u32x4*)(WT + (size_t)dr * K + k0 + 8 * c) = o; }
    asm volatile("s_waitcnt lgkmcnt(0)" ::: "memory");
}
__device__ __forceinline__ void p0_fold_item(const float* Win, const float* Wp, const float* psc, bf16* WT, LAS float* scr, int item, int lane) {
    const int g = item & 3, k0 = (item >> 2) * 16;
#pragma unroll
    for (int i = 0; i < 32; ++i) { const int e = i * 64 + lane, kk = e >> 7, c = e & 127; scr[e] = Win[(size_t)(k0 + kk) * INW + 768 + 128 * g + c]; }
    asm volatile("s_waitcnt lgkmcnt(0)" ::: "memory");
    float a0[16], a1[16];
#pragma unroll
    for (int kk = 0; kk < 16; ++kk) { a0[kk] = 0.f; a1[kk] = 0.f; }
    const float* wp = Wp + (size_t)g * 128 * 128;
    for (int c = 0; c < 128; ++c) {
        const float w0 = wp[c * 128 + lane], w1 = wp[c * 128 + 64 + lane];
#pragma unroll
        for (int kk = 0; kk < 16; ++kk) { const float a = scr[kk * 128 + c]; a0[kk] += a * w0; a1[kk] += a * w1; }
    }
    const float s0 = psc[128 * g + lane], s1 = psc[128 * g + 64 + lane];
    { u32x4 o0, o1; o0.x = pk2(a0[0] * s0, a0[1] * s0); o0.y = pk2(a0[2] * s0, a0[3] * s0); o0.z = pk2(a0[4] * s0, a0[5] * s0); o0.w = pk2(a0[6] * s0, a0[7] * s0);
      o1.x = pk2(a0[8] * s0, a0[9] * s0); o1.y = pk2(a0[10] * s0, a0[11] * s0); o1.z = pk2(a0[12] * s0, a0[13] * s0); o1.w = pk2(a0[14] * s0, a0[15] * s0);
      bf16* d = WT + (size_t)inv_head(768 + 128 * g + lane) * DM + k0; *(u32x4*)d = o0; *(u32x4*)(d + 8) = o1; }
    { u32x4 o0, o1; o0.x = pk2(a1[0] * s1, a1[1] * s1); o0.y = pk2(a1[2] * s1, a1[3] * s1); o0.z = pk2(a1[4] * s1, a1[5] * s1); o0.w = pk2(a1[6] * s1, a1[7] * s1);
      o1.x = pk2(a1[8] * s1, a1[9] * s1); o1.y = pk2(a1[10] * s1, a1[11] * s1); o1.z = pk2(a1[12] * s1, a1[13] * s1); o1.w = pk2(a1[14] * s1, a1[15] * s1);
      bf16* d = WT + (size_t)inv_head(768 + 128 * g + 64 + lane) * DM + k0; *(u32x4*)d = o0; *(u32x4*)(d + 8) = o1; }
    asm volatile("s_waitcnt lgkmcnt(0)" ::: "memory");
}
__device__ __forceinline__ void rms_row_to_bf16(const float* xr_, const float* g, bf16* orow, int lane) {
    const f32x4* xr = (const f32x4*)xr_ + lane; const f32x4* gr = (const f32x4*)g + lane;
    f32x4 v[4]; float s = 0.f;
#pragma unroll
    for (int j = 0; j < 4; ++j) { v[j] = xr[64 * j]; s += (v[j].x * v[j].x + v[j].y * v[j].y) + (v[j].z * v[j].z + v[j].w * v[j].w); }
    const float rstd = 1.0f / sqrtf(wave_sum(s) * (1.f / DM) + EPS);
    unsigned long long* o8 = (unsigned long long*)orow + lane;
#pragma unroll
    for (int j = 0; j < 4; ++j) { const f32x4 gg = gr[64 * j];
        o8[64 * j] = (unsigned long long)pk2(v[j].x * rstd * gg.x, v[j].y * rstd * gg.y) | ((unsigned long long)pk2(v[j].z * rstd * gg.z, v[j].w * rstd * gg.w) << 32); }
}
__device__ __forceinline__ void p0_prologue(const Frame& F, const Args& A) {
    LAS float* scr = (LAS float*)(F.lds + F.wave * 16384);
    const int gw = F.vcu * NWAVES + F.wave, NGW = F.G * NWAVES;
    bf16* Bin = (bf16*)(F.ws + WS_WIN); bf16* Bout = (bf16*)(F.ws + WS_WOUT); bf16* Bup = (bf16*)(F.ws + WS_WUP);
    bf16* Bdown = (bf16*)(F.ws + WS_WDOWN); bf16* Bgate = (bf16*)(F.ws + WS_WGATE); bf16* Bproj = (bf16*)(F.ws + WS_WPROJ);
    constexpr int I_FOLD = 64 * 4, I_IN = (DM / 64) * (768 / 32), I_OUT = (DM / 64) * (DM / 32), I_UP = (DM / 64) * (DFF / 32), I_DOWN = (DFF / 64) * (DM / 32), I_GATE = I_OUT, I_PROJ = (PLE / 64) * (DM / 32);
    constexpr int NITEMS = I_FOLD + I_IN + I_OUT + I_UP + I_DOWN + I_GATE + I_PROJ;
    for (int it = gw; it < NITEMS; it += NGW) {
        int r = it;
        if (r < I_FOLD) { p0_fold_item(A.in[5], A.in[8], A.in[9], Bin, scr, r, F.lane); continue; } r -= I_FOLD;
        if (r < I_IN) { p0_transpose_item(A.in[5], INW, DM, 768, Bin, scr, r, F.lane, nullptr, true); continue; } r -= I_IN;
        if (r < I_OUT) { p0_transpose_item(A.in[10], DM, DM, DM, Bout, scr, r, F.lane, nullptr, true); continue; } r -= I_OUT;
        if (r < I_UP) { p0_transpose_item(A.in[12], DFF, DM, DFF, Bup, scr, r, F.lane, A.in[11], true); continue; } r -= I_UP;
        if (r < I_DOWN) { p0_transpose_item(A.in[13], DM, DFF, DM, Bdown, scr, r, F.lane, nullptr, true); continue; } r -= I_DOWN;
        if (r < I_GATE) { p0_transpose_item(A.in[15], DM, DM, DM, Bgate, scr, r, F.lane, A.in[14], true); continue; } r -= I_GATE;
        p0_transpose_item(A.in[16], DM, PLE, DM, Bproj, scr, r, F.lane, nullptr, true);
    }
    bf16* XN = (bf16*)(F.ws + WS_XN); bf16* PB = (bf16*)(F.ws + WS_PB);
    constexpr int RIF = 4;
    for (int m = gw; m < M; m += RIF * NGW) {
        const f32x4* gr = (const f32x4*)A.in[4] + F.lane;
        f32x4 v[RIF][4], pv[RIF]; float rs[RIF];
#pragma unroll
        for (int r = 0; r < RIF; ++r) { const f32x4* xr = (const f32x4*)xrow(A, m + r * NGW) + F.lane;
#pragma unroll
            for (int j = 0; j < 4; ++j) v[r][j] = xr[64 * j];
            pv[r] = *((const f32x4*)prow(A, m + r * NGW) + F.lane); }
#pragma unroll
        for (int r = 0; r < RIF; ++r) { float q = 0.f;
#pragma unroll
            for (int j = 0; j < 4; ++j) q += (v[r][j].x * v[r][j].x + v[r][j].y * v[r][j].y) + (v[r][j].z * v[r][j].z + v[r][j].w * v[r][j].w);
            rs[r] = 1.0f / sqrtf(wave_sum(q) * (1.f / DM) + EPS); }
#pragma unroll
        for (int r = 0; r < RIF; ++r) { const int mr = m + r * NGW; u32x2* o = (u32x2*)(XN + (size_t)mr * DM) + F.lane;
#pragma unroll
            for (int j = 0; j < 4; ++j) { const f32x4 gg = gr[64 * j], w = v[r][j] * rs[r] * gg; u32x2 t; t.x = cvtpk(w.x, w.y); t.y = cvtpk(w.z, w.w); o[64 * j] = t; }
            u32x2 t; t.x = cvtpk(pv[r].x, pv[r].y); t.y = cvtpk(pv[r].z, pv[r].w); *((u32x2*)(PB + (size_t)mr * PLE) + F.lane) = t; }
    }
    { const int gt = F.vcu * 512 + F.tid;
      if (gt < 2048) { const int p = gt >> 4, i = gt & 15; const float inv = exp2f(-(float)i * (13.287712379549449f / 16.0f)); const float a = (float)p * inv;
          float2* R = (float2*)(F.ws + WS_ROPE); R[gt] = make_float2(cosf(a), sinf(a)); } }
}

namespace pg8 {
#define PG8_LAS __attribute__((address_space(3)))
typedef unsigned short bf16_t;
typedef short bf16x8 __attribute__((ext_vector_type(8)));
typedef float f32x4 __attribute__((ext_vector_type(4)));
typedef unsigned u32x4 __attribute__((ext_vector_type(4)));
constexpr int BM = 256, BK = 64, HALF = 128, HTB = HALF * BK * 2  , STAGE_BYTES = 8 * HTB, NXCD = 8, WGM = 8;

__host__ __device__ __forceinline__ int lds_byte(int r, int c) { const int st = (r >> 4) * 2 + (c >> 5), rr = r & 15, cc = c & 31, ob = rr * 64 + cc * 2; return st * 1024 + (ob ^ (((ob >> 9) & 1) << 5)); }
__host__ __device__ __forceinline__ void stage_rc(int b, int& R, int& C) { const int st = b / 1024, sb = b % 1024, swz = sb ^ (((sb >> 9) & 1) << 5); R = (st >> 1) * 16 + swz / 64; C = (st & 1) * 32 + (swz % 64) / 2; }
__host__ __device__ __forceinline__ int perm32(int rho) { const int n = rho >> 4, i = rho & 15; return 8 * (i >> 2) + 4 * n + (i & 3); }

struct Unit { int pm, pn; };
struct Gemm { const bf16_t* A; const bf16_t* Bt; int M, N, K; };

struct StaticOrder {
    int nM, nN, nwg, G, c;
    __host__ __device__ void init(int M, int N, int G_, int c_) { nM = M / BM; nN = N / BM; nwg = nM * nN; G = G_; c = c_; }
    __host__ __device__ bool next(int i, Unit& u) const {
        const long L = (long)i * G + c; if (L >= nwg) return false;
        int wgid = (int)L; { const int q = nwg / NXCD, r = nwg % NXCD, xcd = wgid % NXCD, off = wgid / NXCD; wgid = (xcd < r ? xcd * (q + 1) : r * (q + 1) + (xcd - r) * q) + off; }
        const int nig = WGM * nN, gid = wgid / nig, fm = gid * WGM, gsz = (nM - fm) < WGM ? (nM - fm) : WGM;
        u.pm = fm + ((wgid % nig) % gsz); u.pn = (wgid % nig) / gsz; return true;
    }
    __device__ __forceinline__ void a_ready(const Unit&) const {}
    __device__ __forceinline__ void done(const Unit&) const {}
};

template <class E, bool PERMV = false> struct EpiAdapt {
    static constexpr bool PERM = PERMV, AFTER_DRAIN = false;
    E e; int row0;
    __device__ __forceinline__ void operator()(f32x4 (&acc)[2][2][4][2], const Unit& u, int wr, int wc, int fr, int fq) const {
        const int c0 = u.pn * BM + wc * 64;
#pragma unroll
        for (int ai = 0; ai < 2; ++ai)
#pragma unroll
            for (int m = 0; m < 4; ++m) {
                ::f32x4 v[4] = {acc[ai][0][m][0], acc[ai][0][m][1], acc[ai][1][m][0], acc[ai][1][m][1]};
                e.seg64(row0 + u.pm * BM + ai * HALF + wr * 64 + m * 16 + fr, c0, v, fq);
                if (m & 1) asm volatile("" ::: "memory");
            }
    }
};
template <class Epi, class Sched, bool ALIGN_EPI = false, bool SP2 = false>
__device__ __forceinline__ void gemm_phase(PG8_LAS unsigned char* lds, const Gemm g, const Sched& S, const Epi& E) {
    int tid_ = threadIdx.x; asm volatile("" : "+v"(tid_));
    const int tid = tid_, wid = __builtin_amdgcn_readfirstlane(tid >> 6), lane = tid & 63, wr = wid >> 2, wc = wid & 3, fr = lane & 15, fq = lane >> 4;
    const int K = g.K, nt = K / BK;
    unsigned voffA[2], voffB[2];
#pragma unroll
    for (int i = 0; i < 2; ++i) { int R, C; stage_rc(tid * 16 + i * 8192, R, C); const int Rb = Epi::PERM ? ((R & ~31) + perm32(R & 31)) : R;
        voffA[i] = (unsigned)(R * K + C) * 2u; voffB[i] = (unsigned)(Rb * K + C) * 2u; }
    const size_t kstep = (size_t)(BK * 2);
    const size_t hstep = (size_t)HALF * K * 2;
    const size_t tstep = 2 * hstep;
    const unsigned ldsw = (unsigned)wid * 1024u;
    const int aoff = lds_byte(wr * 64 + fr, fq * 8), boff = lds_byte(wc * 32 + fr, fq * 8);
#define PG8_SA(b, h) (((b) * 2 + (h)) * HTB)
#define PG8_SB(b, h) ((4 + (b) * 2 + (h)) * HTB)
#define PG8_STAGE(bufoff, gbase, voff) do { _Pragma("unroll") for (int _i = 0; _i < 2; ++_i) { unsigned _vo = (voff)[_i]; asm volatile("" : "+v"(_vo)); \
        __builtin_amdgcn_global_load_lds((const unsigned*)((const char*)(gbase) + _vo), (PG8_LAS unsigned*)(lds + (bufoff) + ldsw + _i * 8192), 16, 0, 0); } } while (0)
#define PG8_LDA(dst, b, h) do { _Pragma("unroll") for (int m = 0; m < 4; ++m) _Pragma("unroll") for (int k = 0; k < 2; ++k) dst[m][k] = *(const PG8_LAS bf16x8*)(lds + PG8_SA(b, h) + aoff + m * 2048 + k * 1024); } while (0)
#define PG8_LDB(dst, b, h) do { _Pragma("unroll") for (int n = 0; n < 2; ++n) _Pragma("unroll") for (int k = 0; k < 2; ++k) dst[n][k] = *(const PG8_LAS bf16x8*)(lds + PG8_SB(b, h) + boff + n * 2048 + k * 1024); } while (0)
#define PG8_MMA(ai, bj, At, Bt) do { __builtin_amdgcn_s_setprio(1); _Pragma("unroll") for (int m = 0; m < 4; ++m) _Pragma("unroll") for (int n = 0; n < 2; ++n) _Pragma("unroll") for (int k = 0; k < 2; ++k) \
        acc[ai][bj][m][n] = __builtin_amdgcn_mfma_f32_16x16x32_bf16(Bt[n][k], At[m][k], acc[ai][bj][m][n], 0, 0, 0); __builtin_amdgcn_s_setprio(0); } while (0)
#define PG8_WAIT_V(n) asm volatile("s_waitcnt vmcnt(" #n ")" ::: "memory")
#define PG8_WAIT_L(n) asm volatile("s_waitcnt lgkmcnt(" #n ")" ::: "memory")
#define PG8_BAR __builtin_amdgcn_s_barrier()
#define PG8_SCHED __builtin_amdgcn_sched_barrier(0)
    Unit cur, nxt; int ui = 0;
    if (!S.next(0, cur)) return;
    f32x4 acc[2][2][4][2];
#pragma unroll
    for (int a = 0; a < 2; ++a)
#pragma unroll
        for (int b = 0; b < 2; ++b)
#pragma unroll
            for (int m = 0; m < 4; ++m)
#pragma unroll
                for (int n = 0; n < 2; ++n) acc[a][b][m][n] = (f32x4){0.f, 0.f, 0.f, 0.f};
    bf16x8 At[4][2], B0[2][2], B1[2][2];
    const char* cA = (const char*)g.A + (size_t)cur.pm * tstep; const char* cB = (const char*)g.Bt + (size_t)cur.pn * tstep;
    S.a_ready(cur);
    if constexpr (SP2) {
        PG8_STAGE(PG8_SB(0, 0), cB, voffB); PG8_STAGE(PG8_SB(0, 1), cB + hstep, voffB); PG8_STAGE(PG8_SA(0, 0), cA, voffA); PG8_STAGE(PG8_SA(0, 1), cA + hstep, voffA);
        if (wr == 1) PG8_BAR;
        PG8_WAIT_V(2); PG8_BAR;
        PG8_STAGE(PG8_SB(1, 0), cB + kstep, voffB); PG8_STAGE(PG8_SA(1, 0), cA + kstep, voffA); PG8_STAGE(PG8_SB(1, 1), cB + hstep + kstep, voffB);
        PG8_WAIT_V(6); PG8_BAR;
    } else {
        PG8_STAGE(PG8_SB(0, 0), cB, voffB); PG8_STAGE(PG8_SA(0, 0), cA, voffA); PG8_STAGE(PG8_SB(0, 1), cB + hstep, voffB); PG8_STAGE(PG8_SA(0, 1), cA + hstep, voffA);
        if (wr == 1) PG8_BAR;
        PG8_WAIT_V(4); PG8_BAR;
        PG8_STAGE(PG8_SB(1, 0), cB + kstep, voffB); PG8_STAGE(PG8_SA(1, 0), cA + kstep, voffA); PG8_STAGE(PG8_SB(1, 1), cB + hstep + kstep, voffB);
        PG8_WAIT_V(6); PG8_BAR;
    }
    for (;;) {
        const bool has_next = S.next(ui + 1, nxt);
        const char* nA = has_next ? (const char*)g.A + (size_t)nxt.pm * tstep : cA; const char* nB = has_next ? (const char*)g.Bt + (size_t)nxt.pn * tstep : cB;
        for (int t = 0; t < nt; t += 2) {
            const bool last = (t == nt - 2);
            const char* a1 = cA + (size_t)(t + 1) * kstep;
            const char* a2 = last ? nA : cA + (size_t)(t + 2) * kstep; const char* b2 = last ? nB : cB + (size_t)(t + 2) * kstep;
            const char* a3 = a2 + kstep; const char* b3 = b2 + kstep;
            if (last && has_next) S.a_ready(nxt);
            if constexpr (SP2) {
            PG8_LDB(B0, 0, 0); PG8_LDB(B1, 0, 1); PG8_SCHED; PG8_LDA(At, 0, 0); PG8_STAGE(PG8_SA(1, 1), a1 + hstep, voffA);
            PG8_WAIT_V(8); PG8_WAIT_L(0); PG8_BAR; PG8_MMA(0, 0, At, B0); PG8_MMA(0, 1, At, B1); PG8_BAR; PG8_SCHED;
            PG8_LDA(At, 0, 1); PG8_STAGE(PG8_SB(0, 0), b2, voffB); PG8_STAGE(PG8_SB(0, 1), b2 + hstep, voffB); PG8_STAGE(PG8_SA(0, 0), a2, voffA);
            PG8_WAIT_V(8); PG8_WAIT_L(0); PG8_BAR; PG8_MMA(1, 0, At, B0); PG8_MMA(1, 1, At, B1); PG8_BAR; PG8_SCHED;
            PG8_LDB(B0, 1, 0); PG8_LDB(B1, 1, 1); PG8_SCHED; PG8_LDA(At, 1, 0); PG8_STAGE(PG8_SA(0, 1), a2 + hstep, voffA);
            PG8_WAIT_V(8); PG8_WAIT_L(0); PG8_BAR; PG8_MMA(0, 0, At, B0); PG8_MMA(0, 1, At, B1); PG8_BAR; PG8_SCHED;
            PG8_LDA(At, 1, 1); PG8_STAGE(PG8_SB(1, 0), b3, voffB); PG8_STAGE(PG8_SB(1, 1), b3 + hstep, voffB); PG8_STAGE(PG8_SA(1, 0), a3, voffA);
            PG8_WAIT_V(8); PG8_WAIT_L(0); PG8_BAR; PG8_MMA(1, 0, At, B0); PG8_MMA(1, 1, At, B1); PG8_BAR; PG8_SCHED;
            } else {
            PG8_LDB(B0, 0, 0); PG8_SCHED; PG8_LDA(At, 0, 0); PG8_STAGE(PG8_SA(1, 1), a1 + hstep, voffA);
            PG8_WAIT_L(8); PG8_BAR; PG8_WAIT_L(0); PG8_MMA(0, 0, At, B0); PG8_BAR; PG8_SCHED;
            PG8_LDB(B1, 0, 1); PG8_STAGE(PG8_SB(0, 0), b2, voffB);
            PG8_BAR; PG8_WAIT_L(0); PG8_MMA(0, 1, At, B1); PG8_BAR;
            PG8_LDA(At, 0, 1); PG8_STAGE(PG8_SA(0, 0), a2, voffA);
            PG8_BAR; PG8_WAIT_L(0); PG8_MMA(1, 0, At, B0); PG8_BAR; PG8_SCHED;
            PG8_STAGE(PG8_SB(0, 1), b2 + hstep, voffB);
            PG8_WAIT_V(6); PG8_BAR; PG8_MMA(1, 1, At, B1); PG8_BAR;
            PG8_LDB(B0, 1, 0); PG8_SCHED; PG8_LDA(At, 1, 0); PG8_STAGE(PG8_SA(0, 1), a2 + hstep, voffA);
            PG8_WAIT_L(8); PG8_BAR; PG8_WAIT_L(0); PG8_MMA(0, 0, At, B0); PG8_BAR; PG8_SCHED;
            PG8_LDB(B1, 1, 1); PG8_STAGE(PG8_SB(1, 0), b3, voffB);
            PG8_BAR; PG8_WAIT_L(0); PG8_MMA(0, 1, At, B1); PG8_BAR;
            PG8_LDA(At, 1, 1); PG8_STAGE(PG8_SA(1, 0), a3, voffA);
            PG8_BAR; PG8_WAIT_L(0); PG8_MMA(1, 0, At, B0); PG8_BAR; PG8_SCHED;
            PG8_STAGE(PG8_SB(1, 1), b3 + hstep, voffB);
            PG8_WAIT_V(6); PG8_BAR; PG8_MMA(1, 1, At, B1); PG8_BAR;
            }
        }
        if constexpr (ALIGN_EPI) { if (wr == 0) PG8_BAR; }
        if constexpr (!Epi::AFTER_DRAIN) { E(acc, cur, wr, wc, fr, fq); S.done(cur); }
        if (!has_next) break;
#pragma unroll
        for (int a = 0; a < 2; ++a)
#pragma unroll
            for (int b = 0; b < 2; ++b)
#pragma unroll
                for (int m = 0; m < 4; ++m)
#pragma unroll
                    for (int n = 0; n < 2; ++n) acc[a][b][m][n] = (f32x4){0.f, 0.f, 0.f, 0.f};
        cur = nxt; cA = nA; cB = nB; ++ui;
        if constexpr (ALIGN_EPI) { if (wr == 1) PG8_BAR; }
    }
    PG8_WAIT_V(0);
    if constexpr (!ALIGN_EPI) { if (wr == 0) PG8_BAR; }
    PG8_BAR;
    if constexpr (Epi::AFTER_DRAIN) { E.fused(acc, cur, wr, wc, fr, fq, lds, wid, lane); S.done(cur); }
#undef PG8_SA
#undef PG8_SB
#undef PG8_STAGE
#undef PG8_LDA
#undef PG8_LDB
#undef PG8_MMA
#undef PG8_WAIT_V
#undef PG8_WAIT_L
#undef PG8_BAR
#undef PG8_SCHED
}
}

template <class Epi>
__device__ __forceinline__ void sgemm(const bf16* A, int lda, int a_row_sub, const bf16* Bt, int K, int row0, int nrows, int N, bool headmap, const Epi& E, const Frame& F) {
    const int nN = N / 64, nU = (nrows / 256) * nN, fr = F.lane & 15, fq = F.lane >> 4;
    for (int u = F.vcu; u < nU; u += F.G) {
        const int pm = u / nN, pn = u % nN, r0 = row0 + pm * 256 + F.wave * 32, c0 = pn * 64;
        f32x4 acc[2][4];
#pragma unroll
        for (int a = 0; a < 2; ++a)
#pragma unroll
            for (int b = 0; b < 4; ++b) acc[a][b] = (f32x4){0.f, 0.f, 0.f, 0.f};
        const bf16* ap0 = A + (size_t)(r0 - a_row_sub + fr) * lda + 8 * fq; const bf16* ap1 = ap0 + (size_t)16 * lda;
        const bf16* bp[4];
#pragma unroll
        for (int nt = 0; nt < 4; ++nt) { const int n = c0 + 16 * nt + fr; bp[nt] = Bt + (size_t)(headmap ? inv_head(n) : n) * K + 8 * fq; }
        for (int k0 = 0; k0 < K; k0 += 32) {
            const bf16x8 a0 = *(const bf16x8*)(ap0 + k0), a1 = *(const bf16x8*)(ap1 + k0);
            bf16x8 b[4];
#pragma unroll
            for (int nt = 0; nt < 4; ++nt) b[nt] = *(const bf16x8*)(bp[nt] + k0);
#pragma unroll
            for (int nt = 0; nt < 4; ++nt) { acc[0][nt] = __builtin_amdgcn_mfma_f32_16x16x32_bf16(b[nt], a0, acc[0][nt], 0, 0, 0); acc[1][nt] = __builtin_amdgcn_mfma_f32_16x16x32_bf16(b[nt], a1, acc[1][nt], 0, 0, 0); }
        }
        E.seg64(r0 + fr, c0, acc[0], fq); E.seg64(r0 + 16 + fr, c0, acc[1], fq);
    }
}

__device__ __forceinline__ void st_bf16x4(bf16* p, f32x4 v) { u32x2 w; w.x = cvtpk(v[0], v[1]); w.y = cvtpk(v[2], v[3]); *(u32x2*)p = w; }
__device__ __forceinline__ void st_bf16x8(bf16* p, f32x4 a, f32x4 b) { u32x4 w; w.x = cvtpk(a[0], a[1]); w.y = cvtpk(a[2], a[3]); w.z = cvtpk(b[0], b[1]); w.w = cvtpk(b[2], b[3]); *(u32x4*)p = w; }
__device__ __forceinline__ void ld_bf16x8(const bf16* p, f32x4& a, f32x4& b) { const u32x4 w = *(const u32x4*)p; a = (f32x4){bflo(w.x), bfhi(w.x), bflo(w.y), bfhi(w.y)}; b = (f32x4){bflo(w.z), bfhi(w.z), bflo(w.w), bfhi(w.w)}; }
__device__ __forceinline__ float quad_sum(float s) { s += __shfl_xor(s, 16); s += __shfl_xor(s, 32); return s; }
__device__ __forceinline__ float rstd_from_ss(const float* ss16) {
    const f32x4* p = (const f32x4*)ss16; const f32x4 a = p[0], b = p[1], c = p[2], d = p[3];
    const float s = ((a.x + a.y) + (a.z + a.w)) + ((b.x + b.y) + (b.z + b.w)) + ((c.x + c.y) + (c.z + c.w)) + ((d.x + d.y) + (d.z + d.w));
    return 1.0f / sqrtf(s * (1.f / DM) + EPS);
}

struct EpiIn {
    bf16 *Q, *K, *V, *U; const float *qg, *kg; const float2* rope;
    __device__ __forceinline__ void seg64(int m, int c0, f32x4 (&v)[4], int fq) const {
        if (c0 < 640) {
            const bool isq = c0 < 512;
            float ss = 0.f;
#pragma unroll
            for (int nt = 0; nt < 4; ++nt) ss += (v[nt][0] * v[nt][0] + v[nt][1] * v[nt][1]) + (v[nt][2] * v[nt][2] + v[nt][3] * v[nt][3]);
            ss = quad_sum(ss);
            const float rstd = 1.0f / sqrtf(ss * (1.f / 64.f) + EPS);
            const float* g = isq ? qg : kg;
#pragma unroll
            for (int nt = 0; nt < 4; ++nt) { const f32x4 gg = *(const f32x4*)(g + 16 * nt + 4 * fq); v[nt] = v[nt] * rstd * gg; }
            const int t = tpos(m), pr = t >> 6, pc = t & 63;
            const float sc = isq ? C2 : 1.0f;
            f32x4 o[4];
#pragma unroll
            for (int j = 0; j < 4; ++j) {
                const float2 cr = rope[pr * 16 + 4 * fq + j], cc = rope[pc * 16 + 4 * fq + j];
                o[0][j] = (v[0][j] * cr.x - v[1][j] * cr.y) * sc; o[1][j] = (v[1][j] * cr.x + v[0][j] * cr.y) * sc;
                o[2][j] = (v[2][j] * cc.x - v[3][j] * cc.y) * sc; o[3][j] = (v[3][j] * cc.x + v[2][j] * cc.y) * sc;
            }
            bf16* dst = isq ? Q + (size_t)m * 512 + c0 : K + (size_t)m * 128 + (c0 - 512);
#pragma unroll
            for (int nt = 0; nt < 4; ++nt) st_bf16x4(dst + 16 * nt + 4 * fq, o[nt]);
        } else {
            bf16* dst = c0 < 768 ? V + (size_t)m * 128 + (c0 - 640) : U + (size_t)m * 512 + (c0 - 768);
#pragma unroll
            for (int nt = 0; nt < 4; ++nt) st_bf16x4(dst + 16 * nt + 4 * fq, v[nt]);
        }
    }
};
struct EpiBf {
    bf16* O; int ld;
    __device__ __forceinline__ void seg64(int m, int c0, f32x4 (&v)[4], int fq) const {
#pragma unroll
        for (int nt = 0; nt < 4; ++nt) st_bf16x4(O + (size_t)m * ld + c0 + 16 * nt + 4 * fq, v[nt]);
    }
};
struct EpiRes {
    const float* base0; const float* base1; float* out; bf16* HB; float* SS;
    __device__ __forceinline__ void seg64(int m, int c0, f32x4 (&v)[4], int fq) const {
        const float* b = (m < MP ? base0 + (size_t)m * DM : base1 + (size_t)(m - MP) * DM) + c0 + 4 * fq;
        float* o = out + (size_t)m * DM + c0 + 4 * fq; bf16* hb = HB + (size_t)m * DM + c0 + 4 * fq; float ss = 0.f;
#pragma unroll
        for (int nt = 0; nt < 4; ++nt) { const f32x4 h = *(const f32x4*)(b + 16 * nt) + v[nt]; *(f32x4*)(o + 16 * nt) = h; st_bf16x4(hb + 16 * nt, h);
            ss += (h[0] * h[0] + h[1] * h[1]) + (h[2] * h[2] + h[3] * h[3]); }
        ss = quad_sum(ss);
        if (fq == 0) SS[(size_t)m * 16 + (c0 >> 6)] = ss;
    }
};
constexpr int RSTD_OFF = 131072 + 1024;
struct EpiUp {
    bf16* HM; const LAS float* rs; int row0;
    __device__ __forceinline__ void seg64(int m, int c0, f32x4 (&v)[4], int fq) const {
        const float rstd = rs[m - row0];
        bf16* d = HM + (size_t)(m - row0) * DFF + c0 + 4 * fq;
#pragma unroll
        for (int nt = 0; nt < 4; ++nt) { f32x4 a = v[nt] * rstd;
#pragma unroll
            for (int j = 0; j < 4; ++j) { const float r = fmaxf(a[j], 0.f); a[j] = r * r; }
            st_bf16x4(d + 16 * nt, a); }
    }
};
__device__ __forceinline__ void rstd_table(const Frame& F, const float* SS, int row0) {
    if (F.tid < 256) ((LAS float*)(F.lds + RSTD_OFF))[F.tid] = rstd_from_ss(SS + (size_t)(row0 + F.tid) * 16);
    __syncthreads();
}
struct EpiGate {
    const float* out; float* dst; const bf16* PP; const float* SS;
    __device__ __forceinline__ void seg64(int m, int c0, f32x4 (&v)[4], int fq) const {
        const float rstd = rstd_from_ss(SS + (size_t)m * 16);
        const float* o = out + (size_t)m * DM + c0 + 4 * fq; float* d = dst + (size_t)m * DM + c0 + 4 * fq; const bf16* pp = PP + (size_t)m * DM + c0 + 4 * fq;
#pragma unroll
        for (int nt = 0; nt < 4; ++nt) { const u32x2 w = *(const u32x2*)(pp + 16 * nt); f32x4 h = *(const f32x4*)(o + 16 * nt);
            const float p0 = bflo(w.x), p1 = bfhi(w.x), p2 = bflo(w.y), p3 = bfhi(w.y);
            h[0] += p0 / (1.0f + __expf(-v[nt][0] * rstd)); h[1] += p1 / (1.0f + __expf(-v[nt][1] * rstd));
            h[2] += p2 / (1.0f + __expf(-v[nt][2] * rstd)); h[3] += p3 / (1.0f + __expf(-v[nt][3] * rstd));
            *(f32x4*)(d + 16 * nt) = h; }
    }
};

namespace attn_body {
using bf16=__hip_bfloat16;
using bf16x8=__attribute__((ext_vector_type(8)))short;
using s16x4=__attribute__((ext_vector_type(4)))short;
using f32x16=__attribute__((ext_vector_type(16)))float;
using u32x4=__attribute__((ext_vector_type(4)))unsigned;
constexpr int D=64,QP=512,KP=128,OP=1024;
constexpr int NW=8,QBLK=32,QB=QBLK*NW,KVBLK=64;
constexpr int ATTN_UNIT_ROWS=QB;
__device__ __forceinline__ int crow(int r,int hi){return (r&3)+8*(r>>2)+4*hi;}
#define SBAR() __builtin_amdgcn_sched_barrier(0)

constexpr int NSLOT=3, SLOTB=8192;
constexpr int LDS_K=0, LDS_V=NSLOT*SLOTB, LDS_WS=2*NSLOT*SLOTB, LDS_OST=LDS_WS+NW*64*4, LDS_BYTES=LDS_OST+NW*4096;
constexpr float C2=0.125f*1.4426950408889634f;
__device__ __forceinline__ void glds16(const void*gsrc,unsigned lds_dst){unsigned keep;
  asm volatile("s_mov_b32 %0, m0\n\ts_mov_b32 m0, %2\n\ts_nop 0\n\tglobal_load_lds_dwordx4 %1, off\n\ts_mov_b32 m0, %0":"=&s"(keep):"v"(gsrc),"s"(lds_dst):"memory");}
__device__ __forceinline__ float max3f(float a,float b,float c){float r;asm("v_max3_f32 %0, %1, %2, %3":"=v"(r):"v"(a),"v"(b),"v"(c));return r;}
__device__ __forceinline__ float max2f(float a,float b){float r;asm("v_max_f32_e32 %0, %1, %2":"=v"(r):"v"(a),"v"(b));return r;}
__device__ __forceinline__ float fadd_s(float a,float b){float r;asm("v_add_f32_e32 %0, %1, %2":"=v"(r):"v"(a),"v"(b));return r;}
__device__ __forceinline__ float fsub_s(float a,float b){float r;asm("v_sub_f32_e32 %0, %1, %2":"=v"(r):"v"(a),"v"(b));return r;}
typedef float f32x2_t __attribute__((ext_vector_type(2))); typedef __bf16 bf16x2_t __attribute__((ext_vector_type(2)));
__device__ __forceinline__ unsigned cvtpk_s(float lo,float hi){f32x2_t v={lo,hi};bf16x2_t b=__builtin_convertvector(v,bf16x2_t);return __builtin_bit_cast(unsigned,b);}
#define WAIT_BAR(N) asm volatile("s_waitcnt vmcnt(" #N ") lgkmcnt(0)\n\ts_barrier":::"memory")

__device__ __forceinline__ void qkt(f32x16&p0,f32x16&p1,const char*Kslot,const bf16x8*qr,const f32x16&negm,int r32,int hi){
  const char*kb=Kslot+hi*1024+r32*16;
  #pragma unroll
  for(int d0=0;d0<4;++d0){
    const bf16x8 b0=*reinterpret_cast<const bf16x8*>(kb+d0*2048);
    const bf16x8 b1=*reinterpret_cast<const bf16x8*>(kb+d0*2048+512);
    if(d0==0){p0=__builtin_amdgcn_mfma_f32_32x32x16_bf16(b0,qr[0],negm,0,0,0);p1=__builtin_amdgcn_mfma_f32_32x32x16_bf16(b1,qr[0],negm,0,0,0);}
    else{p0=__builtin_amdgcn_mfma_f32_32x32x16_bf16(b0,qr[d0],p0,0,0,0);p1=__builtin_amdgcn_mfma_f32_32x32x16_bf16(b1,qr[d0],p1,0,0,0);}}
}
typedef __attribute__((address_space(3))) const char* lds_cptr;
typedef short v4i16_t __attribute__((ext_vector_type(4)));
__device__ __forceinline__ void kload8(bf16x8*kf,lds_cptr kp){
  kf[0]=*(const __attribute__((address_space(3))) bf16x8*)(kp);      kf[1]=*(const __attribute__((address_space(3))) bf16x8*)(kp+512);
  kf[2]=*(const __attribute__((address_space(3))) bf16x8*)(kp+2048); kf[3]=*(const __attribute__((address_space(3))) bf16x8*)(kp+2560);
  kf[4]=*(const __attribute__((address_space(3))) bf16x8*)(kp+4096); kf[5]=*(const __attribute__((address_space(3))) bf16x8*)(kp+4608);
  kf[6]=*(const __attribute__((address_space(3))) bf16x8*)(kp+6144); kf[7]=*(const __attribute__((address_space(3))) bf16x8*)(kp+6656);
}
__device__ __forceinline__ void kload2(bf16x8*kf,lds_cptr kp,int j){ kf[2*j]=*(const __attribute__((address_space(3))) bf16x8*)(kp+j*2048); kf[2*j+1]=*(const __attribute__((address_space(3))) bf16x8*)(kp+j*2048+512); }
__device__ __forceinline__ s16x4 vtr(lds_cptr p){ return __builtin_bit_cast(s16x4,__builtin_amdgcn_ds_read_tr16_b64_v4i16((__attribute__((address_space(3))) v4i16_t*)p)); }
__device__ __forceinline__ float rowmax(const f32x16&p0,const f32x16&p1){
  float a=max3f(p0[0],p0[1],p1[0]),b=max3f(p0[2],p0[3],p1[1]);a=max3f(a,p1[2],p1[3]);
  #pragma unroll
  for(int r=4;r<16;r+=4){a=max3f(a,p0[r],p0[r+1]);b=max3f(b,p0[r+2],p0[r+3]);a=max3f(a,p1[r],p1[r+1]);b=max3f(b,p1[r+2],p1[r+3]);}
  const float m=max2f(a,b);
  auto rr=__builtin_amdgcn_permlane32_swap(__float_as_uint(m),__float_as_uint(m),false,false);
  return max2f(__uint_as_float(rr[0]),__uint_as_float(rr[1]));
}
__device__ __forceinline__ void pv(f32x16*o,int vb,bf16x8 pa0,bf16x8 pa1,bf16x8 pa2,bf16x8 pa3){
  #pragma unroll
  for(int d0=0;d0<2;++d0){s16x4 lo[4],hi[4];
    #pragma unroll
    for(int ks=0;ks<4;++ks){
      asm volatile("ds_read_b64_tr_b16 %0,%1 offset:%c2":"=&v"(lo[ks]):"v"(vb),"i"(d0*4096+ks*1024):"memory");
      asm volatile("ds_read_b64_tr_b16 %0,%1 offset:%c2":"=&v"(hi[ks]):"v"(vb),"i"(d0*4096+ks*1024+512):"memory");}
    asm volatile("s_waitcnt lgkmcnt(0)":::"memory");SBAR();
    #define PK(k) (bf16x8){lo[k][0],lo[k][1],lo[k][2],lo[k][3],hi[k][0],hi[k][1],hi[k][2],hi[k][3]}
    o[d0]=__builtin_amdgcn_mfma_f32_32x32x16_bf16(pa0,PK(0),o[d0],0,0,0);
    o[d0]=__builtin_amdgcn_mfma_f32_32x32x16_bf16(pa1,PK(1),o[d0],0,0,0);
    o[d0]=__builtin_amdgcn_mfma_f32_32x32x16_bf16(pa2,PK(2),o[d0],0,0,0);
    o[d0]=__builtin_amdgcn_mfma_f32_32x32x16_bf16(pa3,PK(3),o[d0],0,0,0);
    #undef PK
  }
}

#ifndef ATTN_STORE16
#define ATTN_STORE16(p,v) (*(u32x4*)(p)=(v))
#endif
template<int THRL> __device__ __forceinline__ void attn_unit(int rowbase_,int T_,int h,int qb,const bf16*Q,const bf16*__restrict__ K,const bf16*__restrict__ V,bf16*O,char*shm){
  const int tid=threadIdx.x,lane=tid&63,r32=lane&31,hi=lane>>5; const int wid=__builtin_amdgcn_readfirstlane(tid>>6);
  const long rowbase=(long)rowbase_; const int q0=qb*QB; const int kvh=h>>2;
  const bf16*Qw=Q+(rowbase+q0+wid*QBLK)*QP+h*D;
  const bf16*Kh=K+rowbase*KP+kvh*D,*Vh=V+rowbase*KP+kvh*D;
  const unsigned lds0=(unsigned)(uintptr_t)shm;
  float*wsf=(float*)(shm+LDS_WS)+wid*64;
  const bf16*ksrc=Kh+(long)lane*KP+wid*8;
  const bf16*vsrc=Vh+(long)(16*(wid&3)+(lane>>2))*KP+(wid>>2)*32+(lane&3)*8;
  const unsigned kdst=lds0+LDS_K+wid*1024, vdst=lds0+LDS_V+wid*1024;
  #define DMA_K(t,slot) glds16(ksrc+(long)(t)*KVBLK*KP,(unsigned)__builtin_amdgcn_readfirstlane(kdst+(slot)))
  #define DMA_V(t,slot) glds16(vsrc+(long)(t)*KVBLK*KP,(unsigned)__builtin_amdgcn_readfirstlane(vdst+(slot)))
  const int vb0=(int)(lds0+LDS_V)+((lane>>4)&1)*32+(lane&3)*8+(4*hi+((lane&15)>>2))*64;
  const char*Kbase=shm+LDS_K; bf16x8 kf[8];
  const lds_cptr shm3=(lds_cptr)shm; const lds_cptr kp0=shm3+LDS_K+hi*1024+r32*16; const lds_cptr vp0=shm3+LDS_V+((lane>>4)&1)*32+(lane&3)*8+(4*hi+((lane&15)>>2))*64;
  const int NT=T_/KVBLK;
  DMA_K(0,0);DMA_V(0,0);DMA_K(1,SLOTB);
  bf16x8 qr[4];
  #pragma unroll
  for(int d0=0;d0<4;++d0)qr[d0]=*reinterpret_cast<const bf16x8*>(&Qw[(long)r32*QP+d0*16+hi*8]);
  float mhat=0.f,l_reg=0.f;f32x16 o[2];o[0]=f32x16{};o[1]=f32x16{};f32x16 negm=f32x16{};
#if !ATTN_NOMAX
  asm volatile("":"+v"(negm));
#endif

  const int qrel=wid*QBLK+r32;
  #define CMASK(P0,P1,t) do{}while(0)
  bool resc=false;
#if ATTN_NOMAX
  #define START(P0,P1) do{ _Pragma("unroll") for(int r=0;r<16;++r)P0[r]=__builtin_amdgcn_exp2f(P0[r]); }while(0)
#else
  #define START(P0,P1) do{ const float rm=rowmax(P0,P1); resc=false; \
    { const float dl=rm; mhat=fadd_s(mhat,dl); \
      _Pragma("unroll") for(int r=0;r<16;++r){P0[r]=fsub_s(P0[r],dl);P1[r]=fsub_s(P1[r],dl);} \
      _Pragma("unroll") for(int r=0;r<16;++r)negm[r]=-mhat; asm volatile("":"+v"(negm)); } \
    _Pragma("unroll") for(int r=0;r<16;++r)P0[r]=__builtin_amdgcn_exp2f(P0[r]); }while(0)
#endif
#if ATTN_NOMAX
  #define RESC() do{}while(0)
#else
  #define RESC() do{ if(resc){ asm volatile("s_waitcnt lgkmcnt(0)":::"memory"); \
      _Pragma("unroll") for(int d_=0;d_<2;++d_) _Pragma("unroll") for(int r=0;r<16;++r)o[d_][r]*=wsf[crow(r,hi)]; } }while(0)
#endif
  f32x16 pA0,pA1,pB0,pB1;
  int sl_prev=0,sl_cur=0,sl_next=SLOTB;
  #define ROT() do{sl_prev=sl_cur;sl_cur=sl_next;sl_next=(sl_next==(NSLOT-1)*SLOTB)?0:sl_next+SLOTB;}while(0)
  DMA_K(2,2*SLOTB);
  WAIT_BAR(3);
  qkt(pA0,pA1,Kbase,qr,negm,r32,hi);asm volatile("s_nop 15\n\ts_nop 7":"+v"(pA0),"+v"(pA1));CMASK(pA0,pA1,0);
  START(pA0,pA1);
  _Pragma("unroll") for(int r=0;r<16;++r)pA1[r]=__builtin_amdgcn_exp2f(pA1[r]);
  WAIT_BAR(0);
  DMA_K(3,0);DMA_V(1,SLOTB);
  ROT();
  kload8(kf,kp0+sl_cur);
  WAIT_BAR(2);
  s16x4 vlo[8],vhi[8]; u32x4 pw0,pw1,pw2,pw3;
  #define PKW(P,B) cvtpk_s(P[B],P[B+1])
  #define PAF(k) __builtin_bit_cast(bf16x8,pw##k)
  #define VFR(i) (bf16x8){vlo[i][0],vlo[i][1],vlo[i][2],vlo[i][3],vhi[i][0],vhi[i][1],vhi[i][2],vhi[i][3]}
  #define PIN(x) asm volatile("":"+v"(x))
  #define MX3(a,b,c) __builtin_fmaxf(__builtin_fmaxf((a),(b)),(c))
  #define GAPA(MF,A0,A1,A2,A3,W0,W1,PW) do{ MF; sacc+=A0; sacc+=A1; sacc+=A2; sacc+=A3; PIN(sacc); W0; W1; PIN(PW); SBAR(); }while(0)
  #define EX(v) __builtin_amdgcn_exp2f(v)
  #define GAPB(MF,X,B) do{ MF; X[B]=EX(X[B]); X[B+1]=EX(X[B+1]); X[B+2]=EX(X[B+2]); X[B+3]=EX(X[B+3]); PIN(X); SBAR(); }while(0)
  #define VRD(i) do{ vlo[i]=vtr(vp_+(((i)>>2)*4096+((i)&3)*1024)); vhi[i]=vtr(vp_+(((i)>>2)*4096+((i)&3)*1024+512)); }while(0)
  #define KRD(G,j) do{ if(G){ kload2(kf,kp0+sl_next,j); SBAR(); } }while(0)
#if ATTN_NOMAX
  #define MAXBLOCK(C0,C1) do{}while(0)
#else
  #define MAXBLOCK(C0,C1) \
    { float a=MX3(C0[0],C0[1],C1[0]),b=MX3(C0[2],C0[3],C1[1]); a=MX3(a,C1[2],C1[3]); \
      _Pragma("unroll") for(int r=4;r<16;r+=4){a=MX3(a,C0[r],C0[r+1]);b=MX3(b,C0[r+2],C0[r+3]);a=MX3(a,C1[r],C1[r+1]);b=MX3(b,C1[r+2],C1[r+3]);} \
      float rm=__builtin_fmaxf(a,b); { auto rr=__builtin_amdgcn_permlane32_swap(__float_as_uint(rm),__float_as_uint(rm),false,false); rm=__builtin_fmaxf(__uint_as_float(rr[0]),__uint_as_float(rr[1])); } \
      resc=false; \
      if(__builtin_expect(__any(rm>(float)THRL),0)){ const float dl=__builtin_fmaxf(rm,0.f); mhat+=dl; \
        _Pragma("unroll") for(int r=0;r<16;++r){C0[r]-=dl;C1[r]-=dl;} \
        _Pragma("unroll") for(int r=0;r<16;++r)negm[r]=-mhat; asm volatile("":"+v"(negm)); \
        const float f=__builtin_amdgcn_exp2f(-dl); l_reg*=f; if(hi==0)wsf[r32]=f; resc=true; } }
#endif
  #define STEP(C0,C1,P0,P1,t,GK,GV,GL) do{ SBAR(); \
    const lds_cptr vp_=vp0+sl_prev; \
    VRD(0); SBAR(); float sacc=(P0[0]+P0[1]); \
    GAPA(C0=__builtin_amdgcn_mfma_f32_32x32x16_bf16(kf[0],qr[0],negm,0,0,0), P0[2],P0[3],P0[4],P0[5],     pw0[0]=PKW(P0,0), pw0[1]=PKW(P0,2), pw0); \
    VRD(4); SBAR(); GAPA(C1=__builtin_amdgcn_mfma_f32_32x32x16_bf16(kf[1],qr[0],negm,0,0,0), P0[6],P0[7],P0[8],P0[9],     pw0[2]=PKW(P0,4), pw0[3]=PKW(P0,6), pw0); \
    VRD(1); SBAR(); GAPA(C0=__builtin_amdgcn_mfma_f32_32x32x16_bf16(kf[2],qr[1],C0,0,0,0),   P0[10],P0[11],P0[12],P0[13], pw1[0]=PKW(P0,8), pw1[1]=PKW(P0,10), pw1); \
    VRD(5); SBAR(); GAPA(C1=__builtin_amdgcn_mfma_f32_32x32x16_bf16(kf[3],qr[1],C1,0,0,0),   P0[14],P0[15],P1[0],P1[1],   pw1[2]=PKW(P0,12),pw1[3]=PKW(P0,14), pw1); \
    VRD(2); SBAR(); GAPA(C0=__builtin_amdgcn_mfma_f32_32x32x16_bf16(kf[4],qr[2],C0,0,0,0),   P1[2],P1[3],P1[4],P1[5],     pw2[0]=PKW(P1,0), pw2[1]=PKW(P1,2), pw2); \
    VRD(6); SBAR(); GAPA(C1=__builtin_amdgcn_mfma_f32_32x32x16_bf16(kf[5],qr[2],C1,0,0,0),   P1[6],P1[7],P1[8],P1[9],     pw2[2]=PKW(P1,4), pw2[3]=PKW(P1,6), pw2); \
    VRD(3); SBAR(); GAPA(C0=__builtin_amdgcn_mfma_f32_32x32x16_bf16(kf[6],qr[3],C0,0,0,0),   P1[10],P1[11],P1[12],P1[13], pw3[0]=PKW(P1,8), pw3[1]=PKW(P1,10), pw3); \
    VRD(7); SBAR(); GAPA(C1=__builtin_amdgcn_mfma_f32_32x32x16_bf16(kf[7],qr[3],C1,0,0,0),   P1[14],P1[15],0.f,0.f,       pw3[2]=PKW(P1,12),pw3[3]=PKW(P1,14), pw3); \
    l_reg+=sacc; \
    if(GK){DMA_K((t)+3,sl_cur);} if(GV){DMA_V((t)+1,sl_next);} \
    CMASK(C0,C1,t); \
    MAXBLOCK(C0,C1); \
    SBAR(); \
    GAPB(o[0]=__builtin_amdgcn_mfma_f32_32x32x16_bf16(PAF(0),VFR(0),o[0],0,0,0), C0,0); \
    GAPB(o[1]=__builtin_amdgcn_mfma_f32_32x32x16_bf16(PAF(0),VFR(4),o[1],0,0,0), C0,4); \
    KRD(GL,0); GAPB(o[0]=__builtin_amdgcn_mfma_f32_32x32x16_bf16(PAF(1),VFR(1),o[0],0,0,0), C0,8); \
    KRD(GL,1); GAPB(o[1]=__builtin_amdgcn_mfma_f32_32x32x16_bf16(PAF(1),VFR(5),o[1],0,0,0), C0,12); \
    KRD(GL,2); GAPB(o[0]=__builtin_amdgcn_mfma_f32_32x32x16_bf16(PAF(2),VFR(2),o[0],0,0,0), C1,0); \
    KRD(GL,3); GAPB(o[1]=__builtin_amdgcn_mfma_f32_32x32x16_bf16(PAF(2),VFR(6),o[1],0,0,0), C1,4); \
    GAPB(o[0]=__builtin_amdgcn_mfma_f32_32x32x16_bf16(PAF(3),VFR(3),o[0],0,0,0), C1,8); \
    GAPB(o[1]=__builtin_amdgcn_mfma_f32_32x32x16_bf16(PAF(3),VFR(7),o[1],0,0,0), C1,12); \
    }while(0)
  int t=1;
  #undef CMASK
  #define CMASK(P0,P1,t) do{}while(0)
  for(;t+5<NT;t+=2){
    STEP(pB0,pB1,pA0,pA1,t,true,true,true);     WAIT_BAR(2); RESC(); ROT();
    STEP(pA0,pA1,pB0,pB1,t+1,true,true,true);   WAIT_BAR(2); RESC(); ROT();
  }
  #undef CMASK
  #define CMASK(P0,P1,t) do{}while(0)
  #define ENDW(tt) do{ if((tt)+3<NT){WAIT_BAR(2);} else if((tt)+2<NT){WAIT_BAR(1);} else {WAIT_BAR(0);} }while(0)
  for(;t+1<NT;t+=2){
    STEP(pB0,pB1,pA0,pA1,t,(t+3<NT),(t+1<NT),(t+1<NT));       ENDW(t);   RESC(); ROT();
    STEP(pA0,pA1,pB0,pB1,t+1,(t+4<NT),(t+2<NT),(t+2<NT));     ENDW(t+1); RESC(); ROT();
  }
  STEP(pB0,pB1,pA0,pA1,NT-1,false,false,false); RESC();
  { float sacc=pB0[0]+pB0[1]; _Pragma("unroll") for(int r=2;r<16;++r)sacc+=pB0[r]; _Pragma("unroll") for(int r=0;r<16;++r)sacc+=pB1[r]; l_reg+=sacc;
    pw0=(u32x4){PKW(pB0,0),PKW(pB0,2),PKW(pB0,4),PKW(pB0,6)};pw1=(u32x4){PKW(pB0,8),PKW(pB0,10),PKW(pB0,12),PKW(pB0,14)};pw2=(u32x4){PKW(pB1,0),PKW(pB1,2),PKW(pB1,4),PKW(pB1,6)};pw3=(u32x4){PKW(pB1,8),PKW(pB1,10),PKW(pB1,12),PKW(pB1,14)};
    SBAR(); pv(o,vb0+sl_cur,PAF(0),PAF(1),PAF(2),PAF(3)); }
  #undef PKW
  #undef PAF
  #undef VFR
  #undef PIN
  #undef MX3
  #undef GAPA
  #undef GAPB
  #undef EX
  #undef VRD
  #undef KRD
  #undef STEP
  #undef ENDW
  {auto rr=__builtin_amdgcn_permlane32_swap(__float_as_uint(l_reg),__float_as_uint(l_reg),false,false);l_reg=__uint_as_float(rr[0])+__uint_as_float(rr[1]);}
  if(hi==0)wsf[32+r32]=l_reg;asm volatile("s_waitcnt lgkmcnt(0)":::"memory");
  float rli[16];
  #pragma unroll
  for(int r=0;r<16;++r)rli[r]=__builtin_amdgcn_rcpf(wsf[32+crow(r,hi)]);
  bf16*Ow=O+(rowbase+q0+wid*QBLK)*OP+h*D;
  { bf16*stg=(bf16*)(shm+LDS_OST)+wid*2048;
    #pragma unroll
    for(int r=0;r<16;++r){const int orow=crow(r,hi);
      #pragma unroll
      for(int d0=0;d0<2;++d0)stg[orow*64+d0*32+r32]=__float2bfloat16(o[d0][r]*rli[r]);}
    asm volatile("s_waitcnt lgkmcnt(0)":::"memory");
    #pragma unroll
    for(int i=0;i<4;++i){const int row=i*8+(lane>>3),ch=lane&7; const u32x4 v=*(const u32x4*)(stg+row*64+ch*8); ATTN_STORE16(Ow+(long)row*OP+ch*8,v);} }
  asm volatile("s_waitcnt lgkmcnt(0)\n\ts_barrier":::"memory");
  #undef DMA_K
  #undef DMA_V
  #undef CMASK
  #undef START
  #undef RESC
  #undef ROT
}
constexpr int ATTN_LDS_BYTES=LDS_BYTES;
struct AttnTensors { const bf16* Q; const bf16* K; const bf16* V; bf16* O; };
template<int THRL=8> __device__ __forceinline__ void attn_phase(char*lds,const AttnTensors&T,int vcu,int G){
  if(G==256){
    const int x=vcu>>5,j=vcu&31;
    for(int i=0;i<4;++i){ const int w=j*4+i,g=w>>5,qb=w&31; attn_unit<THRL>(16384+(x>>1)*8192,8192,(x&1)*4+g,qb,T.Q,T.K,T.V,T.O,lds); }
    for(int i=0;i<2;++i){ const int w=j*2+i,g=w>>4,qb=w&15; attn_unit<THRL>((x>>1)*4096,4096,(x&1)*4+g,qb,T.Q,T.K,T.V,T.O,lds); }
  } else {
    for(int u=vcu;u<1536;u+=G){
      if(u<1024){ const int qb=u&31,h=(u>>5)&7,s=u>>8; attn_unit<THRL>(16384+s*8192,8192,h,qb,T.Q,T.K,T.V,T.O,lds); }
      else { const int v=u-1024,qb=v&15,h=(v>>4)&7,s=v>>7; attn_unit<THRL>(s*4096,4096,h,qb,T.Q,T.K,T.V,T.O,lds); }
    }
  }
}
#undef SBAR
#undef WAIT_BAR
}

__device__ __forceinline__ void sattn_unit(const Frame& F, int seq, int h, int qb) {
    const int T = seq < 4 ? TP : TS; const int rowbase = seq < 4 ? seq * TP : MP + (seq - 4) * TS;
    const bf16* Q = (const bf16*)(F.ws + WS_Q); const bf16* Kb = (const bf16*)(F.ws + WS_K); const bf16* Vb = (const bf16*)(F.ws + WS_V); bf16* MIX = (bf16*)(F.ws + WS_MIX);
    const int kvh = h >> 2, m = rowbase + qb * 512 + F.tid;
    LAS float* Ks = (LAS float*)F.lds; LAS float* Vs = Ks + 64 * 64;
    float q[64], o[64];
    { const u32x4* qp = (const u32x4*)(Q + (size_t)m * 512 + h * 64);
#pragma unroll
      for (int i = 0; i < 8; ++i) { const u32x4 w = qp[i]; q[8 * i] = bflo(w.x); q[8 * i + 1] = bfhi(w.x); q[8 * i + 2] = bflo(w.y); q[8 * i + 3] = bfhi(w.y); q[8 * i + 4] = bflo(w.z); q[8 * i + 5] = bfhi(w.z); q[8 * i + 6] = bflo(w.w); q[8 * i + 7] = bfhi(w.w); } }
#pragma unroll
    for (int d = 0; d < 64; ++d) o[d] = 0.f;
    float mx = -1e30f, l = 0.f;
    const int lr = F.tid >> 3, lc = (F.tid & 7) * 8;
    for (int kt = 0; kt < T / 64; ++kt) {
        __syncthreads();
        { const size_t grow = (size_t)(rowbase + kt * 64 + lr) * 128 + kvh * 64 + lc;
          const u32x4 kw = *(const u32x4*)(Kb + grow), vw = *(const u32x4*)(Vb + grow);
          LAS f32x4* kd = (LAS f32x4*)(Ks + lr * 64 + lc); LAS f32x4* vd = (LAS f32x4*)(Vs + lr * 64 + lc);
          kd[0] = (f32x4){bflo(kw.x), bfhi(kw.x), bflo(kw.y), bfhi(kw.y)}; kd[1] = (f32x4){bflo(kw.z), bfhi(kw.z), bflo(kw.w), bfhi(kw.w)};
          vd[0] = (f32x4){bflo(vw.x), bfhi(vw.x), bflo(vw.y), bfhi(vw.y)}; vd[1] = (f32x4){bflo(vw.z), bfhi(vw.z), bflo(vw.w), bfhi(vw.w)}; }
        __syncthreads();
#pragma unroll 1
        for (int j = 0; j < 64; ++j) {
            const LAS f32x4* Kc = (const LAS f32x4*)(Ks + j * 64); const LAS f32x4* Vc = (const LAS f32x4*)(Vs + j * 64);
            float a = 0.f;
#pragma unroll
            for (int d4 = 0; d4 < 16; ++d4) { const f32x4 kv = Kc[d4]; a += q[4 * d4] * kv.x + q[4 * d4 + 1] * kv.y + q[4 * d4 + 2] * kv.z + q[4 * d4 + 3] * kv.w; }
            const float mn = fmaxf(mx, a), alpha = exp2f(mx - mn), p = exp2f(a - mn); mx = mn; l = l * alpha + p;
#pragma unroll
            for (int d4 = 0; d4 < 16; ++d4) { const f32x4 vv = Vc[d4]; o[4 * d4] = o[4 * d4] * alpha + p * vv.x; o[4 * d4 + 1] = o[4 * d4 + 1] * alpha + p * vv.y; o[4 * d4 + 2] = o[4 * d4 + 2] * alpha + p * vv.z; o[4 * d4 + 3] = o[4 * d4 + 3] * alpha + p * vv.w; }
        }
    }
    const float il = 1.0f / l;
    u32x4* op = (u32x4*)(MIX + (size_t)m * DM + h * 64);
#pragma unroll
    for (int i = 0; i < 8; ++i) { u32x4 w; w.x = pk2(o[8 * i] * il, o[8 * i + 1] * il); w.y = pk2(o[8 * i + 2] * il, o[8 * i + 3] * il); w.z = pk2(o[8 * i + 4] * il, o[8 * i + 5] * il); w.w = pk2(o[8 * i + 6] * il, o[8 * i + 7] * il); op[i] = w; }
}
__device__ __forceinline__ void sattn_phase(const Frame& F) {
    for (int u = F.vcu; u < 768; u += F.G) {
        if (u < 512) { const int qb = u & 15, h = (u >> 4) & 7, s = u >> 7; sattn_unit(F, 4 + s, h, qb); }
        else { const int v = u - 512, qb = v & 7, h = (v >> 3) & 7, s = v >> 6; sattn_unit(F, s, h, qb); }
    }
}
__device__ __forceinline__ void pool_phase(const Frame& F) {
    const bf16* U = (const bf16*)(F.ws + WS_U); bf16* MIX = (bf16*)(F.ws + WS_MIX);
    constexpr int PR = 32, TR = PR + 16, BUFB = TR * 1024, NU = M / PR;
    const unsigned ldsb = (unsigned)(uintptr_t)F.lds;
    const int g = F.wave & 3, half = 1 << g, ch = 16 * g + (F.lane & 15), rbase = 16 * (F.wave >> 2) + 4 * (F.lane >> 4);
#define POOL_LOAD(u_, buf_) do { const int r0_ = (u_) * PR; _Pragma("unroll") for (int i_ = 0; i_ < TR / 8; ++i_) { const int rr_ = F.wave + 8 * i_; int gr_ = r0_ - 8 + rr_; gr_ = gr_ < 0 ? 0 : (gr_ > M - 1 ? M - 1 : gr_); \
        attn_body::glds16(U + (size_t)gr_ * 512 + F.lane * 8, (unsigned)__builtin_amdgcn_readfirstlane(ldsb + (buf_) * BUFB + rr_ * 1024)); } } while (0)
    __syncthreads();
    int u = F.vcu, b = 0;
    if (u < NU) POOL_LOAD(u, 0);
    for (; u < NU; u += F.G, b ^= 1) {
        const bool more = (u + F.G < NU);
        if (more) { POOL_LOAD(u + F.G, b ^ 1); asm volatile("s_waitcnt vmcnt(6)\n\ts_barrier" ::: "memory"); }
        else { asm volatile("s_waitcnt vmcnt(0)\n\ts_barrier" ::: "memory"); }
        const LAS u32x4* T = (const LAS u32x4*)(F.lds + b * BUFB);
        const int r0 = u * PR, Tlen = r0 < MP ? TP : TS, t0 = tpos(r0);
        {
            int t = t0 + rbase; float a[8];
#pragma unroll
            for (int k = 0; k < 8; ++k) a[k] = 0.f;
#define POOL_ACC(pos_, sg_) do { const u32x4 w_ = T[((pos_) - t0 + 8) * 64 + ch]; \
                a[0] += sg_ bflo(w_.x); a[1] += sg_ bfhi(w_.x); a[2] += sg_ bflo(w_.y); a[3] += sg_ bfhi(w_.y); a[4] += sg_ bflo(w_.z); a[5] += sg_ bfhi(w_.z); a[6] += sg_ bflo(w_.w); a[7] += sg_ bfhi(w_.w); } while (0)
            { const int lo = max(t - half, 0), hi = min(t + half, Tlen); for (int j = lo; j < hi; ++j) POOL_ACC(j, +); }
#pragma unroll
            for (int i = 0; i < 4; ++i) {
                if (i > 0) { if (t + half - 1 < Tlen) POOL_ACC(t + half - 1, +); if (t - half - 1 >= 0) POOL_ACC(t - half - 1, -); }
                const int lo = max(t - half, 0), hi = min(t + half, Tlen);
                const float inv = 1.0f / (float)(hi - lo);
                const u32x4 w = T[(t - t0 + 8) * 64 + ch];
                u32x4 o; o.x = cvtpk(a[0] * inv - bflo(w.x), a[1] * inv - bfhi(w.x)); o.y = cvtpk(a[2] * inv - bflo(w.y), a[3] * inv - bfhi(w.y));
                o.z = cvtpk(a[4] * inv - bflo(w.z), a[5] * inv - bfhi(w.z)); o.w = cvtpk(a[6] * inv - bflo(w.w), a[7] * inv - bfhi(w.w));
                *(u32x4*)(MIX + (size_t)(r0 + (t - t0)) * DM + 512 + ch * 8) = o;
                ++t;
            }
#undef POOL_ACC
        }
        asm volatile("s_waitcnt lgkmcnt(0)\n\ts_barrier" ::: "memory");
    }
#undef POOL_LOAD
    asm volatile("s_waitcnt vmcnt(0)" ::: "memory");
    __syncthreads();
}
__device__ __forceinline__ void final_phase(const Frame& F, const float* src, float* out, const float* g) {
    const int gw = F.vcu * NWAVES + F.wave, NGW = F.G * NWAVES; const f32x4* gr = (const f32x4*)g + F.lane;
    for (int m = gw; m < M; m += NGW) {
        const f32x4* xs = (const f32x4*)(src + (size_t)m * DM) + F.lane; f32x4* xr = (f32x4*)(out + (size_t)m * DM) + F.lane; f32x4 v[4]; float s = 0.f;
#pragma unroll
        for (int j = 0; j < 4; ++j) { v[j] = xs[64 * j]; s += (v[j].x * v[j].x + v[j].y * v[j].y) + (v[j].z * v[j].z + v[j].w * v[j].w); }
        const float rstd = 1.0f / sqrtf(wave_sum(s) * (1.f / DM) + EPS);
#pragma unroll
        for (int j = 0; j < 4; ++j) xr[64 * j] = v[j] * rstd * gr[64 * j];
    }
}


constexpr int CW_BAR = 4096;
constexpr int LDSCTL_OFF = 131072, MISC_OFF = LDSCTL_OFF + 320;
#define XB_TMO      128
#define XB_XCNT(j)  (256  + 64 * (j))
#define XB_XSUB(j)  (1280 + 64 * (j))
#define XB_XGEN(j)  (2304 + 64 * (j))
#define XB_TOP      3328
#define XB_TOPGEN   3392
#define XCD_BAR_WORDS 3456
#define XB_SPIN_CAP (1u << 20)
__device__ __forceinline__ unsigned xb_ld(unsigned* p)              { return __hip_atomic_load(p, __ATOMIC_RELAXED, __HIP_MEMORY_SCOPE_AGENT); }
__device__ __forceinline__ unsigned xb_add(unsigned* p, unsigned v) { return __hip_atomic_fetch_add(p, v, __ATOMIC_RELAXED, __HIP_MEMORY_SCOPE_AGENT); }
__device__ __forceinline__ unsigned xb_xcc_id() { return (unsigned)__builtin_amdgcn_s_getreg((3 << 11) | 20) & 0xFu; }
#define XB_SPIN(cond, bar) do { unsigned _sp = 0; while (cond) { __builtin_amdgcn_s_sleep(1); \
    if ((++_sp & 255u) == 0u) { if (xb_ld(&(bar)[XB_TMO])) break; if (_sp > XB_SPIN_CAP) { atomicAdd(&(bar)[XB_TMO], 1u); break; } } } } while (0)
struct XcdBarrier { unsigned* bar; unsigned x; volatile LAS unsigned* st; };
__device__ __forceinline__ XcdBarrier xcd_barrier_post(unsigned* bar, volatile LAS unsigned* st) {
    XcdBarrier b; b.bar = bar; b.x = xb_xcc_id(); b.st = st;
    if (threadIdx.x == 0) (void)xb_add(&bar[XB_XCNT(b.x)], 1u);
    return b;
}
__device__ __forceinline__ void xcd_barrier_complete(unsigned* bar, unsigned x, unsigned& nloc, unsigned& nx) {
    const unsigned G = gridDim.x * gridDim.y * gridDim.z;
    unsigned sum, cnt, mine, sp = 0u;
    for (;;) {
        sum = 0u; cnt = 0u; mine = 0u;
#pragma unroll
        for (unsigned j = 0; j < 16; ++j) { const unsigned c = xb_ld(&bar[XB_XCNT(j)]); sum += c; cnt += (c > 0u) ? 1u : 0u; mine = (j == x) ? c : mine; }
        if (sum == G) break;
        __builtin_amdgcn_s_sleep(1);
        if ((++sp & 255u) == 0u) { if (xb_ld(&bar[XB_TMO])) break; if (sp > XB_SPIN_CAP) { atomicAdd(&bar[XB_TMO], 1u); break; } }
    }
    nloc = mine > 0u ? mine : 1u; nx = cnt > 0u ? cnt : 1u;
}
__device__ __forceinline__ void xcd_barrier(const XcdBarrier& b) {
    asm volatile("s_waitcnt vmcnt(0)" ::: "memory");
    __syncthreads();
    if (threadIdx.x == 0) {
        unsigned* bar = b.bar;
        __builtin_amdgcn_s_waitcnt(0);
        unsigned nloc = b.st[0], nx = b.st[1];
        if (nloc == 0u) { xcd_barrier_complete(bar, b.x, nloc, nx); b.st[0] = nloc; b.st[1] = nx; }
        const unsigned old = xb_add(&bar[XB_XSUB(b.x)], 1u);
        const unsigned gen = old / nloc;
        if (old + 1u == (gen + 1u) * nloc) {
            __builtin_amdgcn_fence(__ATOMIC_RELEASE, "agent");
            asm volatile("s_waitcnt vmcnt(0)" ::: "memory");
            const unsigned og = xb_add(&bar[XB_TOP], 1u);
            const unsigned tg = og / nx;
            if (og + 1u == (tg + 1u) * nx) xb_add(&bar[XB_TOPGEN], 1u);
            else XB_SPIN(xb_ld(&bar[XB_TOPGEN]) == tg, bar);
            __builtin_amdgcn_fence(__ATOMIC_ACQUIRE, "agent");
            xb_add(&bar[XB_XGEN(b.x)], 1u);
            asm volatile("s_waitcnt vmcnt(0)" ::: "memory");
        } else {
            XB_SPIN(xb_ld(&bar[XB_XGEN(b.x)]) == gen, bar);
            __builtin_amdgcn_fence(__ATOMIC_ACQUIRE, "agent");
            asm volatile("s_waitcnt vmcnt(0)" ::: "memory");
        }
    }
    __syncthreads();
}


template <class E>
__device__ __forceinline__ void fgemm(const Frame& F, const bf16* A, const bf16* Bt, int Mrows, int N, int K, int row0, const E& e) {
    pg8::Gemm g{A, Bt, Mrows, N, K}; pg8::StaticOrder S; S.init(Mrows, N, F.G, (int)blockIdx.x);
    pg8::EpiAdapt<E> EA{e, row0};
    pg8::gemm_phase<pg8::EpiAdapt<E>, pg8::StaticOrder, true, true>(F.lds, g, S, EA);
}

constexpr int CW_GRP = 8192;
constexpr int CW_GRP_TMO = 8192 + 64 * 64;
__device__ __forceinline__ void group_sync(unsigned* cnt, unsigned target, unsigned* tmo) {
    asm volatile("s_waitcnt vmcnt(0)" ::: "memory");
    __syncthreads();
    if (threadIdx.x == 0) {
        __builtin_amdgcn_fence(__ATOMIC_RELEASE, "agent");
        asm volatile("s_waitcnt vmcnt(0)" ::: "memory");
        (void)xb_add(cnt, 1u);
        unsigned sp = 0u;
        while (xb_ld(cnt) < target) { __builtin_amdgcn_s_sleep(1); if (++sp > (1u << 21)) { atomicAdd(tmo, 1u); break; } }
        __builtin_amdgcn_fence(__ATOMIC_ACQUIRE, "agent");
        asm volatile("s_waitcnt vmcnt(0)" ::: "memory");
    }
    __syncthreads();
}
__device__ __forceinline__ f32x4 ld_bf16x4(const bf16* p) { const u32x2 w = *(const u32x2*)p; return (f32x4){bflo(w.x), bfhi(w.x), bflo(w.y), bfhi(w.y)}; }
__device__ __forceinline__ float ssq8(f32x4 a, f32x4 b) { return ((a[0] * a[0] + a[1] * a[1]) + (a[2] * a[2] + a[3] * a[3])) + ((b[0] * b[0] + b[1] * b[1]) + (b[2] * b[2] + b[3] * b[3])); }
struct EpiResA {
    const float* x0; const float* x1; bf16* HB; float* SS;
    __device__ __forceinline__ void seg64(int m, int c0, f32x4 (&v)[4], int fq) const {
        const float* b = (m < MP ? x0 + (size_t)m * DM : x1 + (size_t)(m - MP) * DM) + c0 + 8 * fq;
        bf16* hb = HB + (size_t)m * DM + c0 + 8 * fq; float ss = 0.f;
#pragma unroll
        for (int h = 0; h < 2; ++h) { const f32x4 h0 = *(const f32x4*)(b + 32 * h) + v[2 * h], h1 = *(const f32x4*)(b + 32 * h + 4) + v[2 * h + 1]; st_bf16x8(hb + 32 * h, h0, h1); ss += ssq8(h0, h1); }
        ss = quad_sum(ss);
        if (fq == 0) SS[(size_t)m * 16 + (c0 >> 6)] = ss;
    }
};
struct EpiResC {
    bf16* HB; float* SS;
    __device__ __forceinline__ void seg64(int m, int c0, f32x4 (&v)[4], int fq) const {
        bf16* hb = HB + (size_t)m * DM + c0 + 8 * fq; float ss = 0.f;
#pragma unroll
        for (int h = 0; h < 2; ++h) { f32x4 h0, h1; ld_bf16x8(hb + 32 * h, h0, h1); h0 = h0 + v[2 * h]; h1 = h1 + v[2 * h + 1]; st_bf16x8(hb + 32 * h, h0, h1); ss += ssq8(h0, h1); }
        ss = quad_sum(ss);
        if (fq == 0) SS[(size_t)m * 16 + (c0 >> 6)] = ss;
    }
};
struct EpiUpP {
    bf16* HM; const LAS float* rs; int row0;
    __device__ __forceinline__ void seg64(int m, int c0, f32x4 (&v)[4], int fq) const {
        const float rstd = rs[m - row0];
        bf16* d = HM + (size_t)(m - row0) * DFF + c0 + 8 * fq;
#pragma unroll
        for (int h = 0; h < 2; ++h) { f32x4 a = v[2 * h] * rstd, b = v[2 * h + 1] * rstd;
#pragma unroll
            for (int j = 0; j < 4; ++j) { const float r = fmaxf(a[j], 0.f), q = fmaxf(b[j], 0.f); a[j] = r * r; b[j] = q * q; }
            st_bf16x8(d + 32 * h, a, b); }
    }
};
struct EpiBfP {
    bf16* O; int ld;
    __device__ __forceinline__ void seg64(int m, int c0, f32x4 (&v)[4], int fq) const {
        bf16* d = O + (size_t)m * ld + c0 + 8 * fq;
        st_bf16x8(d, v[0], v[1]); st_bf16x8(d + 32, v[2], v[3]);
    }
};
namespace pg8 {
struct EpiGateFinal {
    static constexpr bool PERM = true, AFTER_DRAIN = true;
    const bf16* HB; const bf16* PP; const float* SS2; float* SS3; float* out; const float* fg; unsigned* cnt; unsigned target; unsigned* tmo; int row0;
    __device__ __forceinline__ void fused(f32x4 (&acc)[2][2][4][2], const Unit& u, int wr, int wc, int fr, int fq, PG8_LAS unsigned char* lds, int wid, int lane) const {
        const int c0 = u.pn * BM + wc * 64;
#pragma unroll
        for (int ai = 0; ai < 2; ++ai)
#pragma unroll
            for (int m = 0; m < 4; ++m) {
                const int row = row0 + ai * HALF + wr * 64 + m * 16 + fr;
                const float rstd = ((const PG8_LAS float*)(lds + RSTD_OFF))[row - row0];
                const bf16* hb = HB + (size_t)row * DM + c0 + 8 * fq; const bf16* pp = PP + (size_t)row * DM + c0 + 8 * fq; float ss = 0.f;
#pragma unroll
                for (int bj = 0; bj < 2; ++bj) { ::f32x4 hv[2], pv[2]; ld_bf16x8(hb + 32 * bj, hv[0], hv[1]); ld_bf16x8(pp + 32 * bj, pv[0], pv[1]);
#pragma unroll
                    for (int n = 0; n < 2; ++n) { const ::f32x4 a = acc[ai][bj][m][n]; ::f32x4 h;
#pragma unroll
                        for (int e = 0; e < 4; ++e) h[e] = hv[n][e] + pv[n][e] / (1.0f + __expf(-a[e] * rstd));
                        acc[ai][bj][m][n] = h; ss += (h[0] * h[0] + h[1] * h[1]) + (h[2] * h[2] + h[3] * h[3]); } }
                ss = quad_sum(ss);
                if (fq == 0) SS3[(size_t)row * 16 + (c0 >> 6)] = ss;
                if (m & 1) asm volatile("" ::: "memory");
            }
        group_sync(cnt, target, tmo);
        if (threadIdx.x < 256) ((PG8_LAS float*)(lds + RSTD_OFF))[threadIdx.x] = rstd_from_ss(SS3 + (size_t)(row0 + threadIdx.x) * 16);
        __syncthreads();
#pragma unroll
        for (int ai = 0; ai < 2; ++ai)
#pragma unroll
            for (int m = 0; m < 4; ++m) {
                const int row = row0 + ai * HALF + wr * 64 + m * 16 + fr;
                const float rstd = ((const PG8_LAS float*)(lds + RSTD_OFF))[row - row0];
                float* o = out + (size_t)row * DM + c0 + 8 * fq; const float* g = fg + c0 + 8 * fq;
#pragma unroll
                for (int bj = 0; bj < 2; ++bj)
#pragma unroll
                    for (int n = 0; n < 2; ++n) *(::f32x4*)(o + 32 * bj + 4 * n) = acc[ai][bj][m][n] * rstd * *(const ::f32x4*)(g + 32 * bj + 4 * n);
                if (m & 1) asm volatile("" ::: "memory");
            }
    }
};
struct ListOrder {
    int pn0, n;
    __device__ __forceinline__ bool next(int i, Unit& u) const { if (i >= n) return false; u.pm = 0; u.pn = pn0 + i; return true; }
    __device__ __forceinline__ void a_ready(const Unit&) const {}
    __device__ __forceinline__ void done(const Unit&) const {}
};
}
template <class E>
__device__ __forceinline__ void lgemm(const Frame& F, const bf16* A, const bf16* Bt, int N, int K, int row0, int pn0, int n, const E& e) {
    pg8::Gemm g{A, Bt, 256, N, K}; pg8::ListOrder S{pn0, n};
    pg8::EpiAdapt<E, true> EA{e, row0};
    pg8::gemm_phase<pg8::EpiAdapt<E, true>, pg8::ListOrder, true, true>(F.lds, g, S, EA);
}
__device__ __forceinline__ void tail_phase(const Frame& F, const Args& args) {
    const int gidx = F.vcu >> 2, mem = F.vcu & 3;
    unsigned nsync = 0u;
#pragma unroll 1
    for (int c = 0; c < 4; ++c) {
        unsigned char* ws = F.ws; asm volatile("" : "+s"(ws));
        bf16* HB = (bf16*)(ws + WS_XN); const bf16* PP = (const bf16*)(ws + WS_PP); const bf16* MIX = (const bf16*)(ws + WS_MIX);
        float* SS1 = (float*)(ws + WS_SS1); float* SS2 = (float*)(ws + WS_SS2);
        bf16* HMg = (bf16*)(ws + WS_HM) + (size_t)gidx * 256 * DFF;
        unsigned* cnt = (unsigned*)(ws + WS_CTL) + CW_GRP + 64 * gidx; unsigned* tmo = (unsigned*)(ws + WS_CTL) + CW_GRP_TMO;
        const LAS float* rs = (const LAS float*)(F.lds + RSTD_OFF);
        const bf16* PB = (const bf16*)(ws + WS_PB); bf16* PPw = (bf16*)(ws + WS_PP);
        const int row0 = (c * 64 + gidx) * 256, rowp = row0 - 64 * 256;
        if (c < 3) { EpiResA E{args.in[0], args.in[1], HB, SS1}; lgemm(F, MIX + (size_t)row0 * DM, (const bf16*)(ws + WS_WOUT), DM, DM, row0, mem, 1, E); }
        if (c > 0) {
            { EpiBfP E{PPw, DM}; lgemm(F, PB + (size_t)rowp * PLE, (const bf16*)(ws + WS_WPROJ), DM, PLE, rowp, mem, 1, E); }
            rstd_table(F, SS2, rowp);
            pg8::Gemm g{HB + (size_t)rowp * DM, (const bf16*)(ws + WS_WGATE), 256, DM, DM}; pg8::ListOrder S{mem, 1};
            pg8::EpiGateFinal E{HB, PP, SS2, SS1, args.out, args.in[17], cnt, 4u * (++nsync), tmo, rowp};
            pg8::gemm_phase<pg8::EpiGateFinal, pg8::ListOrder, false, true>(F.lds, g, S, E);
        }
        if (c < 3) {
            if (c == 0) group_sync(cnt, 4u * (++nsync), tmo);
            rstd_table(F, SS1, row0);
            { EpiUpP E{HMg, rs, row0}; lgemm(F, HB + (size_t)row0 * DM, (const bf16*)(ws + WS_WUP), DFF, DM, row0, 4 * mem, 4, E); }
            group_sync(cnt, 4u * (++nsync), tmo);
            { EpiResC E{HB, SS2}; lgemm(F, HMg, (const bf16*)(ws + WS_WDOWN), DM, DFF, row0, mem, 1, E); }
            group_sync(cnt, 4u * (++nsync), tmo);
        }
    }
}

constexpr int NPHASE = 4;
__global__ void __launch_bounds__(NWAVES * 64, 2) fwd_kernel(Args args) {
    extern __shared__ __attribute__((aligned(16))) unsigned char lds[];
    Frame F;
    F.lds = (LAS unsigned char*)lds; F.tid = threadIdx.x; F.lane = F.tid & 63; F.wave = __builtin_amdgcn_readfirstlane(F.tid >> 6);
    F.G = gridDim.x; { const int bx = blockIdx.x; F.vcu = (F.G % 8 == 0) ? (bx % 8) * (F.G / 8) + bx / 8 : bx; }
    F.ws = args.ws;
    unsigned char* ws = args.ws;
    for (int u = F.tid; u < (LDS_BYTES - LDSCTL_OFF) / 4; u += NWAVES * 64) ((LAS unsigned*)(F.lds + LDSCTL_OFF))[u] = 0u;
    __syncthreads();
    XcdBarrier bar; bar.bar = (unsigned*)(ws + WS_CTL) + CW_BAR; bar.x = 0; bar.st = nullptr;
    if (args.ph_hi - args.ph_lo > 1) bar = xcd_barrier_post((unsigned*)(ws + WS_CTL) + CW_BAR, (volatile LAS unsigned*)(F.lds + MISC_OFF) + 8);
    bf16* XN = (bf16*)(ws + WS_XN); bf16* PP = (bf16*)(ws + WS_PP); bf16* MIX = (bf16*)(ws + WS_MIX); bf16* HM = (bf16*)(ws + WS_HM);
    float* SS1 = (float*)(ws + WS_SS1); float* SS2 = (float*)(ws + WS_SS2);
    const int lo = args.ph_lo, hi = args.ph_hi;
#define IN(k) (lo <= (k) && (k) < hi)
#define SEAM(k) do { if (IN(k) && IN((k) + 1)) xcd_barrier(bar); } while (0)
#define NREP(k) ((PROBE_REPEAT == (k)) ? 2 : 1)
#define REPBAR() do { if (rep) xcd_barrier(bar); } while (0)
    float* const dry = (float*)(ws + WS_HM);
    if (IN(0)) {
#pragma unroll 1
        for (int rep = 0; rep < NREP(0); ++rep) { REPBAR(); p0_prologue(F, args); } } SEAM(0);
    if (IN(1)) {
#pragma unroll 1
        for (int rep = 0; rep < NREP(1); ++rep) { REPBAR();
        EpiIn E{(bf16*)(ws + WS_Q), (bf16*)(ws + WS_K), (bf16*)(ws + WS_V), (bf16*)(ws + WS_U), args.in[6], args.in[7], (const float2*)(ws + WS_ROPE)};
        fgemm(F, XN, (const bf16*)(ws + WS_WIN), M, INW, DM, 0, E); }
    } SEAM(1);
    if (IN(2)) {
        const attn_body::AttnTensors AT{(const attn_body::bf16*)(ws + WS_Q), (const attn_body::bf16*)(ws + WS_K), (const attn_body::bf16*)(ws + WS_V), (attn_body::bf16*)MIX};
#pragma unroll 1
        for (int rep = 0; rep < NREP(2); ++rep) { REPBAR(); attn_body::attn_phase<8>((char*)lds, AT, F.vcu, F.G); }
#pragma unroll 1
        for (int rep = 0; rep < NREP(12); ++rep) { REPBAR(); pool_phase(F); }
    } SEAM(2);
    if (IN(3)) tail_phase(F, args);
#undef NREP
#undef REPBAR
#undef IN
#undef SEAM
}

extern "C" void kernel_launch(void* const* d_in, const int* in_sizes, int n_in, void* d_out, int out_size, void* d_ws, size_t ws_size, hipStream_t stream) {
    static int grid = 0;
    if (grid == 0) {
        if (n_in != 18 || out_size != M * DM || ws_size < WS_END) { fprintf(stderr, "kernel_launch: unexpected shapes (n_in %d out %d ws %zu)\n", n_in, out_size, ws_size); grid = -1; return; }
        if (hipFuncSetAttribute((const void*)fwd_kernel, hipFuncAttributeMaxDynamicSharedMemorySize, LDS_BYTES) != hipSuccess) { fprintf(stderr, "kernel_launch: hipFuncSetAttribute failed\n"); grid = -1; return; }
        int dev = 0, cus = 0; (void)hipGetDevice(&dev); (void)hipDeviceGetAttribute(&cus, hipDeviceAttributeMultiprocessorCount, dev);
        grid = cus > 0 ? cus : 256;
    }
    if (grid < 0) return;
    Args a{};
    for (int i = 0; i < 18; ++i) a.in[i] = (const float*)d_in[i];
    a.out = (float*)d_out; a.ws = (unsigned char*)d_ws;
#if MK_ONE_LAUNCH
    if (hipMemsetAsync((char*)d_ws + WS_CTL, 0, 65536, stream) != hipSuccess) { fprintf(stderr, "kernel_launch: memset failed\n"); return; }
    a.ph_lo = 0; a.ph_hi = NPHASE; hipLaunchKernelGGL(fwd_kernel, dim3(grid), dim3(NWAVES * 64), LDS_BYTES, stream, a);
#else
    for (int ph = 0; ph < NPHASE; ++ph) { a.ph_lo = ph; a.ph_hi = ph + 1; hipLaunchKernelGGL(fwd_kernel, dim3(grid), dim3(NWAVES * 64), LDS_BYTES, stream, a); }
#endif
}
```

```cpp
#include <hip/hip_runtime.h>
#include <cstdio>
#include <cstdint>
#include <hip/hip_bf16.h>
#include <cmath>

#ifndef P0_RIF
#define P0_RIF 8
#endif
#ifndef TAIL_SPLIT_P
#define TAIL_SPLIT_P 1
#endif
#ifndef ATTN_PRIO
#define ATTN_PRIO 0
#endif
#ifndef TAIL_LIGHT
#define TAIL_LIGHT 1
#endif
#ifndef PROBE_CLOCK
#define PROBE_CLOCK (0)
#endif
#ifndef PROBE_AVAR
#define PROBE_AVAR (0)
#endif
#ifndef PROBE_REPEAT
#define PROBE_REPEAT (-1)
#endif
#ifndef TAIL_REP
#define TAIL_REP (-1)
#endif
#ifndef TAIL_CLS
#define TAIL_CLS 0
#endif
#ifndef ATTN_NOMAX
#define ATTN_NOMAX 1
#endif
#ifndef TAIL_STAGGER_TICKS
#define TAIL_STAGGER_TICKS 0
#endif
#ifndef TAIL_PROBE_B
#define TAIL_PROBE_B (-1)
#endif
#ifndef ATTN_U4
#define ATTN_U4 1
#endif
#ifndef ATTN_U3
#define ATTN_U3 1
#endif
#ifndef MK_ONE_LAUNCH
#define MK_ONE_LAUNCH 1
#endif

constexpr int DM = 1024, TP = 4096, TS = 8192, MP = 4 * TP, MS = 4 * TS, M = MP + MS;
constexpr int INW = 1280, DFF = 4096, PLE = 256;
constexpr int CHUNK = 16384, NCHUNK = M / CHUNK;
constexpr float EPS = 1e-6f;
constexpr float C2 = 0.125f * 1.4426950408889634f;

typedef unsigned short bf16;
typedef short bf16x8 __attribute__((ext_vector_type(8)));
typedef float f32x4 __attribute__((ext_vector_type(4)));
typedef unsigned u32x4 __attribute__((ext_vector_type(4)));
typedef unsigned u32x2 __attribute__((ext_vector_type(2)));
#define LAS __attribute__((address_space(3)))
#define GAS __attribute__((address_space(1)))

constexpr size_t MiB = 1u << 20;
constexpr size_t WS_CTL = 0, CTL_ZERO_BYTES = 1 * MiB;
constexpr size_t WS_ROPE = 1 * MiB;
constexpr size_t WS_RSX = 1 * MiB + 65536;
constexpr size_t WS_SS1 = 2 * MiB, WS_SS2 = 5 * MiB;
constexpr size_t WS_WIN = 8 * MiB, WS_WOUT = 11 * MiB, WS_WUP = 13 * MiB, WS_WDOWN = 21 * MiB, WS_WGATE = 29 * MiB, WS_WPROJ = 31 * MiB;
constexpr size_t WS_PP = 32 * MiB;
constexpr size_t WS_XN = 128 * MiB;
constexpr size_t WS_PB = 464 * MiB;
constexpr size_t WS_Q = 248 * MiB, WS_K = 296 * MiB, WS_V = 308 * MiB, WS_U = 320 * MiB;
constexpr size_t WS_MIX = 368 * MiB;
constexpr size_t WS_HM = 224 * MiB;
constexpr size_t WS_END = 488 * MiB;

constexpr int LDS_BYTES = 147456;
constexpr int NWAVES = 8;

__device__ __forceinline__ unsigned f2bf(float f) { unsigned u = __builtin_bit_cast(unsigned, f); return (u + 0x7fffu + ((u >> 16) & 1u)) >> 16; }
__device__ __forceinline__ unsigned pk2(float lo, float hi) { return f2bf(lo) | (f2bf(hi) << 16); }
__device__ __forceinline__ float bf2f(unsigned short b) { return __builtin_bit_cast(float, (unsigned)b << 16); }
__device__ __forceinline__ float bflo(unsigned w) { return __builtin_bit_cast(float, w << 16); }
__device__ __forceinline__ float bfhi(unsigned w) { return __builtin_bit_cast(float, w & 0xffff0000u); }
typedef float f32x2_k __attribute__((ext_vector_type(2))); typedef __bf16 bf16x2_k __attribute__((ext_vector_type(2)));
__device__ __forceinline__ unsigned cvtpk(float lo, float hi) { f32x2_k v = {lo, hi}; bf16x2_k b = __builtin_convertvector(v, bf16x2_k); return __builtin_bit_cast(unsigned, b); }
__device__ __forceinline__ float wave_sum(float v) {
#pragma unroll
    for (int o = 1; o < 64; o <<= 1) v += __shfl_xor(v, o);
    return v;
}
__host__ __device__ __forceinline__ int inv_head(int n) { const int pn = n >> 8, r = n & 255, wc = r >> 6, bj = (r >> 5) & 1, j = r & 31; return pn * 256 + bj * 128 + wc * 32 + j; }

struct Args { const float* in[18]; float* out; unsigned char* ws; int ph_lo, ph_hi; };

struct Frame {
    LAS unsigned char* lds;
    int tid, lane, wave, vcu, G;
    unsigned char* ws;
};
__device__ __forceinline__ const float* xrow(const Args& A, int m) { return m < MP ? A.in[0] + (size_t)m * DM : A.in[1] + (size_t)(m - MP) * DM; }
__device__ __forceinline__ const float* prow(const Args& A, int m) { return m < MP ? A.in[2] + (size_t)m * PLE : A.in[3] + (size_t)(m - MP) * PLE; }
__device__ __forceinline__ int tpos(int m) { return m < MP ? (m & (TP - 1)) : ((m - MP) & (TS - 1)); }

__device__ __forceinline__ void p0_transpose_item(const float* W, int ldw, int K, int ncols, bf16* WT, LAS float* scr, int item, int lane, const float* kscale, bool headmap) {
    const int nblk = ncols / 32, kb = item / nblk, nb = item % nblk, k0 = 64 * kb, n0 = 32 * nb;
#pragma unroll
    for (int i = 0; i < 32; ++i) { const int kk = 2 * i + (lane >> 5); float v = W[(size_t)(k0 + kk) * ldw + n0 + (lane & 31)]; if (kscale) v *= kscale[k0 + kk]; scr[kk * 33 + (lane & 31)] = v; }
    asm volatile("s_waitcnt lgkmcnt(0)" ::: "memory");
    const int c = lane & 7;
#pragma unroll
    for (int j = 0; j < 4; ++j) { const int n = (lane >> 3) + 8 * j; const LAS float* s = scr + (8 * c) * 33 + n;
        u32x4 o; o.x = pk2(s[0 * 33], s[1 * 33]); o.y = pk2(s[2 * 33], s[3 * 33]); o.z = pk2(s[4 * 33], s[5 * 33]); o.w = pk2(s[6 * 33], s[7 * 33]);
        const int dr = headmap ? inv_head(n0 + n) : (n0 + n);
        *(u32x4*)(WT + (size_t)dr * K + k0 + 8 * c) = o; }
    asm volatile("s_waitcnt lgkmcnt(0)" ::: "memory");
}
__device__ __forceinline__ void p0_fold_item(const float* Win, const float* Wp, const float* psc, const float* gk, bf16* WT, LAS float* scr, int item, int lane) {
    const int g = item & 3, k0 = (item >> 2) * 8;
#pragma unroll
    for (int i = 0; i < 16; ++i) { const int e = i * 64 + lane, kk = e >> 7, c = e & 127; scr[e] = Win[(size_t)(k0 + kk) * INW + 768 + 128 * g + c] * gk[k0 + kk]; }
    asm volatile("s_waitcnt lgkmcnt(0)" ::: "memory");
    float a0[8], a1[8];
#pragma unroll
    for (int kk = 0; kk < 8; ++kk) { a0[kk] = 0.f; a1[kk] = 0.f; }
    const float* wp = Wp + (size_t)g * 128 * 128 + lane;
#pragma unroll 1
    for (int cb = 0; cb < 128; cb += 8) {
        float w0[8], w1[8];
#pragma unroll
        for (int i = 0; i < 8; ++i) { w0[i] = wp[(cb + i) * 128]; w1[i] = wp[(cb + i) * 128 + 64]; }
#pragma unroll
        for (int i = 0; i < 8; ++i)
#pragma unroll
            for (int kk = 0; kk < 8; ++kk) { const float a = scr[kk * 128 + cb + i]; a0[kk] += a * w0[i]; a1[kk] += a * w1[i]; }
    }
    const float s0 = psc[128 * g + lane], s1 = psc[128 * g + 64 + lane];
    { u32x4 o0; o0.x = pk2(a0[0] * s0, a0[1] * s0); o0.y = pk2(a0[2] * s0, a0[3] * s0); o0.z = pk2(a0[4] * s0, a0[5] * s0); o0.w = pk2(a0[6] * s0, a0[7] * s0);
      *(u32x4*)(WT + (size_t)inv_head(768 + 128 * g + lane) * DM + k0) = o0; }
    { u32x4 o1; o1.x = pk2(a1[0] * s1, a1[1] * s1); o1.y = pk2(a1[2] * s1, a1[3] * s1); o1.z = pk2(a1[4] * s1, a1[5] * s1); o1.w = pk2(a1[6] * s1, a1[7] * s1);
      *(u32x4*)(WT + (size_t)inv_head(768 + 128 * g + 64 + lane) * DM + k0) = o1; }
    asm volatile("s_waitcnt lgkmcnt(0)" ::: "memory");
}
__device__ __forceinline__ void rms_row_to_bf16(const float* xr_, const float* g, bf16* orow, int lane) {
    const f32x4* xr = (const f32x4*)xr_ + lane; const f32x4* gr = (const f32x4*)g + lane;
    f32x4 v[4]; float s = 0.f;
#pragma unroll
    for (int j = 0; j < 4; ++j) { v[j] = xr[64 * j]; s += (v[j].x * v[j].x + v[j].y * v[j].y) + (v[j].z * v[j].z + v[j].w * v[j].w); }
    const float rstd = 1.0f / sqrtf(wave_sum(s) * (1.f / DM) + EPS);
    unsigned long long* o8 = (unsigned long long*)orow + lane;
#pragma unroll
    for (int j = 0; j < 4; ++j) { const f32x4 gg = gr[64 * j];
        o8[64 * j] = (unsigned long long)pk2(v[j].x * rstd * gg.x, v[j].y * rstd * gg.y) | ((unsigned long long)pk2(v[j].z * rstd * gg.z, v[j].w * rstd * gg.w) << 32); }
}
constexpr int P0_I_FOLD = 128 * 4, P0_I_IN = (DM / 64) * (768 / 32), P0_I_OUT = (DM / 64) * (DM / 32), P0_I_UP = (DM / 64) * (DFF / 32), P0_I_DOWN = (DFF / 64) * (DM / 32), P0_I_GATE = P0_I_OUT, P0_I_PROJ = (PLE / 64) * (DM / 32);
constexpr int P0_NW_IN = P0_I_FOLD + P0_I_IN, P0_NITEMS = P0_NW_IN + P0_I_OUT + P0_I_UP + P0_I_DOWN + P0_I_GATE + P0_I_PROJ;
__device__ __forceinline__ void p0_items(const Frame& F, const Args& A, int lo, int hi, int gw, int ngw) {
    LAS float* scr = (LAS float*)(F.lds + F.wave * 16384);
    bf16* Bin = (bf16*)(F.ws + WS_WIN); bf16* Bout = (bf16*)(F.ws + WS_WOUT); bf16* Bup = (bf16*)(F.ws + WS_WUP);
    bf16* Bdown = (bf16*)(F.ws + WS_WDOWN); bf16* Bgate = (bf16*)(F.ws + WS_WGATE); bf16* Bproj = (bf16*)(F.ws + WS_WPROJ);
    for (int it = lo + gw; it < hi; it += ngw) {
        int r = it;
        if (r < P0_I_FOLD) { p0_fold_item(A.in[5], A.in[8], A.in[9], A.in[4], Bin, scr, r, F.lane); continue; } r -= P0_I_FOLD;
        if (r < P0_I_IN) { p0_transpose_item(A.in[5], INW, DM, 768, Bin, scr, r, F.lane, A.in[4], true); continue; } r -= P0_I_IN;
        if (r < P0_I_OUT) { p0_transpose_item(A.in[10], DM, DM, DM, Bout, scr, r, F.lane, nullptr, true); continue; } r -= P0_I_OUT;
        if (r < P0_I_UP) { p0_transpose_item(A.in[12], DFF, DM, DFF, Bup, scr, r, F.lane, A.in[11], true); continue; } r -= P0_I_UP;
        if (r < P0_I_DOWN) { p0_transpose_item(A.in[13], DM, DFF, DM, Bdown, scr, r, F.lane, nullptr, true); continue; } r -= P0_I_DOWN;
        if (r < P0_I_GATE) { p0_transpose_item(A.in[15], DM, DM, DM, Bgate, scr, r, F.lane, A.in[14], true); continue; } r -= P0_I_GATE;
        p0_transpose_item(A.in[16], DM, PLE, DM, Bproj, scr, r, F.lane, nullptr, true);
    }
}
template <int R>
__device__ __forceinline__ void p0_rows(const Frame& F, const Args& A, int m0, int mstep) {
    bf16* XN = (bf16*)(F.ws + WS_XN); bf16* PB = (bf16*)(F.ws + WS_PB);
    f32x4 v[R][4], pv[R];
#pragma unroll
    for (int r = 0; r < R; ++r) { const f32x4* xr = (const f32x4*)xrow(A, m0 + r * mstep) + F.lane;
#pragma unroll
        for (int j = 0; j < 4; ++j) v[r][j] = __builtin_nontemporal_load(xr + 64 * j);
        pv[r] = __builtin_nontemporal_load((const f32x4*)prow(A, m0 + r * mstep) + F.lane); }
#pragma unroll
    for (int r = 0; r < R; ++r) { const int mr = m0 + r * mstep; u32x2* o = (u32x2*)(XN + (size_t)mr * DM) + F.lane;
#pragma unroll
        for (int j = 0; j < 4; ++j) { const f32x4 w = v[r][j]; u32x2 t; t.x = cvtpk(w.x, w.y); t.y = cvtpk(w.z, w.w); o[64 * j] = t; }
        u32x2 t; t.x = cvtpk(pv[r].x, pv[r].y); t.y = cvtpk(pv[r].z, pv[r].w); *((u32x2*)(PB + (size_t)mr * PLE) + F.lane) = t; }
#pragma unroll
    for (int r = 0; r < R; ++r) { float q = 0.f;
#pragma unroll
        for (int j = 0; j < 4; ++j) q += (v[r][j].x * v[r][j].x + v[r][j].y * v[r][j].y) + (v[r][j].z * v[r][j].z + v[r][j].w * v[r][j].w);
        const float rs = 1.0f / sqrtf(wave_sum(q) * (1.f / DM) + EPS);
        if (F.lane == 0) ((float*)(F.ws + WS_RSX))[m0 + r * mstep] = rs; }
}
__device__ __forceinline__ void p0_rope(const Frame& F) {
    const int gt = F.vcu * 512 + F.tid;
    if (gt < 2048) { const int p = gt >> 4, i = gt & 15; const float inv = exp2f(-(float)i * (13.287712379549449f / 16.0f)); const float a = (float)p * inv;
        float2* R = (float2*)(F.ws + WS_ROPE); R[gt] = make_float2(cosf(a), sinf(a)); }
}
__device__ __forceinline__ void p0_prologue(const Frame& F, const Args& A) {
    const int gw = F.vcu * NWAVES + F.wave, NGW = F.G * NWAVES;
    p0_items(F, A, 0, P0_NITEMS, gw, NGW);
    for (int m = gw; m < M; m += P0_RIF * NGW) p0_rows<P0_RIF>(F, A, m, NGW);
    p0_rope(F);
}
namespace pg8 {
#define PG8_LAS __attribute__((address_space(3)))
typedef unsigned short bf16_t;
typedef short bf16x8 __attribute__((ext_vector_type(8)));
typedef float f32x4 __attribute__((ext_vector_type(4)));
typedef unsigned u32x4 __attribute__((ext_vector_type(4)));
constexpr int BM = 256, BK = 64, HALF = 128, HTB = HALF * BK * 2  , STAGE_BYTES = 8 * HTB, NXCD = 8, WGM = 8;

__host__ __device__ __forceinline__ int lds_byte(int r, int c) { const int st = (r >> 4) * 2 + (c >> 5), rr = r & 15, cc = c & 31, ob = rr * 64 + cc * 2; return st * 1024 + (ob ^ (((ob >> 9) & 1) << 5)); }
__host__ __device__ __forceinline__ void stage_rc(int b, int& R, int& C) { const int st = b / 1024, sb = b % 1024, swz = sb ^ (((sb >> 9) & 1) << 5); R = (st >> 1) * 16 + swz / 64; C = (st & 1) * 32 + (swz % 64) / 2; }
__host__ __device__ __forceinline__ int perm32(int rho) { const int n = rho >> 4, i = rho & 15; return 8 * (i >> 2) + 4 * n + (i & 3); }

struct Unit { int pm, pn; };
struct Gemm { const bf16_t* A; const bf16_t* Bt; int M, N, K; };

struct StaticOrder {
    int nM, nN, nwg, G, c;
    __host__ __device__ void init(int M, int N, int G_, int c_) { nM = M / BM; nN = N / BM; nwg = nM * nN; G = G_; c = c_; }
    __host__ __device__ bool next(int i, Unit& u) const {
        const long L = (long)i * G + c; if (L >= nwg) return false;
        int wgid = (int)L; { const int q = nwg / NXCD, r = nwg % NXCD, xcd = wgid % NXCD, off = wgid / NXCD; wgid = (xcd < r ? xcd * (q + 1) : r * (q + 1) + (xcd - r) * q) + off; }
        const int nig = WGM * nN, gid = wgid / nig, fm = gid * WGM, gsz = (nM - fm) < WGM ? (nM - fm) : WGM;
        u.pm = fm + ((wgid % nig) % gsz); u.pn = (wgid % nig) / gsz; return true;
    }
    __device__ __forceinline__ void a_ready(const Unit&) const {}
    __device__ __forceinline__ void done(const Unit&) const {}
};

template <class T, class = void> struct nofence_of { static constexpr bool value = false; };
template <class T> struct nofence_of<T, decltype((void)T::NOFENCE)> { static constexpr bool value = T::NOFENCE; };
template <class E, bool PERMV = false> struct EpiAdapt {
    static constexpr bool PERM = PERMV, AFTER_DRAIN = false;
    E e; int row0;
    __device__ __forceinline__ void operator()(f32x4 (&acc)[2][2][4][2], const Unit& u, int wr, int wc, int fr, int fq) const {
        const int c0 = u.pn * BM + wc * 64;
        if constexpr (nofence_of<E>::value) { e.tile(acc, row0 + u.pm * BM + wr * 64 + fr, c0, fq); return; }
#pragma unroll
        for (int ai = 0; ai < 2; ++ai)
#pragma unroll
            for (int m = 0; m < 4; ++m) {
                ::f32x4 v[4] = {acc[ai][0][m][0], acc[ai][0][m][1], acc[ai][1][m][0], acc[ai][1][m][1]};
                e.seg64(row0 + u.pm * BM + ai * HALF + wr * 64 + m * 16 + fr, c0, v, fq);
                if (!nofence_of<E>::value && (m & 1)) asm volatile("" ::: "memory");
            }
    }
};
template <class Epi, class Sched, bool ALIGN_EPI = false, bool SP2 = false>
__device__ __forceinline__ void gemm_phase(PG8_LAS unsigned char* lds, const Gemm g, const Sched& S, const Epi& E) {
    int tid_ = threadIdx.x; asm volatile("" : "+v"(tid_));
    const int tid = tid_, wid = __builtin_amdgcn_readfirstlane(tid >> 6), lane = tid & 63, wr = wid >> 2, wc = wid & 3, fr = lane & 15, fq = lane >> 4;
    const int K = g.K, nt = K / BK;
    unsigned voffA[2], voffB[2];
#pragma unroll
    for (int i = 0; i < 2; ++i) { int R, C; stage_rc(tid * 16 + i * 8192, R, C); const int Rb = Epi::PERM ? ((R & ~31) + perm32(R & 31)) : R;
        voffA[i] = (unsigned)(R * K + C) * 2u; voffB[i] = (unsigned)(Rb * K + C) * 2u; }
    const size_t kstep = (size_t)(BK * 2);
    const size_t hstep = (size_t)HALF * K * 2;
    const size_t tstep = 2 * hstep;
    const unsigned ldsw = (unsigned)wid * 1024u;
    const int aoff = lds_byte(wr * 64 + fr, fq * 8), boff = lds_byte(wc * 32 + fr, fq * 8);
#define PG8_SA(b, h) (((b) * 2 + (h)) * HTB)
#define PG8_SB(b, h) ((4 + (b) * 2 + (h)) * HTB)
#define PG8_STAGE(bufoff, gbase, voff) do { _Pragma("unroll") for (int _i = 0; _i < 2; ++_i) { unsigned _vo = (voff)[_i]; asm volatile("" : "+v"(_vo)); \
        __builtin_amdgcn_global_load_lds((const unsigned*)((const char*)(gbase) + _vo), (PG8_LAS unsigned*)(lds + (bufoff) + ldsw + _i * 8192), 16, 0, 0); } } while (0)
#define PG8_LDA(dst, b, h) do { _Pragma("unroll") for (int m = 0; m < 4; ++m) _Pragma("unroll") for (int k = 0; k < 2; ++k) dst[m][k] = *(const PG8_LAS bf16x8*)(lds + PG8_SA(b, h) + aoff + m * 2048 + k * 1024); } while (0)
#define PG8_LDB(dst, b, h) do { _Pragma("unroll") for (int n = 0; n < 2; ++n) _Pragma("unroll") for (int k = 0; k < 2; ++k) dst[n][k] = *(const PG8_LAS bf16x8*)(lds + PG8_SB(b, h) + boff + n * 2048 + k * 1024); } while (0)
#define PG8_MMA(ai, bj, At, Bt) do { __builtin_amdgcn_s_setprio(1); _Pragma("unroll") for (int m = 0; m < 4; ++m) _Pragma("unroll") for (int n = 0; n < 2; ++n) _Pragma("unroll") for (int k = 0; k < 2; ++k) \
        acc[ai][bj][m][n] = __builtin_amdgcn_mfma_f32_16x16x32_bf16(Bt[n][k], At[m][k], acc[ai][bj][m][n], 0, 0, 0); __builtin_amdgcn_s_setprio(0); } while (0)
#define PG8_WAIT_V(n) asm volatile("s_waitcnt vmcnt(" #n ")" ::: "memory")
#define PG8_WAIT_L(n) asm volatile("s_waitcnt lgkmcnt(" #n ")" ::: "memory")
#define PG8_BAR __builtin_amdgcn_s_barrier()
#define PG8_SCHED __builtin_amdgcn_sched_barrier(0)
    Unit cur, nxt; int ui = 0;
    if (!S.next(0, cur)) return;
    f32x4 acc[2][2][4][2];
#pragma unroll
    for (int a = 0; a < 2; ++a)
#pragma unroll
        for (int b = 0; b < 2; ++b)
#pragma unroll
            for (int m = 0; m < 4; ++m)
#pragma unroll
                for (int n = 0; n < 2; ++n) acc[a][b][m][n] = (f32x4){0.f, 0.f, 0.f, 0.f};
    bf16x8 At[4][2], B0[2][2], B1[2][2];
    const char* cA = (const char*)g.A + (size_t)cur.pm * tstep; const char* cB = (const char*)g.Bt + (size_t)cur.pn * tstep;
    S.a_ready(cur);
    if constexpr (SP2) {
        PG8_STAGE(PG8_SB(0, 0), cB, voffB); PG8_STAGE(PG8_SB(0, 1), cB + hstep, voffB); PG8_STAGE(PG8_SA(0, 0), cA, voffA); PG8_STAGE(PG8_SA(0, 1), cA + hstep, voffA);
        if (wr == 1) PG8_BAR;
        PG8_WAIT_V(2); PG8_BAR;
        PG8_STAGE(PG8_SB(1, 0), cB + kstep, voffB); PG8_STAGE(PG8_SA(1, 0), cA + kstep, voffA); PG8_STAGE(PG8_SB(1, 1), cB + hstep + kstep, voffB);
        PG8_WAIT_V(6); PG8_BAR;
    } else {
        PG8_STAGE(PG8_SB(0, 0), cB, voffB); PG8_STAGE(PG8_SA(0, 0), cA, voffA); PG8_STAGE(PG8_SB(0, 1), cB + hstep, voffB); PG8_STAGE(PG8_SA(0, 1), cA + hstep, voffA);
        if (wr == 1) PG8_BAR;
        PG8_WAIT_V(4); PG8_BAR;
        PG8_STAGE(PG8_SB(1, 0), cB + kstep, voffB); PG8_STAGE(PG8_SA(1, 0), cA + kstep, voffA); PG8_STAGE(PG8_SB(1, 1), cB + hstep + kstep, voffB);
        PG8_WAIT_V(6); PG8_BAR;
    }
    for (;;) {
        const bool has_next = S.next(ui + 1, nxt);
        const char* nA = has_next ? (const char*)g.A + (size_t)nxt.pm * tstep : cA; const char* nB = has_next ? (const char*)g.Bt + (size_t)nxt.pn * tstep : cB;
        for (int t = 0; t < nt; t += 2) {
            const bool last = (t == nt - 2);
            const char* a1 = cA + (size_t)(t + 1) * kstep;
            const char* a2 = last ? nA : cA + (size_t)(t + 2) * kstep; const char* b2 = last ? nB : cB + (size_t)(t + 2) * kstep;
            const char* a3 = a2 + kstep; const char* b3 = b2 + kstep;
            if (last && has_next) S.a_ready(nxt);
            if constexpr (SP2) {
            PG8_LDB(B0, 0, 0); PG8_LDB(B1, 0, 1); PG8_SCHED; PG8_LDA(At, 0, 0); PG8_STAGE(PG8_SA(1, 1), a1 + hstep, voffA);
            PG8_WAIT_V(8); PG8_WAIT_L(0); PG8_BAR; PG8_MMA(0, 0, At, B0); PG8_MMA(0, 1, At, B1); PG8_BAR; PG8_SCHED;
            PG8_LDA(At, 0, 1); PG8_STAGE(PG8_SB(0, 0), b2, voffB); PG8_STAGE(PG8_SB(0, 1), b2 + hstep, voffB); PG8_STAGE(PG8_SA(0, 0), a2, voffA);
            PG8_WAIT_V(8); PG8_WAIT_L(0); PG8_BAR; PG8_MMA(1, 0, At, B0); PG8_MMA(1, 1, At, B1); PG8_BAR; PG8_SCHED;
            PG8_LDB(B0, 1, 0); PG8_LDB(B1, 1, 1); PG8_SCHED; PG8_LDA(At, 1, 0); PG8_STAGE(PG8_SA(0, 1), a2 + hstep, voffA);
            PG8_WAIT_V(8); PG8_WAIT_L(0); PG8_BAR; PG8_MMA(0, 0, At, B0); PG8_MMA(0, 1, At, B1); PG8_BAR; PG8_SCHED;
            PG8_LDA(At, 1, 1); PG8_STAGE(PG8_SB(1, 0), b3, voffB); PG8_STAGE(PG8_SB(1, 1), b3 + hstep, voffB); PG8_STAGE(PG8_SA(1, 0), a3, voffA);
            PG8_WAIT_V(8); PG8_WAIT_L(0); PG8_BAR; PG8_MMA(1, 0, At, B0); PG8_MMA(1, 1, At, B1); PG8_BAR; PG8_SCHED;
            } else {
            PG8_LDB(B0, 0, 0); PG8_SCHED; PG8_LDA(At, 0, 0); PG8_STAGE(PG8_SA(1, 1), a1 + hstep, voffA);
            PG8_WAIT_L(8); PG8_BAR; PG8_WAIT_L(0); PG8_MMA(0, 0, At, B0); PG8_BAR; PG8_SCHED;
            PG8_LDB(B1, 0, 1); PG8_STAGE(PG8_SB(0, 0), b2, voffB);
            PG8_BAR; PG8_WAIT_L(0); PG8_MMA(0, 1, At, B1); PG8_BAR;
            PG8_LDA(At, 0, 1); PG8_STAGE(PG8_SA(0, 0), a2, voffA);
            PG8_BAR; PG8_WAIT_L(0); PG8_MMA(1, 0, At, B0); PG8_BAR; PG8_SCHED;
            PG8_STAGE(PG8_SB(0, 1), b2 + hstep, voffB);
            PG8_WAIT_V(6); PG8_BAR; PG8_MMA(1, 1, At, B1); PG8_BAR;
            PG8_LDB(B0, 1, 0); PG8_SCHED; PG8_LDA(At, 1, 0); PG8_STAGE(PG8_SA(0, 1), a2 + hstep, voffA);
            PG8_WAIT_L(8); PG8_BAR; PG8_WAIT_L(0); PG8_MMA(0, 0, At, B0); PG8_BAR; PG8_SCHED;
            PG8_LDB(B1, 1, 1); PG8_STAGE(PG8_SB(1, 0), b3, voffB);
            PG8_BAR; PG8_WAIT_L(0); PG8_MMA(0, 1, At, B1); PG8_BAR;
            PG8_LDA(At, 1, 1); PG8_STAGE(PG8_SA(1, 0), a3, voffA);
            PG8_BAR; PG8_WAIT_L(0); PG8_MMA(1, 0, At, B0); PG8_BAR; PG8_SCHED;
            PG8_STAGE(PG8_SB(1, 1), b3 + hstep, voffB);
            PG8_WAIT_V(6); PG8_BAR; PG8_MMA(1, 1, At, B1); PG8_BAR;
            }
        }
        if constexpr (ALIGN_EPI) { if (wr == 0) PG8_BAR; }
        if constexpr (!Epi::AFTER_DRAIN) { E(acc, cur, wr, wc, fr, fq); S.done(cur); }
        if (!has_next) break;
#pragma unroll
        for (int a = 0; a < 2; ++a)
#pragma unroll
            for (int b = 0; b < 2; ++b)
#pragma unroll
                for (int m = 0; m < 4; ++m)
#pragma unroll
                    for (int n = 0; n < 2; ++n) acc[a][b][m][n] = (f32x4){0.f, 0.f, 0.f, 0.f};
        cur = nxt; cA = nA; cB = nB; ++ui;
        if constexpr (ALIGN_EPI) { if (wr == 1) PG8_BAR; }
    }
    PG8_WAIT_V(0);
    if constexpr (!ALIGN_EPI) { if (wr == 0) PG8_BAR; }
    PG8_BAR;
    if constexpr (Epi::AFTER_DRAIN) { E.fused(acc, cur, wr, wc, fr, fq, lds, wid, lane); S.done(cur); }
#undef PG8_SA
#undef PG8_SB
#undef PG8_STAGE
#undef PG8_LDA
#undef PG8_LDB
#undef PG8_MMA
#undef PG8_WAIT_V
#undef PG8_WAIT_L
#undef PG8_BAR
#undef PG8_SCHED
}
}

template <class Epi>
__device__ __forceinline__ void sgemm(const bf16* A, int lda, int a_row_sub, const bf16* Bt, int K, int row0, int nrows, int N, bool headmap, const Epi& E, const Frame& F) {
    const int nN = N / 64, nU = (nrows / 256) * nN, fr = F.lane & 15, fq = F.lane >> 4;
    for (int u = F.vcu; u < nU; u += F.G) {
        const int pm = u / nN, pn = u % nN, r0 = row0 + pm * 256 + F.wave * 32, c0 = pn * 64;
        f32x4 acc[2][4];
#pragma unroll
        for (int a = 0; a < 2; ++a)
#pragma unroll
            for (int b = 0; b < 4; ++b) acc[a][b] = (f32x4){0.f, 0.f, 0.f, 0.f};
        const bf16* ap0 = A + (size_t)(r0 - a_row_sub + fr) * lda + 8 * fq; const bf16* ap1 = ap0 + (size_t)16 * lda;
        const bf16* bp[4];
#pragma unroll
        for (int nt = 0; nt < 4; ++nt) { const int n = c0 + 16 * nt + fr; bp[nt] = Bt + (size_t)(headmap ? inv_head(n) : n) * K + 8 * fq; }
        for (int k0 = 0; k0 < K; k0 += 32) {
            const bf16x8 a0 = *(const bf16x8*)(ap0 + k0), a1 = *(const bf16x8*)(ap1 + k0);
            bf16x8 b[4];
#pragma unroll
            for (int nt = 0; nt < 4; ++nt) b[nt] = *(const bf16x8*)(bp[nt] + k0);
#pragma unroll
            for (int nt = 0; nt < 4; ++nt) { acc[0][nt] = __builtin_amdgcn_mfma_f32_16x16x32_bf16(b[nt], a0, acc[0][nt], 0, 0, 0); acc[1][nt] = __builtin_amdgcn_mfma_f32_16x16x32_bf16(b[nt], a1, acc[1][nt], 0, 0, 0); }
        }
        E.seg64(r0 + fr, c0, acc[0], fq); E.seg64(r0 + 16 + fr, c0, acc[1], fq);
    }
}

__device__ __forceinline__ void st_bf16x4(bf16* p, f32x4 v) { u32x2 w; w.x = cvtpk(v[0], v[1]); w.y = cvtpk(v[2], v[3]); *(u32x2*)p = w; }
__device__ __forceinline__ void st_bf16x8(bf16* p, f32x4 a, f32x4 b) { u32x4 w; w.x = cvtpk(a[0], a[1]); w.y = cvtpk(a[2], a[3]); w.z = cvtpk(b[0], b[1]); w.w = cvtpk(b[2], b[3]); *(u32x4*)p = w; }
__device__ __forceinline__ u32x4 pk_bf16x8(f32x4 a, f32x4 b) { u32x4 w; w.x = cvtpk(a[0], a[1]); w.y = cvtpk(a[2], a[3]); w.z = cvtpk(b[0], b[1]); w.w = cvtpk(b[2], b[3]); return w; }
__device__ __forceinline__ unsigned dpp_ror8(unsigned x) { return (unsigned)__builtin_amdgcn_update_dpp(0, (int)x, 0x128, 0xF, 0xF, false); }
__device__ __forceinline__ void st_lines_bf16(bf16* d, long rows8, u32x4 P0, u32x4 P1, bool hi) {
    const u32x4 T = {dpp_ror8(P1.x), dpp_ror8(P1.y), dpp_ror8(P1.z), dpp_ror8(P1.w)};
    *(u32x4*)(hi ? d - rows8 + 32 : d) = hi ? T : P0;
    *(u32x4*)(hi ? d : d + rows8 + 32) = hi ? P0 : T;
}
__device__ __forceinline__ void ld_bf16x8(const bf16* p, f32x4& a, f32x4& b) { const u32x4 w = *(const u32x4*)p; a = (f32x4){bflo(w.x), bfhi(w.x), bflo(w.y), bfhi(w.y)}; b = (f32x4){bflo(w.z), bfhi(w.z), bflo(w.w), bfhi(w.w)}; }
__device__ __forceinline__ float quad_sum(float s) {
    { const unsigned u = __float_as_uint(s); auto r = __builtin_amdgcn_permlane16_swap(u, u, false, false); s = __uint_as_float(r[0]) + __uint_as_float(r[1]); }
    { const unsigned u = __float_as_uint(s); auto r = __builtin_amdgcn_permlane32_swap(u, u, false, false); s = __uint_as_float(r[0]) + __uint_as_float(r[1]); }
    return s;
}
__device__ __forceinline__ float rstd_from_ss(const float* ss16) {
    const f32x4* p = (const f32x4*)ss16; const f32x4 a = p[0], b = p[1], c = p[2], d = p[3];
    const float s = ((a.x + a.y) + (a.z + a.w)) + ((b.x + b.y) + (b.z + b.w)) + ((c.x + c.y) + (c.z + c.w)) + ((d.x + d.y) + (d.z + d.w));
    return __builtin_amdgcn_rsqf(s * (1.f / DM) + EPS);
}

__device__ __forceinline__ size_t kv_base(int m, int kvh) {
    const int Tl = m < MP ? TP : TS, rb = m < MP ? (m & ~(TP - 1)) : MP + ((m - MP) & ~(TS - 1));
    return (size_t)rb * 128 + (size_t)kvh * Tl * 64;
}
struct EpiIn {
    static constexpr bool NOFENCE = true;
    bf16 *Q, *K, *V, *U; const float *qg, *kg; const float2* rope; const float* rsx;
    __device__ __forceinline__ void row_qk(int m, int c0, f32x4 (&v)[4], int fq, float rx, const f32x4 (&gg)[4], const float2 (&cr)[4], const float2 (&cc)[4]) const {
        const bool isq = c0 < 512;
        float ss = 0.f;
#pragma unroll
        for (int nt = 0; nt < 4; ++nt) ss += (v[nt][0] * v[nt][0] + v[nt][1] * v[nt][1]) + (v[nt][2] * v[nt][2] + v[nt][3] * v[nt][3]);
        ss = quad_sum(ss);
        const float rstd = rx * __builtin_amdgcn_rsqf(ss * (rx * rx) * (1.f / 64.f) + EPS);
#pragma unroll
        for (int nt = 0; nt < 4; ++nt) v[nt] = v[nt] * rstd * gg[nt];
        const int t = tpos(m);
        const float sc = isq ? C2 : 1.0f;
        f32x4 o[4];
#pragma unroll
        for (int j = 0; j < 4; ++j) {
            o[0][j] = (v[0][j] * cr[j].x - v[1][j] * cr[j].y) * sc; o[1][j] = (v[1][j] * cr[j].x + v[0][j] * cr[j].y) * sc;
            o[2][j] = (v[2][j] * cc[j].x - v[3][j] * cc[j].y) * sc; o[3][j] = (v[3][j] * cc[j].x + v[2][j] * cc[j].y) * sc;
        }
        if (isq) { bf16* dst = Q + (size_t)m * 512 + c0;
#pragma unroll
            for (int nt = 0; nt < 4; ++nt) st_bf16x4(dst + 16 * nt + 4 * fq, o[nt]);
        } else {
            bf16* dst = K + kv_base(m, (c0 - 512) >> 6) + (size_t)(t >> 6) * 4096 + (t & 63) * 8 + 4 * (fq & 1) + (fq >> 1) * 512;
#pragma unroll
            for (int nt = 0; nt < 4; ++nt) st_bf16x4(dst + nt * 1024, o[nt]);
        }
    }
    __device__ __forceinline__ void row_vu(int m, int c0, f32x4 (&v)[4], int fq, float rx) const {
        if (c0 < 768) {
            const int t = tpos(m);
            bf16* dst = V + kv_base(m, (c0 - 640) >> 6) + (size_t)(t >> 6) * 4096 + ((t & 63) >> 4) * 512 + (t & 15) * 32 + 4 * fq;
#pragma unroll
            for (int nt = 0; nt < 4; ++nt) st_bf16x4(dst + (nt >> 1) * 2048 + (nt & 1) * 16, v[nt] * rx);
        } else {
            bf16* dst = U + (size_t)m * 512 + (c0 - 768);
#pragma unroll
            for (int nt = 0; nt < 4; ++nt) st_bf16x4(dst + 16 * nt + 4 * fq, v[nt] * rx);
        }
    }
    __device__ __forceinline__ void tile(pg8::f32x4 (&acc)[2][2][4][2], int mrow, int c0, int fq) const {
        static_assert(TP % 256 == 0 && TS % 256 == 0 && MP % 256 == 0, "row-panel alignment");
        float rx[2][4];
#pragma unroll
        for (int ai = 0; ai < 2; ++ai)
#pragma unroll
            for (int mi = 0; mi < 4; ++mi) rx[ai][mi] = rsx[mrow + 128 * ai + 16 * mi];
        if (c0 < 640) {
            const float* g = c0 < 512 ? qg : kg;
            f32x4 gg[4]; float2 cr[2][4], cc[4][4];
#pragma unroll
            for (int nt = 0; nt < 4; ++nt) gg[nt] = *(const f32x4*)(g + 16 * nt + 4 * fq);
#pragma unroll
            for (int ai = 0; ai < 2; ++ai) { const int pr = tpos(mrow + 128 * ai) >> 6;
#pragma unroll
                for (int j = 0; j < 4; ++j) cr[ai][j] = rope[pr * 16 + 4 * fq + j]; }
#pragma unroll
            for (int mi = 0; mi < 4; ++mi) { const int pc = tpos(mrow + 16 * mi) & 63;
#pragma unroll
                for (int j = 0; j < 4; ++j) cc[mi][j] = rope[pc * 16 + 4 * fq + j]; }
#pragma unroll
            for (int ai = 0; ai < 2; ++ai)
#pragma unroll
                for (int mi = 0; mi < 4; ++mi) { f32x4 v[4] = {acc[ai][0][mi][0], acc[ai][0][mi][1], acc[ai][1][mi][0], acc[ai][1][mi][1]};
                    row_qk(mrow + 128 * ai + 16 * mi, c0, v, fq, rx[ai][mi], gg, cr[ai], cc[mi]); }
        } else {
#pragma unroll
            for (int ai = 0; ai < 2; ++ai)
#pragma unroll
                for (int mi = 0; mi < 4; ++mi) { f32x4 v[4] = {acc[ai][0][mi][0], acc[ai][0][mi][1], acc[ai][1][mi][0], acc[ai][1][mi][1]};
                    row_vu(mrow + 128 * ai + 16 * mi, c0, v, fq, rx[ai][mi]); }
        }
    }
    __device__ __forceinline__ void seg64(int m, int c0, f32x4 (&v)[4], int fq) const {
        const float rx = rsx[m];
        if (c0 < 640) { const float* g = c0 < 512 ? qg : kg; const int t = tpos(m), pr = t >> 6, pc = t & 63; f32x4 gg[4]; float2 cr[4], cc[4];
#pragma unroll
            for (int nt = 0; nt < 4; ++nt) gg[nt] = *(const f32x4*)(g + 16 * nt + 4 * fq);
#pragma unroll
            for (int j = 0; j < 4; ++j) { cr[j] = rope[pr * 16 + 4 * fq + j]; cc[j] = rope[pc * 16 + 4 * fq + j]; }
            row_qk(m, c0, v, fq, rx, gg, cr, cc);
        } else row_vu(m, c0, v, fq, rx);
    }
};
struct EpiBf {
    bf16* O; int ld;
    __device__ __forceinline__ void seg64(int m, int c0, f32x4 (&v)[4], int fq) const {
#pragma unroll
        for (int nt = 0; nt < 4; ++nt) st_bf16x4(O + (size_t)m * ld + c0 + 16 * nt + 4 * fq, v[nt]);
    }
};
struct EpiRes {
    const float* base0; const float* base1; float* out; bf16* HB; float* SS;
    __device__ __forceinline__ void seg64(int m, int c0, f32x4 (&v)[4], int fq) const {
        const float* b = (m < MP ? base0 + (size_t)m * DM : base1 + (size_t)(m - MP) * DM) + c0 + 4 * fq;
        float* o = out + (size_t)m * DM + c0 + 4 * fq; bf16* hb = HB + (size_t)m * DM + c0 + 4 * fq; float ss = 0.f;
#pragma unroll
        for (int nt = 0; nt < 4; ++nt) { const f32x4 h = *(const f32x4*)(b + 16 * nt) + v[nt]; *(f32x4*)(o + 16 * nt) = h; st_bf16x4(hb + 16 * nt, h);
            ss += (h[0] * h[0] + h[1] * h[1]) + (h[2] * h[2] + h[3] * h[3]); }
        ss = quad_sum(ss);
        if (fq == 0) SS[(size_t)m * 16 + (c0 >> 6)] = ss;
    }
};
constexpr int RSTD_OFF = 131072 + 1024;
struct EpiUp {
    bf16* HM; const LAS float* rs; int row0;
    __device__ __forceinline__ void seg64(int m, int c0, f32x4 (&v)[4], int fq) const {
        const float rstd = rs[m - row0];
        bf16* d = HM + (size_t)(m - row0) * DFF + c0 + 4 * fq;
#pragma unroll
        for (int nt = 0; nt < 4; ++nt) { f32x4 a = v[nt] * rstd;
#pragma unroll
            for (int j = 0; j < 4; ++j) { const float r = fmaxf(a[j], 0.f); a[j] = r * r; }
            st_bf16x4(d + 16 * nt, a); }
    }
};
__device__ __forceinline__ void rstd_table(const Frame& F, const float* SS, int row0) {
    if (F.tid < 256) ((LAS float*)(F.lds + RSTD_OFF))[F.tid] = rstd_from_ss(SS + (size_t)(row0 + F.tid) * 16);
    __syncthreads();
}
struct EpiGate {
    const float* out; float* dst; const bf16* PP; const float* SS;
    __device__ __forceinline__ void seg64(int m, int c0, f32x4 (&v)[4], int fq) const {
        const float rstd = rstd_from_ss(SS + (size_t)m * 16);
        const float* o = out + (size_t)m * DM + c0 + 4 * fq; float* d = dst + (size_t)m * DM + c0 + 4 * fq; const bf16* pp = PP + (size_t)m * DM + c0 + 4 * fq;
#pragma unroll
        for (int nt = 0; nt < 4; ++nt) { const u32x2 w = *(const u32x2*)(pp + 16 * nt); f32x4 h = *(const f32x4*)(o + 16 * nt);
            const float p0 = bflo(w.x), p1 = bfhi(w.x), p2 = bflo(w.y), p3 = bfhi(w.y);
            h[0] += p0 / (1.0f + __expf(-v[nt][0] * rstd)); h[1] += p1 / (1.0f + __expf(-v[nt][1] * rstd));
            h[2] += p2 / (1.0f + __expf(-v[nt][2] * rstd)); h[3] += p3 / (1.0f + __expf(-v[nt][3] * rstd));
            *(f32x4*)(d + 16 * nt) = h; }
    }
};

namespace attn_body {
using bf16=__hip_bfloat16;
using bf16x8=__attribute__((ext_vector_type(8)))short;
using s16x4=__attribute__((ext_vector_type(4)))short;
using f32x16=__attribute__((ext_vector_type(16)))float;
using u32x4=__attribute__((ext_vector_type(4)))unsigned;
constexpr int D=64,QP=512,KP=128,OP=1024;
constexpr int NW=8,QBLK=32,QB=QBLK*NW,KVBLK=64;
constexpr int ATTN_UNIT_ROWS=QB;
__device__ __forceinline__ int crow(int r,int hi){return (r&3)+8*(r>>2)+4*hi;}
#define SBAR() __builtin_amdgcn_sched_barrier(0)

constexpr int NSLOT=3, SLOTB=8192;
constexpr int LDS_K=0, LDS_V=NSLOT*SLOTB, LDS_WS=2*NSLOT*SLOTB, LDS_OST=LDS_WS+NW*64*4, LDS_BYTES=LDS_OST+NW*4096;
constexpr float C2=0.125f*1.4426950408889634f;
__device__ __forceinline__ void glds16(const void*gsrc,unsigned lds_dst){unsigned keep;
  asm volatile("s_mov_b32 %0, m0\n\ts_mov_b32 m0, %2\n\ts_nop 0\n\tglobal_load_lds_dwordx4 %1, off\n\ts_mov_b32 m0, %0":"=&s"(keep):"v"(gsrc),"s"(lds_dst):"memory");}
__device__ __forceinline__ float max3f(float a,float b,float c){float r;asm("v_max3_f32 %0, %1, %2, %3":"=v"(r):"v"(a),"v"(b),"v"(c));return r;}
__device__ __forceinline__ float max2f(float a,float b){float r;asm("v_max_f32_e32 %0, %1, %2":"=v"(r):"v"(a),"v"(b));return r;}
__device__ __forceinline__ float fadd_s(float a,float b){float r;asm("v_add_f32_e32 %0, %1, %2":"=v"(r):"v"(a),"v"(b));return r;}
__device__ __forceinline__ float fsub_s(float a,float b){float r;asm("v_sub_f32_e32 %0, %1, %2":"=v"(r):"v"(a),"v"(b));return r;}
typedef float f32x2_t __attribute__((ext_vector_type(2))); typedef __bf16 bf16x2_t __attribute__((ext_vector_type(2)));
__device__ __forceinline__ unsigned cvtpk_s(float lo,float hi){f32x2_t v={lo,hi};bf16x2_t b=__builtin_convertvector(v,bf16x2_t);return __builtin_bit_cast(unsigned,b);}
#define WAIT_BAR(N) asm volatile("s_waitcnt vmcnt(" #N ") lgkmcnt(0)\n\ts_barrier":::"memory")

__device__ __forceinline__ void qkt(f32x16&p0,f32x16&p1,const char*Kslot,const bf16x8*qr,const f32x16&negm,int r32,int hi){
  const char*kb=Kslot+hi*1024+r32*16;
  #pragma unroll
  for(int d0=0;d0<4;++d0){
    const bf16x8 b0=*reinterpret_cast<const bf16x8*>(kb+d0*2048);
    const bf16x8 b1=*reinterpret_cast<const bf16x8*>(kb+d0*2048+512);
    if(d0==0){p0=__builtin_amdgcn_mfma_f32_32x32x16_bf16(b0,qr[0],negm,0,0,0);p1=__builtin_amdgcn_mfma_f32_32x32x16_bf16(b1,qr[0],negm,0,0,0);}
    else{p0=__builtin_amdgcn_mfma_f32_32x32x16_bf16(b0,qr[d0],p0,0,0,0);p1=__builtin_amdgcn_mfma_f32_32x32x16_bf16(b1,qr[d0],p1,0,0,0);}}
}
typedef __attribute__((address_space(3))) const char* lds_cptr;
typedef short v4i16_t __attribute__((ext_vector_type(4)));
__device__ __forceinline__ void kload8(bf16x8*kf,lds_cptr kp){
  kf[0]=*(const __attribute__((address_space(3))) bf16x8*)(kp);      kf[1]=*(const __attribute__((address_space(3))) bf16x8*)(kp+512);
  kf[2]=*(const __attribute__((address_space(3))) bf16x8*)(kp+2048); kf[3]=*(const __attribute__((address_space(3))) bf16x8*)(kp+2560);
  kf[4]=*(const __attribute__((address_space(3))) bf16x8*)(kp+4096); kf[5]=*(const __attribute__((address_space(3))) bf16x8*)(kp+4608);
  kf[6]=*(const __attribute__((address_space(3))) bf16x8*)(kp+6144); kf[7]=*(const __attribute__((address_space(3))) bf16x8*)(kp+6656);
}
__device__ __forceinline__ void kload2(bf16x8*kf,lds_cptr kp,int j){ kf[2*j]=*(const __attribute__((address_space(3))) bf16x8*)(kp+j*2048); kf[2*j+1]=*(const __attribute__((address_space(3))) bf16x8*)(kp+j*2048+512); }
__device__ __forceinline__ s16x4 vtr(lds_cptr p){ return __builtin_bit_cast(s16x4,__builtin_amdgcn_ds_read_tr16_b64_v4i16((__attribute__((address_space(3))) v4i16_t*)p)); }
__device__ __forceinline__ float rowmax(const f32x16&p0,const f32x16&p1){
  float a=max3f(p0[0],p0[1],p1[0]),b=max3f(p0[2],p0[3],p1[1]);a=max3f(a,p1[2],p1[3]);
  #pragma unroll
  for(int r=4;r<16;r+=4){a=max3f(a,p0[r],p0[r+1]);b=max3f(b,p0[r+2],p0[r+3]);a=max3f(a,p1[r],p1[r+1]);b=max3f(b,p1[r+2],p1[r+3]);}
  const float m=max2f(a,b);
  auto rr=__builtin_amdgcn_permlane32_swap(__float_as_uint(m),__float_as_uint(m),false,false);
  return max2f(__uint_as_float(rr[0]),__uint_as_float(rr[1]));
}
__device__ __forceinline__ void pv(f32x16*o,int vb,bf16x8 pa0,bf16x8 pa1,bf16x8 pa2,bf16x8 pa3){
  #pragma unroll
  for(int d0=0;d0<2;++d0){s16x4 lo[4],hi[4];
    #pragma unroll
    for(int ks=0;ks<4;++ks){
      asm volatile("ds_read_b64_tr_b16 %0,%1 offset:%c2":"=&v"(lo[ks]):"v"(vb),"i"(d0*4096+ks*1024):"memory");
      asm volatile("ds_read_b64_tr_b16 %0,%1 offset:%c2":"=&v"(hi[ks]):"v"(vb),"i"(d0*4096+ks*1024+512):"memory");}
    asm volatile("s_waitcnt lgkmcnt(0)":::"memory");SBAR();
    #define PK(k) (bf16x8){lo[k][0],lo[k][1],lo[k][2],lo[k][3],hi[k][0],hi[k][1],hi[k][2],hi[k][3]}
    o[d0]=__builtin_amdgcn_mfma_f32_32x32x16_bf16(pa0,PK(0),o[d0],0,0,0);
    o[d0]=__builtin_amdgcn_mfma_f32_32x32x16_bf16(pa1,PK(1),o[d0],0,0,0);
    o[d0]=__builtin_amdgcn_mfma_f32_32x32x16_bf16(pa2,PK(2),o[d0],0,0,0);
    o[d0]=__builtin_amdgcn_mfma_f32_32x32x16_bf16(pa3,PK(3),o[d0],0,0,0);
    #undef PK
  }
}

#ifndef ATTN_STORE16
#define ATTN_STORE16(p,v) (*(u32x4*)(p)=(v))
#endif
template<int THRL> __device__ __forceinline__ void attn_unit(int rowbase_,int T_,int h,int qb,const bf16*Q,const bf16*__restrict__ K,const bf16*__restrict__ V,bf16*O,char*shm){
  const int tid=threadIdx.x,lane=tid&63,r32=lane&31,hi=lane>>5; const int wid=__builtin_amdgcn_readfirstlane(tid>>6);
  const long rowbase=(long)rowbase_; const int q0=qb*QB; const int kvh=h>>2;
  const bf16*Qw=Q+(rowbase+q0+wid*QBLK)*QP+h*D;
  const bf16*Kh=K+rowbase*KP+(long)kvh*T_*D,*Vh=V+rowbase*KP+(long)kvh*T_*D;
  const unsigned lds0=(unsigned)(uintptr_t)shm;
  float*wsf=(float*)(shm+LDS_WS)+wid*64;
  const bf16*ksrc=Kh+wid*512+lane*8;
  const bf16*vsrc=Vh+wid*512+lane*8;
  const unsigned kdst=lds0+LDS_K+wid*1024, vdst=lds0+LDS_V+wid*1024;
  #define DMA_K(t,slot) glds16(ksrc+(long)(t)*4096,(unsigned)__builtin_amdgcn_readfirstlane(kdst+(slot)))
  #define DMA_V(t,slot) glds16(vsrc+(long)(t)*4096,(unsigned)__builtin_amdgcn_readfirstlane(vdst+(slot)))
  const int vb0=(int)(lds0+LDS_V)+((lane>>4)&1)*32+(lane&3)*8+(4*hi+((lane&15)>>2))*64;
  const char*Kbase=shm+LDS_K; bf16x8 kf[8];
  const lds_cptr shm3=(lds_cptr)shm; const lds_cptr kp0=shm3+LDS_K+hi*1024+r32*16; const lds_cptr vp0=shm3+LDS_V+((lane>>4)&1)*32+(lane&3)*8+(4*hi+((lane&15)>>2))*64;
  const int NT=T_/KVBLK;
  DMA_K(0,0);DMA_V(0,0);DMA_K(1,SLOTB);
  bf16x8 qr[4];
  #pragma unroll
  for(int d0=0;d0<4;++d0)qr[d0]=*reinterpret_cast<const bf16x8*>(&Qw[(long)r32*QP+d0*16+hi*8]);
  float mhat=0.f,l_reg=0.f;f32x16 o[2];o[0]=f32x16{};o[1]=f32x16{};f32x16 negm=f32x16{};
#if !ATTN_NOMAX
  asm volatile("":"+v"(negm));
#endif

  const int qrel=wid*QBLK+r32;
  #define CMASK(P0,P1,t) do{}while(0)
  bool resc=false;
#if ATTN_NOMAX
  #define START(P0,P1) do{ _Pragma("unroll") for(int r=0;r<16;++r)P0[r]=__builtin_amdgcn_exp2f(P0[r]); }while(0)
#else
  #define START(P0,P1) do{ const float rm=rowmax(P0,P1); resc=false; \
    { const float dl=rm; mhat=fadd_s(mhat,dl); \
      _Pragma("unroll") for(int r=0;r<16;++r){P0[r]=fsub_s(P0[r],dl);P1[r]=fsub_s(P1[r],dl);} \
      _Pragma("unroll") for(int r=0;r<16;++r)negm[r]=-mhat; asm volatile("":"+v"(negm)); } \
    _Pragma("unroll") for(int r=0;r<16;++r)P0[r]=__builtin_amdgcn_exp2f(P0[r]); }while(0)
#endif
#if ATTN_NOMAX
  #define RESC() do{}while(0)
#else
  #define RESC() do{ if(resc){ asm volatile("s_waitcnt lgkmcnt(0)":::"memory"); \
      _Pragma("unroll") for(int d_=0;d_<2;++d_) _Pragma("unroll") for(int r=0;r<16;++r)o[d_][r]*=wsf[crow(r,hi)]; } }while(0)
#endif
  f32x16 pA0,pA1,pB0,pB1;
  int sl_prev=0,sl_cur=0,sl_next=SLOTB;
  #define ROT() do{sl_prev=sl_cur;sl_cur=sl_next;sl_next=(sl_next==(NSLOT-1)*SLOTB)?0:sl_next+SLOTB;}while(0)
  DMA_K(2,2*SLOTB);
  WAIT_BAR(3);
  qkt(pA0,pA1,Kbase,qr,negm,r32,hi);asm volatile("s_nop 15\n\ts_nop 7":"+v"(pA0),"+v"(pA1));CMASK(pA0,pA1,0);
  START(pA0,pA1);
  _Pragma("unroll") for(int r=0;r<16;++r)pA1[r]=__builtin_amdgcn_exp2f(pA1[r]);
  WAIT_BAR(0);
  DMA_K(3,0);DMA_V(1,SLOTB);
  ROT();
  kload8(kf,kp0+sl_cur);
  WAIT_BAR(2);
  s16x4 vlo[8],vhi[8]; u32x4 pw0,pw1,pw2,pw3;
  #define PKW(P,B) cvtpk_s(P[B],P[B+1])
  #define PAF(k) __builtin_bit_cast(bf16x8,pw##k)
  #define VFR(i) (bf16x8){vlo[i][0],vlo[i][1],vlo[i][2],vlo[i][3],vhi[i][0],vhi[i][1],vhi[i][2],vhi[i][3]}
  #define PIN(x) asm volatile("":"+v"(x))
  #define MX3(a,b,c) __builtin_fmaxf(__builtin_fmaxf((a),(b)),(c))
  #define GAPA(MF,A0,A1,A2,A3,W0,W1,PW) do{ MF; sacc+=A0; sacc+=A1; sacc+=A2; sacc+=A3; PIN(sacc); W0; W1; PIN(PW); SBAR(); }while(0)
  #define EX(v) __builtin_amdgcn_exp2f(v)
  #define GAPB(MF,X,B) do{ MF; X[B]=EX(X[B]); X[B+1]=EX(X[B+1]); X[B+2]=EX(X[B+2]); X[B+3]=EX(X[B+3]); PIN(X); SBAR(); }while(0)
  #define VRD(i) do{ vlo[i]=vtr(vp_+(((i)>>2)*4096+((i)&3)*1024)); vhi[i]=vtr(vp_+(((i)>>2)*4096+((i)&3)*1024+512)); }while(0)
  #define KRD(G,j) do{ if(G){ kload2(kf,kp0+sl_next,j); SBAR(); } }while(0)
#if ATTN_NOMAX
  #define MAXBLOCK(C0,C1) do{}while(0)
#else
  #define MAXBLOCK(C0,C1) \
    { float a=MX3(C0[0],C0[1],C1[0]),b=MX3(C0[2],C0[3],C1[1]); a=MX3(a,C1[2],C1[3]); \
      _Pragma("unroll") for(int r=4;r<16;r+=4){a=MX3(a,C0[r],C0[r+1]);b=MX3(b,C0[r+2],C0[r+3]);a=MX3(a,C1[r],C1[r+1]);b=MX3(b,C1[r+2],C1[r+3]);} \
      float rm=__builtin_fmaxf(a,b); { auto rr=__builtin_amdgcn_permlane32_swap(__float_as_uint(rm),__float_as_uint(rm),false,false); rm=__builtin_fmaxf(__uint_as_float(rr[0]),__uint_as_float(rr[1])); } \
      resc=false; \
      if(__builtin_expect(__any(rm>(float)THRL),0)){ const float dl=__builtin_fmaxf(rm,0.f); mhat+=dl; \
        _Pragma("unroll") for(int r=0;r<16;++r){C0[r]-=dl;C1[r]-=dl;} \
        _Pragma("unroll") for(int r=0;r<16;++r)negm[r]=-mhat; asm volatile("":"+v"(negm)); \
        const float f=__builtin_amdgcn_exp2f(-dl); l_reg*=f; if(hi==0)wsf[r32]=f; resc=true; } }
#endif
  #define STEP(C0,C1,P0,P1,t,GK,GV,GL) do{ SBAR(); \
    const lds_cptr vp_=vp0+sl_prev; \
    VRD(0); SBAR(); float sacc=(P0[0]+P0[1]); \
    GAPA(C0=__builtin_amdgcn_mfma_f32_32x32x16_bf16(kf[0],qr[0],negm,0,0,0), P0[2],P0[3],P0[4],P0[5],     pw0[0]=PKW(P0,0), pw0[1]=PKW(P0,2), pw0); \
    VRD(4); SBAR(); GAPA(C1=__builtin_amdgcn_mfma_f32_32x32x16_bf16(kf[1],qr[0],negm,0,0,0), P0[6],P0[7],P0[8],P0[9],     pw0[2]=PKW(P0,4), pw0[3]=PKW(P0,6), pw0); \
    VRD(1); SBAR(); GAPA(C0=__builtin_amdgcn_mfma_f32_32x32x16_bf16(kf[2],qr[1],C0,0,0,0),   P0[10],P0[11],P0[12],P0[13], pw1[0]=PKW(P0,8), pw1[1]=PKW(P0,10), pw1); \
    VRD(5); SBAR(); GAPA(C1=__builtin_amdgcn_mfma_f32_32x32x16_bf16(kf[3],qr[1],C1,0,0,0),   P0[14],P0[15],P1[0],P1[1],   pw1[2]=PKW(P0,12),pw1[3]=PKW(P0,14), pw1); \
    VRD(2); SBAR(); GAPA(C0=__builtin_amdgcn_mfma_f32_32x32x16_bf16(kf[4],qr[2],C0,0,0,0),   P1[2],P1[3],P1[4],P1[5],     pw2[0]=PKW(P1,0), pw2[1]=PKW(P1,2), pw2); \
    VRD(6); SBAR(); GAPA(C1=__builtin_amdgcn_mfma_f32_32x32x16_bf16(kf[5],qr[2],C1,0,0,0),   P1[6],P1[7],P1[8],P1[9],     pw2[2]=PKW(P1,4), pw2[3]=PKW(P1,6), pw2); \
    VRD(3); SBAR(); GAPA(C0=__builtin_amdgcn_mfma_f32_32x32x16_bf16(kf[6],qr[3],C0,0,0,0),   P1[10],P1[11],P1[12],P1[13], pw3[0]=PKW(P1,8), pw3[1]=PKW(P1,10), pw3); \
    VRD(7); SBAR(); GAPA(C1=__builtin_amdgcn_mfma_f32_32x32x16_bf16(kf[7],qr[3],C1,0,0,0),   P1[14],P1[15],0.f,0.f,       pw3[2]=PKW(P1,12),pw3[3]=PKW(P1,14), pw3); \
    l_reg+=sacc; \
    if(GK){DMA_K((t)+3,sl_cur);} if(GV){DMA_V((t)+1,sl_next);} \
    CMASK(C0,C1,t); \
    MAXBLOCK(C0,C1); \
    SBAR(); \
    GAPB(o[0]=__builtin_amdgcn_mfma_f32_32x32x16_bf16(PAF(0),VFR(0),o[0],0,0,0), C0,0); \
    GAPB(o[1]=__builtin_amdgcn_mfma_f32_32x32x16_bf16(PAF(0),VFR(4),o[1],0,0,0), C0,4); \
    KRD(GL,0); GAPB(o[0]=__builtin_amdgcn_mfma_f32_32x32x16_bf16(PAF(1),VFR(1),o[0],0,0,0), C0,8); \
    KRD(GL,1); GAPB(o[1]=__builtin_amdgcn_mfma_f32_32x32x16_bf16(PAF(1),VFR(5),o[1],0,0,0), C0,12); \
    KRD(GL,2); GAPB(o[0]=__builtin_amdgcn_mfma_f32_32x32x16_bf16(PAF(2),VFR(2),o[0],0,0,0), C1,0); \
    KRD(GL,3); GAPB(o[1]=__builtin_amdgcn_mfma_f32_32x32x16_bf16(PAF(2),VFR(6),o[1],0,0,0), C1,4); \
    GAPB(o[0]=__builtin_amdgcn_mfma_f32_32x32x16_bf16(PAF(3),VFR(3),o[0],0,0,0), C1,8); \
    GAPB(o[1]=__builtin_amdgcn_mfma_f32_32x32x16_bf16(PAF(3),VFR(7),o[1],0,0,0), C1,12); \
    }while(0)
  int t=1;
  #undef CMASK
  #define CMASK(P0,P1,t) do{}while(0)
  for(;t+5<NT;t+=2){
    STEP(pB0,pB1,pA0,pA1,t,true,true,true);     WAIT_BAR(2); RESC(); ROT();
    STEP(pA0,pA1,pB0,pB1,t+1,true,true,true);   WAIT_BAR(2); RESC(); ROT();
  }
  #undef CMASK
  #define CMASK(P0,P1,t) do{}while(0)
  #define ENDW(tt) do{ if((tt)+3<NT){WAIT_BAR(2);} else if((tt)+2<NT){WAIT_BAR(1);} else {WAIT_BAR(0);} }while(0)
  for(;t+1<NT;t+=2){
    STEP(pB0,pB1,pA0,pA1,t,(t+3<NT),(t+1<NT),(t+1<NT));       ENDW(t);   RESC(); ROT();
    STEP(pA0,pA1,pB0,pB1,t+1,(t+4<NT),(t+2<NT),(t+2<NT));     ENDW(t+1); RESC(); ROT();
  }
  STEP(pB0,pB1,pA0,pA1,NT-1,false,false,false); RESC();
  { float sacc=pB0[0]+pB0[1]; _Pragma("unroll") for(int r=2;r<16;++r)sacc+=pB0[r]; _Pragma("unroll") for(int r=0;r<16;++r)sacc+=pB1[r]; l_reg+=sacc;
    pw0=(u32x4){PKW(pB0,0),PKW(pB0,2),PKW(pB0,4),PKW(pB0,6)};pw1=(u32x4){PKW(pB0,8),PKW(pB0,10),PKW(pB0,12),PKW(pB0,14)};pw2=(u32x4){PKW(pB1,0),PKW(pB1,2),PKW(pB1,4),PKW(pB1,6)};pw3=(u32x4){PKW(pB1,8),PKW(pB1,10),PKW(pB1,12),PKW(pB1,14)};
    SBAR(); pv(o,vb0+sl_cur,PAF(0),PAF(1),PAF(2),PAF(3)); }
  #undef PKW
  #undef PAF
  #undef VFR
  #undef PIN
  #undef MX3
  #undef GAPA
  #undef GAPB
  #undef EX
  #undef VRD
  #undef KRD
  #undef STEP
  #undef ENDW
  {auto rr=__builtin_amdgcn_permlane32_swap(__float_as_uint(l_reg),__float_as_uint(l_reg),false,false);l_reg=__uint_as_float(rr[0])+__uint_as_float(rr[1]);}
  if(hi==0)wsf[32+r32]=l_reg;asm volatile("s_waitcnt lgkmcnt(0)":::"memory");
  float rli[16];
  #pragma unroll
  for(int r=0;r<16;++r)rli[r]=__builtin_amdgcn_rcpf(wsf[32+crow(r,hi)]);
  bf16*Ow=O+(rowbase+q0+wid*QBLK)*OP+h*D;
  { bf16*stg=(bf16*)(shm+LDS_OST)+wid*2048;
    #pragma unroll
    for(int r=0;r<16;++r){const int orow=crow(r,hi);
      #pragma unroll
      for(int d0=0;d0<2;++d0)stg[orow*64+d0*32+r32]=__float2bfloat16(o[d0][r]*rli[r]);}
    asm volatile("s_waitcnt lgkmcnt(0)":::"memory");
    #pragma unroll
    for(int i=0;i<4;++i){const int row=i*8+(lane>>3),ch=lane&7; const u32x4 v=*(const u32x4*)(stg+row*64+ch*8); ATTN_STORE16(Ow+(long)row*OP+ch*8,v);} }
  asm volatile("s_waitcnt lgkmcnt(0)\n\ts_barrier":::"memory");
  #undef DMA_K
  #undef DMA_V
  #undef CMASK
  #undef START
  #undef RESC
  #undef ROT
}

__device__ __forceinline__ void attn_unit3(int rowbase_,int T_,int h,int qb,const bf16*Q,const bf16*__restrict__ K,const bf16*__restrict__ V,bf16*O,char*shm){
  int tid_=threadIdx.x; asm volatile("":"+v"(tid_));
  const int tid=tid_,lane=tid&63,r32=lane&31,hi=lane>>5; const int wid=__builtin_amdgcn_readfirstlane(tid>>6);
  const long rowbase=(long)rowbase_; const int q0=qb*512; const int kvh=h>>2;
  const bf16*Qw=Q+(rowbase+q0+wid*64)*QP+h*D;
  const bf16*Kh=K+rowbase*KP+(long)kvh*T_*D,*Vh=V+rowbase*KP+(long)kvh*T_*D;
  const unsigned lds0=(unsigned)(uintptr_t)shm;
  const int kvoff=wid*512+lane*8;
  const unsigned kdst=lds0+LDS_K+wid*1024, vdst=lds0+LDS_V+wid*1024;
  #define DMA_K(t,slot) do{ int o_=kvoff; asm volatile("":"+v"(o_)); glds16(Kh+(long)(t)*4096+o_,(unsigned)__builtin_amdgcn_readfirstlane(kdst+(slot))); }while(0)
  #define DMA_V(t,slot) do{ int o_=kvoff; asm volatile("":"+v"(o_)); glds16(Vh+(long)(t)*4096+o_,(unsigned)__builtin_amdgcn_readfirstlane(vdst+(slot))); }while(0)
  const lds_cptr shm3=(lds_cptr)shm; const lds_cptr kp0=shm3+LDS_K+hi*1024+r32*16; const lds_cptr vp0=shm3+LDS_V+((lane>>4)&1)*32+(lane&3)*8+(4*hi+((lane&15)>>2))*64;
  const int NT=T_/KVBLK;
  DMA_K(0,0);DMA_V(0,0);DMA_K(1,SLOTB);DMA_V(1,SLOTB);DMA_K(2,2*SLOTB);
  bf16x8 qr[2][4];
  #pragma unroll
  for(int b=0;b<2;++b)
    #pragma unroll
    for(int d0=0;d0<4;++d0)qr[b][d0]=*reinterpret_cast<const bf16x8*>(&Qw[(long)(b*32+r32)*QP+d0*16+hi*8]);
  f32x16 o[2][2];o[0][0]=f32x16{};o[0][1]=f32x16{};o[1][0]=f32x16{};o[1][1]=f32x16{}; float lsum[2]={0.f,0.f};
  f32x16 C0,C1; u32x4 pa0,pa1,pa2,pa3,pb0,pb1,pb2,pb3; bf16x8 kf[8];
  #define PKW(P,B) cvtpk_s(P[B],P[B+1])
  #define MM(acc,a,b) acc=__builtin_amdgcn_mfma_f32_32x32x16_bf16(a,b,acc,0,0,0)
  #define QKP(b,w0,w1,w2,w3) do{ const f32x16 z_=f32x16{}; \
      C0=__builtin_amdgcn_mfma_f32_32x32x16_bf16(kf[0],qr[b][0],z_,0,0,0); C1=__builtin_amdgcn_mfma_f32_32x32x16_bf16(kf[1],qr[b][0],z_,0,0,0); \
      MM(C0,kf[2],qr[b][1]); MM(C1,kf[3],qr[b][1]); MM(C0,kf[4],qr[b][2]); MM(C1,kf[5],qr[b][2]); MM(C0,kf[6],qr[b][3]); MM(C1,kf[7],qr[b][3]); \
      _Pragma("unroll") for(int r=0;r<16;++r){C0[r]=__builtin_amdgcn_exp2f(C0[r]);C1[r]=__builtin_amdgcn_exp2f(C1[r]);} \
      { float sa=C0[0]+C1[0],sb=C0[1]+C1[1]; _Pragma("unroll") for(int r=2;r<16;r+=2){sa+=C0[r]+C1[r];sb+=C0[r+1]+C1[r+1];} lsum[b]+=sa+sb; } \
      w0=(u32x4){PKW(C0,0),PKW(C0,2),PKW(C0,4),PKW(C0,6)};w1=(u32x4){PKW(C0,8),PKW(C0,10),PKW(C0,12),PKW(C0,14)}; \
      w2=(u32x4){PKW(C1,0),PKW(C1,2),PKW(C1,4),PKW(C1,6)};w3=(u32x4){PKW(C1,8),PKW(C1,10),PKW(C1,12),PKW(C1,14)}; }while(0)
  #define VLD(F,i) do{ const s16x4 lo_=vtr(vp_+(((i)>>2)*4096+((i)&3)*1024)), hi_=vtr(vp_+(((i)>>2)*4096+((i)&3)*1024+512)); F=(bf16x8){lo_[0],lo_[1],lo_[2],lo_[3],hi_[0],hi_[1],hi_[2],hi_[3]}; }while(0)
  #define PVU(F,i,wa,wb) do{ MM(o[0][(i)>>2],__builtin_bit_cast(bf16x8,wa),F); MM(o[1][(i)>>2],__builtin_bit_cast(bf16x8,wb),F); }while(0)
  #define STEP3(t,GK,GV,GL) do{ SBAR(); \
      if(GK){DMA_K((t)+3,s_cur);} if(GV){DMA_V((t)+2,s_prev);} \
      const lds_cptr vp_=vp0+s_cur; bf16x8 F0,F1,F2; \
      QKP(0,pa0,pa1,pa2,pa3); \
      VLD(F0,0); VLD(F1,4); VLD(F2,1); \
      QKP(1,pb0,pb1,pb2,pb3); \
      if(GL){kload8(kf,kp0+s_next);} \
      PVU(F0,0,pa0,pb0); VLD(F0,5); PVU(F1,4,pa0,pb0); VLD(F1,2); PVU(F2,1,pa1,pb1); VLD(F2,6); PVU(F0,5,pa1,pb1); VLD(F0,3); \
      PVU(F1,2,pa2,pb2); VLD(F1,7); PVU(F2,6,pa2,pb2); PVU(F0,3,pa3,pb3); PVU(F1,7,pa3,pb3); \
      SBAR(); \
      if((GK)&&(GV)){ asm volatile("s_waitcnt vmcnt(2) lgkmcnt(0)\n\ts_barrier":::"memory"); } \
      else if((GK)||(GV)){ asm volatile("s_waitcnt vmcnt(1) lgkmcnt(0)\n\ts_barrier":::"memory"); } \
      else { asm volatile("s_waitcnt vmcnt(0) lgkmcnt(0)\n\ts_barrier":::"memory"); } \
      SBAR(); { const int n_=s_prev; s_prev=s_cur; s_cur=s_next; s_next=n_; } }while(0)
  asm volatile("s_waitcnt vmcnt(0) lgkmcnt(0)\n\ts_barrier":::"memory"); SBAR();
  kload8(kf,kp0);
  asm volatile("s_waitcnt lgkmcnt(0)":::"memory"); SBAR();
  int s_prev=2*SLOTB,s_cur=0,s_next=SLOTB;
  _Pragma("unroll 1") for(int t=0;t+3<NT;++t){ STEP3(t,true,true,true); }
  STEP3(NT-3,false,true,true); STEP3(NT-2,false,false,true); STEP3(NT-1,false,false,false);
  #undef PKW
  #undef MM
  #undef QKP
  #undef VLD
  #undef PVU
  #undef STEP3
  int te_=threadIdx.x; asm volatile("":"+v"(te_));
  const int lane_e=te_&63,r32_e=lane_e&31,hi_e=lane_e>>5; const int wid_e=__builtin_amdgcn_readfirstlane(te_>>6);
  float*wsf=(float*)(shm+LDS_WS)+wid_e*64;
  #pragma unroll
  for(int b=0;b<2;++b){
    float l=lsum[b]; {auto rr=__builtin_amdgcn_permlane32_swap(__float_as_uint(l),__float_as_uint(l),false,false);l=__uint_as_float(rr[0])+__uint_as_float(rr[1]);}
    if(hi_e==0)wsf[32*b+r32_e]=l; asm volatile("s_waitcnt lgkmcnt(0)":::"memory");
    float rli[16];
    #pragma unroll
    for(int r=0;r<16;++r)rli[r]=__builtin_amdgcn_rcpf(wsf[32*b+crow(r,hi_e)]);
    bf16*Ow=O+((long)rowbase_+qb*512+wid_e*64+b*32)*OP+h*D;
    bf16*stg=(bf16*)(shm+LDS_OST)+wid_e*2048;
    #pragma unroll
    for(int r=0;r<16;++r){const int orow=crow(r,hi_e);
      #pragma unroll
      for(int d0=0;d0<2;++d0)stg[orow*64+d0*32+r32_e]=__float2bfloat16(o[b][d0][r]*rli[r]);}
    asm volatile("s_waitcnt lgkmcnt(0)":::"memory");
    #pragma unroll
    for(int i=0;i<4;++i){const int row=i*8+(lane_e>>3),ch=lane_e&7; const u32x4 v=*(const u32x4*)(stg+row*64+ch*8); ATTN_STORE16(Ow+(long)row*OP+ch*8,v);}
    asm volatile("s_waitcnt lgkmcnt(0)":::"memory");
  }
  asm volatile("s_waitcnt lgkmcnt(0)\n\ts_barrier":::"memory");
  #undef DMA_K
  #undef DMA_V
}

constexpr int U4_K=0, U4_V=4*SLOTB, U4_WS=7*SLOTB, U4_OST=U4_WS+NW*64*4, U4_BYTES=U4_OST+NW*4096;
template<int VAR=0> __device__ __forceinline__ void attn_unit4(int rowbase_,int T_,int h,int qb,const bf16*Q,const bf16*__restrict__ K,const bf16*__restrict__ V,bf16*O,char*shm){
  if(VAR==7)return;
  if(VAR==11){ float x_=(float)(threadIdx.x&63)*1e-3f; const unsigned long long e_=__builtin_amdgcn_s_memrealtime()+5000ull;
    while(__builtin_amdgcn_s_memrealtime()<e_){ _Pragma("unroll") for(int i=0;i<64;++i) x_=__builtin_amdgcn_exp2f(x_)*0.25f+x_*0.5f; } asm volatile(""::"v"(x_)); return; }
  if(VAR==8){ const unsigned long long e_=__builtin_amdgcn_s_memrealtime()+5000ull; while(__builtin_amdgcn_s_memrealtime()<e_)__builtin_amdgcn_s_sleep(8); return; }
  int tid_=threadIdx.x; asm volatile("":"+v"(tid_));
  const int tid=tid_,lane=tid&63,r32=lane&31,hi=lane>>5; const int wid=__builtin_amdgcn_readfirstlane(tid>>6);
  const long rowbase=(long)rowbase_; const int q0=qb*512; const int kvh=h>>2;
  const bf16*Qw=Q+(rowbase+q0+wid*64)*QP+h*D;
  const bf16*Kh=K+rowbase*KP+(long)kvh*T_*D,*Vh=V+rowbase*KP+(long)kvh*T_*D;
  const unsigned lds0=(unsigned)(uintptr_t)shm;
  const int kvoff=wid*512+lane*8;
  const unsigned kdst=lds0+U4_K+wid*1024, vdst=lds0+U4_V+wid*1024;
  #define DMA_K(t,slot) do{ if(VAR==4||VAR==9)break; int o_=kvoff; asm volatile("":"+v"(o_)); glds16(Kh+(long)(t)*4096+o_,(unsigned)__builtin_amdgcn_readfirstlane(kdst+(slot))); }while(0)
  #define DMA_V(t,slot) do{ if(VAR==4||VAR==9)break; int o_=kvoff; asm volatile("":"+v"(o_)); glds16(Vh+(long)(t)*4096+o_,(unsigned)__builtin_amdgcn_readfirstlane(vdst+(slot))); }while(0)
  const lds_cptr shm3=(lds_cptr)shm; const lds_cptr kp0=shm3+U4_K+hi*1024+r32*16; const lds_cptr vp0=shm3+U4_V+((lane>>4)&1)*32+(lane&3)*8+(4*hi+((lane&15)>>2))*64;
  const int NT=T_/KVBLK;
  DMA_K(0,0);DMA_V(0,0);DMA_K(1,SLOTB);DMA_K(2,2*SLOTB);DMA_V(1,SLOTB);DMA_K(3,3*SLOTB);
  bf16x8 qr[2][4];
  #pragma unroll
  for(int b=0;b<2;++b)
    #pragma unroll
    for(int d0=0;d0<4;++d0)qr[b][d0]=*reinterpret_cast<const bf16x8*>(&Qw[(long)(b*32+r32)*QP+d0*16+hi*8]);
  f32x16 o[2][2];o[0][0]=f32x16{};o[0][1]=f32x16{};o[1][0]=f32x16{};o[1][1]=f32x16{}; float la0=0.f,la1=0.f,lb0=0.f,lb1=0.f;
  f32x16 S00,S10,S01,S11; u32x4 pa0,pa1,pa2,pa3,pb0,pb1,pb2,pb3; bf16x8 kf[4];
  #define PIN(x) asm volatile("":"+v"(x))
  #define MM(acc,a,b) do{ if(VAR!=2&&VAR!=9&&VAR!=10){acc=__builtin_amdgcn_mfma_f32_32x32x16_bf16(a,b,acc,0,0,0);} PIN(acc); }while(0)
  #define KLD(kp,j) do{ if(VAR==3&&INLOOP)break; _Pragma("unroll") for(int d_=0;d_<4;++d_) kf[d_]=*(const __attribute__((address_space(3))) bf16x8*)((kp)+d_*2048+(j)*512); }while(0)
  #define VLD(F,i) do{ if(VAR==3){PIN(F);break;} const s16x4 lo_=vtr(vp_+(((i)>>2)*4096+((i)&3)*1024)), hi_=vtr(vp_+(((i)>>2)*4096+((i)&3)*1024+512)); F=(bf16x8){lo_[0],lo_[1],lo_[2],lo_[3],hi_[0],hi_[1],hi_[2],hi_[3]}; }while(0)
  #define SMB(C,r,sa,sb,W,wi) do{ if(VAR==1||VAR==10){W[wi]=__float_as_uint(C[r]);break;} const float ea_=__builtin_amdgcn_exp2f(C[r]),eb_=__builtin_amdgcn_exp2f(C[(r)+1]); sa=fadd_s(sa,ea_); sb=fadd_s(sb,eb_); W[wi]=cvtpk_s(ea_,eb_); }while(0)
  #define GQK(C,b,CS,r0,sa,sb,W,DQ,DS) do{ \
      if(DQ){ const f32x16 z_=f32x16{}; if((VAR!=2&&VAR!=9&&VAR!=10)||!INLOOP){C=__builtin_amdgcn_mfma_f32_32x32x16_bf16(kf[0],qr[b][0],z_,0,0,0);} PIN(C); } if(DS){ SMB(CS,(r0)+0,sa,sb,W,0); } SBAR(); \
      if(DQ){ MM(C,kf[1],qr[b][1]); } if(DS){ SMB(CS,(r0)+2,sa,sb,W,1); } SBAR(); \
      if(DQ){ MM(C,kf[2],qr[b][2]); } if(DS){ SMB(CS,(r0)+4,sa,sb,W,2); } SBAR(); \
      if(DQ){ MM(C,kf[3],qr[b][3]); } if(DS){ SMB(CS,(r0)+6,sa,sb,W,3); } SBAR(); }while(0)
  #define GPV(G0,G1,dh,wa0,wb0,wa1,wb1,CS,r0,sa,sb,W,DS) do{ \
      MM(o[0][dh],__builtin_bit_cast(bf16x8,wa0),G0); if(DS){ SMB(CS,(r0)+0,sa,sb,W,0); } SBAR(); \
      MM(o[1][dh],__builtin_bit_cast(bf16x8,wb0),G0); if(DS){ SMB(CS,(r0)+2,sa,sb,W,1); } SBAR(); \
      MM(o[0][dh],__builtin_bit_cast(bf16x8,wa1),G1); if(DS){ SMB(CS,(r0)+4,sa,sb,W,2); } SBAR(); \
      MM(o[1][dh],__builtin_bit_cast(bf16x8,wb1),G1); if(DS){ SMB(CS,(r0)+6,sa,sb,W,3); } SBAR(); }while(0)
  #define STEP4(t,GK,GV,GQ,GL) do{ SBAR(); \
      if(GK){DMA_K((t)+4,((t)&3)*SLOTB);} if(GV){DMA_V((t)+2,s_prev);} \
      const lds_cptr vp_=vp0+s_cur; const lds_cptr kq_=kp0+((((t)+1)&3)*SLOTB), kn_=kp0+((((t)+2)&3)*SLOTB); bf16x8 Fa0=qr[0][0],Fa1=qr[0][1],Fb0=qr[0][2],Fb1=qr[0][3]; \
      VLD(Fa0,0); VLD(Fa1,1); \
      GQK(S00,0,S01,0,la0,la1,pa2,GQ,true); \
      VLD(Fb0,4); VLD(Fb1,5); \
      GQK(S10,1,S01,8,la0,la1,pa3,GQ,true); \
      if(GQ){KLD(kq_,1);} \
      GPV(Fa0,Fa1,0,pa0,pb0,pa1,pb1,S11,0,lb0,lb1,pb2,true); \
      VLD(Fa0,2); VLD(Fa1,3); \
      GPV(Fb0,Fb1,1,pa0,pb0,pa1,pb1,S11,8,lb0,lb1,pb3,true); \
      VLD(Fb0,6); VLD(Fb1,7); \
      if(GQ){ GQK(S01,0,S00,0,la0,la1,pa0,true,true); GQK(S11,1,S00,8,la0,la1,pa1,true,true); } \
      if(GL){KLD(kn_,0);} \
      GPV(Fa0,Fa1,0,pa2,pb2,pa3,pb3,S10,0,lb0,lb1,pb0,GQ); \
      GPV(Fb0,Fb1,1,pa2,pb2,pa3,pb3,S10,8,lb0,lb1,pb1,GQ); \
      if((GK)&&(GV)){ if(VAR==5){asm volatile("s_waitcnt vmcnt(2) lgkmcnt(0)":::"memory");}else{asm volatile("s_waitcnt vmcnt(2) lgkmcnt(0)\n\ts_barrier":::"memory");} } \
      else if((GK)||(GV)){ if(VAR==5){asm volatile("s_waitcnt vmcnt(1) lgkmcnt(0)":::"memory");}else{asm volatile("s_waitcnt vmcnt(1) lgkmcnt(0)\n\ts_barrier":::"memory");} } \
      else { if(VAR==5){asm volatile("s_waitcnt vmcnt(0) lgkmcnt(0)":::"memory");}else{asm volatile("s_waitcnt vmcnt(0) lgkmcnt(0)\n\ts_barrier":::"memory");} } \
      SBAR(); { const int n_=s_prev; s_prev=s_cur; s_cur=s_next; s_next=n_; } }while(0)
  asm volatile("s_waitcnt vmcnt(0) lgkmcnt(0)\n\ts_barrier":::"memory"); SBAR();
  #pragma unroll
  for(int b=0;b<2;++b)
    #pragma unroll
    for(int d0=0;d0<4;++d0) asm volatile("":"+v"(qr[b][d0]));
  #define INLOOP 0
  KLD(kp0,0); GQK(S00,0,S00,0,la0,la1,pa0,true,false); GQK(S10,1,S00,0,la0,la1,pa0,true,false);
  KLD(kp0,1); GQK(S01,0,S00,0,la0,la1,pa0,true,false); GQK(S11,1,S00,0,la0,la1,pa0,true,false);
  KLD(kp0+SLOTB,0);
  GQK(S00,0,S00,0,la0,la1,pa0,false,true); GQK(S00,0,S00,8,la0,la1,pa1,false,true); GQK(S00,0,S10,0,lb0,lb1,pb0,false,true); GQK(S00,0,S10,8,lb0,lb1,pb1,false,true);
  asm volatile("s_waitcnt lgkmcnt(0)\n\ts_barrier":::"memory"); SBAR();
  #undef INLOOP
  #define INLOOP 1
  int s_prev=2*SLOTB,s_cur=0,s_next=SLOTB;
  if(ATTN_PRIO&&wid>=4) __builtin_amdgcn_s_setprio(1);
  _Pragma("unroll 1") for(int t=0;t+4<NT;++t){ STEP4(t,true,true,true,true); }
  STEP4(NT-4,false,true,true,true); STEP4(NT-3,false,true,true,true); STEP4(NT-2,false,false,true,false); STEP4(NT-1,false,false,false,false);
  if(ATTN_PRIO) __builtin_amdgcn_s_setprio(0);
  #undef INLOOP
  #undef MM
  #undef PIN
  #undef KLD
  #undef VLD
  #undef SMB
  #undef GQK
  #undef GPV
  #undef STEP4
  int te_=threadIdx.x; asm volatile("":"+v"(te_));
  const int lane_e=te_&63,r32_e=lane_e&31,hi_e=lane_e>>5; const int wid_e=__builtin_amdgcn_readfirstlane(te_>>6);
  float*wsf=(float*)(shm+U4_WS)+wid_e*64;
  #pragma unroll
  for(int b=0;b<2;++b){
    float l=b?lb0+lb1:la0+la1; {auto rr=__builtin_amdgcn_permlane32_swap(__float_as_uint(l),__float_as_uint(l),false,false);l=__uint_as_float(rr[0])+__uint_as_float(rr[1]);}
    if(hi_e==0)wsf[32*b+r32_e]=l; asm volatile("s_waitcnt lgkmcnt(0)":::"memory");
    float rli[16];
    #pragma unroll
    for(int r=0;r<16;++r)rli[r]=__builtin_amdgcn_rcpf(wsf[32*b+crow(r,hi_e)]);
    bf16*Ow=O+((long)rowbase_+qb*512+wid_e*64+b*32)*OP+h*D;
    bf16*stg=(bf16*)(shm+U4_OST)+wid_e*2048;
    #pragma unroll
    for(int r=0;r<16;++r){const int orow=crow(r,hi_e);
      #pragma unroll
      for(int d0=0;d0<2;++d0)stg[orow*64+d0*32+r32_e]=__float2bfloat16(o[b][d0][r]*rli[r]);}
    asm volatile("s_waitcnt lgkmcnt(0)":::"memory");
    #pragma unroll
    for(int i=0;i<4;++i){const int row=i*8+(lane_e>>3),ch=lane_e&7; const u32x4 v=*(const u32x4*)(stg+row*64+ch*8); if(VAR==0)ATTN_STORE16(Ow+(long)row*OP+ch*8,v);}
    asm volatile("s_waitcnt lgkmcnt(0)":::"memory");
  }
  asm volatile("s_waitcnt lgkmcnt(0)\n\ts_barrier":::"memory");
  #undef DMA_K
  #undef DMA_V
}
constexpr int ATTN_LDS_BYTES=(LDS_BYTES>U4_BYTES?LDS_BYTES:U4_BYTES);
struct AttnTensors { const bf16* Q; const bf16* K; const bf16* V; bf16* O; };
#if ATTN_U4
#define ATTN_UNIT attn_unit4<VAR>
#else
#define ATTN_UNIT attn_unit3
#endif
template<int VAR=0> __device__ __forceinline__ void attn_phase3(char*lds,const AttnTensors&T,int vcu,int G){
  if(G==256){
    const int x=vcu>>5,j=vcu&31;
    for(int i=0;i<2;++i){ const int w=j*2+i,g=w>>4,qb=w&15; ATTN_UNIT(16384+(x>>1)*8192,8192,(x&1)*4+g,qb,T.Q,T.K,T.V,T.O,lds); }
    { const int w=j,g=w>>3,qb=w&7; ATTN_UNIT((x>>1)*4096,4096,(x&1)*4+g,qb,T.Q,T.K,T.V,T.O,lds); }
  }
}
template<int THRL=8> __device__ __forceinline__ void attn_phase(char*lds,const AttnTensors&T,int vcu,int G){
  if(G==256){
    const int x=vcu>>5,j=vcu&31;
    for(int i=0;i<4;++i){ const int w=j*4+i,g=w>>5,qb=w&31; attn_unit<THRL>(16384+(x>>1)*8192,8192,(x&1)*4+g,qb,T.Q,T.K,T.V,T.O,lds); }
    for(int i=0;i<2;++i){ const int w=j*2+i,g=w>>4,qb=w&15; attn_unit<THRL>((x>>1)*4096,4096,(x&1)*4+g,qb,T.Q,T.K,T.V,T.O,lds); }
  } else {
    for(int u=vcu;u<1536;u+=G){
      if(u<1024){ const int qb=u&31,h=(u>>5)&7,s=u>>8; attn_unit<THRL>(16384+s*8192,8192,h,qb,T.Q,T.K,T.V,T.O,lds); }
      else { const int v=u-1024,qb=v&15,h=(v>>4)&7,s=v>>7; attn_unit<THRL>(s*4096,4096,h,qb,T.Q,T.K,T.V,T.O,lds); }
    }
  }
}
#undef SBAR
#undef WAIT_BAR
}

__device__ __forceinline__ void sattn_unit(const Frame& F, int seq, int h, int qb) {
    const int T = seq < 4 ? TP : TS; const int rowbase = seq < 4 ? seq * TP : MP + (seq - 4) * TS;
    const bf16* Q = (const bf16*)(F.ws + WS_Q); const bf16* Kb = (const bf16*)(F.ws + WS_K); const bf16* Vb = (const bf16*)(F.ws + WS_V); bf16* MIX = (bf16*)(F.ws + WS_MIX);
    const int kvh = h >> 2, m = rowbase + qb * 512 + F.tid;
    LAS float* Ks = (LAS float*)F.lds; LAS float* Vs = Ks + 64 * 64;
    float q[64], o[64];
    { const u32x4* qp = (const u32x4*)(Q + (size_t)m * 512 + h * 64);
#pragma unroll
      for (int i = 0; i < 8; ++i) { const u32x4 w = qp[i]; q[8 * i] = bflo(w.x); q[8 * i + 1] = bfhi(w.x); q[8 * i + 2] = bflo(w.y); q[8 * i + 3] = bfhi(w.y); q[8 * i + 4] = bflo(w.z); q[8 * i + 5] = bfhi(w.z); q[8 * i + 6] = bflo(w.w); q[8 * i + 7] = bfhi(w.w); } }
#pragma unroll
    for (int d = 0; d < 64; ++d) o[d] = 0.f;
    float mx = -1e30f, l = 0.f;
    const int lr = F.tid >> 3, lc = (F.tid & 7) * 8;
    for (int kt = 0; kt < T / 64; ++kt) {
        __syncthreads();
        { const size_t grow = (size_t)(rowbase + kt * 64 + lr) * 128 + kvh * 64 + lc;
          const u32x4 kw = *(const u32x4*)(Kb + grow), vw = *(const u32x4*)(Vb + grow);
          LAS f32x4* kd = (LAS f32x4*)(Ks + lr * 64 + lc); LAS f32x4* vd = (LAS f32x4*)(Vs + lr * 64 + lc);
          kd[0] = (f32x4){bflo(kw.x), bfhi(kw.x), bflo(kw.y), bfhi(kw.y)}; kd[1] = (f32x4){bflo(kw.z), bfhi(kw.z), bflo(kw.w), bfhi(kw.w)};
          vd[0] = (f32x4){bflo(vw.x), bfhi(vw.x), bflo(vw.y), bfhi(vw.y)}; vd[1] = (f32x4){bflo(vw.z), bfhi(vw.z), bflo(vw.w), bfhi(vw.w)}; }
        __syncthreads();
#pragma unroll 1
        for (int j = 0; j < 64; ++j) {
            const LAS f32x4* Kc = (const LAS f32x4*)(Ks + j * 64); const LAS f32x4* Vc = (const LAS f32x4*)(Vs + j * 64);
            float a = 0.f;
#pragma unroll
            for (int d4 = 0; d4 < 16; ++d4) { const f32x4 kv = Kc[d4]; a += q[4 * d4] * kv.x + q[4 * d4 + 1] * kv.y + q[4 * d4 + 2] * kv.z + q[4 * d4 + 3] * kv.w; }
            const float mn = fmaxf(mx, a), alpha = exp2f(mx - mn), p = exp2f(a - mn); mx = mn; l = l * alpha + p;
#pragma unroll
            for (int d4 = 0; d4 < 16; ++d4) { const f32x4 vv = Vc[d4]; o[4 * d4] = o[4 * d4] * alpha + p * vv.x; o[4 * d4 + 1] = o[4 * d4 + 1] * alpha + p * vv.y; o[4 * d4 + 2] = o[4 * d4 + 2] * alpha + p * vv.z; o[4 * d4 + 3] = o[4 * d4 + 3] * alpha + p * vv.w; }
        }
    }
    const float il = 1.0f / l;
    u32x4* op = (u32x4*)(MIX + (size_t)m * DM + h * 64);
#pragma unroll
    for (int i = 0; i < 8; ++i) { u32x4 w; w.x = pk2(o[8 * i] * il, o[8 * i + 1] * il); w.y = pk2(o[8 * i + 2] * il, o[8 * i + 3] * il); w.z = pk2(o[8 * i + 4] * il, o[8 * i + 5] * il); w.w = pk2(o[8 * i + 6] * il, o[8 * i + 7] * il); op[i] = w; }
}
__device__ __forceinline__ void sattn_phase(const Frame& F) {
    for (int u = F.vcu; u < 768; u += F.G) {
        if (u < 512) { const int qb = u & 15, h = (u >> 4) & 7, s = u >> 7; sattn_unit(F, 4 + s, h, qb); }
        else { const int v = u - 512, qb = v & 7, h = (v >> 3) & 7, s = v >> 6; sattn_unit(F, s, h, qb); }
    }
}
__device__ __forceinline__ void pool_phase(const Frame& F) {
    const bf16* U = (const bf16*)(F.ws + WS_U); bf16* MIX = (bf16*)(F.ws + WS_MIX);
    constexpr int PR = 32, TR = PR + 16, BUFB = TR * 1024, NU = M / PR;
    const unsigned ldsb = (unsigned)(uintptr_t)F.lds;
    const int g = F.wave & 3, half = 1 << g, ch = 16 * g + (F.lane & 15), rbase = 16 * (F.wave >> 2) + 4 * (F.lane >> 4);
#define POOL_LOAD(u_, buf_) do { const int r0_ = (u_) * PR; _Pragma("unroll") for (int i_ = 0; i_ < TR / 8; ++i_) { const int rr_ = F.wave + 8 * i_; int gr_ = r0_ - 8 + rr_; gr_ = gr_ < 0 ? 0 : (gr_ > M - 1 ? M - 1 : gr_); \
        attn_body::glds16(U + (size_t)gr_ * 512 + F.lane * 8, (unsigned)__builtin_amdgcn_readfirstlane(ldsb + (buf_) * BUFB + rr_ * 1024)); } } while (0)
    __syncthreads();
    int u = F.vcu, b = 0;
    if (u < NU) POOL_LOAD(u, 0);
    for (; u < NU; u += F.G, b ^= 1) {
        const bool more = (u + F.G < NU);
        if (more) { POOL_LOAD(u + F.G, b ^ 1); asm volatile("s_waitcnt vmcnt(6)\n\ts_barrier" ::: "memory"); }
        else { asm volatile("s_waitcnt vmcnt(0)\n\ts_barrier" ::: "memory"); }
        const LAS u32x4* T = (const LAS u32x4*)(F.lds + b * BUFB);
        const int r0 = u * PR, Tlen = r0 < MP ? TP : TS, t0 = tpos(r0);
        {
            int t = t0 + rbase; float a[8];
#pragma unroll
            for (int k = 0; k < 8; ++k) a[k] = 0.f;
#define POOL_ACC(pos_, sg_) do { const u32x4 w_ = T[((pos_) - t0 + 8) * 64 + ch]; \
                a[0] += sg_ bflo(w_.x); a[1] += sg_ bfhi(w_.x); a[2] += sg_ bflo(w_.y); a[3] += sg_ bfhi(w_.y); a[4] += sg_ bflo(w_.z); a[5] += sg_ bfhi(w_.z); a[6] += sg_ bflo(w_.w); a[7] += sg_ bfhi(w_.w); } while (0)
            { const int lo = max(t - half, 0), hi = min(t + half, Tlen); for (int j = lo; j < hi; ++j) POOL_ACC(j, +); }
#pragma unroll
            for (int i = 0; i < 4; ++i) {
                if (i > 0) { if (t + half - 1 < Tlen) POOL_ACC(t + half - 1, +); if (t - half - 1 >= 0) POOL_ACC(t - half - 1, -); }
                const int lo = max(t - half, 0), hi = min(t + half, Tlen);
                const float inv = __builtin_amdgcn_rcpf((float)(hi - lo));
                const u32x4 w = T[(t - t0 + 8) * 64 + ch];
                u32x4 o; o.x = cvtpk(a[0] * inv - bflo(w.x), a[1] * inv - bfhi(w.x)); o.y = cvtpk(a[2] * inv - bflo(w.y), a[3] * inv - bfhi(w.y));
                o.z = cvtpk(a[4] * inv - bflo(w.z), a[5] * inv - bfhi(w.z)); o.w = cvtpk(a[6] * inv - bflo(w.w), a[7] * inv - bfhi(w.w));
                *(u32x4*)(MIX + (size_t)(r0 + (t - t0)) * DM + 512 + ch * 8) = o;
                ++t;
            }
#undef POOL_ACC
        }
        asm volatile("s_waitcnt lgkmcnt(0)\n\ts_barrier" ::: "memory");
    }
#undef POOL_LOAD
    asm volatile("s_waitcnt vmcnt(0)" ::: "memory");
    __syncthreads();
}
__device__ __forceinline__ void final_phase(const Frame& F, const float* src, float* out, const float* g) {
    const int gw = F.vcu * NWAVES + F.wave, NGW = F.G * NWAVES; const f32x4* gr = (const f32x4*)g + F.lane;
    for (int m = gw; m < M; m += NGW) {
        const f32x4* xs = (const f32x4*)(src + (size_t)m * DM) + F.lane; f32x4* xr = (f32x4*)(out + (size_t)m * DM) + F.lane; f32x4 v[4]; float s = 0.f;
#pragma unroll
        for (int j = 0; j < 4; ++j) { v[j] = xs[64 * j]; s += (v[j].x * v[j].x + v[j].y * v[j].y) + (v[j].z * v[j].z + v[j].w * v[j].w); }
        const float rstd = 1.0f / sqrtf(wave_sum(s) * (1.f / DM) + EPS);
#pragma unroll
        for (int j = 0; j < 4; ++j) xr[64 * j] = v[j] * rstd * gr[64 * j];
    }
}


constexpr int CW_BAR = 4096;
constexpr int LDSCTL_OFF = 131072, MISC_OFF = LDSCTL_OFF + 320;
#define XB_TMO      128
#define XB_XCNT(j)  (256  + 64 * (j))
#define XB_XSUB(j)  (1280 + 64 * (j))
#define XB_XGEN(j)  (2304 + 64 * (j))
#define XB_TOP      3328
#define XB_TOPGEN   3392
#define XCD_BAR_WORDS 3456
#define XB_SPIN_CAP (1u << 20)
__device__ __forceinline__ unsigned xb_ld(unsigned* p)              { return __hip_atomic_load(p, __ATOMIC_RELAXED, __HIP_MEMORY_SCOPE_AGENT); }
__device__ __forceinline__ unsigned xb_add(unsigned* p, unsigned v) { return __hip_atomic_fetch_add(p, v, __ATOMIC_RELAXED, __HIP_MEMORY_SCOPE_AGENT); }
__device__ __forceinline__ unsigned xb_xcc_id() { return (unsigned)__builtin_amdgcn_s_getreg((3 << 11) | 20) & 0xFu; }
#define XB_SPIN(cond, bar) do { unsigned _sp = 0; while (cond) { __builtin_amdgcn_s_sleep(1); \
    if ((++_sp & 255u) == 0u) { if (xb_ld(&(bar)[XB_TMO])) break; if (_sp > XB_SPIN_CAP) { atomicAdd(&(bar)[XB_TMO], 1u); break; } } } } while (0)
struct XcdBarrier { unsigned* bar; unsigned x; volatile LAS unsigned* st; };
__device__ __forceinline__ XcdBarrier xcd_barrier_post(unsigned* bar, volatile LAS unsigned* st) {
    XcdBarrier b; b.bar = bar; b.x = xb_xcc_id(); b.st = st;
    if (threadIdx.x == 0) (void)xb_add(&bar[XB_XCNT(b.x)], 1u);
    return b;
}
__device__ __forceinline__ void xcd_barrier_complete(unsigned* bar, unsigned x, unsigned& nloc, unsigned& nx) {
    const unsigned G = gridDim.x * gridDim.y * gridDim.z;
    unsigned sum, cnt, mine, sp = 0u;
    for (;;) {
        sum = 0u; cnt = 0u; mine = 0u;
#pragma unroll
        for (unsigned j = 0; j < 16; ++j) { const unsigned c = xb_ld(&bar[XB_XCNT(j)]); sum += c; cnt += (c > 0u) ? 1u : 0u; mine = (j == x) ? c : mine; }
        if (sum == G) break;
        __builtin_amdgcn_s_sleep(1);
        if ((++sp & 255u) == 0u) { if (xb_ld(&bar[XB_TMO])) break; if (sp > XB_SPIN_CAP) { atomicAdd(&bar[XB_TMO], 1u); break; } }
    }
    nloc = mine > 0u ? mine : 1u; nx = cnt > 0u ? cnt : 1u;
}
__device__ __forceinline__ void xcd_barrier(const XcdBarrier& b) {
    asm volatile("s_waitcnt vmcnt(0)" ::: "memory");
    __syncthreads();
    if (threadIdx.x == 0) {
        unsigned* bar = b.bar;
        __builtin_amdgcn_s_waitcnt(0);
        unsigned nloc = b.st[0], nx = b.st[1];
        if (nloc == 0u) { xcd_barrier_complete(bar, b.x, nloc, nx); b.st[0] = nloc; b.st[1] = nx; }
        const unsigned old = xb_add(&bar[XB_XSUB(b.x)], 1u);
        const unsigned gen = old / nloc;
        if (old + 1u == (gen + 1u) * nloc) {
            __builtin_amdgcn_fence(__ATOMIC_RELEASE, "agent");
            asm volatile("s_waitcnt vmcnt(0)" ::: "memory");
            const unsigned og = xb_add(&bar[XB_TOP], 1u);
            const unsigned tg = og / nx;
            if (og + 1u == (tg + 1u) * nx) xb_add(&bar[XB_TOPGEN], 1u);
            else XB_SPIN(xb_ld(&bar[XB_TOPGEN]) == tg, bar);
            __builtin_amdgcn_fence(__ATOMIC_ACQUIRE, "agent");
            xb_add(&bar[XB_XGEN(b.x)], 1u);
            asm volatile("s_waitcnt vmcnt(0)" ::: "memory");
        } else {
            XB_SPIN(xb_ld(&bar[XB_XGEN(b.x)]) == gen, bar);
            __builtin_amdgcn_fence(__ATOMIC_ACQUIRE, "agent");
            asm volatile("s_waitcnt vmcnt(0)" ::: "memory");
        }
    }
    __syncthreads();
}


template <class E>
__device__ __forceinline__ void fgemm(const Frame& F, const bf16* A, const bf16* Bt, int Mrows, int N, int K, int row0, const E& e) {
    pg8::Gemm g{A, Bt, Mrows, N, K}; pg8::StaticOrder S; S.init(Mrows, N, F.G, (int)blockIdx.x);
    pg8::EpiAdapt<E> EA{e, row0};
    pg8::gemm_phase<pg8::EpiAdapt<E>, pg8::StaticOrder, true, true>(F.lds, g, S, EA);
}

constexpr int CW_GRP = 8192;
constexpr int CW_GRP_TMO = 8192 + 64 * 64;
__device__ __forceinline__ void group_sync(unsigned* cnt, unsigned target, unsigned* tmo, bool light) {
    asm volatile("s_waitcnt vmcnt(0)" ::: "memory");
    __syncthreads();
    if (threadIdx.x == 0) {
        if (!light) __builtin_amdgcn_fence(__ATOMIC_RELEASE, "agent");
        asm volatile("s_waitcnt vmcnt(0)" ::: "memory");
        (void)xb_add(cnt, 1u);
        unsigned sp = 0u;
        while (xb_ld(cnt) < target) { __builtin_amdgcn_s_sleep(1); if (++sp > (1u << 21)) { atomicAdd(tmo, 1u); break; } }
        __builtin_amdgcn_fence(__ATOMIC_ACQUIRE, "agent");
        asm volatile("s_waitcnt vmcnt(0)" ::: "memory");
    }
    __syncthreads();
}
__device__ __forceinline__ f32x4 ld_bf16x4(const bf16* p) { const u32x2 w = *(const u32x2*)p; return (f32x4){bflo(w.x), bfhi(w.x), bflo(w.y), bfhi(w.y)}; }
__device__ __forceinline__ float ssq8(f32x4 a, f32x4 b) { return ((a[0] * a[0] + a[1] * a[1]) + (a[2] * a[2] + a[3] * a[3])) + ((b[0] * b[0] + b[1] * b[1]) + (b[2] * b[2] + b[3] * b[3])); }
struct EpiResA {
    static constexpr bool NOFENCE = true;
    bf16* HB; float* SS;
    __device__ __forceinline__ void tile(pg8::f32x4 (&acc)[2][2][4][2], int mrow, int c0, int fq) const {
        u32x4 x[2][4][2];
#pragma unroll
        for (int ai = 0; ai < 2; ++ai)
#pragma unroll
            for (int m = 0; m < 4; ++m)
#pragma unroll
                for (int h = 0; h < 2; ++h) x[ai][m][h] = *(const u32x4*)(HB + (size_t)(mrow + 128 * ai + 16 * m) * DM + c0 + 8 * fq + 32 * h);
        asm volatile("" ::: "memory");
#pragma unroll
        for (int ai = 0; ai < 2; ++ai)
#pragma unroll
            for (int m = 0; m < 4; ++m) { const int r = mrow + 128 * ai + 16 * m; bf16* hb = HB + (size_t)r * DM + c0 + 8 * fq; float ss = 0.f;
                u32x4 P[2];
#pragma unroll
                for (int h = 0; h < 2; ++h) { const u32x4 w = x[ai][m][h];
                    const f32x4 h0 = (f32x4){bflo(w.x), bfhi(w.x), bflo(w.y), bfhi(w.y)} + acc[ai][h][m][0], h1 = (f32x4){bflo(w.z), bfhi(w.z), bflo(w.w), bfhi(w.w)} + acc[ai][h][m][1];
                    P[h] = pk_bf16x8(h0, h1); ss += ssq8(h0, h1); }
                st_lines_bf16(hb, 8L * DM, P[0], P[1], (r & 8) != 0);
                ss = quad_sum(ss);
                if (fq == 0) SS[(size_t)r * 16 + (c0 >> 6)] = ss; }
    }
    __device__ __forceinline__ void seg64(int m, int c0, f32x4 (&v)[4], int fq) const {
        bf16* hb = HB + (size_t)m * DM + c0 + 8 * fq; float ss = 0.f;
#pragma unroll
        for (int h = 0; h < 2; ++h) { f32x4 h0, h1; ld_bf16x8(hb + 32 * h, h0, h1); h0 = h0 + v[2 * h]; h1 = h1 + v[2 * h + 1]; st_bf16x8(hb + 32 * h, h0, h1); ss += ssq8(h0, h1); }
        ss = quad_sum(ss);
        if (fq == 0) SS[(size_t)m * 16 + (c0 >> 6)] = ss;
    }
};
typedef EpiResA EpiResC;
template <int V = 0> struct EpiUpPT {
    bf16* HM; const LAS float* rs; int row0;
    __device__ __forceinline__ void seg64(int m, int c0, f32x4 (&v)[4], int fq) const {
        if (V == 2) { asm volatile("" :: "v"(v[0]), "v"(v[1]), "v"(v[2]), "v"(v[3])); return; }
        const float rstd = rs[m - row0];
        bf16* d = HM + (size_t)(m - row0) * DFF + c0 + 8 * fq;
        u32x4 P[2];
#pragma unroll
        for (int h = 0; h < 2; ++h) { f32x4 a = v[2 * h] * rstd, b = v[2 * h + 1] * rstd;
#pragma unroll
            for (int j = 0; j < 4; ++j) { const float r = fmaxf(a[j], 0.f), q = fmaxf(b[j], 0.f); a[j] = r * r; b[j] = q * q; }
            P[h] = pk_bf16x8(a, b); }
        if (V == 1) { asm volatile("" :: "v"(P[0]), "v"(P[1])); } else st_lines_bf16(d, 8L * DFF, P[0], P[1], (m & 8) != 0);
    }
};
typedef EpiUpPT<0> EpiUpP;
struct EpiBfP {
    bf16* O; int ld;
    __device__ __forceinline__ void seg64(int m, int c0, f32x4 (&v)[4], int fq) const {
        bf16* d = O + (size_t)m * ld + c0 + 8 * fq;
        st_bf16x8(d, v[0], v[1]); st_bf16x8(d + 32, v[2], v[3]);
    }
};
namespace pg8 {
struct EpiGateFinal {
    static constexpr bool PERM = true, AFTER_DRAIN = true;
    const bf16* HB; const bf16* PP; const float* SS2; float* SS3; float* out; const float* fg; unsigned* cnt; unsigned target; unsigned* tmo; int row0; bool light;
    __device__ __forceinline__ void fused(f32x4 (&acc)[2][2][4][2], const Unit& u, int wr, int wc, int fr, int fq, PG8_LAS unsigned char* lds, int wid, int lane) const {
        const int c0 = u.pn * BM + wc * 64;
#pragma unroll
        for (int ai = 0; ai < 2; ++ai)
#pragma unroll
            for (int m = 0; m < 4; ++m) {
                const int row = row0 + ai * HALF + wr * 64 + m * 16 + fr;
                const float rstd = ((const PG8_LAS float*)(lds + RSTD_OFF))[row - row0], nrl = -1.4426950408889634f * rstd;
                const bf16* hb = HB + (size_t)row * DM + c0 + 8 * fq; const bf16* pp = PP + (size_t)row * DM + c0 + 8 * fq; float ss = 0.f;
#pragma unroll
                for (int bj = 0; bj < 2; ++bj) { ::f32x4 hv[2], pv[2]; ld_bf16x8(hb + 32 * bj, hv[0], hv[1]); ld_bf16x8(pp + 32 * bj, pv[0], pv[1]);
#pragma unroll
                    for (int n = 0; n < 2; ++n) { const ::f32x4 a = acc[ai][bj][m][n]; ::f32x4 h;
#pragma unroll
                        for (int e = 0; e < 4; ++e) h[e] = hv[n][e] + pv[n][e] * __builtin_amdgcn_rcpf(1.0f + __builtin_amdgcn_exp2f(a[e] * nrl));
                        acc[ai][bj][m][n] = h; ss += (h[0] * h[0] + h[1] * h[1]) + (h[2] * h[2] + h[3] * h[3]); } }
                ss = quad_sum(ss);
                if (fq == 0) SS3[(size_t)row * 16 + (c0 >> 6)] = ss;
                if (m & 1) asm volatile("" ::: "memory");
            }
        group_sync(cnt, target, tmo, light);
        if (threadIdx.x < 256) ((PG8_LAS float*)(lds + RSTD_OFF))[threadIdx.x] = rstd_from_ss(SS3 + (size_t)(row0 + threadIdx.x) * 16);
        __syncthreads();
#pragma unroll
        for (int ai = 0; ai < 2; ++ai)
#pragma unroll
            for (int m = 0; m < 4; ++m) {
                const int row = row0 + ai * HALF + wr * 64 + m * 16 + fr;
                const float rstd = ((const PG8_LAS float*)(lds + RSTD_OFF))[row - row0];
                float* o = out + (size_t)row * DM + c0 + 8 * fq; const float* g = fg + c0 + 8 * fq;
#pragma unroll
                for (int bj = 0; bj < 2; ++bj)
#pragma unroll
                    for (int n = 0; n < 2; ++n) *(::f32x4*)(o + 32 * bj + 4 * n) = acc[ai][bj][m][n] * rstd * *(const ::f32x4*)(g + 32 * bj + 4 * n);
                if (m & 1) asm volatile("" ::: "memory");
            }
    }
};
struct ListOrder {
    int pn0, n;
    __device__ __forceinline__ bool next(int i, Unit& u) const { if (i >= n) return false; u.pm = 0; u.pn = pn0 + i; return true; }
    __device__ __forceinline__ void a_ready(const Unit&) const {}
    __device__ __forceinline__ void done(const Unit&) const {}
};
}
template <class E>
__device__ __forceinline__ void lgemm(const Frame& F, const bf16* A, const bf16* Bt, int N, int K, int row0, int pn0, int n, const E& e) {
    pg8::Gemm g{A, Bt, 256, N, K}; pg8::ListOrder S{pn0, n};
    pg8::EpiAdapt<E, true> EA{e, row0};
    pg8::gemm_phase<pg8::EpiAdapt<E, true>, pg8::ListOrder, true, true>(F.lds, g, S, EA);
}
namespace pg8 {
struct PanelOrder {
    int gidx, pn;
    __device__ __forceinline__ bool next(int i, Unit& u) const { if (i >= 3) return false; u.pm = i * 64 + gidx; u.pn = pn; return true; }
    __device__ __forceinline__ void a_ready(const Unit&) const {}
    __device__ __forceinline__ void done(const Unit&) const {}
};
}
template <class E>
__device__ __forceinline__ void lgemm3(const Frame& F, const bf16* A, const bf16* Bt, int N, int K, int gidx, int pn, const E& e) {
    pg8::Gemm g{A, Bt, M, N, K}; pg8::PanelOrder S{gidx, pn};
    pg8::EpiAdapt<E, true> EA{e, 0};
    pg8::gemm_phase<pg8::EpiAdapt<E, true>, pg8::PanelOrder, true, true>(F.lds, g, S, EA);
}
__device__ __forceinline__ void tail_phase(const Frame& F, const Args& args, bool early) {
    const int gidx = F.vcu >> 2, mem = F.vcu & 3;
    unsigned nsync = 0u;
    bool light = false;
    if (early && F.tid == 0) { const unsigned m_ = xb_ld((unsigned*)(F.ws + WS_CTL) + CW_GRP + 64 * gidx + 1); light = TAIL_LIGHT && (m_ != 0u) && ((m_ & (m_ - 1u)) == 0u); }
    if (TAIL_STAGGER_TICKS > 0) {
        const unsigned long long t0 = __builtin_amdgcn_s_memrealtime(), dt = (unsigned long long)((gidx & 7) * TAIL_STAGGER_TICKS);
        while (__builtin_amdgcn_s_memrealtime() - t0 < dt) __builtin_amdgcn_s_sleep(8);
    }
    const bool late_p = TAIL_SPLIT_P && (gidx & 1);
    { unsigned char* ws = F.ws; asm volatile("" : "+s"(ws));
      { EpiResA E{(bf16*)(ws + WS_XN), (float*)(ws + WS_SS1)}; lgemm3(F, (const bf16*)(ws + WS_MIX), (const bf16*)(ws + WS_WOUT), DM, DM, gidx, mem, E); }
      if (!late_p) { EpiBfP E{(bf16*)(ws + WS_PP), DM}; lgemm3(F, (const bf16*)(ws + WS_PB), (const bf16*)(ws + WS_WPROJ), DM, PLE, gidx, mem, E); }
      unsigned* cnt = (unsigned*)(ws + WS_CTL) + CW_GRP + 64 * gidx; unsigned* tmo = (unsigned*)(ws + WS_CTL) + CW_GRP_TMO;
      group_sync(cnt, 4u * (++nsync), tmo, light);
      if (!early && F.tid == 0) { const unsigned m_ = xb_ld((unsigned*)(ws + WS_CTL) + CW_GRP + 64 * gidx + 1); light = TAIL_LIGHT && (m_ != 0u) && ((m_ & (m_ - 1u)) == 0u); } }
#pragma unroll 1
    for (int c = 0; c < 3; ++c) {
        unsigned char* ws = F.ws; asm volatile("" : "+s"(ws));
        bf16* HB = (bf16*)(ws + WS_XN); const bf16* PP = (const bf16*)(ws + WS_PP);
        float* SS1 = (float*)(ws + WS_SS1); float* SS2 = (float*)(ws + WS_SS2);
        bf16* HMg = (bf16*)(ws + WS_HM) + (size_t)gidx * 256 * DFF;
        unsigned* cnt = (unsigned*)(ws + WS_CTL) + CW_GRP + 64 * gidx; unsigned* tmo = (unsigned*)(ws + WS_CTL) + CW_GRP_TMO;
        const LAS float* rs = (const LAS float*)(F.lds + RSTD_OFF);
        const int row0 = (c * 64 + gidx) * 256;
        rstd_table(F, SS1, row0);
        { EpiUpP E{HMg, rs, row0}; lgemm(F, HB + (size_t)row0 * DM, (const bf16*)(ws + WS_WUP), DFF, DM, row0, 4 * mem, 4, E); }
        group_sync(cnt, 4u * (++nsync), tmo, light);
        { EpiResC E{HB, SS2}; lgemm(F, HMg, (const bf16*)(ws + WS_WDOWN), DM, DFF, row0, mem, 1, E); }
        group_sync(cnt, 4u * (++nsync), tmo, light);
        if (late_p && c == 0) { EpiBfP E{(bf16*)(ws + WS_PP), DM}; lgemm3(F, (const bf16*)(ws + WS_PB), (const bf16*)(ws + WS_WPROJ), DM, PLE, gidx, mem, E); }
        rstd_table(F, SS2, row0);
        { pg8::Gemm g{HB + (size_t)row0 * DM, (const bf16*)(ws + WS_WGATE), 256, DM, DM}; pg8::ListOrder S{mem, 1};
          pg8::EpiGateFinal E{HB, PP, SS2, SS1, args.out, args.in[17], cnt, 4u * (++nsync), tmo, row0, light};
          pg8::gemm_phase<pg8::EpiGateFinal, pg8::ListOrder, false, true>(F.lds, g, S, E); }
    }
}

constexpr int NPHASE = 4;
__global__ void __launch_bounds__(NWAVES * 64, 2) fwd_kernel(Args args) {
    extern __shared__ __attribute__((aligned(16))) unsigned char lds[];
    Frame F;
    F.lds = (LAS unsigned char*)lds; F.tid = threadIdx.x; F.lane = F.tid & 63; F.wave = __builtin_amdgcn_readfirstlane(F.tid >> 6);
    F.G = gridDim.x; { const int bx = blockIdx.x; F.vcu = (F.G % 8 == 0) ? (bx % 8) * (F.G / 8) + bx / 8 : bx; }
    F.ws = args.ws;
    unsigned char* ws = args.ws;
    for (int u = F.tid; u < (LDS_BYTES - LDSCTL_OFF) / 4; u += NWAVES * 64) ((LAS unsigned*)(F.lds + LDSCTL_OFF))[u] = 0u;
    __syncthreads();
    if (F.tid == 0) (void)__hip_atomic_fetch_or((unsigned*)(ws + WS_CTL) + CW_GRP + 64 * (F.vcu >> 2) + 1, 1u << xb_xcc_id(), __ATOMIC_RELAXED, __HIP_MEMORY_SCOPE_AGENT);
    XcdBarrier bar; bar.bar = (unsigned*)(ws + WS_CTL) + CW_BAR; bar.x = 0; bar.st = nullptr;
    if (args.ph_hi - args.ph_lo > 1) bar = xcd_barrier_post((unsigned*)(ws + WS_CTL) + CW_BAR, (volatile LAS unsigned*)(F.lds + MISC_OFF) + 8);
    bf16* XN = (bf16*)(ws + WS_XN); bf16* PP = (bf16*)(ws + WS_PP); bf16* MIX = (bf16*)(ws + WS_MIX); bf16* HM = (bf16*)(ws + WS_HM);
    float* SS1 = (float*)(ws + WS_SS1); float* SS2 = (float*)(ws + WS_SS2);
    const int lo = args.ph_lo, hi = args.ph_hi;
#define IN(k) (lo <= (k) && (k) < hi)
#define SEAM(k) do { if (IN(k) && IN((k) + 1)) xcd_barrier(bar); } while (0)
#define NREP(k) ((PROBE_REPEAT == (k)) ? 2 : 1)
#define REPBAR() do { if (rep) xcd_barrier(bar); } while (0)
    float* const dry = (float*)(ws + WS_HM);
    if (IN(0)) p0_prologue(F, args);
    SEAM(0);
    if (IN(1)) {
        EpiIn E{(bf16*)(ws + WS_Q), (bf16*)(ws + WS_K), (bf16*)(ws + WS_V), (bf16*)(ws + WS_U), args.in[6], args.in[7], (const float2*)(ws + WS_ROPE), (const float*)(ws + WS_RSX)};
        fgemm(F, XN, (const bf16*)(ws + WS_WIN), M, INW, DM, 0, E);
    } SEAM(1);
    unsigned long long pc_t0 = 0, pc_r0 = 0;
    if (PROBE_CLOCK == 2) { pc_t0 = __builtin_amdgcn_s_memtime(); pc_r0 = __builtin_amdgcn_s_memrealtime(); }
    if (IN(2)) {
        const attn_body::AttnTensors AT{(const attn_body::bf16*)(ws + WS_Q), (const attn_body::bf16*)(ws + WS_K), (const attn_body::bf16*)(ws + WS_V), (attn_body::bf16*)MIX};
#pragma unroll 1
        for (int rep = 0; rep < NREP(12); ++rep) { REPBAR(); pool_phase(F); }
#pragma unroll 1
        for (int rep = 0; rep < NREP(2); ++rep) { REPBAR(); if (ATTN_U3) { if (rep == 0) attn_body::attn_phase3<0>((char*)lds, AT, F.vcu, F.G); else attn_body::attn_phase3<PROBE_AVAR>((char*)lds, AT, F.vcu, F.G); } else attn_body::attn_phase<8>((char*)lds, AT, F.vcu, F.G); }
    }
#define PC_SPIN() do { const unsigned long long t1_ = __builtin_amdgcn_s_memtime(), r1_ = __builtin_amdgcn_s_memrealtime(); const unsigned long long mhz_ = (t1_ - pc_t0) * 100ull / (r1_ - pc_r0); \
        if (blockIdx.x == 0) { const unsigned long long e_ = r1_ + mhz_ * 10ull; while (__builtin_amdgcn_s_memrealtime() < e_) __builtin_amdgcn_s_sleep(8); } } while (0)
    if (PROBE_CLOCK == 2) PC_SPIN();
    SEAM(2);
    if (PROBE_CLOCK == 3) { pc_t0 = __builtin_amdgcn_s_memtime(); pc_r0 = __builtin_amdgcn_s_memrealtime(); }
    if (IN(3)) tail_phase(F, args, lo < 3);
    if (PROBE_CLOCK == 3) PC_SPIN();
#undef PC_SPIN
#undef NREP
#undef REPBAR
#undef IN
#undef SEAM
}

extern "C" void kernel_launch(void* const* d_in, const int* in_sizes, int n_in, void* d_out, int out_size, void* d_ws, size_t ws_size, hipStream_t stream) {
    static int grid = 0;
    if (grid == 0) {
        if (n_in != 18 || out_size != M * DM || ws_size < WS_END) { fprintf(stderr, "kernel_launch: unexpected shapes (n_in %d out %d ws %zu)\n", n_in, out_size, ws_size); grid = -1; return; }
        if (hipFuncSetAttribute((const void*)fwd_kernel, hipFuncAttributeMaxDynamicSharedMemorySize, LDS_BYTES) != hipSuccess) { fprintf(stderr, "kernel_launch: hipFuncSetAttribute failed\n"); grid = -1; return; }
        int dev = 0, cus = 0; (void)hipGetDevice(&dev); (void)hipDeviceGetAttribute(&cus, hipDeviceAttributeMultiprocessorCount, dev);
        int per_cu = 0;
        if (hipOccupancyMaxActiveBlocksPerMultiprocessor(&per_cu, (const void*)fwd_kernel, NWAVES * 64, LDS_BYTES) != hipSuccess || per_cu < 1) { fprintf(stderr, "kernel_launch: occupancy query admits %d workgroups per CU; nothing launched\n", per_cu); (void)hipGetLastError(); grid = -1; return; }
        if (cus != 256) { fprintf(stderr, "kernel_launch: built for 256 CUs (64 groups of 4 workgroups in the tail), device has %d; nothing launched\n", cus); grid = -1; return; }
        grid = cus;
    }
    if (grid < 0) return;
    Args a{};
    for (int i = 0; i < 18; ++i) a.in[i] = (const float*)d_in[i];
    a.out = (float*)d_out; a.ws = (unsigned char*)d_ws;
#if MK_ONE_LAUNCH
    if (hipMemsetAsync((char*)d_ws + WS_CTL, 0, 65536, stream) != hipSuccess) { fprintf(stderr, "kernel_launch: memset failed\n"); return; }
    a.ph_lo = 0; a.ph_hi = NPHASE; hipLaunchKernelGGL(fwd_kernel, dim3(grid), dim3(NWAVES * 64), LDS_BYTES, stream, a);
#else
    for (int ph = 0; ph < NPHASE; ++ph) { a.ph_lo = ph; a.ph_hi = ph + 1; hipLaunchKernelGGL(fwd_kernel, dim3(grid), dim3(NWAVES * 64), LDS_BYTES, stream, a); }
#endif
}
```

```cpp
#include <hip/hip_runtime.h>
#include <cstdio>
#include <cstdint>
#include <hip/hip_bf16.h>
#include <cmath>

#ifndef P0_RIF
#define P0_RIF 8
#endif
#ifndef P0_NTSTORE
#define P0_NTSTORE 1
#endif
#ifndef POOL_DYNAMIC
#define POOL_DYNAMIC 1
#endif
#ifndef P0_MIXORDER
#define P0_MIXORDER 1
#endif
#ifndef TAIL_SPLIT_P
#define TAIL_SPLIT_P 1
#endif
#ifndef ATTN_PRIO
#define ATTN_PRIO 0
#endif
#ifndef TAIL_LIGHT
#define TAIL_LIGHT 1
#endif
#ifndef PROBE_CLOCK
#define PROBE_CLOCK (0)
#endif
#ifndef PROBE_AVAR
#define PROBE_AVAR (0)
#endif
#ifndef PROBE_REPEAT
#define PROBE_REPEAT (-1)
#endif
#ifndef TAIL_REP
#define TAIL_REP (-1)
#endif
#ifndef TAIL_CLS
#define TAIL_CLS 0
#endif
#ifndef ATTN_NOMAX
#define ATTN_NOMAX 1
#endif
#ifndef TAIL_STAGGER_TICKS
#define TAIL_STAGGER_TICKS 0
#endif
#ifndef TAIL_PROBE_B
#define TAIL_PROBE_B (-1)
#endif
#ifndef ATTN_U4
#define ATTN_U4 1
#endif
#ifndef ATTN_U3
#define ATTN_U3 1
#endif
#ifndef MK_ONE_LAUNCH
#define MK_ONE_LAUNCH 1
#endif

constexpr int DM = 1024, TP = 4096, TS = 8192, MP = 4 * TP, MS = 4 * TS, M = MP + MS;
constexpr int INW = 1280, DFF = 4096, PLE = 256;
constexpr int CHUNK = 16384, NCHUNK = M / CHUNK;
constexpr float EPS = 1e-6f;
constexpr float C2 = 0.125f * 1.4426950408889634f;

typedef unsigned short bf16;
typedef short bf16x8 __attribute__((ext_vector_type(8)));
typedef float f32x4 __attribute__((ext_vector_type(4)));
typedef unsigned u32x4 __attribute__((ext_vector_type(4)));
typedef unsigned u32x2 __attribute__((ext_vector_type(2)));
#define LAS __attribute__((address_space(3)))
#define GAS __attribute__((address_space(1)))

constexpr size_t MiB = 1u << 20;
constexpr size_t WS_CTL = 0, CTL_ZERO_BYTES = 1 * MiB;
constexpr size_t WS_ROPE = 1 * MiB;
constexpr size_t WS_RSX = 1 * MiB + 65536;
constexpr size_t WS_SS1 = 2 * MiB, WS_SS2 = 5 * MiB;
constexpr size_t WS_WIN = 8 * MiB, WS_WOUT = 11 * MiB, WS_WUP = 13 * MiB, WS_WDOWN = 21 * MiB, WS_WGATE = 29 * MiB, WS_WPROJ = 31 * MiB;
constexpr size_t WS_PP = 32 * MiB;
constexpr size_t WS_XN = 128 * MiB;
constexpr size_t WS_PB = 464 * MiB;
constexpr size_t WS_Q = 248 * MiB, WS_K = 296 * MiB, WS_V = 308 * MiB, WS_U = 320 * MiB;
constexpr size_t WS_MIX = 368 * MiB;
constexpr size_t WS_HM = 224 * MiB;
constexpr size_t WS_END = 488 * MiB;

constexpr int LDS_BYTES = 147456;
constexpr int NWAVES = 8;

__device__ __forceinline__ unsigned f2bf(float f) { unsigned u = __builtin_bit_cast(unsigned, f); return (u + 0x7fffu + ((u >> 16) & 1u)) >> 16; }
__device__ __forceinline__ unsigned pk2(float lo, float hi) { return f2bf(lo) | (f2bf(hi) << 16); }
__device__ __forceinline__ float bf2f(unsigned short b) { return __builtin_bit_cast(float, (unsigned)b << 16); }
__device__ __forceinline__ float bflo(unsigned w) { return __builtin_bit_cast(float, w << 16); }
__device__ __forceinline__ float bfhi(unsigned w) { return __builtin_bit_cast(float, w & 0xffff0000u); }
typedef float f32x2_k __attribute__((ext_vector_type(2))); typedef __bf16 bf16x2_k __attribute__((ext_vector_type(2)));
__device__ __forceinline__ unsigned cvtpk(float lo, float hi) { f32x2_k v = {lo, hi}; bf16x2_k b = __builtin_convertvector(v, bf16x2_k); return __builtin_bit_cast(unsigned, b); }
__device__ __forceinline__ float wave_sum(float v) {
#pragma unroll
    for (int o = 1; o < 64; o <<= 1) v += __shfl_xor(v, o);
    return v;
}
__host__ __device__ __forceinline__ int inv_head(int n) { const int pn = n >> 8, r = n & 255, wc = r >> 6, bj = (r >> 5) & 1, j = r & 31; return pn * 256 + bj * 128 + wc * 32 + j; }

struct Args { const float* in[18]; float* out; unsigned char* ws; int ph_lo, ph_hi; };

struct Frame {
    LAS unsigned char* lds;
    int tid, lane, wave, vcu, G;
    unsigned char* ws;
};
__device__ __forceinline__ const float* xrow(const Args& A, int m) { return m < MP ? A.in[0] + (size_t)m * DM : A.in[1] + (size_t)(m - MP) * DM; }
__device__ __forceinline__ const float* prow(const Args& A, int m) { return m < MP ? A.in[2] + (size_t)m * PLE : A.in[3] + (size_t)(m - MP) * PLE; }
__device__ __forceinline__ int tpos(int m) { return m < MP ? (m & (TP - 1)) : ((m - MP) & (TS - 1)); }

__device__ __forceinline__ void p0_transpose_item(const float* W, int ldw, int K, int ncols, bf16* WT, LAS float* scr, int item, int lane, const float* kscale, bool headmap) {
    const int nblk = ncols / 32, kb = item / nblk, nb = item % nblk, k0 = 64 * kb, n0 = 32 * nb;
#pragma unroll
    for (int i = 0; i < 32; ++i) { const int kk = 2 * i + (lane >> 5); float v = W[(size_t)(k0 + kk) * ldw + n0 + (lane & 31)]; if (kscale) v *= kscale[k0 + kk]; scr[kk * 33 + (lane & 31)] = v; }
    asm volatile("s_waitcnt lgkmcnt(0)" ::: "memory");
    const int c = lane & 7;
#pragma unroll
    for (int j = 0; j < 4; ++j) { const int n = (lane >> 3) + 8 * j; const LAS float* s = scr + (8 * c) * 33 + n;
        u32x4 o; o.x = pk2(s[0 * 33], s[1 * 33]); o.y = pk2(s[2 * 33], s[3 * 33]); o.z = pk2(s[4 * 33], s[5 * 33]); o.w = pk2(s[6 * 33], s[7 * 33]);
        const int dr = headmap ? inv_head(n0 + n) : (n0 + n);
        *(u32x4*)(WT + (size_t)dr * K + k0 + 8 * c) = o; }
    asm volatile("s_waitcnt lgkmcnt(0)" ::: "memory");
}
__device__ __forceinline__ void p0_fold_item(const float* Win, const float* Wp, const float* psc, const float* gk, bf16* WT, LAS float* scr, int item, int lane) {
    const int g = item & 3, k0 = (item >> 2) * 8;
#pragma unroll
    for (int i = 0; i < 16; ++i) { const int e = i * 64 + lane, kk = e >> 7, c = e & 127; scr[e] = Win[(size_t)(k0 + kk) * INW + 768 + 128 * g + c] * gk[k0 + kk]; }
    asm volatile("s_waitcnt lgkmcnt(0)" ::: "memory");
    float a0[8], a1[8];
#pragma unroll
    for (int kk = 0; kk < 8; ++kk) { a0[kk] = 0.f; a1[kk] = 0.f; }
    const float* wp = Wp + (size_t)g * 128 * 128 + lane;
#pragma unroll 1
    for (int cb = 0; cb < 128; cb += 8) {
        float w0[8], w1[8];
#pragma unroll
        for (int i = 0; i < 8; ++i) { w0[i] = wp[(cb + i) * 128]; w1[i] = wp[(cb + i) * 128 + 64]; }
#pragma unroll
        for (int i = 0; i < 8; ++i)
#pragma unroll
            for (int kk = 0; kk < 8; ++kk) { const float a = scr[kk * 128 + cb + i]; a0[kk] += a * w0[i]; a1[kk] += a * w1[i]; }
    }
    const float s0 = psc[128 * g + lane], s1 = psc[128 * g + 64 + lane];
    { u32x4 o0; o0.x = pk2(a0[0] * s0, a0[1] * s0); o0.y = pk2(a0[2] * s0, a0[3] * s0); o0.z = pk2(a0[4] * s0, a0[5] * s0); o0.w = pk2(a0[6] * s0, a0[7] * s0);
      *(u32x4*)(WT + (size_t)inv_head(768 + 128 * g + lane) * DM + k0) = o0; }
    { u32x4 o1; o1.x = pk2(a1[0] * s1, a1[1] * s1); o1.y = pk2(a1[2] * s1, a1[3] * s1); o1.z = pk2(a1[4] * s1, a1[5] * s1); o1.w = pk2(a1[6] * s1, a1[7] * s1);
      *(u32x4*)(WT + (size_t)inv_head(768 + 128 * g + 64 + lane) * DM + k0) = o1; }
    asm volatile("s_waitcnt lgkmcnt(0)" ::: "memory");
}
__device__ __forceinline__ void rms_row_to_bf16(const float* xr_, const float* g, bf16* orow, int lane) {
    const f32x4* xr = (const f32x4*)xr_ + lane; const f32x4* gr = (const f32x4*)g + lane;
    f32x4 v[4]; float s = 0.f;
#pragma unroll
    for (int j = 0; j < 4; ++j) { v[j] = xr[64 * j]; s += (v[j].x * v[j].x + v[j].y * v[j].y) + (v[j].z * v[j].z + v[j].w * v[j].w); }
    const float rstd = 1.0f / sqrtf(wave_sum(s) * (1.f / DM) + EPS);
    unsigned long long* o8 = (unsigned long long*)orow + lane;
#pragma unroll
    for (int j = 0; j < 4; ++j) { const f32x4 gg = gr[64 * j];
        o8[64 * j] = (unsigned long long)pk2(v[j].x * rstd * gg.x, v[j].y * rstd * gg.y) | ((unsigned long long)pk2(v[j].z * rstd * gg.z, v[j].w * rstd * gg.w) << 32); }
}
constexpr int P0_I_FOLD = 128 * 4, P0_I_IN = (DM / 64) * (768 / 32), P0_I_OUT = (DM / 64) * (DM / 32), P0_I_UP = (DM / 64) * (DFF / 32), P0_I_DOWN = (DFF / 64) * (DM / 32), P0_I_GATE = P0_I_OUT, P0_I_PROJ = (PLE / 64) * (DM / 32);
constexpr int P0_NW_IN = P0_I_FOLD + P0_I_IN, P0_NITEMS = P0_NW_IN + P0_I_OUT + P0_I_UP + P0_I_DOWN + P0_I_GATE + P0_I_PROJ;
__device__ __forceinline__ void p0_items(const Frame& F, const Args& A, int lo, int hi, int gw, int ngw) {
    LAS float* scr = (LAS float*)(F.lds + F.wave * 16384);
    bf16* Bin = (bf16*)(F.ws + WS_WIN); bf16* Bout = (bf16*)(F.ws + WS_WOUT); bf16* Bup = (bf16*)(F.ws + WS_WUP);
    bf16* Bdown = (bf16*)(F.ws + WS_WDOWN); bf16* Bgate = (bf16*)(F.ws + WS_WGATE); bf16* Bproj = (bf16*)(F.ws + WS_WPROJ);
    for (int it = lo + gw; it < hi; it += ngw) {
        int r = it;
        if (r < P0_I_FOLD) { p0_fold_item(A.in[5], A.in[8], A.in[9], A.in[4], Bin, scr, r, F.lane); continue; } r -= P0_I_FOLD;
        if (r < P0_I_IN) { p0_transpose_item(A.in[5], INW, DM, 768, Bin, scr, r, F.lane, A.in[4], true); continue; } r -= P0_I_IN;
        if (r < P0_I_OUT) { p0_transpose_item(A.in[10], DM, DM, DM, Bout, scr, r, F.lane, nullptr, true); continue; } r -= P0_I_OUT;
        if (r < P0_I_UP) { p0_transpose_item(A.in[12], DFF, DM, DFF, Bup, scr, r, F.lane, A.in[11], true); continue; } r -= P0_I_UP;
        if (r < P0_I_DOWN) { p0_transpose_item(A.in[13], DM, DFF, DM, Bdown, scr, r, F.lane, nullptr, true); continue; } r -= P0_I_DOWN;
        if (r < P0_I_GATE) { p0_transpose_item(A.in[15], DM, DM, DM, Bgate, scr, r, F.lane, A.in[14], true); continue; } r -= P0_I_GATE;
        p0_transpose_item(A.in[16], DM, PLE, DM, Bproj, scr, r, F.lane, nullptr, true);
    }
}
template <int R>
__device__ __forceinline__ void p0_rows(const Frame& F, const Args& A, int m0, int mstep) {
    bf16* XN = (bf16*)(F.ws + WS_XN); bf16* PB = (bf16*)(F.ws + WS_PB);
    f32x4 v[R][4], pv[R];
#pragma unroll
    for (int r = 0; r < R; ++r) { const f32x4* xr = (const f32x4*)xrow(A, m0 + r * mstep) + F.lane;
#pragma unroll
        for (int j = 0; j < 4; ++j) v[r][j] = __builtin_nontemporal_load(xr + 64 * j);
        pv[r] = __builtin_nontemporal_load((const f32x4*)prow(A, m0 + r * mstep) + F.lane); }
#pragma unroll
    for (int r = 0; r < R; ++r) { const int mr = m0 + r * mstep; u32x2* o = (u32x2*)(XN + (size_t)mr * DM) + F.lane;
#pragma unroll
        for (int j = 0; j < 4; ++j) { const f32x4 w = v[r][j]; u32x2 t; t.x = cvtpk(w.x, w.y); t.y = cvtpk(w.z, w.w); if (P0_NTSTORE) __builtin_nontemporal_store(t, o + 64 * j); else o[64 * j] = t; }
        u32x2 t; t.x = cvtpk(pv[r].x, pv[r].y); t.y = cvtpk(pv[r].z, pv[r].w); if (P0_NTSTORE) __builtin_nontemporal_store(t, (u32x2*)(PB + (size_t)mr * PLE) + F.lane); else *((u32x2*)(PB + (size_t)mr * PLE) + F.lane) = t; }
#pragma unroll
    for (int r = 0; r < R; ++r) { float q = 0.f;
#pragma unroll
        for (int j = 0; j < 4; ++j) q += (v[r][j].x * v[r][j].x + v[r][j].y * v[r][j].y) + (v[r][j].z * v[r][j].z + v[r][j].w * v[r][j].w);
        const float rs = 1.0f / sqrtf(wave_sum(q) * (1.f / DM) + EPS);
        if (F.lane == 0) ((float*)(F.ws + WS_RSX))[m0 + r * mstep] = rs; }
}
__device__ __forceinline__ void p0_rope(const Frame& F) {
    const int gt = F.vcu * 512 + F.tid;
    if (gt < 2048) { const int p = gt >> 4, i = gt & 15; const float inv = exp2f(-(float)i * (13.287712379549449f / 16.0f)); const float a = (float)p * inv;
        float2* R = (float2*)(F.ws + WS_ROPE); R[gt] = make_float2(cosf(a), sinf(a)); }
}
__device__ __forceinline__ void p0_my_items(const Frame& F, const Args& A) {
    static_assert(P0_I_FOLD == 512 && P0_NITEMS == 6144, "item split");
    const bool fw = F.wave < 2;
    int it = fw ? F.vcu * 2 + F.wave : P0_I_FOLD + 512 + F.vcu * 6 + (F.wave - 2);
    const int step = fw ? 512 : 1536, last = fw ? P0_I_FOLD + 512 : P0_NITEMS;
#pragma unroll 1
    for (; it < last; it += step) p0_items(F, A, it, it + 1, 0, 1);
}
__device__ __forceinline__ void p0_prologue(const Frame& F, const Args& A) {
    const int gw = F.vcu * NWAVES + F.wave, NGW = F.G * NWAVES;
    const bool items_first = !(P0_MIXORDER && (F.wave & 1));
    if (items_first) p0_my_items(F, A);
#pragma unroll 1
    for (int m = gw * P0_RIF; m < M; m += P0_RIF * NGW) p0_rows<P0_RIF>(F, A, m, 1);
    if (!items_first) p0_my_items(F, A);
    p0_rope(F);
}
namespace pg8 {
#define PG8_LAS __attribute__((address_space(3)))
typedef unsigned short bf16_t;
typedef short bf16x8 __attribute__((ext_vector_type(8)));
typedef float f32x4 __attribute__((ext_vector_type(4)));
typedef unsigned u32x4 __attribute__((ext_vector_type(4)));
constexpr int BM = 256, BK = 64, HALF = 128, HTB = HALF * BK * 2  , STAGE_BYTES = 8 * HTB, NXCD = 8, WGM = 8;

__host__ __device__ __forceinline__ int lds_byte(int r, int c) { const int st = (r >> 4) * 2 + (c >> 5), rr = r & 15, cc = c & 31, ob = rr * 64 + cc * 2; return st * 1024 + (ob ^ (((ob >> 9) & 1) << 5)); }
__host__ __device__ __forceinline__ void stage_rc(int b, int& R, int& C) { const int st = b / 1024, sb = b % 1024, swz = sb ^ (((sb >> 9) & 1) << 5); R = (st >> 1) * 16 + swz / 64; C = (st & 1) * 32 + (swz % 64) / 2; }
__host__ __device__ __forceinline__ int perm32(int rho) { const int n = rho >> 4, i = rho & 15; return 8 * (i >> 2) + 4 * n + (i & 3); }

struct Unit { int pm, pn; };
struct Gemm { const bf16_t* A; const bf16_t* Bt; int M, N, K; };

struct StaticOrder {
    int nM, nN, nwg, G, c;
    __host__ __device__ void init(int M, int N, int G_, int c_) { nM = M / BM; nN = N / BM; nwg = nM * nN; G = G_; c = c_; }
    __host__ __device__ bool next(int i, Unit& u) const {
        const long L = (long)i * G + c; if (L >= nwg) return false;
        int wgid = (int)L; { const int q = nwg / NXCD, r = nwg % NXCD, xcd = wgid % NXCD, off = wgid / NXCD; wgid = (xcd < r ? xcd * (q + 1) : r * (q + 1) + (xcd - r) * q) + off; }
        const int nig = WGM * nN, gid = wgid / nig, fm = gid * WGM, gsz = (nM - fm) < WGM ? (nM - fm) : WGM;
        u.pm = fm + ((wgid % nig) % gsz); u.pn = (wgid % nig) / gsz; return true;
    }
    __device__ __forceinline__ void a_ready(const Unit&) const {}
    __device__ __forceinline__ void done(const Unit&) const {}
};

template <class T, class = void> struct nofence_of { static constexpr bool value = false; };
template <class T> struct nofence_of<T, decltype((void)T::NOFENCE)> { static constexpr bool value = T::NOFENCE; };
template <class E, bool PERMV = false> struct EpiAdapt {
    static constexpr bool PERM = PERMV, AFTER_DRAIN = false;
    E e; int row0;
    __device__ __forceinline__ void operator()(f32x4 (&acc)[2][2][4][2], const Unit& u, int wr, int wc, int fr, int fq) const {
        const int c0 = u.pn * BM + wc * 64;
        if constexpr (nofence_of<E>::value) { e.tile(acc, row0 + u.pm * BM + wr * 64 + fr, c0, fq); return; }
#pragma unroll
        for (int ai = 0; ai < 2; ++ai)
#pragma unroll
            for (int m = 0; m < 4; ++m) {
                ::f32x4 v[4] = {acc[ai][0][m][0], acc[ai][0][m][1], acc[ai][1][m][0], acc[ai][1][m][1]};
                e.seg64(row0 + u.pm * BM + ai * HALF + wr * 64 + m * 16 + fr, c0, v, fq);
                if (!nofence_of<E>::value && (m & 1)) asm volatile("" ::: "memory");
            }
    }
};
template <class Epi, class Sched, bool ALIGN_EPI = false, bool SP2 = false>
__device__ __forceinline__ void gemm_phase(PG8_LAS unsigned char* lds, const Gemm g, const Sched& S, const Epi& E) {
    int tid_ = threadIdx.x; asm volatile("" : "+v"(tid_));
    const int tid = tid_, wid = __builtin_amdgcn_readfirstlane(tid >> 6), lane = tid & 63, wr = wid >> 2, wc = wid & 3, fr = lane & 15, fq = lane >> 4;
    const int K = g.K, nt = K / BK;
    unsigned voffA[2], voffB[2];
#pragma unroll
    for (int i = 0; i < 2; ++i) { int R, C; stage_rc(tid * 16 + i * 8192, R, C); const int Rb = Epi::PERM ? ((R & ~31) + perm32(R & 31)) : R;
        voffA[i] = (unsigned)(R * K + C) * 2u; voffB[i] = (unsigned)(Rb * K + C) * 2u; }
    const size_t kstep = (size_t)(BK * 2);
    const size_t hstep = (size_t)HALF * K * 2;
    const size_t tstep = 2 * hstep;
    const unsigned ldsw = (unsigned)wid * 1024u;
    const int aoff = lds_byte(wr * 64 + fr, fq * 8), boff = lds_byte(wc * 32 + fr, fq * 8);
#define PG8_SA(b, h) (((b) * 2 + (h)) * HTB)
#define PG8_SB(b, h) ((4 + (b) * 2 + (h)) * HTB)
#define PG8_STAGE(bufoff, gbase, voff) do { _Pragma("unroll") for (int _i = 0; _i < 2; ++_i) { unsigned _vo = (voff)[_i]; asm volatile("" : "+v"(_vo)); \
        __builtin_amdgcn_global_load_lds((const unsigned*)((const char*)(gbase) + _vo), (PG8_LAS unsigned*)(lds + (bufoff) + ldsw + _i * 8192), 16, 0, 0); } } while (0)
#define PG8_LDA(dst, b, h) do { _Pragma("unroll") for (int m = 0; m < 4; ++m) _Pragma("unroll") for (int k = 0; k < 2; ++k) dst[m][k] = *(const PG8_LAS bf16x8*)(lds + PG8_SA(b, h) + aoff + m * 2048 + k * 1024); } while (0)
#define PG8_LDB(dst, b, h) do { _Pragma("unroll") for (int n = 0; n < 2; ++n) _Pragma("unroll") for (int k = 0; k < 2; ++k) dst[n][k] = *(const PG8_LAS bf16x8*)(lds + PG8_SB(b, h) + boff + n * 2048 + k * 1024); } while (0)
#define PG8_MMA(ai, bj, At, Bt) do { __builtin_amdgcn_s_setprio(1); _Pragma("unroll") for (int m = 0; m < 4; ++m) _Pragma("unroll") for (int n = 0; n < 2; ++n) _Pragma("unroll") for (int k = 0; k < 2; ++k) \
        acc[ai][bj][m][n] = __builtin_amdgcn_mfma_f32_16x16x32_bf16(Bt[n][k], At[m][k], acc[ai][bj][m][n], 0, 0, 0); __builtin_amdgcn_s_setprio(0); } while (0)
#define PG8_WAIT_V(n) asm volatile("s_waitcnt vmcnt(" #n ")" ::: "memory")
#define PG8_WAIT_L(n) asm volatile("s_waitcnt lgkmcnt(" #n ")" ::: "memory")
#define PG8_BAR __builtin_amdgcn_s_barrier()
#define PG8_SCHED __builtin_amdgcn_sched_barrier(0)
    Unit cur, nxt; int ui = 0;
    if (!S.next(0, cur)) return;
    f32x4 acc[2][2][4][2];
#pragma unroll
    for (int a = 0; a < 2; ++a)
#pragma unroll
        for (int b = 0; b < 2; ++b)
#pragma unroll
            for (int m = 0; m < 4; ++m)
#pragma unroll
                for (int n = 0; n < 2; ++n) acc[a][b][m][n] = (f32x4){0.f, 0.f, 0.f, 0.f};
    bf16x8 At[4][2], B0[2][2], B1[2][2];
    const char* cA = (const char*)g.A + (size_t)cur.pm * tstep; const char* cB = (const char*)g.Bt + (size_t)cur.pn * tstep;
    S.a_ready(cur);
    if constexpr (SP2) {
        PG8_STAGE(PG8_SB(0, 0), cB, voffB); PG8_STAGE(PG8_SB(0, 1), cB + hstep, voffB); PG8_STAGE(PG8_SA(0, 0), cA, voffA); PG8_STAGE(PG8_SA(0, 1), cA + hstep, voffA);
        if (wr == 1) PG8_BAR;
        PG8_WAIT_V(2); PG8_BAR;
        PG8_STAGE(PG8_SB(1, 0), cB + kstep, voffB); PG8_STAGE(PG8_SA(1, 0), cA + kstep, voffA); PG8_STAGE(PG8_SB(1, 1), cB + hstep + kstep, voffB);
        PG8_WAIT_V(6); PG8_BAR;
    } else {
        PG8_STAGE(PG8_SB(0, 0), cB, voffB); PG8_STAGE(PG8_SA(0, 0), cA, voffA); PG8_STAGE(PG8_SB(0, 1), cB + hstep, voffB); PG8_STAGE(PG8_SA(0, 1), cA + hstep, voffA);
        if (wr == 1) PG8_BAR;
        PG8_WAIT_V(4); PG8_BAR;
        PG8_STAGE(PG8_SB(1, 0), cB + kstep, voffB); PG8_STAGE(PG8_SA(1, 0), cA + kstep, voffA); PG8_STAGE(PG8_SB(1, 1), cB + hstep + kstep, voffB);
        PG8_WAIT_V(6); PG8_BAR;
    }
    for (;;) {
        const bool has_next = S.next(ui + 1, nxt);
        const char* nA = has_next ? (const char*)g.A + (size_t)nxt.pm * tstep : cA; const char* nB = has_next ? (const char*)g.Bt + (size_t)nxt.pn * tstep : cB;
        for (int t = 0; t < nt; t += 2) {
            const bool last = (t == nt - 2);
            const char* a1 = cA + (size_t)(t + 1) * kstep;
            const char* a2 = last ? nA : cA + (size_t)(t + 2) * kstep; const char* b2 = last ? nB : cB + (size_t)(t + 2) * kstep;
            const char* a3 = a2 + kstep; const char* b3 = b2 + kstep;
            if (last && has_next) S.a_ready(nxt);
            if constexpr (SP2) {
            PG8_LDB(B0, 0, 0); PG8_LDB(B1, 0, 1); PG8_SCHED; PG8_LDA(At, 0, 0); PG8_STAGE(PG8_SA(1, 1), a1 + hstep, voffA);
            PG8_WAIT_V(8); PG8_WAIT_L(0); PG8_BAR; PG8_MMA(0, 0, At, B0); PG8_MMA(0, 1, At, B1); PG8_BAR; PG8_SCHED;
            PG8_LDA(At, 0, 1); PG8_STAGE(PG8_SB(0, 0), b2, voffB); PG8_STAGE(PG8_SB(0, 1), b2 + hstep, voffB); PG8_STAGE(PG8_SA(0, 0), a2, voffA);
            PG8_WAIT_V(8); PG8_WAIT_L(0); PG8_BAR; PG8_MMA(1, 0, At, B0); PG8_MMA(1, 1, At, B1); PG8_BAR; PG8_SCHED;
            PG8_LDB(B0, 1, 0); PG8_LDB(B1, 1, 1); PG8_SCHED; PG8_LDA(At, 1, 0); PG8_STAGE(PG8_SA(0, 1), a2 + hstep, voffA);
            PG8_WAIT_V(8); PG8_WAIT_L(0); PG8_BAR; PG8_MMA(0, 0, At, B0); PG8_MMA(0, 1, At, B1); PG8_BAR; PG8_SCHED;
            PG8_LDA(At, 1, 1); PG8_STAGE(PG8_SB(1, 0), b3, voffB); PG8_STAGE(PG8_SB(1, 1), b3 + hstep, voffB); PG8_STAGE(PG8_SA(1, 0), a3, voffA);
            PG8_WAIT_V(8); PG8_WAIT_L(0); PG8_BAR; PG8_MMA(1, 0, At, B0); PG8_MMA(1, 1, At, B1); PG8_BAR; PG8_SCHED;
            } else {
            PG8_LDB(B0, 0, 0); PG8_SCHED; PG8_LDA(At, 0, 0); PG8_STAGE(PG8_SA(1, 1), a1 + hstep, voffA);
            PG8_WAIT_L(8); PG8_BAR; PG8_WAIT_L(0); PG8_MMA(0, 0, At, B0); PG8_BAR; PG8_SCHED;
            PG8_LDB(B1, 0, 1); PG8_STAGE(PG8_SB(0, 0), b2, voffB);
            PG8_BAR; PG8_WAIT_L(0); PG8_MMA(0, 1, At, B1); PG8_BAR;
            PG8_LDA(At, 0, 1); PG8_STAGE(PG8_SA(0, 0), a2, voffA);
            PG8_BAR; PG8_WAIT_L(0); PG8_MMA(1, 0, At, B0); PG8_BAR; PG8_SCHED;
            PG8_STAGE(PG8_SB(0, 1), b2 + hstep, voffB);
            PG8_WAIT_V(6); PG8_BAR; PG8_MMA(1, 1, At, B1); PG8_BAR;
            PG8_LDB(B0, 1, 0); PG8_SCHED; PG8_LDA(At, 1, 0); PG8_STAGE(PG8_SA(0, 1), a2 + hstep, voffA);
            PG8_WAIT_L(8); PG8_BAR; PG8_WAIT_L(0); PG8_MMA(0, 0, At, B0); PG8_BAR; PG8_SCHED;
            PG8_LDB(B1, 1, 1); PG8_STAGE(PG8_SB(1, 0), b3, voffB);
            PG8_BAR; PG8_WAIT_L(0); PG8_MMA(0, 1, At, B1); PG8_BAR;
            PG8_LDA(At, 1, 1); PG8_STAGE(PG8_SA(1, 0), a3, voffA);
            PG8_BAR; PG8_WAIT_L(0); PG8_MMA(1, 0, At, B0); PG8_BAR; PG8_SCHED;
            PG8_STAGE(PG8_SB(1, 1), b3 + hstep, voffB);
            PG8_WAIT_V(6); PG8_BAR; PG8_MMA(1, 1, At, B1); PG8_BAR;
            }
        }
        if constexpr (ALIGN_EPI) { if (wr == 0) PG8_BAR; }
        if constexpr (!Epi::AFTER_DRAIN) { E(acc, cur, wr, wc, fr, fq); S.done(cur); }
        if (!has_next) break;
#pragma unroll
        for (int a = 0; a < 2; ++a)
#pragma unroll
            for (int b = 0; b < 2; ++b)
#pragma unroll
                for (int m = 0; m < 4; ++m)
#pragma unroll
                    for (int n = 0; n < 2; ++n) acc[a][b][m][n] = (f32x4){0.f, 0.f, 0.f, 0.f};
        cur = nxt; cA = nA; cB = nB; ++ui;
        if constexpr (ALIGN_EPI) { if (wr == 1) PG8_BAR; }
    }
    PG8_WAIT_V(0);
    if constexpr (!ALIGN_EPI) { if (wr == 0) PG8_BAR; }
    PG8_BAR;
    if constexpr (Epi::AFTER_DRAIN) { E.fused(acc, cur, wr, wc, fr, fq, lds, wid, lane); S.done(cur); }
#undef PG8_SA
#undef PG8_SB
#undef PG8_STAGE
#undef PG8_LDA
#undef PG8_LDB
#undef PG8_MMA
#undef PG8_WAIT_V
#undef PG8_WAIT_L
#undef PG8_BAR
#undef PG8_SCHED
}
}

template <class Epi>
__device__ __forceinline__ void sgemm(const bf16* A, int lda, int a_row_sub, const bf16* Bt, int K, int row0, int nrows, int N, bool headmap, const Epi& E, const Frame& F) {
    const int nN = N / 64, nU = (nrows / 256) * nN, fr = F.lane & 15, fq = F.lane >> 4;
    for (int u = F.vcu; u < nU; u += F.G) {
        const int pm = u / nN, pn = u % nN, r0 = row0 + pm * 256 + F.wave * 32, c0 = pn * 64;
        f32x4 acc[2][4];
#pragma unroll
        for (int a = 0; a < 2; ++a)
#pragma unroll
            for (int b = 0; b < 4; ++b) acc[a][b] = (f32x4){0.f, 0.f, 0.f, 0.f};
        const bf16* ap0 = A + (size_t)(r0 - a_row_sub + fr) * lda + 8 * fq; const bf16* ap1 = ap0 + (size_t)16 * lda;
        const bf16* bp[4];
#pragma unroll
        for (int nt = 0; nt < 4; ++nt) { const int n = c0 + 16 * nt + fr; bp[nt] = Bt + (size_t)(headmap ? inv_head(n) : n) * K + 8 * fq; }
        for (int k0 = 0; k0 < K; k0 += 32) {
            const bf16x8 a0 = *(const bf16x8*)(ap0 + k0), a1 = *(const bf16x8*)(ap1 + k0);
            bf16x8 b[4];
#pragma unroll
            for (int nt = 0; nt < 4; ++nt) b[nt] = *(const bf16x8*)(bp[nt] + k0);
#pragma unroll
            for (int nt = 0; nt < 4; ++nt) { acc[0][nt] = __builtin_amdgcn_mfma_f32_16x16x32_bf16(b[nt], a0, acc[0][nt], 0, 0, 0); acc[1][nt] = __builtin_amdgcn_mfma_f32_16x16x32_bf16(b[nt], a1, acc[1][nt], 0, 0, 0); }
        }
        E.seg64(r0 + fr, c0, acc[0], fq); E.seg64(r0 + 16 + fr, c0, acc[1], fq);
    }
}

__device__ __forceinline__ void st_bf16x4(bf16* p, f32x4 v) { u32x2 w; w.x = cvtpk(v[0], v[1]); w.y = cvtpk(v[2], v[3]); *(u32x2*)p = w; }
__device__ __forceinline__ void st_bf16x8(bf16* p, f32x4 a, f32x4 b) { u32x4 w; w.x = cvtpk(a[0], a[1]); w.y = cvtpk(a[2], a[3]); w.z = cvtpk(b[0], b[1]); w.w = cvtpk(b[2], b[3]); *(u32x4*)p = w; }
__device__ __forceinline__ u32x4 pk_bf16x8(f32x4 a, f32x4 b) { u32x4 w; w.x = cvtpk(a[0], a[1]); w.y = cvtpk(a[2], a[3]); w.z = cvtpk(b[0], b[1]); w.w = cvtpk(b[2], b[3]); return w; }
__device__ __forceinline__ unsigned dpp_ror8(unsigned x) { return (unsigned)__builtin_amdgcn_update_dpp(0, (int)x, 0x128, 0xF, 0xF, false); }
__device__ __forceinline__ void st_lines_bf16(bf16* d, long rows8, u32x4 P0, u32x4 P1, bool hi) {
    const u32x4 T = {dpp_ror8(P1.x), dpp_ror8(P1.y), dpp_ror8(P1.z), dpp_ror8(P1.w)};
    *(u32x4*)(hi ? d - rows8 + 32 : d) = hi ? T : P0;
    *(u32x4*)(hi ? d : d + rows8 + 32) = hi ? P0 : T;
}
__device__ __forceinline__ void st_lines_f32(float* d, long rows8, f32x4 Q0, f32x4 Q1, bool hi) {
    f32x4 T;
#pragma unroll
    for (int e = 0; e < 4; ++e) T[e] = __uint_as_float(dpp_ror8(__float_as_uint(Q1[e])));
    *(f32x4*)(hi ? d - rows8 + 4 : d) = hi ? T : Q0;
    *(f32x4*)(hi ? d : d + rows8 + 4) = hi ? Q0 : T;
}
__device__ __forceinline__ void ld_bf16x8(const bf16* p, f32x4& a, f32x4& b) { const u32x4 w = *(const u32x4*)p; a = (f32x4){bflo(w.x), bfhi(w.x), bflo(w.y), bfhi(w.y)}; b = (f32x4){bflo(w.z), bfhi(w.z), bflo(w.w), bfhi(w.w)}; }
__device__ __forceinline__ float quad_sum(float s) {
    { const unsigned u = __float_as_uint(s); auto r = __builtin_amdgcn_permlane16_swap(u, u, false, false); s = __uint_as_float(r[0]) + __uint_as_float(r[1]); }
    { const unsigned u = __float_as_uint(s); auto r = __builtin_amdgcn_permlane32_swap(u, u, false, false); s = __uint_as_float(r[0]) + __uint_as_float(r[1]); }
    return s;
}
__device__ __forceinline__ float rstd_from_ss(const float* ss16) {
    const f32x4* p = (const f32x4*)ss16; const f32x4 a = p[0], b = p[1], c = p[2], d = p[3];
    const float s = ((a.x + a.y) + (a.z + a.w)) + ((b.x + b.y) + (b.z + b.w)) + ((c.x + c.y) + (c.z + c.w)) + ((d.x + d.y) + (d.z + d.w));
    return __builtin_amdgcn_rsqf(s * (1.f / DM) + EPS);
}

__device__ __forceinline__ size_t kv_base(int m, int kvh) {
    const int Tl = m < MP ? TP : TS, rb = m < MP ? (m & ~(TP - 1)) : MP + ((m - MP) & ~(TS - 1));
    return (size_t)rb * 128 + (size_t)kvh * Tl * 64;
}
struct EpiIn {
    static constexpr bool NOFENCE = true;
    bf16 *Q, *K, *V, *U; const float *qg, *kg; const float2* rope; const float* rsx;
    __device__ __forceinline__ void row_qk(int m, int c0, f32x4 (&v)[4], int fq, float rx, const f32x4 (&gg)[4], const float2 (&cr)[4], const float2 (&cc)[4]) const {
        const bool isq = c0 < 512;
        float ss = 0.f;
#pragma unroll
        for (int nt = 0; nt < 4; ++nt) ss += (v[nt][0] * v[nt][0] + v[nt][1] * v[nt][1]) + (v[nt][2] * v[nt][2] + v[nt][3] * v[nt][3]);
        ss = quad_sum(ss);
        const float rstd = rx * __builtin_amdgcn_rsqf(ss * (rx * rx) * (1.f / 64.f) + EPS);
#pragma unroll
        for (int nt = 0; nt < 4; ++nt) v[nt] = v[nt] * rstd * gg[nt];
        const int t = tpos(m);
        const float sc = isq ? C2 : 1.0f;
        f32x4 o[4];
#pragma unroll
        for (int j = 0; j < 4; ++j) {
            o[0][j] = (v[0][j] * cr[j].x - v[1][j] * cr[j].y) * sc; o[1][j] = (v[1][j] * cr[j].x + v[0][j] * cr[j].y) * sc;
            o[2][j] = (v[2][j] * cc[j].x - v[3][j] * cc[j].y) * sc; o[3][j] = (v[3][j] * cc[j].x + v[2][j] * cc[j].y) * sc;
        }
        if (isq) { bf16* dst = Q + (size_t)m * 512 + c0;
#pragma unroll
            for (int nt = 0; nt < 4; ++nt) st_bf16x4(dst + 16 * nt + 4 * fq, o[nt]);
        } else {
            bf16* dst = K + kv_base(m, (c0 - 512) >> 6) + (size_t)(t >> 6) * 4096 + (t & 63) * 8 + 4 * (fq & 1) + (fq >> 1) * 512;
#pragma unroll
            for (int nt = 0; nt < 4; ++nt) st_bf16x4(dst + nt * 1024, o[nt]);
        }
    }
    __device__ __forceinline__ void row_vu(int m, int c0, f32x4 (&v)[4], int fq, float rx) const {
        if (c0 < 768) {
            const int t = tpos(m);
            bf16* dst = V + kv_base(m, (c0 - 640) >> 6) + (size_t)(t >> 6) * 4096 + ((t & 63) >> 4) * 512 + (t & 15) * 32 + 4 * fq;
#pragma unroll
            for (int nt = 0; nt < 4; ++nt) st_bf16x4(dst + (nt >> 1) * 2048 + (nt & 1) * 16, v[nt] * rx);
        } else {
            bf16* dst = U + (size_t)m * 512 + (c0 - 768);
#pragma unroll
            for (int nt = 0; nt < 4; ++nt) st_bf16x4(dst + 16 * nt + 4 * fq, v[nt] * rx);
        }
    }
    __device__ __forceinline__ void tile(pg8::f32x4 (&acc)[2][2][4][2], int mrow, int c0, int fq) const {
        static_assert(TP % 256 == 0 && TS % 256 == 0 && MP % 256 == 0, "row-panel alignment");
        float rx[2][4];
#pragma unroll
        for (int ai = 0; ai < 2; ++ai)
#pragma unroll
            for (int mi = 0; mi < 4; ++mi) rx[ai][mi] = rsx[mrow + 128 * ai + 16 * mi];
        if (c0 < 640) {
            const float* g = c0 < 512 ? qg : kg;
            f32x4 gg[4]; float2 cr[2][4], cc[4][4];
#pragma unroll
            for (int nt = 0; nt < 4; ++nt) gg[nt] = *(const f32x4*)(g + 16 * nt + 4 * fq);
#pragma unroll
            for (int ai = 0; ai < 2; ++ai) { const int pr = tpos(mrow + 128 * ai) >> 6;
#pragma unroll
                for (int j = 0; j < 4; ++j) cr[ai][j] = rope[pr * 16 + 4 * fq + j]; }
#pragma unroll
            for (int mi = 0; mi < 4; ++mi) { const int pc = tpos(mrow + 16 * mi) & 63;
#pragma unroll
                for (int j = 0; j < 4; ++j) cc[mi][j] = rope[pc * 16 + 4 * fq + j]; }
#pragma unroll
            for (int ai = 0; ai < 2; ++ai)
#pragma unroll
                for (int mi = 0; mi < 4; ++mi) { f32x4 v[4] = {acc[ai][0][mi][0], acc[ai][0][mi][1], acc[ai][1][mi][0], acc[ai][1][mi][1]};
                    row_qk(mrow + 128 * ai + 16 * mi, c0, v, fq, rx[ai][mi], gg, cr[ai], cc[mi]); }
        } else {
#pragma unroll
            for (int ai = 0; ai < 2; ++ai)
#pragma unroll
                for (int mi = 0; mi < 4; ++mi) { f32x4 v[4] = {acc[ai][0][mi][0], acc[ai][0][mi][1], acc[ai][1][mi][0], acc[ai][1][mi][1]};
                    row_vu(mrow + 128 * ai + 16 * mi, c0, v, fq, rx[ai][mi]); }
        }
    }
    __device__ __forceinline__ void seg64(int m, int c0, f32x4 (&v)[4], int fq) const {
        const float rx = rsx[m];
        if (c0 < 640) { const float* g = c0 < 512 ? qg : kg; const int t = tpos(m), pr = t >> 6, pc = t & 63; f32x4 gg[4]; float2 cr[4], cc[4];
#pragma unroll
            for (int nt = 0; nt < 4; ++nt) gg[nt] = *(const f32x4*)(g + 16 * nt + 4 * fq);
#pragma unroll
            for (int j = 0; j < 4; ++j) { cr[j] = rope[pr * 16 + 4 * fq + j]; cc[j] = rope[pc * 16 + 4 * fq + j]; }
            row_qk(m, c0, v, fq, rx, gg, cr, cc);
        } else row_vu(m, c0, v, fq, rx);
    }
};
struct EpiBf {
    bf16* O; int ld;
    __device__ __forceinline__ void seg64(int m, int c0, f32x4 (&v)[4], int fq) const {
#pragma unroll
        for (int nt = 0; nt < 4; ++nt) st_bf16x4(O + (size_t)m * ld + c0 + 16 * nt + 4 * fq, v[nt]);
    }
};
struct EpiRes {
    const float* base0; const float* base1; float* out; bf16* HB; float* SS;
    __device__ __forceinline__ void seg64(int m, int c0, f32x4 (&v)[4], int fq) const {
        const float* b = (m < MP ? base0 + (size_t)m * DM : base1 + (size_t)(m - MP) * DM) + c0 + 4 * fq;
        float* o = out + (size_t)m * DM + c0 + 4 * fq; bf16* hb = HB + (size_t)m * DM + c0 + 4 * fq; float ss = 0.f;
#pragma unroll
        for (int nt = 0; nt < 4; ++nt) { const f32x4 h = *(const f32x4*)(b + 16 * nt) + v[nt]; *(f32x4*)(o + 16 * nt) = h; st_bf16x4(hb + 16 * nt, h);
            ss += (h[0] * h[0] + h[1] * h[1]) + (h[2] * h[2] + h[3] * h[3]); }
        ss = quad_sum(ss);
        if (fq == 0) SS[(size_t)m * 16 + (c0 >> 6)] = ss;
    }
};
constexpr int RSTD_OFF = 131072 + 1024;
struct EpiUp {
    bf16* HM; const LAS float* rs; int row0;
    __device__ __forceinline__ void seg64(int m, int c0, f32x4 (&v)[4], int fq) const {
        const float rstd = rs[m - row0];
        bf16* d = HM + (size_t)(m - row0) * DFF + c0 + 4 * fq;
#pragma unroll
        for (int nt = 0; nt < 4; ++nt) { f32x4 a = v[nt] * rstd;
#pragma unroll
            for (int j = 0; j < 4; ++j) { const float r = fmaxf(a[j], 0.f); a[j] = r * r; }
            st_bf16x4(d + 16 * nt, a); }
    }
};
__device__ __forceinline__ void rstd_table(const Frame& F, const float* SS, int row0) {
    __syncthreads();
    if (F.tid < 256) ((LAS float*)(F.lds + RSTD_OFF))[F.tid] = rstd_from_ss(SS + (size_t)(row0 + F.tid) * 16);
    __syncthreads();
}
struct EpiGate {
    const float* out; float* dst; const bf16* PP; const float* SS;
    __device__ __forceinline__ void seg64(int m, int c0, f32x4 (&v)[4], int fq) const {
        const float rstd = rstd_from_ss(SS + (size_t)m * 16);
        const float* o = out + (size_t)m * DM + c0 + 4 * fq; float* d = dst + (size_t)m * DM + c0 + 4 * fq; const bf16* pp = PP + (size_t)m * DM + c0 + 4 * fq;
#pragma unroll
        for (int nt = 0; nt < 4; ++nt) { const u32x2 w = *(const u32x2*)(pp + 16 * nt); f32x4 h = *(const f32x4*)(o + 16 * nt);
            const float p0 = bflo(w.x), p1 = bfhi(w.x), p2 = bflo(w.y), p3 = bfhi(w.y);
            h[0] += p0 / (1.0f + __expf(-v[nt][0] * rstd)); h[1] += p1 / (1.0f + __expf(-v[nt][1] * rstd));
            h[2] += p2 / (1.0f + __expf(-v[nt][2] * rstd)); h[3] += p3 / (1.0f + __expf(-v[nt][3] * rstd));
            *(f32x4*)(d + 16 * nt) = h; }
    }
};

namespace attn_body {
using bf16=__hip_bfloat16;
using bf16x8=__attribute__((ext_vector_type(8)))short;
using s16x4=__attribute__((ext_vector_type(4)))short;
using f32x16=__attribute__((ext_vector_type(16)))float;
using u32x4=__attribute__((ext_vector_type(4)))unsigned;
constexpr int D=64,QP=512,KP=128,OP=1024;
constexpr int NW=8,QBLK=32,QB=QBLK*NW,KVBLK=64;
constexpr int ATTN_UNIT_ROWS=QB;
__device__ __forceinline__ int crow(int r,int hi){return (r&3)+8*(r>>2)+4*hi;}
#define SBAR() __builtin_amdgcn_sched_barrier(0)

constexpr int NSLOT=3, SLOTB=8192;
constexpr int LDS_K=0, LDS_V=NSLOT*SLOTB, LDS_WS=2*NSLOT*SLOTB, LDS_OST=LDS_WS+NW*64*4, LDS_BYTES=LDS_OST+NW*4096;
constexpr float C2=0.125f*1.4426950408889634f;
__device__ __forceinline__ void glds16(const void*gsrc,unsigned lds_dst){unsigned keep;
  asm volatile("s_mov_b32 %0, m0\n\ts_mov_b32 m0, %2\n\ts_nop 0\n\tglobal_load_lds_dwordx4 %1, off\n\ts_mov_b32 m0, %0":"=&s"(keep):"v"(gsrc),"s"(lds_dst):"memory");}
__device__ __forceinline__ float max3f(float a,float b,float c){float r;asm("v_max3_f32 %0, %1, %2, %3":"=v"(r):"v"(a),"v"(b),"v"(c));return r;}
__device__ __forceinline__ float max2f(float a,float b){float r;asm("v_max_f32_e32 %0, %1, %2":"=v"(r):"v"(a),"v"(b));return r;}
__device__ __forceinline__ float fadd_s(float a,float b){float r;asm("v_add_f32_e32 %0, %1, %2":"=v"(r):"v"(a),"v"(b));return r;}
__device__ __forceinline__ float fsub_s(float a,float b){float r;asm("v_sub_f32_e32 %0, %1, %2":"=v"(r):"v"(a),"v"(b));return r;}
typedef float f32x2_t __attribute__((ext_vector_type(2))); typedef __bf16 bf16x2_t __attribute__((ext_vector_type(2)));
__device__ __forceinline__ unsigned cvtpk_s(float lo,float hi){f32x2_t v={lo,hi};bf16x2_t b=__builtin_convertvector(v,bf16x2_t);return __builtin_bit_cast(unsigned,b);}
#define WAIT_BAR(N) asm volatile("s_waitcnt vmcnt(" #N ") lgkmcnt(0)\n\ts_barrier":::"memory")

__device__ __forceinline__ void qkt(f32x16&p0,f32x16&p1,const char*Kslot,const bf16x8*qr,const f32x16&negm,int r32,int hi){
  const char*kb=Kslot+hi*1024+r32*16;
  #pragma unroll
  for(int d0=0;d0<4;++d0){
    const bf16x8 b0=*reinterpret_cast<const bf16x8*>(kb+d0*2048);
    const bf16x8 b1=*reinterpret_cast<const bf16x8*>(kb+d0*2048+512);
    if(d0==0){p0=__builtin_amdgcn_mfma_f32_32x32x16_bf16(b0,qr[0],negm,0,0,0);p1=__builtin_amdgcn_mfma_f32_32x32x16_bf16(b1,qr[0],negm,0,0,0);}
    else{p0=__builtin_amdgcn_mfma_f32_32x32x16_bf16(b0,qr[d0],p0,0,0,0);p1=__builtin_amdgcn_mfma_f32_32x32x16_bf16(b1,qr[d0],p1,0,0,0);}}
}
typedef __attribute__((address_space(3))) const char* lds_cptr;
typedef short v4i16_t __attribute__((ext_vector_type(4)));
__device__ __forceinline__ void kload8(bf16x8*kf,lds_cptr kp){
  kf[0]=*(const __attribute__((address_space(3))) bf16x8*)(kp);      kf[1]=*(const __attribute__((address_space(3))) bf16x8*)(kp+512);
  kf[2]=*(const __attribute__((address_space(3))) bf16x8*)(kp+2048); kf[3]=*(const __attribute__((address_space(3))) bf16x8*)(kp+2560);
  kf[4]=*(const __attribute__((address_space(3))) bf16x8*)(kp+4096); kf[5]=*(const __attribute__((address_space(3))) bf16x8*)(kp+4608);
  kf[6]=*(const __attribute__((address_space(3))) bf16x8*)(kp+6144); kf[7]=*(const __attribute__((address_space(3))) bf16x8*)(kp+6656);
}
__device__ __forceinline__ void kload2(bf16x8*kf,lds_cptr kp,int j){ kf[2*j]=*(const __attribute__((address_space(3))) bf16x8*)(kp+j*2048); kf[2*j+1]=*(const __attribute__((address_space(3))) bf16x8*)(kp+j*2048+512); }
__device__ __forceinline__ s16x4 vtr(lds_cptr p){ return __builtin_bit_cast(s16x4,__builtin_amdgcn_ds_read_tr16_b64_v4i16((__attribute__((address_space(3))) v4i16_t*)p)); }
__device__ __forceinline__ float rowmax(const f32x16&p0,const f32x16&p1){
  float a=max3f(p0[0],p0[1],p1[0]),b=max3f(p0[2],p0[3],p1[1]);a=max3f(a,p1[2],p1[3]);
  #pragma unroll
  for(int r=4;r<16;r+=4){a=max3f(a,p0[r],p0[r+1]);b=max3f(b,p0[r+2],p0[r+3]);a=max3f(a,p1[r],p1[r+1]);b=max3f(b,p1[r+2],p1[r+3]);}
  const float m=max2f(a,b);
  auto rr=__builtin_amdgcn_permlane32_swap(__float_as_uint(m),__float_as_uint(m),false,false);
  return max2f(__uint_as_float(rr[0]),__uint_as_float(rr[1]));
}
__device__ __forceinline__ void pv(f32x16*o,int vb,bf16x8 pa0,bf16x8 pa1,bf16x8 pa2,bf16x8 pa3){
  #pragma unroll
  for(int d0=0;d0<2;++d0){s16x4 lo[4],hi[4];
    #pragma unroll
    for(int ks=0;ks<4;++ks){
      asm volatile("ds_read_b64_tr_b16 %0,%1 offset:%c2":"=&v"(lo[ks]):"v"(vb),"i"(d0*4096+ks*1024):"memory");
      asm volatile("ds_read_b64_tr_b16 %0,%1 offset:%c2":"=&v"(hi[ks]):"v"(vb),"i"(d0*4096+ks*1024+512):"memory");}
    asm volatile("s_waitcnt lgkmcnt(0)":::"memory");SBAR();
    #define PK(k) (bf16x8){lo[k][0],lo[k][1],lo[k][2],lo[k][3],hi[k][0],hi[k][1],hi[k][2],hi[k][3]}
    o[d0]=__builtin_amdgcn_mfma_f32_32x32x16_bf16(pa0,PK(0),o[d0],0,0,0);
    o[d0]=__builtin_amdgcn_mfma_f32_32x32x16_bf16(pa1,PK(1),o[d0],0,0,0);
    o[d0]=__builtin_amdgcn_mfma_f32_32x32x16_bf16(pa2,PK(2),o[d0],0,0,0);
    o[d0]=__builtin_amdgcn_mfma_f32_32x32x16_bf16(pa3,PK(3),o[d0],0,0,0);
    #undef PK
  }
}

#ifndef ATTN_STORE16
#define ATTN_STORE16(p,v) (*(u32x4*)(p)=(v))
#endif
template<int THRL> __device__ __forceinline__ void attn_unit(int rowbase_,int T_,int h,int qb,const bf16*Q,const bf16*__restrict__ K,const bf16*__restrict__ V,bf16*O,char*shm){
  const int tid=threadIdx.x,lane=tid&63,r32=lane&31,hi=lane>>5; const int wid=__builtin_amdgcn_readfirstlane(tid>>6);
  const long rowbase=(long)rowbase_; const int q0=qb*QB; const int kvh=h>>2;
  const bf16*Qw=Q+(rowbase+q0+wid*QBLK)*QP+h*D;
  const bf16*Kh=K+rowbase*KP+(long)kvh*T_*D,*Vh=V+rowbase*KP+(long)kvh*T_*D;
  const unsigned lds0=(unsigned)(uintptr_t)shm;
  float*wsf=(float*)(shm+LDS_WS)+wid*64;
  const bf16*ksrc=Kh+wid*512+lane*8;
  const bf16*vsrc=Vh+wid*512+lane*8;
  const unsigned kdst=lds0+LDS_K+wid*1024, vdst=lds0+LDS_V+wid*1024;
  #define DMA_K(t,slot) glds16(ksrc+(long)(t)*4096,(unsigned)__builtin_amdgcn_readfirstlane(kdst+(slot)))
  #define DMA_V(t,slot) glds16(vsrc+(long)(t)*4096,(unsigned)__builtin_amdgcn_readfirstlane(vdst+(slot)))
  const int vb0=(int)(lds0+LDS_V)+((lane>>4)&1)*32+(lane&3)*8+(4*hi+((lane&15)>>2))*64;
  const char*Kbase=shm+LDS_K; bf16x8 kf[8];
  const lds_cptr shm3=(lds_cptr)shm; const lds_cptr kp0=shm3+LDS_K+hi*1024+r32*16; const lds_cptr vp0=shm3+LDS_V+((lane>>4)&1)*32+(lane&3)*8+(4*hi+((lane&15)>>2))*64;
  const int NT=T_/KVBLK;
  DMA_K(0,0);DMA_V(0,0);DMA_K(1,SLOTB);
  bf16x8 qr[4];
  #pragma unroll
  for(int d0=0;d0<4;++d0)qr[d0]=*reinterpret_cast<const bf16x8*>(&Qw[(long)r32*QP+d0*16+hi*8]);
  float mhat=0.f,l_reg=0.f;f32x16 o[2];o[0]=f32x16{};o[1]=f32x16{};f32x16 negm=f32x16{};
#if !ATTN_NOMAX
  asm volatile("":"+v"(negm));
#endif

  const int qrel=wid*QBLK+r32;
  #define CMASK(P0,P1,t) do{}while(0)
  bool resc=false;
#if ATTN_NOMAX
  #define START(P0,P1) do{ _Pragma("unroll") for(int r=0;r<16;++r)P0[r]=__builtin_amdgcn_exp2f(P0[r]); }while(0)
#else
  #define START(P0,P1) do{ const float rm=rowmax(P0,P1); resc=false; \
    { const float dl=rm; mhat=fadd_s(mhat,dl); \
      _Pragma("unroll") for(int r=0;r<16;++r){P0[r]=fsub_s(P0[r],dl);P1[r]=fsub_s(P1[r],dl);} \
      _Pragma("unroll") for(int r=0;r<16;++r)negm[r]=-mhat; asm volatile("":"+v"(negm)); } \
    _Pragma("unroll") for(int r=0;r<16;++r)P0[r]=__builtin_amdgcn_exp2f(P0[r]); }while(0)
#endif
#if ATTN_NOMAX
  #define RESC() do{}while(0)
#else
  #define RESC() do{ if(resc){ asm volatile("s_waitcnt lgkmcnt(0)":::"memory"); \
      _Pragma("unroll") for(int d_=0;d_<2;++d_) _Pragma("unroll") for(int r=0;r<16;++r)o[d_][r]*=wsf[crow(r,hi)]; } }while(0)
#endif
  f32x16 pA0,pA1,pB0,pB1;
  int sl_prev=0,sl_cur=0,sl_next=SLOTB;
  #define ROT() do{sl_prev=sl_cur;sl_cur=sl_next;sl_next=(sl_next==(NSLOT-1)*SLOTB)?0:sl_next+SLOTB;}while(0)
  DMA_K(2,2*SLOTB);
  WAIT_BAR(3);
  qkt(pA0,pA1,Kbase,qr,negm,r32,hi);asm volatile("s_nop 15\n\ts_nop 7":"+v"(pA0),"+v"(pA1));CMASK(pA0,pA1,0);
  START(pA0,pA1);
  _Pragma("unroll") for(int r=0;r<16;++r)pA1[r]=__builtin_amdgcn_exp2f(pA1[r]);
  WAIT_BAR(0);
  DMA_K(3,0);DMA_V(1,SLOTB);
  ROT();
  kload8(kf,kp0+sl_cur);
  WAIT_BAR(2);
  s16x4 vlo[8],vhi[8]; u32x4 pw0,pw1,pw2,pw3;
  #define PKW(P,B) cvtpk_s(P[B],P[B+1])
  #define PAF(k) __builtin_bit_cast(bf16x8,pw##k)
  #define VFR(i) (bf16x8){vlo[i][0],vlo[i][1],vlo[i][2],vlo[i][3],vhi[i][0],vhi[i][1],vhi[i][2],vhi[i][3]}
  #define PIN(x) asm volatile("":"+v"(x))
  #define MX3(a,b,c) __builtin_fmaxf(__builtin_fmaxf((a),(b)),(c))
  #define GAPA(MF,A0,A1,A2,A3,W0,W1,PW) do{ MF; sacc+=A0; sacc+=A1; sacc+=A2; sacc+=A3; PIN(sacc); W0; W1; PIN(PW); SBAR(); }while(0)
  #define EX(v) __builtin_amdgcn_exp2f(v)
  #define GAPB(MF,X,B) do{ MF; X[B]=EX(X[B]); X[B+1]=EX(X[B+1]); X[B+2]=EX(X[B+2]); X[B+3]=EX(X[B+3]); PIN(X); SBAR(); }while(0)
  #define VRD(i) do{ vlo[i]=vtr(vp_+(((i)>>2)*4096+((i)&3)*1024)); vhi[i]=vtr(vp_+(((i)>>2)*4096+((i)&3)*1024+512)); }while(0)
  #define KRD(G,j) do{ if(G){ kload2(kf,kp0+sl_next,j); SBAR(); } }while(0)
#if ATTN_NOMAX
  #define MAXBLOCK(C0,C1) do{}while(0)
#else
  #define MAXBLOCK(C0,C1) \
    { float a=MX3(C0[0],C0[1],C1[0]),b=MX3(C0[2],C0[3],C1[1]); a=MX3(a,C1[2],C1[3]); \
      _Pragma("unroll") for(int r=4;r<16;r+=4){a=MX3(a,C0[r],C0[r+1]);b=MX3(b,C0[r+2],C0[r+3]);a=MX3(a,C1[r],C1[r+1]);b=MX3(b,C1[r+2],C1[r+3]);} \
      float rm=__builtin_fmaxf(a,b); { auto rr=__builtin_amdgcn_permlane32_swap(__float_as_uint(rm),__float_as_uint(rm),false,false); rm=__builtin_fmaxf(__uint_as_float(rr[0]),__uint_as_float(rr[1])); } \
      resc=false; \
      if(__builtin_expect(__any(rm>(float)THRL),0)){ const float dl=__builtin_fmaxf(rm,0.f); mhat+=dl; \
        _Pragma("unroll") for(int r=0;r<16;++r){C0[r]-=dl;C1[r]-=dl;} \
        _Pragma("unroll") for(int r=0;r<16;++r)negm[r]=-mhat; asm volatile("":"+v"(negm)); \
        const float f=__builtin_amdgcn_exp2f(-dl); l_reg*=f; if(hi==0)wsf[r32]=f; resc=true; } }
#endif
  #define STEP(C0,C1,P0,P1,t,GK,GV,GL) do{ SBAR(); \
    const lds_cptr vp_=vp0+sl_prev; \
    VRD(0); SBAR(); float sacc=(P0[0]+P0[1]); \
    GAPA(C0=__builtin_amdgcn_mfma_f32_32x32x16_bf16(kf[0],qr[0],negm,0,0,0), P0[2],P0[3],P0[4],P0[5],     pw0[0]=PKW(P0,0), pw0[1]=PKW(P0,2), pw0); \
    VRD(4); SBAR(); GAPA(C1=__builtin_amdgcn_mfma_f32_32x32x16_bf16(kf[1],qr[0],negm,0,0,0), P0[6],P0[7],P0[8],P0[9],     pw0[2]=PKW(P0,4), pw0[3]=PKW(P0,6), pw0); \
    VRD(1); SBAR(); GAPA(C0=__builtin_amdgcn_mfma_f32_32x32x16_bf16(kf[2],qr[1],C0,0,0,0),   P0[10],P0[11],P0[12],P0[13], pw1[0]=PKW(P0,8), pw1[1]=PKW(P0,10), pw1); \
    VRD(5); SBAR(); GAPA(C1=__builtin_amdgcn_mfma_f32_32x32x16_bf16(kf[3],qr[1],C1,0,0,0),   P0[14],P0[15],P1[0],P1[1],   pw1[2]=PKW(P0,12),pw1[3]=PKW(P0,14), pw1); \
    VRD(2); SBAR(); GAPA(C0=__builtin_amdgcn_mfma_f32_32x32x16_bf16(kf[4],qr[2],C0,0,0,0),   P1[2],P1[3],P1[4],P1[5],     pw2[0]=PKW(P1,0), pw2[1]=PKW(P1,2), pw2); \
    VRD(6); SBAR(); GAPA(C1=__builtin_amdgcn_mfma_f32_32x32x16_bf16(kf[5],qr[2],C1,0,0,0),   P1[6],P1[7],P1[8],P1[9],     pw2[2]=PKW(P1,4), pw2[3]=PKW(P1,6), pw2); \
    VRD(3); SBAR(); GAPA(C0=__builtin_amdgcn_mfma_f32_32x32x16_bf16(kf[6],qr[3],C0,0,0,0),   P1[10],P1[11],P1[12],P1[13], pw3[0]=PKW(P1,8), pw3[1]=PKW(P1,10), pw3); \
    VRD(7); SBAR(); GAPA(C1=__builtin_amdgcn_mfma_f32_32x32x16_bf16(kf[7],qr[3],C1,0,0,0),   P1[14],P1[15],0.f,0.f,       pw3[2]=PKW(P1,12),pw3[3]=PKW(P1,14), pw3); \
    l_reg+=sacc; \
    if(GK){DMA_K((t)+3,sl_cur);} if(GV){DMA_V((t)+1,sl_next);} \
    CMASK(C0,C1,t); \
    MAXBLOCK(C0,C1); \
    SBAR(); \
    GAPB(o[0]=__builtin_amdgcn_mfma_f32_32x32x16_bf16(PAF(0),VFR(0),o[0],0,0,0), C0,0); \
    GAPB(o[1]=__builtin_amdgcn_mfma_f32_32x32x16_bf16(PAF(0),VFR(4),o[1],0,0,0), C0,4); \
    KRD(GL,0); GAPB(o[0]=__builtin_amdgcn_mfma_f32_32x32x16_bf16(PAF(1),VFR(1),o[0],0,0,0), C0,8); \
    KRD(GL,1); GAPB(o[1]=__builtin_amdgcn_mfma_f32_32x32x16_bf16(PAF(1),VFR(5),o[1],0,0,0), C0,12); \
    KRD(GL,2); GAPB(o[0]=__builtin_amdgcn_mfma_f32_32x32x16_bf16(PAF(2),VFR(2),o[0],0,0,0), C1,0); \
    KRD(GL,3); GAPB(o[1]=__builtin_amdgcn_mfma_f32_32x32x16_bf16(PAF(2),VFR(6),o[1],0,0,0), C1,4); \
    GAPB(o[0]=__builtin_amdgcn_mfma_f32_32x32x16_bf16(PAF(3),VFR(3),o[0],0,0,0), C1,8); \
    GAPB(o[1]=__builtin_amdgcn_mfma_f32_32x32x16_bf16(PAF(3),VFR(7),o[1],0,0,0), C1,12); \
    }while(0)
  int t=1;
  #undef CMASK
  #define CMASK(P0,P1,t) do{}while(0)
  for(;t+5<NT;t+=2){
    STEP(pB0,pB1,pA0,pA1,t,true,true,true);     WAIT_BAR(2); RESC(); ROT();
    STEP(pA0,pA1,pB0,pB1,t+1,true,true,true);   WAIT_BAR(2); RESC(); ROT();
  }
  #undef CMASK
  #define CMASK(P0,P1,t) do{}while(0)
  #define ENDW(tt) do{ if((tt)+3<NT){WAIT_BAR(2);} else if((tt)+2<NT){WAIT_BAR(1);} else {WAIT_BAR(0);} }while(0)
  for(;t+1<NT;t+=2){
    STEP(pB0,pB1,pA0,pA1,t,(t+3<NT),(t+1<NT),(t+1<NT));       ENDW(t);   RESC(); ROT();
    STEP(pA0,pA1,pB0,pB1,t+1,(t+4<NT),(t+2<NT),(t+2<NT));     ENDW(t+1); RESC(); ROT();
  }
  STEP(pB0,pB1,pA0,pA1,NT-1,false,false,false); RESC();
  { float sacc=pB0[0]+pB0[1]; _Pragma("unroll") for(int r=2;r<16;++r)sacc+=pB0[r]; _Pragma("unroll") for(int r=0;r<16;++r)sacc+=pB1[r]; l_reg+=sacc;
    pw0=(u32x4){PKW(pB0,0),PKW(pB0,2),PKW(pB0,4),PKW(pB0,6)};pw1=(u32x4){PKW(pB0,8),PKW(pB0,10),PKW(pB0,12),PKW(pB0,14)};pw2=(u32x4){PKW(pB1,0),PKW(pB1,2),PKW(pB1,4),PKW(pB1,6)};pw3=(u32x4){PKW(pB1,8),PKW(pB1,10),PKW(pB1,12),PKW(pB1,14)};
    SBAR(); pv(o,vb0+sl_cur,PAF(0),PAF(1),PAF(2),PAF(3)); }
  #undef PKW
  #undef PAF
  #undef VFR
  #undef PIN
  #undef MX3
  #undef GAPA
  #undef GAPB
  #undef EX
  #undef VRD
  #undef KRD
  #undef STEP
  #undef ENDW
  {auto rr=__builtin_amdgcn_permlane32_swap(__float_as_uint(l_reg),__float_as_uint(l_reg),false,false);l_reg=__uint_as_float(rr[0])+__uint_as_float(rr[1]);}
  if(hi==0)wsf[32+r32]=l_reg;asm volatile("s_waitcnt lgkmcnt(0)":::"memory");
  float rli[16];
  #pragma unroll
  for(int r=0;r<16;++r)rli[r]=__builtin_amdgcn_rcpf(wsf[32+crow(r,hi)]);
  bf16*Ow=O+(rowbase+q0+wid*QBLK)*OP+h*D;
  { bf16*stg=(bf16*)(shm+LDS_OST)+wid*2048;
    #pragma unroll
    for(int r=0;r<16;++r){const int orow=crow(r,hi);
      #pragma unroll
      for(int d0=0;d0<2;++d0)stg[orow*64+d0*32+r32]=__float2bfloat16(o[d0][r]*rli[r]);}
    asm volatile("s_waitcnt lgkmcnt(0)":::"memory");
    #pragma unroll
    for(int i=0;i<4;++i){const int row=i*8+(lane>>3),ch=lane&7; const u32x4 v=*(const u32x4*)(stg+row*64+ch*8); ATTN_STORE16(Ow+(long)row*OP+ch*8,v);} }
  asm volatile("s_waitcnt lgkmcnt(0)\n\ts_barrier":::"memory");
  #undef DMA_K
  #undef DMA_V
  #undef CMASK
  #undef START
  #undef RESC
  #undef ROT
}

__device__ __forceinline__ void attn_unit3(int rowbase_,int T_,int h,int qb,const bf16*Q,const bf16*__restrict__ K,const bf16*__restrict__ V,bf16*O,char*shm){
  int tid_=threadIdx.x; asm volatile("":"+v"(tid_));
  const int tid=tid_,lane=tid&63,r32=lane&31,hi=lane>>5; const int wid=__builtin_amdgcn_readfirstlane(tid>>6);
  const long rowbase=(long)rowbase_; const int q0=qb*512; const int kvh=h>>2;
  const bf16*Qw=Q+(rowbase+q0+wid*64)*QP+h*D;
  const bf16*Kh=K+rowbase*KP+(long)kvh*T_*D,*Vh=V+rowbase*KP+(long)kvh*T_*D;
  const unsigned lds0=(unsigned)(uintptr_t)shm;
  const int kvoff=wid*512+lane*8;
  const unsigned kdst=lds0+LDS_K+wid*1024, vdst=lds0+LDS_V+wid*1024;
  #define DMA_K(t,slot) do{ int o_=kvoff; asm volatile("":"+v"(o_)); glds16(Kh+(long)(t)*4096+o_,(unsigned)__builtin_amdgcn_readfirstlane(kdst+(slot))); }while(0)
  #define DMA_V(t,slot) do{ int o_=kvoff; asm volatile("":"+v"(o_)); glds16(Vh+(long)(t)*4096+o_,(unsigned)__builtin_amdgcn_readfirstlane(vdst+(slot))); }while(0)
  const lds_cptr shm3=(lds_cptr)shm; const lds_cptr kp0=shm3+LDS_K+hi*1024+r32*16; const lds_cptr vp0=shm3+LDS_V+((lane>>4)&1)*32+(lane&3)*8+(4*hi+((lane&15)>>2))*64;
  const int NT=T_/KVBLK;
  DMA_K(0,0);DMA_V(0,0);DMA_K(1,SLOTB);DMA_V(1,SLOTB);DMA_K(2,2*SLOTB);
  bf16x8 qr[2][4];
  #pragma unroll
  for(int b=0;b<2;++b)
    #pragma unroll
    for(int d0=0;d0<4;++d0)qr[b][d0]=*reinterpret_cast<const bf16x8*>(&Qw[(long)(b*32+r32)*QP+d0*16+hi*8]);
  f32x16 o[2][2];o[0][0]=f32x16{};o[0][1]=f32x16{};o[1][0]=f32x16{};o[1][1]=f32x16{}; float lsum[2]={0.f,0.f};
  f32x16 C0,C1; u32x4 pa0,pa1,pa2,pa3,pb0,pb1,pb2,pb3; bf16x8 kf[8];
  #define PKW(P,B) cvtpk_s(P[B],P[B+1])
  #define MM(acc,a,b) acc=__builtin_amdgcn_mfma_f32_32x32x16_bf16(a,b,acc,0,0,0)
  #define QKP(b,w0,w1,w2,w3) do{ const f32x16 z_=f32x16{}; \
      C0=__builtin_amdgcn_mfma_f32_32x32x16_bf16(kf[0],qr[b][0],z_,0,0,0); C1=__builtin_amdgcn_mfma_f32_32x32x16_bf16(kf[1],qr[b][0],z_,0,0,0); \
      MM(C0,kf[2],qr[b][1]); MM(C1,kf[3],qr[b][1]); MM(C0,kf[4],qr[b][2]); MM(C1,kf[5],qr[b][2]); MM(C0,kf[6],qr[b][3]); MM(C1,kf[7],qr[b][3]); \
      _Pragma("unroll") for(int r=0;r<16;++r){C0[r]=__builtin_amdgcn_exp2f(C0[r]);C1[r]=__builtin_amdgcn_exp2f(C1[r]);} \
      { float sa=C0[0]+C1[0],sb=C0[1]+C1[1]; _Pragma("unroll") for(int r=2;r<16;r+=2){sa+=C0[r]+C1[r];sb+=C0[r+1]+C1[r+1];} lsum[b]+=sa+sb; } \
      w0=(u32x4){PKW(C0,0),PKW(C0,2),PKW(C0,4),PKW(C0,6)};w1=(u32x4){PKW(C0,8),PKW(C0,10),PKW(C0,12),PKW(C0,14)}; \
      w2=(u32x4){PKW(C1,0),PKW(C1,2),PKW(C1,4),PKW(C1,6)};w3=(u32x4){PKW(C1,8),PKW(C1,10),PKW(C1,12),PKW(C1,14)}; }while(0)
  #define VLD(F,i) do{ const s16x4 lo_=vtr(vp_+(((i)>>2)*4096+((i)&3)*1024)), hi_=vtr(vp_+(((i)>>2)*4096+((i)&3)*1024+512)); F=(bf16x8){lo_[0],lo_[1],lo_[2],lo_[3],hi_[0],hi_[1],hi_[2],hi_[3]}; }while(0)
  #define PVU(F,i,wa,wb) do{ MM(o[0][(i)>>2],__builtin_bit_cast(bf16x8,wa),F); MM(o[1][(i)>>2],__builtin_bit_cast(bf16x8,wb),F); }while(0)
  #define STEP3(t,GK,GV,GL) do{ SBAR(); \
      if(GK){DMA_K((t)+3,s_cur);} if(GV){DMA_V((t)+2,s_prev);} \
      const lds_cptr vp_=vp0+s_cur; bf16x8 F0,F1,F2; \
      QKP(0,pa0,pa1,pa2,pa3); \
      VLD(F0,0); VLD(F1,4); VLD(F2,1); \
      QKP(1,pb0,pb1,pb2,pb3); \
      if(GL){kload8(kf,kp0+s_next);} \
      PVU(F0,0,pa0,pb0); VLD(F0,5); PVU(F1,4,pa0,pb0); VLD(F1,2); PVU(F2,1,pa1,pb1); VLD(F2,6); PVU(F0,5,pa1,pb1); VLD(F0,3); \
      PVU(F1,2,pa2,pb2); VLD(F1,7); PVU(F2,6,pa2,pb2); PVU(F0,3,pa3,pb3); PVU(F1,7,pa3,pb3); \
      SBAR(); \
      if((GK)&&(GV)){ asm volatile("s_waitcnt vmcnt(2) lgkmcnt(0)\n\ts_barrier":::"memory"); } \
      else if((GK)||(GV)){ asm volatile("s_waitcnt vmcnt(1) lgkmcnt(0)\n\ts_barrier":::"memory"); } \
      else { asm volatile("s_waitcnt vmcnt(0) lgkmcnt(0)\n\ts_barrier":::"memory"); } \
      SBAR(); { const int n_=s_prev; s_prev=s_cur; s_cur=s_next; s_next=n_; } }while(0)
  asm volatile("s_waitcnt vmcnt(0) lgkmcnt(0)\n\ts_barrier":::"memory"); SBAR();
  kload8(kf,kp0);
  asm volatile("s_waitcnt lgkmcnt(0)":::"memory"); SBAR();
  int s_prev=2*SLOTB,s_cur=0,s_next=SLOTB;
  _Pragma("unroll 1") for(int t=0;t+3<NT;++t){ STEP3(t,true,true,true); }
  STEP3(NT-3,false,true,true); STEP3(NT-2,false,false,true); STEP3(NT-1,false,false,false);
  #undef PKW
  #undef MM
  #undef QKP
  #undef VLD
  #undef PVU
  #undef STEP3
  int te_=threadIdx.x; asm volatile("":"+v"(te_));
  const int lane_e=te_&63,r32_e=lane_e&31,hi_e=lane_e>>5; const int wid_e=__builtin_amdgcn_readfirstlane(te_>>6);
  float*wsf=(float*)(shm+LDS_WS)+wid_e*64;
  #pragma unroll
  for(int b=0;b<2;++b){
    float l=lsum[b]; {auto rr=__builtin_amdgcn_permlane32_swap(__float_as_uint(l),__float_as_uint(l),false,false);l=__uint_as_float(rr[0])+__uint_as_float(rr[1]);}
    if(hi_e==0)wsf[32*b+r32_e]=l; asm volatile("s_waitcnt lgkmcnt(0)":::"memory");
    float rli[16];
    #pragma unroll
    for(int r=0;r<16;++r)rli[r]=__builtin_amdgcn_rcpf(wsf[32*b+crow(r,hi_e)]);
    bf16*Ow=O+((long)rowbase_+qb*512+wid_e*64+b*32)*OP+h*D;
    bf16*stg=(bf16*)(shm+LDS_OST)+wid_e*2048;
    #pragma unroll
    for(int r=0;r<16;++r){const int orow=crow(r,hi_e);
      #pragma unroll
      for(int d0=0;d0<2;++d0)stg[orow*64+d0*32+r32_e]=__float2bfloat16(o[b][d0][r]*rli[r]);}
    asm volatile("s_waitcnt lgkmcnt(0)":::"memory");
    #pragma unroll
    for(int i=0;i<4;++i){const int row=i*8+(lane_e>>3),ch=lane_e&7; const u32x4 v=*(const u32x4*)(stg+row*64+ch*8); ATTN_STORE16(Ow+(long)row*OP+ch*8,v);}
    asm volatile("s_waitcnt lgkmcnt(0)":::"memory");
  }
  asm volatile("s_waitcnt lgkmcnt(0)\n\ts_barrier":::"memory");
  #undef DMA_K
  #undef DMA_V
}

constexpr int U4_K=0, U4_V=4*SLOTB, U4_WS=7*SLOTB, U4_OST=U4_WS+NW*64*4, U4_BYTES=U4_OST+NW*4096;
template<int VAR=0> __device__ __forceinline__ void attn_unit4(int rowbase_,int T_,int h,int qb,const bf16*Q,const bf16*__restrict__ K,const bf16*__restrict__ V,bf16*O,char*shm){
  if(VAR==7)return;
  if(VAR==11){ float x_=(float)(threadIdx.x&63)*1e-3f; const unsigned long long e_=__builtin_amdgcn_s_memrealtime()+5000ull;
    while(__builtin_amdgcn_s_memrealtime()<e_){ _Pragma("unroll") for(int i=0;i<64;++i) x_=__builtin_amdgcn_exp2f(x_)*0.25f+x_*0.5f; } asm volatile(""::"v"(x_)); return; }
  if(VAR==8){ const unsigned long long e_=__builtin_amdgcn_s_memrealtime()+5000ull; while(__builtin_amdgcn_s_memrealtime()<e_)__builtin_amdgcn_s_sleep(8); return; }
  int tid_=threadIdx.x; asm volatile("":"+v"(tid_));
  const int tid=tid_,lane=tid&63,r32=lane&31,hi=lane>>5; const int wid=__builtin_amdgcn_readfirstlane(tid>>6);
  const long rowbase=(long)rowbase_; const int q0=qb*512; const int kvh=h>>2;
  const bf16*Qw=Q+(rowbase+q0+wid*64)*QP+h*D;
  const bf16*Kh=K+rowbase*KP+(long)kvh*T_*D,*Vh=V+rowbase*KP+(long)kvh*T_*D;
  const unsigned lds0=(unsigned)(uintptr_t)shm;
  const int kvoff=wid*512+lane*8;
  const unsigned kdst=lds0+U4_K+wid*1024, vdst=lds0+U4_V+wid*1024;
  #define DMA_K(t,slot) do{ if(VAR==4||VAR==9)break; int o_=kvoff; asm volatile("":"+v"(o_)); glds16(Kh+(long)(t)*4096+o_,(unsigned)__builtin_amdgcn_readfirstlane(kdst+(slot))); }while(0)
  #define DMA_V(t,slot) do{ if(VAR==4||VAR==9)break; int o_=kvoff; asm volatile("":"+v"(o_)); glds16(Vh+(long)(t)*4096+o_,(unsigned)__builtin_amdgcn_readfirstlane(vdst+(slot))); }while(0)
  const lds_cptr shm3=(lds_cptr)shm; const lds_cptr kp0=shm3+U4_K+hi*1024+r32*16; const lds_cptr vp0=shm3+U4_V+((lane>>4)&1)*32+(lane&3)*8+(4*hi+((lane&15)>>2))*64;
  const int NT=T_/KVBLK;
  DMA_K(0,0);DMA_V(0,0);DMA_K(1,SLOTB);DMA_K(2,2*SLOTB);DMA_V(1,SLOTB);DMA_K(3,3*SLOTB);
  bf16x8 qr[2][4];
  #pragma unroll
  for(int b=0;b<2;++b)
    #pragma unroll
    for(int d0=0;d0<4;++d0)qr[b][d0]=*reinterpret_cast<const bf16x8*>(&Qw[(long)(b*32+r32)*QP+d0*16+hi*8]);
  f32x16 o[2][2];o[0][0]=f32x16{};o[0][1]=f32x16{};o[1][0]=f32x16{};o[1][1]=f32x16{}; float la0=0.f,la1=0.f,lb0=0.f,lb1=0.f;
  f32x16 S00,S10,S01,S11; u32x4 pa0,pa1,pa2,pa3,pb0,pb1,pb2,pb3; bf16x8 kf[4];
  #define PIN(x) asm volatile("":"+v"(x))
  #define MM(acc,a,b) do{ if(VAR!=2&&VAR!=9&&VAR!=10){acc=__builtin_amdgcn_mfma_f32_32x32x16_bf16(a,b,acc,0,0,0);} PIN(acc); }while(0)
  #define KLD(kp,j) do{ if(VAR==3&&INLOOP)break; _Pragma("unroll") for(int d_=0;d_<4;++d_) kf[d_]=*(const __attribute__((address_space(3))) bf16x8*)((kp)+d_*2048+(j)*512); }while(0)
  #define VLD(F,i) do{ if(VAR==3){PIN(F);break;} const s16x4 lo_=vtr(vp_+(((i)>>2)*4096+((i)&3)*1024)), hi_=vtr(vp_+(((i)>>2)*4096+((i)&3)*1024+512)); F=(bf16x8){lo_[0],lo_[1],lo_[2],lo_[3],hi_[0],hi_[1],hi_[2],hi_[3]}; }while(0)
  #define SMB(C,r,sa,sb,W,wi) do{ if(VAR==1||VAR==10){W[wi]=__float_as_uint(C[r]);break;} const float ea_=__builtin_amdgcn_exp2f(C[r]),eb_=__builtin_amdgcn_exp2f(C[(r)+1]); sa=fadd_s(sa,ea_); sb=fadd_s(sb,eb_); W[wi]=cvtpk_s(ea_,eb_); }while(0)
  #define GQK(C,b,CS,r0,sa,sb,W,DQ,DS) do{ \
      if(DQ){ const f32x16 z_=f32x16{}; if((VAR!=2&&VAR!=9&&VAR!=10)||!INLOOP){C=__builtin_amdgcn_mfma_f32_32x32x16_bf16(kf[0],qr[b][0],z_,0,0,0);} PIN(C); } if(DS){ SMB(CS,(r0)+0,sa,sb,W,0); } SBAR(); \
      if(DQ){ MM(C,kf[1],qr[b][1]); } if(DS){ SMB(CS,(r0)+2,sa,sb,W,1); } SBAR(); \
      if(DQ){ MM(C,kf[2],qr[b][2]); } if(DS){ SMB(CS,(r0)+4,sa,sb,W,2); } SBAR(); \
      if(DQ){ MM(C,kf[3],qr[b][3]); } if(DS){ SMB(CS,(r0)+6,sa,sb,W,3); } SBAR(); }while(0)
  #define GPV(G0,G1,dh,wa0,wb0,wa1,wb1,CS,r0,sa,sb,W,DS) do{ \
      MM(o[0][dh],__builtin_bit_cast(bf16x8,wa0),G0); if(DS){ SMB(CS,(r0)+0,sa,sb,W,0); } SBAR(); \
      MM(o[1][dh],__builtin_bit_cast(bf16x8,wb0),G0); if(DS){ SMB(CS,(r0)+2,sa,sb,W,1); } SBAR(); \
      MM(o[0][dh],__builtin_bit_cast(bf16x8,wa1),G1); if(DS){ SMB(CS,(r0)+4,sa,sb,W,2); } SBAR(); \
      MM(o[1][dh],__builtin_bit_cast(bf16x8,wb1),G1); if(DS){ SMB(CS,(r0)+6,sa,sb,W,3); } SBAR(); }while(0)
  #define STEP4(t,GK,GV,GQ,GL) do{ SBAR(); \
      if(GK){DMA_K((t)+4,((t)&3)*SLOTB);} if(GV){DMA_V((t)+2,s_prev);} \
      const lds_cptr vp_=vp0+s_cur; const lds_cptr kq_=kp0+((((t)+1)&3)*SLOTB), kn_=kp0+((((t)+2)&3)*SLOTB); bf16x8 Fa0=qr[0][0],Fa1=qr[0][1],Fb0=qr[0][2],Fb1=qr[0][3]; \
      VLD(Fa0,0); VLD(Fa1,1); \
      GQK(S00,0,S01,0,la0,la1,pa2,GQ,true); \
      VLD(Fb0,4); VLD(Fb1,5); \
      GQK(S10,1,S01,8,la0,la1,pa3,GQ,true); \
      if(GQ){KLD(kq_,1);} \
      GPV(Fa0,Fa1,0,pa0,pb0,pa1,pb1,S11,0,lb0,lb1,pb2,true); \
      VLD(Fa0,2); VLD(Fa1,3); \
      GPV(Fb0,Fb1,1,pa0,pb0,pa1,pb1,S11,8,lb0,lb1,pb3,true); \
      VLD(Fb0,6); VLD(Fb1,7); \
      if(GQ){ GQK(S01,0,S00,0,la0,la1,pa0,true,true); GQK(S11,1,S00,8,la0,la1,pa1,true,true); } \
      if(GL){KLD(kn_,0);} \
      GPV(Fa0,Fa1,0,pa2,pb2,pa3,pb3,S10,0,lb0,lb1,pb0,GQ); \
      GPV(Fb0,Fb1,1,pa2,pb2,pa3,pb3,S10,8,lb0,lb1,pb1,GQ); \
      if((GK)&&(GV)){ if(VAR==5){asm volatile("s_waitcnt vmcnt(2) lgkmcnt(0)":::"memory");}else{asm volatile("s_waitcnt vmcnt(2) lgkmcnt(0)\n\ts_barrier":::"memory");} } \
      else if((GK)||(GV)){ if(VAR==5){asm volatile("s_waitcnt vmcnt(1) lgkmcnt(0)":::"memory");}else{asm volatile("s_waitcnt vmcnt(1) lgkmcnt(0)\n\ts_barrier":::"memory");} } \
      else { if(VAR==5){asm volatile("s_waitcnt vmcnt(0) lgkmcnt(0)":::"memory");}else{asm volatile("s_waitcnt vmcnt(0) lgkmcnt(0)\n\ts_barrier":::"memory");} } \
      SBAR(); { const int n_=s_prev; s_prev=s_cur; s_cur=s_next; s_next=n_; } }while(0)
  asm volatile("s_waitcnt vmcnt(0) lgkmcnt(0)\n\ts_barrier":::"memory"); SBAR();
  #pragma unroll
  for(int b=0;b<2;++b)
    #pragma unroll
    for(int d0=0;d0<4;++d0) asm volatile("":"+v"(qr[b][d0]));
  #define INLOOP 0
  KLD(kp0,0); GQK(S00,0,S00,0,la0,la1,pa0,true,false); GQK(S10,1,S00,0,la0,la1,pa0,true,false);
  KLD(kp0,1); GQK(S01,0,S00,0,la0,la1,pa0,true,false); GQK(S11,1,S00,0,la0,la1,pa0,true,false);
  KLD(kp0+SLOTB,0);
  GQK(S00,0,S00,0,la0,la1,pa0,false,true); GQK(S00,0,S00,8,la0,la1,pa1,false,true); GQK(S00,0,S10,0,lb0,lb1,pb0,false,true); GQK(S00,0,S10,8,lb0,lb1,pb1,false,true);
  asm volatile("s_waitcnt lgkmcnt(0)\n\ts_barrier":::"memory"); SBAR();
  #undef INLOOP
  #define INLOOP 1
  int s_prev=2*SLOTB,s_cur=0,s_next=SLOTB;
  if(ATTN_PRIO&&wid>=4) __builtin_amdgcn_s_setprio(1);
  _Pragma("unroll 1") for(int t=0;t+4<NT;++t){ STEP4(t,true,true,true,true); }
  STEP4(NT-4,false,true,true,true); STEP4(NT-3,false,true,true,true); STEP4(NT-2,false,false,true,false); STEP4(NT-1,false,false,false,false);
  if(ATTN_PRIO) __builtin_amdgcn_s_setprio(0);
  #undef INLOOP
  #undef MM
  #undef PIN
  #undef KLD
  #undef VLD
  #undef SMB
  #undef GQK
  #undef GPV
  #undef STEP4
  int te_=threadIdx.x; asm volatile("":"+v"(te_));
  const int lane_e=te_&63,r32_e=lane_e&31,hi_e=lane_e>>5; const int wid_e=__builtin_amdgcn_readfirstlane(te_>>6);
  float*wsf=(float*)(shm+U4_WS)+wid_e*64;
  #pragma unroll
  for(int b=0;b<2;++b){
    float l=b?lb0+lb1:la0+la1; {auto rr=__builtin_amdgcn_permlane32_swap(__float_as_uint(l),__float_as_uint(l),false,false);l=__uint_as_float(rr[0])+__uint_as_float(rr[1]);}
    if(hi_e==0)wsf[32*b+r32_e]=l; asm volatile("s_waitcnt lgkmcnt(0)":::"memory");
    float rli[16];
    #pragma unroll
    for(int r=0;r<16;++r)rli[r]=__builtin_amdgcn_rcpf(wsf[32*b+crow(r,hi_e)]);
    bf16*Ow=O+((long)rowbase_+qb*512+wid_e*64+b*32)*OP+h*D;
    bf16*stg=(bf16*)(shm+U4_OST)+wid_e*2048;
    #pragma unroll
    for(int r=0;r<16;++r){const int orow=crow(r,hi_e);
      #pragma unroll
      for(int d0=0;d0<2;++d0)stg[orow*64+d0*32+r32_e]=__float2bfloat16(o[b][d0][r]*rli[r]);}
    asm volatile("s_waitcnt lgkmcnt(0)":::"memory");
    #pragma unroll
    for(int i=0;i<4;++i){const int row=i*8+(lane_e>>3),ch=lane_e&7; const u32x4 v=*(const u32x4*)(stg+row*64+ch*8); if(VAR==0)ATTN_STORE16(Ow+(long)row*OP+ch*8,v);}
    asm volatile("s_waitcnt lgkmcnt(0)":::"memory");
  }
  asm volatile("s_waitcnt lgkmcnt(0)\n\ts_barrier":::"memory");
  #undef DMA_K
  #undef DMA_V
}
constexpr int ATTN_LDS_BYTES=(LDS_BYTES>U4_BYTES?LDS_BYTES:U4_BYTES);
struct AttnTensors { const bf16* Q; const bf16* K; const bf16* V; bf16* O; };
#if ATTN_U4
#define ATTN_UNIT attn_unit4<VAR>
#else
#define ATTN_UNIT attn_unit3
#endif
template<int VAR=0> __device__ __forceinline__ void attn_phase3(char*lds,const AttnTensors&T,int vcu,int G){
  if(G==256){
    const int x=vcu>>5,j=vcu&31;
    for(int i=0;i<2;++i){ const int w=j*2+i,g=w>>4,qb=w&15; ATTN_UNIT(16384+(x>>1)*8192,8192,(x&1)*4+g,qb,T.Q,T.K,T.V,T.O,lds); }
    { const int w=j,g=w>>3,qb=w&7; ATTN_UNIT((x>>1)*4096,4096,(x&1)*4+g,qb,T.Q,T.K,T.V,T.O,lds); }
  }
}
template<int THRL=8> __device__ __forceinline__ void attn_phase(char*lds,const AttnTensors&T,int vcu,int G){
  if(G==256){
    const int x=vcu>>5,j=vcu&31;
    for(int i=0;i<4;++i){ const int w=j*4+i,g=w>>5,qb=w&31; attn_unit<THRL>(16384+(x>>1)*8192,8192,(x&1)*4+g,qb,T.Q,T.K,T.V,T.O,lds); }
    for(int i=0;i<2;++i){ const int w=j*2+i,g=w>>4,qb=w&15; attn_unit<THRL>((x>>1)*4096,4096,(x&1)*4+g,qb,T.Q,T.K,T.V,T.O,lds); }
  } else {
    for(int u=vcu;u<1536;u+=G){
      if(u<1024){ const int qb=u&31,h=(u>>5)&7,s=u>>8; attn_unit<THRL>(16384+s*8192,8192,h,qb,T.Q,T.K,T.V,T.O,lds); }
      else { const int v=u-1024,qb=v&15,h=(v>>4)&7,s=v>>7; attn_unit<THRL>(s*4096,4096,h,qb,T.Q,T.K,T.V,T.O,lds); }
    }
  }
}
#undef SBAR
#undef WAIT_BAR
}

__device__ __forceinline__ void sattn_unit(const Frame& F, int seq, int h, int qb) {
    const int T = seq < 4 ? TP : TS; const int rowbase = seq < 4 ? seq * TP : MP + (seq - 4) * TS;
    const bf16* Q = (const bf16*)(F.ws + WS_Q); const bf16* Kb = (const bf16*)(F.ws + WS_K); const bf16* Vb = (const bf16*)(F.ws + WS_V); bf16* MIX = (bf16*)(F.ws + WS_MIX);
    const int kvh = h >> 2, m = rowbase + qb * 512 + F.tid;
    LAS float* Ks = (LAS float*)F.lds; LAS float* Vs = Ks + 64 * 64;
    float q[64], o[64];
    { const u32x4* qp = (const u32x4*)(Q + (size_t)m * 512 + h * 64);
#pragma unroll
      for (int i = 0; i < 8; ++i) { const u32x4 w = qp[i]; q[8 * i] = bflo(w.x); q[8 * i + 1] = bfhi(w.x); q[8 * i + 2] = bflo(w.y); q[8 * i + 3] = bfhi(w.y); q[8 * i + 4] = bflo(w.z); q[8 * i + 5] = bfhi(w.z); q[8 * i + 6] = bflo(w.w); q[8 * i + 7] = bfhi(w.w); } }
#pragma unroll
    for (int d = 0; d < 64; ++d) o[d] = 0.f;
    float mx = -1e30f, l = 0.f;
    const int lr = F.tid >> 3, lc = (F.tid & 7) * 8;
    for (int kt = 0; kt < T / 64; ++kt) {
        __syncthreads();
        { const size_t grow = (size_t)(rowbase + kt * 64 + lr) * 128 + kvh * 64 + lc;
          const u32x4 kw = *(const u32x4*)(Kb + grow), vw = *(const u32x4*)(Vb + grow);
          LAS f32x4* kd = (LAS f32x4*)(Ks + lr * 64 + lc); LAS f32x4* vd = (LAS f32x4*)(Vs + lr * 64 + lc);
          kd[0] = (f32x4){bflo(kw.x), bfhi(kw.x), bflo(kw.y), bfhi(kw.y)}; kd[1] = (f32x4){bflo(kw.z), bfhi(kw.z), bflo(kw.w), bfhi(kw.w)};
          vd[0] = (f32x4){bflo(vw.x), bfhi(vw.x), bflo(vw.y), bfhi(vw.y)}; vd[1] = (f32x4){bflo(vw.z), bfhi(vw.z), bflo(vw.w), bfhi(vw.w)}; }
        __syncthreads();
#pragma unroll 1
        for (int j = 0; j < 64; ++j) {
            const LAS f32x4* Kc = (const LAS f32x4*)(Ks + j * 64); const LAS f32x4* Vc = (const LAS f32x4*)(Vs + j * 64);
            float a = 0.f;
#pragma unroll
            for (int d4 = 0; d4 < 16; ++d4) { const f32x4 kv = Kc[d4]; a += q[4 * d4] * kv.x + q[4 * d4 + 1] * kv.y + q[4 * d4 + 2] * kv.z + q[4 * d4 + 3] * kv.w; }
            const float mn = fmaxf(mx, a), alpha = exp2f(mx - mn), p = exp2f(a - mn); mx = mn; l = l * alpha + p;
#pragma unroll
            for (int d4 = 0; d4 < 16; ++d4) { const f32x4 vv = Vc[d4]; o[4 * d4] = o[4 * d4] * alpha + p * vv.x; o[4 * d4 + 1] = o[4 * d4 + 1] * alpha + p * vv.y; o[4 * d4 + 2] = o[4 * d4 + 2] * alpha + p * vv.z; o[4 * d4 + 3] = o[4 * d4 + 3] * alpha + p * vv.w; }
        }
    }
    const float il = 1.0f / l;
    u32x4* op = (u32x4*)(MIX + (size_t)m * DM + h * 64);
#pragma unroll
    for (int i = 0; i < 8; ++i) { u32x4 w; w.x = pk2(o[8 * i] * il, o[8 * i + 1] * il); w.y = pk2(o[8 * i + 2] * il, o[8 * i + 3] * il); w.z = pk2(o[8 * i + 4] * il, o[8 * i + 5] * il); w.w = pk2(o[8 * i + 6] * il, o[8 * i + 7] * il); op[i] = w; }
}
__device__ __forceinline__ void sattn_phase(const Frame& F) {
    for (int u = F.vcu; u < 768; u += F.G) {
        if (u < 512) { const int qb = u & 15, h = (u >> 4) & 7, s = u >> 7; sattn_unit(F, 4 + s, h, qb); }
        else { const int v = u - 512, qb = v & 7, h = (v >> 3) & 7, s = v >> 6; sattn_unit(F, s, h, qb); }
    }
}
__device__ __forceinline__ void pool_run(const Frame& F, int ufirst, int ustride, int ucount) {
    const bf16* U = (const bf16*)(F.ws + WS_U); bf16* MIX = (bf16*)(F.ws + WS_MIX);
    constexpr int PR = 32, TR = PR + 16, BUFB = TR * 1024, NU = M / PR;
    const unsigned ldsb = (unsigned)(uintptr_t)F.lds;
    const int g = F.wave & 3, half = 1 << g, ch = 16 * g + (F.lane & 15), rbase = 16 * (F.wave >> 2) + 4 * (F.lane >> 4);
#define POOL_LOAD(u_, buf_) do { const int r0_ = (u_) * PR; _Pragma("unroll") for (int i_ = 0; i_ < TR / 8; ++i_) { const int rr_ = F.wave + 8 * i_; int gr_ = r0_ - 8 + rr_; gr_ = gr_ < 0 ? 0 : (gr_ > M - 1 ? M - 1 : gr_); \
        attn_body::glds16(U + (size_t)gr_ * 512 + F.lane * 8, (unsigned)__builtin_amdgcn_readfirstlane(ldsb + (buf_) * BUFB + rr_ * 1024)); } } while (0)
    __syncthreads();
    int u = ufirst, b = 0; const int uend = ufirst + ustride * ucount;
    if (u < uend) POOL_LOAD(u, 0);
    for (; u < uend; u += ustride, b ^= 1) {
        const bool more = (u + ustride < uend);
        if (more) { POOL_LOAD(u + ustride, b ^ 1); asm volatile("s_waitcnt vmcnt(6)\n\ts_barrier" ::: "memory"); }
        else { asm volatile("s_waitcnt vmcnt(0)\n\ts_barrier" ::: "memory"); }
        const LAS u32x4* T = (const LAS u32x4*)(F.lds + b * BUFB);
        const int r0 = u * PR, Tlen = r0 < MP ? TP : TS, t0 = tpos(r0);
        {
            int t = t0 + rbase; float a[8];
#pragma unroll
            for (int k = 0; k < 8; ++k) a[k] = 0.f;
#define POOL_ACC(pos_, sg_) do { const u32x4 w_ = T[((pos_) - t0 + 8) * 64 + ch]; \
                a[0] += sg_ bflo(w_.x); a[1] += sg_ bfhi(w_.x); a[2] += sg_ bflo(w_.y); a[3] += sg_ bfhi(w_.y); a[4] += sg_ bflo(w_.z); a[5] += sg_ bfhi(w_.z); a[6] += sg_ bflo(w_.w); a[7] += sg_ bfhi(w_.w); } while (0)
            { const int lo = max(t - half, 0), hi = min(t + half, Tlen); for (int j = lo; j < hi; ++j) POOL_ACC(j, +); }
#pragma unroll
            for (int i = 0; i < 4; ++i) {
                if (i > 0) { if (t + half - 1 < Tlen) POOL_ACC(t + half - 1, +); if (t - half - 1 >= 0) POOL_ACC(t - half - 1, -); }
                const int lo = max(t - half, 0), hi = min(t + half, Tlen);
                const float inv = __builtin_amdgcn_rcpf((float)(hi - lo));
                const u32x4 w = T[(t - t0 + 8) * 64 + ch];
                u32x4 o; o.x = cvtpk(a[0] * inv - bflo(w.x), a[1] * inv - bfhi(w.x)); o.y = cvtpk(a[2] * inv - bflo(w.y), a[3] * inv - bfhi(w.y));
                o.z = cvtpk(a[4] * inv - bflo(w.z), a[5] * inv - bfhi(w.z)); o.w = cvtpk(a[6] * inv - bflo(w.w), a[7] * inv - bfhi(w.w));
                *(u32x4*)(MIX + (size_t)(r0 + (t - t0)) * DM + 512 + ch * 8) = o;
                ++t;
            }
#undef POOL_ACC
        }
        asm volatile("s_waitcnt lgkmcnt(0)\n\ts_barrier" ::: "memory");
    }
#undef POOL_LOAD
    asm volatile("s_waitcnt vmcnt(0)" ::: "memory");
    __syncthreads();
}
__device__ __forceinline__ void pool_phase(const Frame& F) { pool_run(F, F.vcu, F.G, (M / 32 + F.G - 1 - F.vcu) / F.G); }
__device__ __forceinline__ void pool_phase_dyn(const Frame& F) {
    constexpr int KB = 3, NB = M / 32 / KB;
    volatile LAS unsigned* tk = (volatile LAS unsigned*)(F.lds + (131072 + 320 + 160));
    unsigned* q = (unsigned*)(F.ws + WS_CTL) + 13000;
    __syncthreads();
    if (F.tid == 0) *tk = __hip_atomic_fetch_add(q, 1u, __ATOMIC_RELAXED, __HIP_MEMORY_SCOPE_AGENT);
    __syncthreads();
    unsigned bt = (unsigned)__builtin_amdgcn_readfirstlane((int)*tk);
#pragma unroll 1
    while (bt < (unsigned)NB) {
        unsigned nv = 0u; if (F.tid == 0) nv = __hip_atomic_fetch_add(q, 1u, __ATOMIC_RELAXED, __HIP_MEMORY_SCOPE_AGENT);
        pool_run(F, (int)bt * KB, 1, KB);
        if (F.tid == 0) *tk = nv;
        __syncthreads();
        bt = (unsigned)__builtin_amdgcn_readfirstlane((int)*tk);
    }
}
__device__ __forceinline__ void final_phase(const Frame& F, const float* src, float* out, const float* g) {
    const int gw = F.vcu * NWAVES + F.wave, NGW = F.G * NWAVES; const f32x4* gr = (const f32x4*)g + F.lane;
    for (int m = gw; m < M; m += NGW) {
        const f32x4* xs = (const f32x4*)(src + (size_t)m * DM) + F.lane; f32x4* xr = (f32x4*)(out + (size_t)m * DM) + F.lane; f32x4 v[4]; float s = 0.f;
#pragma unroll
        for (int j = 0; j < 4; ++j) { v[j] = xs[64 * j]; s += (v[j].x * v[j].x + v[j].y * v[j].y) + (v[j].z * v[j].z + v[j].w * v[j].w); }
        const float rstd = 1.0f / sqrtf(wave_sum(s) * (1.f / DM) + EPS);
#pragma unroll
        for (int j = 0; j < 4; ++j) xr[64 * j] = v[j] * rstd * gr[64 * j];
    }
}


constexpr int CW_BAR = 4096;
constexpr int LDSCTL_OFF = 131072, MISC_OFF = LDSCTL_OFF + 320;
#define XB_TMO      128
#define XB_XCNT(j)  (256  + 64 * (j))
#define XB_XSUB(j)  (1280 + 64 * (j))
#define XB_XGEN(j)  (2304 + 64 * (j))
#define XB_TOP      3328
#define XB_TOPGEN   3392
#define XCD_BAR_WORDS 3456
#define XB_SPIN_CAP (1u << 20)
__device__ __forceinline__ unsigned xb_ld(unsigned* p)              { return __hip_atomic_load(p, __ATOMIC_RELAXED, __HIP_MEMORY_SCOPE_AGENT); }
__device__ __forceinline__ unsigned xb_add(unsigned* p, unsigned v) { return __hip_atomic_fetch_add(p, v, __ATOMIC_RELAXED, __HIP_MEMORY_SCOPE_AGENT); }
__device__ __forceinline__ unsigned xb_xcc_id() { return (unsigned)__builtin_amdgcn_s_getreg((3 << 11) | 20) & 0xFu; }
#define XB_SPIN(cond, bar) do { unsigned _sp = 0; while (cond) { __builtin_amdgcn_s_sleep(1); \
    if ((++_sp & 255u) == 0u) { if (xb_ld(&(bar)[XB_TMO])) break; if (_sp > XB_SPIN_CAP) { atomicAdd(&(bar)[XB_TMO], 1u); break; } } } } while (0)
struct XcdBarrier { unsigned* bar; unsigned x; volatile LAS unsigned* st; };
__device__ __forceinline__ XcdBarrier xcd_barrier_post(unsigned* bar, volatile LAS unsigned* st) {
    XcdBarrier b; b.bar = bar; b.x = xb_xcc_id(); b.st = st;
    if (threadIdx.x == 0) (void)xb_add(&bar[XB_XCNT(b.x)], 1u);
    return b;
}
__device__ __forceinline__ void xcd_barrier_complete(unsigned* bar, unsigned x, unsigned& nloc, unsigned& nx) {
    const unsigned G = gridDim.x * gridDim.y * gridDim.z;
    unsigned sum, cnt, mine, sp = 0u;
    for (;;) {
        sum = 0u; cnt = 0u; mine = 0u;
#pragma unroll
        for (unsigned j = 0; j < 16; ++j) { const unsigned c = xb_ld(&bar[XB_XCNT(j)]); sum += c; cnt += (c > 0u) ? 1u : 0u; mine = (j == x) ? c : mine; }
        if (sum == G) break;
        __builtin_amdgcn_s_sleep(1);
        if ((++sp & 255u) == 0u) { if (xb_ld(&bar[XB_TMO])) break; if (sp > XB_SPIN_CAP) { atomicAdd(&bar[XB_TMO], 1u); break; } }
    }
    nloc = mine > 0u ? mine : 1u; nx = cnt > 0u ? cnt : 1u;
}
__device__ __forceinline__ void xcd_barrier(const XcdBarrier& b) {
    asm volatile("s_waitcnt vmcnt(0)" ::: "memory");
    __syncthreads();
    if (threadIdx.x == 0) {
        unsigned* bar = b.bar;
        __builtin_amdgcn_s_waitcnt(0);
        unsigned nloc = b.st[0], nx = b.st[1];
        if (nloc == 0u) { xcd_barrier_complete(bar, b.x, nloc, nx); b.st[0] = nloc; b.st[1] = nx; }
        const unsigned old = xb_add(&bar[XB_XSUB(b.x)], 1u);
        const unsigned gen = old / nloc;
        if (old + 1u == (gen + 1u) * nloc) {
            __builtin_amdgcn_fence(__ATOMIC_RELEASE, "agent");
            asm volatile("s_waitcnt vmcnt(0)" ::: "memory");
            const unsigned og = xb_add(&bar[XB_TOP], 1u);
            const unsigned tg = og / nx;
            if (og + 1u == (tg + 1u) * nx) xb_add(&bar[XB_TOPGEN], 1u);
            else XB_SPIN(xb_ld(&bar[XB_TOPGEN]) == tg, bar);
            __builtin_amdgcn_fence(__ATOMIC_ACQUIRE, "agent");
            xb_add(&bar[XB_XGEN(b.x)], 1u);
            asm volatile("s_waitcnt vmcnt(0)" ::: "memory");
        } else {
            XB_SPIN(xb_ld(&bar[XB_XGEN(b.x)]) == gen, bar);
            __builtin_amdgcn_fence(__ATOMIC_ACQUIRE, "agent");
            asm volatile("s_waitcnt vmcnt(0)" ::: "memory");
        }
    }
    __syncthreads();
}


template <class E>
__device__ __forceinline__ void fgemm(const Frame& F, const bf16* A, const bf16* Bt, int Mrows, int N, int K, int row0, const E& e) {
    pg8::Gemm g{A, Bt, Mrows, N, K}; pg8::StaticOrder S; S.init(Mrows, N, F.G, (int)blockIdx.x);
    pg8::EpiAdapt<E> EA{e, row0};
    pg8::gemm_phase<pg8::EpiAdapt<E>, pg8::StaticOrder, true, true>(F.lds, g, S, EA);
}

constexpr int CW_GRP = 8192;
constexpr int CW_GRP_TMO = 8192 + 64 * 64;
__device__ __forceinline__ void group_sync(unsigned* cnt, unsigned target, unsigned* tmo, bool light) {
    asm volatile("s_waitcnt vmcnt(0)" ::: "memory");
    __syncthreads();
    if (threadIdx.x == 0) {
        if (!light) __builtin_amdgcn_fence(__ATOMIC_RELEASE, "agent");
        asm volatile("s_waitcnt vmcnt(0)" ::: "memory");
        (void)xb_add(cnt, 1u);
        unsigned sp = 0u;
        while (xb_ld(cnt) < target) { __builtin_amdgcn_s_sleep(1); if (++sp > (1u << 21)) { atomicAdd(tmo, 1u); break; } }
        __builtin_amdgcn_fence(__ATOMIC_ACQUIRE, "agent");
        asm volatile("s_waitcnt vmcnt(0)" ::: "memory");
    }
    __syncthreads();
}
__device__ __forceinline__ f32x4 ld_bf16x4(const bf16* p) { const u32x2 w = *(const u32x2*)p; return (f32x4){bflo(w.x), bfhi(w.x), bflo(w.y), bfhi(w.y)}; }
__device__ __forceinline__ float ssq8(f32x4 a, f32x4 b) { return ((a[0] * a[0] + a[1] * a[1]) + (a[2] * a[2] + a[3] * a[3])) + ((b[0] * b[0] + b[1] * b[1]) + (b[2] * b[2] + b[3] * b[3])); }
struct EpiResA {
    static constexpr bool NOFENCE = true;
    bf16* HB; float* SS;
    __device__ __forceinline__ void tile(pg8::f32x4 (&acc)[2][2][4][2], int mrow, int c0, int fq) const {
        u32x4 x[2][4][2];
#pragma unroll
        for (int ai = 0; ai < 2; ++ai)
#pragma unroll
            for (int m = 0; m < 4; ++m)
#pragma unroll
                for (int h = 0; h < 2; ++h) x[ai][m][h] = *(const u32x4*)(HB + (size_t)(mrow + 128 * ai + 16 * m) * DM + c0 + 8 * fq + 32 * h);
        asm volatile("" ::: "memory");
#pragma unroll
        for (int ai = 0; ai < 2; ++ai)
#pragma unroll
            for (int m = 0; m < 4; ++m) { const int r = mrow + 128 * ai + 16 * m; bf16* hb = HB + (size_t)r * DM + c0 + 8 * fq; float ss = 0.f;
                u32x4 P[2];
#pragma unroll
                for (int h = 0; h < 2; ++h) { const u32x4 w = x[ai][m][h];
                    const f32x4 h0 = (f32x4){bflo(w.x), bfhi(w.x), bflo(w.y), bfhi(w.y)} + acc[ai][h][m][0], h1 = (f32x4){bflo(w.z), bfhi(w.z), bflo(w.w), bfhi(w.w)} + acc[ai][h][m][1];
                    P[h] = pk_bf16x8(h0, h1); ss += ssq8(h0, h1); }
                st_lines_bf16(hb, 8L * DM, P[0], P[1], (r & 8) != 0);
                ss = quad_sum(ss);
                if (fq == 0) SS[(size_t)r * 16 + (c0 >> 6)] = ss; }
    }
    __device__ __forceinline__ void seg64(int m, int c0, f32x4 (&v)[4], int fq) const {
        bf16* hb = HB + (size_t)m * DM + c0 + 8 * fq; float ss = 0.f;
#pragma unroll
        for (int h = 0; h < 2; ++h) { f32x4 h0, h1; ld_bf16x8(hb + 32 * h, h0, h1); h0 = h0 + v[2 * h]; h1 = h1 + v[2 * h + 1]; st_bf16x8(hb + 32 * h, h0, h1); ss += ssq8(h0, h1); }
        ss = quad_sum(ss);
        if (fq == 0) SS[(size_t)m * 16 + (c0 >> 6)] = ss;
    }
};
typedef EpiResA EpiResC;
template <int V = 0> struct EpiUpPT {
    bf16* HM; const LAS float* rs; int row0;
    __device__ __forceinline__ void seg64(int m, int c0, f32x4 (&v)[4], int fq) const {
        if (V == 2) { asm volatile("" :: "v"(v[0]), "v"(v[1]), "v"(v[2]), "v"(v[3])); return; }
        const float rstd = rs[m - row0];
        bf16* d = HM + (size_t)(m - row0) * DFF + c0 + 8 * fq;
        u32x4 P[2];
#pragma unroll
        for (int h = 0; h < 2; ++h) { f32x4 a = v[2 * h] * rstd, b = v[2 * h + 1] * rstd;
#pragma unroll
            for (int j = 0; j < 4; ++j) { const float r = fmaxf(a[j], 0.f), q = fmaxf(b[j], 0.f); a[j] = r * r; b[j] = q * q; }
            P[h] = pk_bf16x8(a, b); }
        if (V == 1) { asm volatile("" :: "v"(P[0]), "v"(P[1])); } else st_lines_bf16(d, 8L * DFF, P[0], P[1], (m & 8) != 0);
    }
};
typedef EpiUpPT<0> EpiUpP;
struct EpiBfP {
    bf16* O; int ld;
    __device__ __forceinline__ void seg64(int m, int c0, f32x4 (&v)[4], int fq) const {
        bf16* d = O + (size_t)m * ld + c0 + 8 * fq;
        st_bf16x8(d, v[0], v[1]); st_bf16x8(d + 32, v[2], v[3]);
    }
};
namespace pg8 {
struct EpiGateFinal {
    static constexpr bool PERM = true, AFTER_DRAIN = true;
    const bf16* HB; const bf16* PP; const float* SS2; float* SS3; float* out; const float* fg; unsigned* cnt; unsigned target; unsigned* tmo; int row0; bool light;
    __device__ __forceinline__ void fused(f32x4 (&acc)[2][2][4][2], const Unit& u, int wr, int wc, int fr, int fq, PG8_LAS unsigned char* lds, int wid, int lane) const {
        const int c0 = u.pn * BM + wc * 64;
#pragma unroll
        for (int ai = 0; ai < 2; ++ai)
#pragma unroll
            for (int m = 0; m < 4; ++m) {
                const int row = row0 + ai * HALF + wr * 64 + m * 16 + fr;
                const float rstd = ((const PG8_LAS float*)(lds + RSTD_OFF))[row - row0], nrl = -1.4426950408889634f * rstd;
                const bf16* hb = HB + (size_t)row * DM + c0 + 8 * fq; const bf16* pp = PP + (size_t)row * DM + c0 + 8 * fq; float ss = 0.f;
#pragma unroll
                for (int bj = 0; bj < 2; ++bj) { ::f32x4 hv[2], pv[2]; ld_bf16x8(hb + 32 * bj, hv[0], hv[1]); ld_bf16x8(pp + 32 * bj, pv[0], pv[1]);
#pragma unroll
                    for (int n = 0; n < 2; ++n) { const ::f32x4 a = acc[ai][bj][m][n]; ::f32x4 h;
#pragma unroll
                        for (int e = 0; e < 4; ++e) h[e] = hv[n][e] + pv[n][e] * __builtin_amdgcn_rcpf(1.0f + __builtin_amdgcn_exp2f(a[e] * nrl));
                        acc[ai][bj][m][n] = h; ss += (h[0] * h[0] + h[1] * h[1]) + (h[2] * h[2] + h[3] * h[3]); } }
                ss = quad_sum(ss);
                if (fq == 0) SS3[(size_t)row * 16 + (c0 >> 6)] = ss;
                if (m & 1) asm volatile("" ::: "memory");
            }
        group_sync(cnt, target, tmo, light);
        if (threadIdx.x < 256) ((PG8_LAS float*)(lds + RSTD_OFF))[threadIdx.x] = rstd_from_ss(SS3 + (size_t)(row0 + threadIdx.x) * 16);
        __syncthreads();
#pragma unroll
        for (int ai = 0; ai < 2; ++ai)
#pragma unroll
            for (int m = 0; m < 4; ++m) {
                const int row = row0 + ai * HALF + wr * 64 + m * 16 + fr;
                const float rstd = ((const PG8_LAS float*)(lds + RSTD_OFF))[row - row0];
                float* o = out + (size_t)row * DM + c0 + 8 * fq; const float* g = fg + c0 + 8 * fq;
#pragma unroll
                for (int bj = 0; bj < 2; ++bj)
                    st_lines_f32(o + 32 * bj, 8L * DM, acc[ai][bj][m][0] * rstd * *(const ::f32x4*)(g + 32 * bj), acc[ai][bj][m][1] * rstd * *(const ::f32x4*)(g + 32 * bj + 4), (row & 8) != 0);
                if (m & 1) asm volatile("" ::: "memory");
            }
    }
};
struct ListOrder {
    int pn0, n;
    __device__ __forceinline__ bool next(int i, Unit& u) const { if (i >= n) return false; u.pm = 0; u.pn = pn0 + i; return true; }
    __device__ __forceinline__ void a_ready(const Unit&) const {}
    __device__ __forceinline__ void done(const Unit&) const {}
};
}
template <class E>
__device__ __forceinline__ void lgemm(const Frame& F, const bf16* A, const bf16* Bt, int N, int K, int row0, int pn0, int n, const E& e) {
    pg8::Gemm g{A, Bt, 256, N, K}; pg8::ListOrder S{pn0, n};
    pg8::EpiAdapt<E, true> EA{e, row0};
    pg8::gemm_phase<pg8::EpiAdapt<E, true>, pg8::ListOrder, true, true>(F.lds, g, S, EA);
}
namespace pg8 {
struct PanelOrder {
    int gidx, pn;
    __device__ __forceinline__ bool next(int i, Unit& u) const { if (i >= 3) return false; u.pm = i * 64 + gidx; u.pn = pn; return true; }
    __device__ __forceinline__ void a_ready(const Unit&) const {}
    __device__ __forceinline__ void done(const Unit&) const {}
};
}
template <class E>
__device__ __forceinline__ void lgemm3(const Frame& F, const bf16* A, const bf16* Bt, int N, int K, int gidx, int pn, const E& e) {
    pg8::Gemm g{A, Bt, M, N, K}; pg8::PanelOrder S{gidx, pn};
    pg8::EpiAdapt<E, true> EA{e, 0};
    pg8::gemm_phase<pg8::EpiAdapt<E, true>, pg8::PanelOrder, true, true>(F.lds, g, S, EA);
}
__device__ __forceinline__ void tail_phase(const Frame& F, const Args& args, bool early) {
    const int gidx = F.vcu >> 2, mem = F.vcu & 3;
    unsigned nsync = 0u;
    bool light = false;
    if (early && F.tid == 0) { const unsigned m_ = xb_ld((unsigned*)(F.ws + WS_CTL) + CW_GRP + 64 * gidx + 1); light = TAIL_LIGHT && (m_ != 0u) && ((m_ & (m_ - 1u)) == 0u); }
    if (TAIL_STAGGER_TICKS > 0) {
        const unsigned long long t0 = __builtin_amdgcn_s_memrealtime(), dt = (unsigned long long)((gidx & 7) * TAIL_STAGGER_TICKS);
        while (__builtin_amdgcn_s_memrealtime() - t0 < dt) __builtin_amdgcn_s_sleep(8);
    }
    const bool late_p = TAIL_SPLIT_P && (gidx & 1);
    { unsigned char* ws = F.ws; asm volatile("" : "+s"(ws));
      { EpiResA E{(bf16*)(ws + WS_XN), (float*)(ws + WS_SS1)}; lgemm3(F, (const bf16*)(ws + WS_MIX), (const bf16*)(ws + WS_WOUT), DM, DM, gidx, mem, E); }
      if (!late_p) { EpiBfP E{(bf16*)(ws + WS_PP), DM}; lgemm3(F, (const bf16*)(ws + WS_PB), (const bf16*)(ws + WS_WPROJ), DM, PLE, gidx, mem, E); }
      unsigned* cnt = (unsigned*)(ws + WS_CTL) + CW_GRP + 64 * gidx; unsigned* tmo = (unsigned*)(ws + WS_CTL) + CW_GRP_TMO;
      group_sync(cnt, 4u * (++nsync), tmo, light);
      if (!early && F.tid == 0) { const unsigned m_ = xb_ld((unsigned*)(ws + WS_CTL) + CW_GRP + 64 * gidx + 1); light = TAIL_LIGHT && (m_ != 0u) && ((m_ & (m_ - 1u)) == 0u); } }
#pragma unroll 1
    for (int c = 0; c < 3; ++c) {
        unsigned char* ws = F.ws; asm volatile("" : "+s"(ws));
        bf16* HB = (bf16*)(ws + WS_XN); const bf16* PP = (const bf16*)(ws + WS_PP);
        float* SS1 = (float*)(ws + WS_SS1); float* SS2 = (float*)(ws + WS_SS2);
        bf16* HMg = (bf16*)(ws + WS_HM) + (size_t)gidx * 256 * DFF;
        unsigned* cnt = (unsigned*)(ws + WS_CTL) + CW_GRP + 64 * gidx; unsigned* tmo = (unsigned*)(ws + WS_CTL) + CW_GRP_TMO;
        const LAS float* rs = (const LAS float*)(F.lds + RSTD_OFF);
        const int row0 = (c * 64 + gidx) * 256;
        rstd_table(F, SS1, row0);
        { EpiUpP E{HMg, rs, row0}; lgemm(F, HB + (size_t)row0 * DM, (const bf16*)(ws + WS_WUP), DFF, DM, row0, 4 * mem, 4, E); }
        group_sync(cnt, 4u * (++nsync), tmo, light);
        { EpiResC E{HB, SS2}; lgemm(F, HMg, (const bf16*)(ws + WS_WDOWN), DM, DFF, row0, mem, 1, E); }
        group_sync(cnt, 4u * (++nsync), tmo, light);
        if (late_p && c == 0) { EpiBfP E{(bf16*)(ws + WS_PP), DM}; lgemm3(F, (const bf16*)(ws + WS_PB), (const bf16*)(ws + WS_WPROJ), DM, PLE, gidx, mem, E); }
        rstd_table(F, SS2, row0);
        { pg8::Gemm g{HB + (size_t)row0 * DM, (const bf16*)(ws + WS_WGATE), 256, DM, DM}; pg8::ListOrder S{mem, 1};
          pg8::EpiGateFinal E{HB, PP, SS2, SS1, args.out, args.in[17], cnt, 4u * (++nsync), tmo, row0, light};
          pg8::gemm_phase<pg8::EpiGateFinal, pg8::ListOrder, false, true>(F.lds, g, S, E); }
    }
}

constexpr int NPHASE = 4;
__global__ void __launch_bounds__(NWAVES * 64, 2) fwd_kernel(Args args) {
    extern __shared__ __attribute__((aligned(16))) unsigned char lds[];
    Frame F;
    F.lds = (LAS unsigned char*)lds; F.tid = threadIdx.x; F.lane = F.tid & 63; F.wave = __builtin_amdgcn_readfirstlane(F.tid >> 6);
    F.G = gridDim.x; { const int bx = blockIdx.x; F.vcu = (F.G % 8 == 0) ? (bx % 8) * (F.G / 8) + bx / 8 : bx; }
    F.ws = args.ws;
    unsigned char* ws = args.ws;
    for (int u = F.tid; u < (LDS_BYTES - LDSCTL_OFF) / 4; u += NWAVES * 64) ((LAS unsigned*)(F.lds + LDSCTL_OFF))[u] = 0u;
    __syncthreads();
    if (F.tid == 0) (void)__hip_atomic_fetch_or((unsigned*)(ws + WS_CTL) + CW_GRP + 64 * (F.vcu >> 2) + 1, 1u << xb_xcc_id(), __ATOMIC_RELAXED, __HIP_MEMORY_SCOPE_AGENT);
    XcdBarrier bar; bar.bar = (unsigned*)(ws + WS_CTL) + CW_BAR; bar.x = 0; bar.st = nullptr;
    if (args.ph_hi - args.ph_lo > 1) bar = xcd_barrier_post((unsigned*)(ws + WS_CTL) + CW_BAR, (volatile LAS unsigned*)(F.lds + MISC_OFF) + 8);
    bf16* XN = (bf16*)(ws + WS_XN); bf16* PP = (bf16*)(ws + WS_PP); bf16* MIX = (bf16*)(ws + WS_MIX); bf16* HM = (bf16*)(ws + WS_HM);
    float* SS1 = (float*)(ws + WS_SS1); float* SS2 = (float*)(ws + WS_SS2);
    const int lo = args.ph_lo, hi = args.ph_hi;
#define IN(k) (lo <= (k) && (k) < hi)
#define SEAM(k) do { if (IN(k) && IN((k) + 1)) xcd_barrier(bar); } while (0)
#define NREP(k) ((PROBE_REPEAT == (k)) ? 2 : 1)
#define REPBAR() do { if (rep) xcd_barrier(bar); } while (0)
    float* const dry = (float*)(ws + WS_HM);
    if (IN(0)) p0_prologue(F, args);
    SEAM(0);
    if (IN(1)) {
        EpiIn E{(bf16*)(ws + WS_Q), (bf16*)(ws + WS_K), (bf16*)(ws + WS_V), (bf16*)(ws + WS_U), args.in[6], args.in[7], (const float2*)(ws + WS_ROPE), (const float*)(ws + WS_RSX)};
        fgemm(F, XN, (const bf16*)(ws + WS_WIN), M, INW, DM, 0, E);
    } SEAM(1);
    unsigned long long pc_t0 = 0, pc_r0 = 0;
    if (PROBE_CLOCK == 2) { pc_t0 = __builtin_amdgcn_s_memtime(); pc_r0 = __builtin_amdgcn_s_memrealtime(); }
    if (IN(2)) {
        const attn_body::AttnTensors AT{(const attn_body::bf16*)(ws + WS_Q), (const attn_body::bf16*)(ws + WS_K), (const attn_body::bf16*)(ws + WS_V), (attn_body::bf16*)MIX};
        if (!POOL_DYNAMIC)
#pragma unroll 1
        for (int rep = 0; rep < NREP(12); ++rep) { REPBAR(); pool_phase(F); }
#pragma unroll 1
        for (int rep = 0; rep < NREP(2); ++rep) { REPBAR(); if (ATTN_U3) { if (rep == 0) attn_body::attn_phase3<0>((char*)lds, AT, F.vcu, F.G); else attn_body::attn_phase3<PROBE_AVAR>((char*)lds, AT, F.vcu, F.G); } else attn_body::attn_phase<8>((char*)lds, AT, F.vcu, F.G); }
        if (POOL_DYNAMIC) pool_phase_dyn(F);
    }
#define PC_SPIN() do { const unsigned long long t1_ = __builtin_amdgcn_s_memtime(), r1_ = __builtin_amdgcn_s_memrealtime(); const unsigned long long mhz_ = (t1_ - pc_t0) * 100ull / (r1_ - pc_r0); \
        if (blockIdx.x == 0) { const unsigned long long e_ = r1_ + mhz_ * 10ull; while (__builtin_amdgcn_s_memrealtime() < e_) __builtin_amdgcn_s_sleep(8); } } while (0)
    if (PROBE_CLOCK == 2) PC_SPIN();
    SEAM(2);
    if (PROBE_CLOCK == 3) { pc_t0 = __builtin_amdgcn_s_memtime(); pc_r0 = __builtin_amdgcn_s_memrealtime(); }
    if (IN(3)) tail_phase(F, args, lo < 3);
    if (PROBE_CLOCK == 3) PC_SPIN();
#undef PC_SPIN
#undef NREP
#undef REPBAR
#undef IN
#undef SEAM
}

extern "C" void kernel_launch(void* const* d_in, const int* in_sizes, int n_in, void* d_out, int out_size, void* d_ws, size_t ws_size, hipStream_t stream) {
    static int grid = 0;
    if (grid == 0) {
        if (n_in != 18 || out_size != M * DM || ws_size < WS_END) { fprintf(stderr, "kernel_launch: unexpected shapes (n_in %d out %d ws %zu)\n", n_in, out_size, ws_size); grid = -1; return; }
        if (hipFuncSetAttribute((const void*)fwd_kernel, hipFuncAttributeMaxDynamicSharedMemorySize, LDS_BYTES) != hipSuccess) { fprintf(stderr, "kernel_launch: hipFuncSetAttribute failed\n"); grid = -1; return; }
        int dev = 0, cus = 0; (void)hipGetDevice(&dev); (void)hipDeviceGetAttribute(&cus, hipDeviceAttributeMultiprocessorCount, dev);
        int per_cu = 0;
        if (hipOccupancyMaxActiveBlocksPerMultiprocessor(&per_cu, (const void*)fwd_kernel, NWAVES * 64, LDS_BYTES) != hipSuccess || per_cu < 1) { fprintf(stderr, "kernel_launch: occupancy query admits %d workgroups per CU; nothing launched\n", per_cu); (void)hipGetLastError(); grid = -1; return; }
        if (cus != 256) { fprintf(stderr, "kernel_launch: built for 256 CUs (64 groups of 4 workgroups in the tail), device has %d; nothing launched\n", cus); grid = -1; return; }
        grid = cus;
    }
    if (grid < 0) return;
    Args a{};
    for (int i = 0; i < 18; ++i) a.in[i] = (const float*)d_in[i];
    a.out = (float*)d_out; a.ws = (unsigned char*)d_ws;
#if MK_ONE_LAUNCH
    if (hipMemsetAsync((char*)d_ws + WS_CTL, 0, 65536, stream) != hipSuccess) { fprintf(stderr, "kernel_launch: memset failed\n"); return; }
    a.ph_lo = 0; a.ph_hi = NPHASE; hipLaunchKernelGGL(fwd_kernel, dim3(grid), dim3(NWAVES * 64), LDS_BYTES, stream, a);
#else
    for (int ph = 0; ph < NPHASE; ++ph) { a.ph_lo = ph; a.ph_hi = ph + 1; hipLaunchKernelGGL(fwd_kernel, dim3(grid), dim3(NWAVES * 64), LDS_BYTES, stream, a); }
#endif
}
```
